# Optimizing an MI355X kernel written in HIP

```python
import math
import jax, jax.numpy as jnp
from jax import lax
import numpy as np

D_MODEL = 1024
BATCH = 8
SEQ = 2048
DEPTH = 2
DEC_BATCH = 128
DEC_SEQ = 1
PAST_LEN = 16384
PAGE_SIZE = 128

N_EVEN = (DEPTH + 1) // 2
N_ODD = DEPTH // 2
RMS_EPS = 1e-6
NORM_EPS = 1e-5

RET_HEADS = 4
RET_DK = D_MODEL // RET_HEADS // 2
RET_DV = D_MODEL // RET_HEADS
RET_QK_WIDTH = RET_HEADS * RET_DK
RET_V_WIDTH = RET_HEADS * RET_DV
RET_CHUNK = 128
ROPE_BASE = 10000.0

S5_GROUP = 16
S5_WIDTH = D_MODEL
S5_GROUPS = S5_WIDTH // S5_GROUP
S5_STATE = 64
S5_DT_MIN = 1e-3
S5_DT_MAX = 1e-1

HG_HEAD_DIM = 128
HG_WIDTH = D_MODEL
HG_HEADS = HG_WIDTH // HG_HEAD_DIM
HG_CHUNK = 64

MIX0_WIDTH = RET_V_WIDTH + S5_WIDTH
IN0_WIDTH = 2 * RET_QK_WIDTH + 2 * RET_V_WIDTH + 2 * S5_WIDTH
SPLIT0 = (RET_QK_WIDTH, 2 * RET_QK_WIDTH, 2 * RET_QK_WIDTH + RET_V_WIDTH,
          2 * RET_QK_WIDTH + 2 * RET_V_WIDTH, 2 * RET_QK_WIDTH + 2 * RET_V_WIDTH + S5_WIDTH)
IN1_WIDTH = 4 * HG_WIDTH

kernel_name = "retnet_s5_hgrn2_hybrid_step"


def rms_norm(x, w):
    x32 = x.astype(jnp.float32)
    y = x32 * lax.rsqrt(jnp.mean(x32 * x32, axis=-1, keepdims=True) + RMS_EPS)
    return y.astype(x.dtype) * w


def head_group_norm(o, w):
    mu = jnp.mean(o, axis=-1, keepdims=True)
    c = o - mu
    y = c * lax.rsqrt(jnp.mean(c * c, axis=-1, keepdims=True) + NORM_EPS)
    return y.reshape(o.shape[0], o.shape[1], -1) * w.astype(jnp.float32)


def head_rms_norm(o, w):
    y = o * lax.rsqrt(jnp.mean(o * o, axis=-1, keepdims=True) + RMS_EPS)
    return y.reshape(o.shape[0], o.shape[1], -1) * w.astype(jnp.float32)


def rotary(x, pos):
    half = x.shape[-1] // 2
    inv = ROPE_BASE ** (-jnp.arange(half, dtype=jnp.float32) / half)
    ang = pos.astype(jnp.float32)[:, None] * inv[None, :]
    cos = jnp.cos(ang)[None, :, None, :]
    sin = jnp.sin(ang)[None, :, None, :]
    x1, x2 = x[..., :half], x[..., half:]
    return jnp.concatenate([x1 * cos - x2 * sin, x1 * sin + x2 * cos], axis=-1)


def retention(q, k, v, s0):
    bsz, t, nh, _ = q.shape
    dv = v.shape[-1]
    blk = math.gcd(t, RET_CHUNK)
    nblk = t // blk
    log_gamma = jnp.log1p(-jnp.exp2(-5.0 - jnp.arange(nh, dtype=jnp.float32)))
    idx = jnp.arange(blk, dtype=jnp.float32)
    diff = idx[:, None] - idx[None, :]
    decay_mask = jnp.where(diff >= 0, jnp.exp(log_gamma[:, None, None] * jnp.maximum(diff, 0.0)), 0.0)
    q_decay = jnp.exp(log_gamma[:, None] * (idx + 1.0))[:, :, None]
    k_decay = jnp.exp(log_gamma[:, None] * (blk - 1.0 - idx))[:, :, None]
    blk_decay = jnp.exp(log_gamma * blk)[:, None, None]

    def to_blocks(a):
        return a.reshape(bsz, nblk, blk, nh, a.shape[-1]).transpose(1, 0, 3, 2, 4)

    def step(s, inp):
        qb, kb, vb = inp
        scores = jnp.einsum('bhld,bhmd->bhlm', qb, kb) * decay_mask
        o = (jnp.einsum('bhlm,bhme->bhle', scores, vb)
             + jnp.einsum('bhld,bhde->bhle', qb * q_decay, s))
        s = blk_decay * s + jnp.einsum('bhld,bhle->bhde', kb * k_decay, vb)
        return s, o

    s, o = lax.scan(step, s0, (to_blocks(q), to_blocks(k), to_blocks(v)))
    o = o.transpose(1, 0, 3, 2, 4).reshape(bsz, t, nh, dv)
    return o, s


def s5_scan(u, lam_re, lam_im, log_dt, b_re, b_im, c_re, c_im, d_skip, s0_re, s0_im):
    bsz, t, w = u.shape
    f32 = jnp.float32
    lam_re = lam_re.astype(f32); lam_im = lam_im.astype(f32)
    b_re = b_re.astype(f32); b_im = b_im.astype(f32)
    c_re = c_re.astype(f32); c_im = c_im.astype(f32)
    ug = u.reshape(bsz, t, S5_GROUPS, S5_GROUP).transpose(1, 0, 2, 3)
    dt = jnp.exp(log_dt.astype(f32))[:, None]
    mag = jnp.exp(lam_re * dt)
    ang = lam_im * dt
    lb_re = mag * jnp.cos(ang)
    lb_im = mag * jnp.sin(ang)
    nr = lb_re - 1.0
    den = lam_re * lam_re + lam_im * lam_im
    fac_re = (nr * lam_re + lb_im * lam_im) / den
    fac_im = (lb_im * lam_re - nr * lam_im) / den
    bb_re = fac_re[..., None] * b_re - fac_im[..., None] * b_im
    bb_im = fac_re[..., None] * b_im + fac_im[..., None] * b_re
    x_re = jnp.einsum('tbgc,gpc->tbgp', ug, bb_re)
    x_im = jnp.einsum('tbgc,gpc->tbgp', ug, bb_im)
    s0_re = s0_re.astype(f32); s0_im = s0_im.astype(f32)
    x_re = x_re.at[0].add(lb_re * s0_re - lb_im * s0_im)
    x_im = x_im.at[0].add(lb_re * s0_im + lb_im * s0_re)
    a_re = jnp.broadcast_to(lb_re, (t, 1, S5_GROUPS, S5_STATE))
    a_im = jnp.broadcast_to(lb_im, (t, 1, S5_GROUPS, S5_STATE))

    def combine(e1, e2):
        a1r, a1i, b1r, b1i = e1
        a2r, a2i, b2r, b2i = e2
        return (a2r * a1r - a2i * a1i, a2r * a1i + a2i * a1r,
                a2r * b1r - a2i * b1i + b2r, a2r * b1i + a2i * b1r + b2i)

    _, _, h_re, h_im = lax.associative_scan(combine, (a_re, a_im, x_re, x_im), axis=0)
    y = jnp.einsum('tbgp,gcp->tbgc', h_re, c_re) - jnp.einsum('tbgp,gcp->tbgc', h_im, c_im)
    y = y.transpose(1, 0, 2, 3).reshape(bsz, t, w) + d_skip.astype(f32) * u
    return y, h_re[-1], h_im[-1]


def hgrn2_chunkwise(q, log_f, k, i, s0):
    bsz, t, nh, dk = q.shape
    blk = math.gcd(t, HG_CHUNK)
    nblk = t // blk
    causal = jnp.tril(jnp.ones((blk, blk), dtype=bool))[:, :, None]

    def to_blocks(a):
        return a.reshape(bsz, nblk, blk, nh, a.shape[-1]).transpose(1, 0, 3, 2, 4)

    def step(s, inp):
        qb, fb, kb, ib = inp
        cum = jnp.cumsum(fb, axis=2)
        rel = cum[:, :, :, None, :] - cum[:, :, None, :, :]
        wdec = jnp.exp(jnp.where(causal, rel, -jnp.inf))
        att = jnp.einsum('bhld,bhlmd,bhmd->bhlm', qb, wdec, kb)
        o = (jnp.einsum('bhlm,bhme->bhle', att, ib)
             + jnp.einsum('bhld,bhde->bhle', qb * jnp.exp(cum), s))
        last = cum[:, :, -1:, :]
        s = (jnp.exp(last[:, :, 0, :])[..., None] * s
             + jnp.einsum('bhld,bhle->bhde', kb * jnp.exp(last - cum), ib))
        return s, o

    s, o = lax.scan(step, s0, (to_blocks(q), to_blocks(log_f), to_blocks(k), to_blocks(i)))
    o = o.transpose(1, 0, 3, 2, 4).reshape(bsz, t, nh, dk)
    return o, s


def hgrn_lower_bound(p, layer):
    sm = jax.nn.softmax(p.astype(jnp.float32), axis=0)
    return (jnp.cumsum(sm, axis=0) - sm[0])[layer]


def even_mixer(h, pos, s_ret, s5_re0, s5_im0, w_in, gn_w, lam_re, lam_im, log_dt,
               b_re, b_im, c_re, c_im, d_skip, glu_w, glu_b, w_out):
    bsz, t, _ = h.shape
    f32 = jnp.float32
    z = h @ w_in
    q, k, v, g_a, u, g_b = jnp.split(z, SPLIT0, axis=-1)
    q = rotary(q.astype(f32).reshape(bsz, t, RET_HEADS, RET_DK), pos)
    k = rotary(k.astype(f32).reshape(bsz, t, RET_HEADS, RET_DK), pos) * (RET_DK ** -0.5)
    v = v.astype(f32).reshape(bsz, t, RET_HEADS, RET_DV)
    o_ret, s_ret_new = retention(q, k, v, s_ret.astype(f32))
    a_out = head_group_norm(o_ret, gn_w).astype(h.dtype) * jax.nn.silu(g_a)
    y5, s5_re_new, s5_im_new = s5_scan(u.astype(f32), lam_re, lam_im, log_dt, b_re, b_im,
                                       c_re, c_im, d_skip, s5_re0, s5_im0)
    y5 = jax.nn.gelu(y5).astype(h.dtype)
    y5 = y5 * jax.nn.sigmoid(y5 @ glu_w + glu_b)
    b_out = y5 * jax.nn.silu(g_b)
    out = jnp.concatenate([a_out, b_out], axis=-1) @ w_out
    return out, s_ret_new, s5_re_new, s5_im_new


def odd_mixer(h, s_hg, lower_bound, w_in, norm_w, w_out):
    bsz, t, _ = h.shape
    f32 = jnp.float32
    z = h @ w_in
    q, f_raw, i, g = jnp.split(z, 4, axis=-1)
    q = jax.nn.silu(q.astype(f32))
    f_gate = lower_bound + (1.0 - lower_bound) * jax.nn.sigmoid(f_raw.astype(f32))
    log_f = jnp.log(f_gate)
    k = 1.0 - f_gate
    shp = (bsz, t, HG_HEADS, HG_HEAD_DIM)
    o, s_new = hgrn2_chunkwise(q.reshape(shp), log_f.reshape(shp), k.reshape(shp),
                               i.astype(f32).reshape(shp), s_hg.astype(f32))
    o = head_rms_norm(o, norm_w).astype(h.dtype) * jax.nn.silu(g)
    return o @ w_out, s_new


def trunk(x, pos, ret_s, s5r_s, s5i_s, hg_s, weights):
    (norm_w, final_norm_w, w_in0, ret_gn_w, s5_lam_re, s5_lam_im, s5_log_dt, s5_b_re, s5_b_im,
     s5_c_re, s5_c_im, s5_d, s5_glu_w, s5_glu_b, w_out0, w_in1, hg_lower_bounds, hg_norm_w, w_out1) = weights
    new_ret, new_s5r, new_s5i, new_hg = [], [], [], []
    for layer in range(DEPTH):
        h = rms_norm(x, norm_w[layer])
        if layer % 2 == 0:
            e = layer // 2
            mix, sr, s5r, s5i = even_mixer(h, pos, ret_s[e], s5r_s[e], s5i_s[e], w_in0[e], ret_gn_w[e],
                                           s5_lam_re[e], s5_lam_im[e], s5_log_dt[e], s5_b_re[e], s5_b_im[e],
                                           s5_c_re[e], s5_c_im[e], s5_d[e], s5_glu_w[e], s5_glu_b[e], w_out0[e])
            new_ret.append(sr.astype(x.dtype))
            new_s5r.append(s5r.astype(x.dtype))
            new_s5i.append(s5i.astype(x.dtype))
        else:
            o_idx = layer // 2
            lb = hgrn_lower_bound(hg_lower_bounds, layer)
            mix, sh = odd_mixer(h, hg_s[o_idx], lb, w_in1[o_idx], hg_norm_w[o_idx], w_out1[o_idx])
            new_hg.append(sh.astype(x.dtype))
        x = x + mix
    y = rms_norm(x, final_norm_w)
    return y, jnp.stack(new_ret), jnp.stack(new_s5r), jnp.stack(new_s5i), jnp.stack(new_hg)


def setup_inputs(seed: int = 0) -> dict:
    key = jax.random.key(seed)
    ks = jax.random.split(key, 32)
    f32 = jnp.float32

    def nrm(k, shape, scale):
        return jax.random.normal(k, shape, f32) * scale

    n_idx = jnp.arange(S5_STATE, dtype=f32)
    return {
        'x_prompt': nrm(ks[0], (BATCH, SEQ, D_MODEL), 1.0),
        'x_sample': nrm(ks[1], (DEC_BATCH, DEC_SEQ, D_MODEL), 1.0),
        'state_ret': nrm(ks[2], (N_EVEN, DEC_BATCH, RET_HEADS, RET_DK, RET_DV), 0.5),
        'state_s5_re': nrm(ks[3], (N_EVEN, DEC_BATCH, S5_GROUPS, S5_STATE), 0.5),
        'state_s5_im': nrm(ks[4], (N_EVEN, DEC_BATCH, S5_GROUPS, S5_STATE), 0.5),
        'state_hgrn': nrm(ks[5], (N_ODD, DEC_BATCH, HG_HEADS, HG_HEAD_DIM, HG_HEAD_DIM), 0.5),
        'norm_w': 1.0 + nrm(ks[6], (DEPTH, D_MODEL), 0.02),
        'final_norm_w': 1.0 + nrm(ks[7], (D_MODEL,), 0.02),
        'w_in0': nrm(ks[8], (N_EVEN, D_MODEL, IN0_WIDTH), D_MODEL ** -0.5),
        'ret_gn_w': 1.0 + nrm(ks[9], (N_EVEN, RET_V_WIDTH), 0.02),
        's5_lam_re': -0.5 + nrm(ks[10], (N_EVEN, S5_GROUPS, S5_STATE), 0.01),
        's5_lam_im': math.pi * n_idx + nrm(ks[11], (N_EVEN, S5_GROUPS, S5_STATE), 0.01),
        's5_log_dt': jax.random.uniform(ks[12], (N_EVEN, S5_GROUPS), f32,
                                        math.log(S5_DT_MIN), math.log(S5_DT_MAX)),
        's5_b_re': nrm(ks[13], (N_EVEN, S5_GROUPS, S5_STATE, S5_GROUP), (2.0 * S5_GROUP) ** -0.5),
        's5_b_im': nrm(ks[14], (N_EVEN, S5_GROUPS, S5_STATE, S5_GROUP), (2.0 * S5_GROUP) ** -0.5),
        's5_c_re': nrm(ks[15], (N_EVEN, S5_GROUPS, S5_GROUP, S5_STATE), (2.0 * S5_STATE) ** -0.5),
        's5_c_im': nrm(ks[16], (N_EVEN, S5_GROUPS, S5_GROUP, S5_STATE), (2.0 * S5_STATE) ** -0.5),
        's5_d': nrm(ks[17], (N_EVEN, S5_WIDTH), 1.0),
        's5_glu_w': nrm(ks[18], (N_EVEN, S5_WIDTH, S5_WIDTH), S5_WIDTH ** -0.5),
        's5_glu_b': nrm(ks[19], (N_EVEN, S5_WIDTH), 0.02),
        'w_out0': nrm(ks[20], (N_EVEN, MIX0_WIDTH, D_MODEL), MIX0_WIDTH ** -0.5),
        'w_in1': nrm(ks[21], (N_ODD, D_MODEL, IN1_WIDTH), D_MODEL ** -0.5),
        'hg_lower_bounds': nrm(ks[22], (DEPTH, HG_WIDTH), 0.1),
        'hg_norm_w': 1.0 + nrm(ks[23], (N_ODD, HG_WIDTH), 0.02),
        'w_out1': nrm(ks[24], (N_ODD, HG_WIDTH, D_MODEL), HG_WIDTH ** -0.5),
    }


def reference(x_prompt, x_sample, state_ret, state_s5_re, state_s5_im, state_hgrn,
              norm_w, final_norm_w, w_in0, ret_gn_w, s5_lam_re, s5_lam_im, s5_log_dt,
              s5_b_re, s5_b_im, s5_c_re, s5_c_im, s5_d, s5_glu_w, s5_glu_b, w_out0,
              w_in1, hg_lower_bounds, hg_norm_w, w_out1):
    weights = (norm_w, final_norm_w, w_in0, ret_gn_w, s5_lam_re, s5_lam_im, s5_log_dt,
               s5_b_re, s5_b_im, s5_c_re, s5_c_im, s5_d, s5_glu_w, s5_glu_b, w_out0,
               w_in1, hg_lower_bounds, hg_norm_w, w_out1)
    bp, tp, _ = x_prompt.shape
    dt = x_prompt.dtype
    zero_ret = jnp.zeros((N_EVEN, bp, RET_HEADS, RET_DK, RET_DV), dt)
    zero_s5 = jnp.zeros((N_EVEN, bp, S5_GROUPS, S5_STATE), dt)
    zero_hg = jnp.zeros((N_ODD, bp, HG_HEADS, HG_HEAD_DIM, HG_HEAD_DIM), dt)
    pos_prompt = jnp.arange(tp, dtype=jnp.int32)
    y_prompt, ret_p, s5r_p, s5i_p, hg_p = trunk(x_prompt, pos_prompt, zero_ret, zero_s5, zero_s5,
                                                zero_hg, weights)
    pos_sample = PAST_LEN + jnp.arange(x_sample.shape[1], dtype=jnp.int32)
    y_sample, ret_s, s5r_s, s5i_s, hg_s = trunk(x_sample, pos_sample, state_ret, state_s5_re,
                                                state_s5_im, state_hgrn, weights)
    return (y_prompt, y_sample, ret_p, ret_s, s5r_p, s5i_p, s5r_s, s5i_s, hg_p, hg_s)
```

```cpp
#include <hip/hip_runtime.h>
#include <hip/hip_cooperative_groups.h>
#include <cstdio>
namespace cg = cooperative_groups;

#ifndef PH_MAX
#define PH_MAX 13
#endif
#ifndef COOP
#define COOP 1
#endif

typedef unsigned short bf16_t;
typedef short bf16x8 __attribute__((ext_vector_type(8)));
typedef float f32x4 __attribute__((ext_vector_type(4)));
typedef unsigned u32x4 __attribute__((ext_vector_type(4)));
typedef unsigned u32x2 __attribute__((ext_vector_type(2)));
#define LAS __attribute__((address_space(3)))
#define DEVI __device__ __forceinline__

constexpr int TT = 2048, NBP = 8, MP = 16384, MS = 128, DM = 1024;
constexpr size_t MiB = (size_t)1 << 20;
constexpr size_t O_YP = 0, O_YS = 16777216, O_RETP = 16908288, O_RETS = 17956864, O_S5RP = 34734080, O_S5IP = 34766848,
                 O_S5RS = 34799616, O_S5IS = 35323904, O_HGP = 35848192, O_HGS = 36896768;
constexpr size_t WS_WIN0T = 0, WS_BT1 = 10 * MiB, WS_KT = 18 * MiB, WS_WGLUT = 34 * MiB, WS_WOUT0T = 36 * MiB, WS_WIN1T = 40 * MiB,
                 WS_BT2 = 48 * MiB, WS_Q = 60 * MiB, WS_KN = 76 * MiB, WS_VT = 92 * MiB, WS_SGA = 124 * MiB, WS_SGB = 156 * MiB,
                 WS_A2 = 188 * MiB, WS_Y5 = 0, WS_X1B = 60 * MiB, WS_SG1 = 0, WS_Q1 = 96 * MiB, WS_CUM = 128 * MiB, WS_IT = 192 * MiB,
                 WS_HKV = 32 * MiB;
constexpr size_t WS_MISC = 240 * MiB;
constexpr size_t WS_WOUT1T = WS_MISC;
constexpr size_t WS_ROPE = WS_MISC + 2 * MiB;
constexpr size_t WS_SSQ1 = WS_ROPE + 1280 * 1024;
constexpr size_t WS_SSQ2 = WS_SSQ1 + MiB;
constexpr size_t WS_H0S = WS_SSQ2 + MiB;
constexpr size_t WS_ZS = WS_H0S + 512 * 1024;
constexpr size_t WS_Y5S = WS_ZS + 2560 * 1024;
constexpr size_t WS_MIX0S = WS_Y5S + 512 * 1024;
constexpr size_t WS_X1S = WS_MIX0S + MiB;
constexpr size_t WS_X1SB = WS_X1S + 512 * 1024;
constexpr size_t WS_Z1S = WS_X1SB + 512 * 1024;
constexpr size_t WS_O1S = WS_Z1S + 2 * MiB;
constexpr size_t WS_BBG = WS_O1S + 512 * 1024;
constexpr size_t WS_LAM1 = WS_BBG + 512 * 1024;
constexpr size_t WS_LAM16 = WS_LAM1 + 32 * 1024;
constexpr size_t WS_LB = WS_LAM16 + 32 * 1024;
constexpr size_t WS_SSQ1S = WS_LB + 4096;
constexpr size_t WS_SSQ2S = WS_SSQ1S + MiB;
constexpr size_t WS_END = WS_SSQ2S + MiB;
static_assert(WS_END <= 256 * MiB, "workspace overflow");

struct Params {
    const float *xp, *xs, *sret, *s5r, *s5i, *shg, *normw, *fnormw, *win0, *gnw, *lamre, *lamim, *logdt, *bre, *bim, *cre, *cim, *s5d,
        *gluw, *glub, *wout0, *win1, *hglb, *hgnw, *wout1;
    float* out;
    char* ws;
    int ph_lo, ph_hi;
};

DEVI bf16_t f2bf(float f) { unsigned u = __float_as_uint(f); u += 0x7FFFu + ((u >> 16) & 1u); return (bf16_t)(u >> 16); }
DEVI float bf2f(bf16_t b) { return __uint_as_float(((unsigned)b) << 16); }
DEVI unsigned pack2(float lo, float hi) { return (unsigned)f2bf(lo) | ((unsigned)f2bf(hi) << 16); }
DEVI float bflo(unsigned w) { return __uint_as_float(w << 16); }
DEVI float bfhi(unsigned w) { return __uint_as_float(w & 0xffff0000u); }
DEVI float sigm(float x) { return 1.f / (1.f + __expf(-x)); }
DEVI float silu_(float x) { return x * sigm(x); }
DEVI float gelu_(float x) { float u = 1.5957691216f * (x + 0.044715f * x * x * x); return x / (1.f + __expf(-u)); }
DEVI u32x2 pack4(f32x4 v) { u32x2 r; r.x = pack2(v[0], v[1]); r.y = pack2(v[2], v[3]); return r; }
DEVI float wave_sum(float v) {
#pragma unroll
    for (int o = 32; o > 0; o >>= 1) v += __shfl_xor(v, o);
    return v;
}
DEVI float grp16_sum(float v) { v += __shfl_xor(v, 1); v += __shfl_xor(v, 2); v += __shfl_xor(v, 4); v += __shfl_xor(v, 8); return v; }
DEVI f32x4 mfma16(bf16x8 a, bf16x8 b, f32x4 c) { return __builtin_amdgcn_mfma_f32_16x16x32_bf16(a, b, c, 0, 0, 0); }
DEVI float row_rstd16(const float* ssq, size_t row) {
    const f32x4 a = *(const f32x4*)(ssq + row * 4), b = *(const f32x4*)(ssq + (MP + row) * 4), c = *(const f32x4*)(ssq + (2 * (size_t)MP + row) * 4), d = *(const f32x4*)(ssq + (3 * (size_t)MP + row) * 4);
    float s = (a[0] + a[1] + a[2] + a[3]) + (b[0] + b[1] + b[2] + b[3]) + (c[0] + c[1] + c[2] + c[3]) + (d[0] + d[1] + d[2] + d[3]);
    return rsqrtf(s * (1.0f / 1024.0f) + 1e-6f);
}

constexpr int BM = 256, BK = 64, HALF = 128, HTB = HALF * BK * 2, NXCD = 8, WGM = 8;
DEVI int lds_byte(int r, int c) { const int st = (r >> 4) * 2 + (c >> 5), rr = r & 15, cc = c & 31, ob = rr * 64 + cc * 2; return st * 1024 + (ob ^ (((ob >> 9) & 1) << 5)); }
DEVI void stage_rc(int b, int& R, int& C) { const int st = b / 1024, sb = b % 1024, swz = sb ^ (((sb >> 9) & 1) << 5); R = (st >> 1) * 16 + swz / 64; C = (st & 1) * 32 + (swz % 64) / 2; }

enum { K_Q = 0, K_K, K_VT, K_GA, K_U, K_GB, K_SIN0, K_E5, K_Y5, K_GLU, K_SGLU, K_OUT0, K_SOUT0, K_Q1, K_F, K_IT, K_G1, K_SIN1, K_OUT1, K_SOUT1 };
enum { L_IN0 = 0, L_IN0S, L_GA, L_GB, L_GLU, L_GLUS, L_OUT0, L_OUT0S, L_IN1, L_IN1S, L_OUT1, L_OUT1S };

struct Unit { const char* a; const char* b; int kind, pm, pn; };

DEVI void static_order(int L, int nM, int nN, int& pm, int& pn) {
    const int nwg = nM * nN; int wgid = L;
    { const int q = nwg / NXCD, r = nwg % NXCD, xcd = wgid % NXCD, off = wgid / NXCD; wgid = (xcd < r ? xcd * (q + 1) : r * (q + 1) + (xcd - r) * q) + off; }
    const int nig = WGM * nN, gid = wgid / nig, fm = gid * WGM, gsz = (nM - fm) < WGM ? (nM - fm) : WGM;
    pm = fm + ((wgid % nig) % gsz); pn = (wgid % nig) / gsz;
}

struct Sched {
    int list, G, c; char* wsp; float* outp;
    DEVI bool next(int i, Unit& u) const {
        const int L = i * G + c; const char* ws = wsp;
        switch (list) {
        case L_IN0: {
            if (L >= 1280) return false; int pm, pn; static_order(L, 64, 20, pm, pn); u.pm = pm; u.pn = pn;
            const char* h0 = (const char*)(outp + O_RETS);
            if (pn >= 4 && pn < 8) { u.kind = K_VT; u.a = ws + WS_WIN0T + (size_t)(1024 + 256 * (pn - 4)) * 2048; u.b = h0 + (size_t)pm * 256 * 2048; }
            else { u.kind = pn < 2 ? K_Q : pn < 4 ? K_K : pn < 12 ? K_GA : pn < 16 ? K_U : K_GB; u.a = h0 + (size_t)pm * 256 * 2048; u.b = ws + WS_WIN0T + (size_t)pn * 256 * 2048; }
            return true; }
        case L_IN0S: if (L >= 20) return false; u.pm = 0; u.pn = L; u.kind = K_SIN0; u.a = ws + WS_H0S; u.b = ws + WS_WIN0T + (size_t)L * 256 * 2048; return true;
        case L_GA: if (L >= 256) return false; u.pm = L & 3; u.pn = L >> 2; u.kind = K_E5; u.a = ws + WS_A2 + ((size_t)(L >> 2) * 1024 + (L & 3) * 256) * 768; u.b = ws + WS_BT1 + (size_t)(L >> 2) * 256 * 512; return true;
        case L_GB: if (L >= 256) return false; u.pm = L & 3; u.pn = L >> 2; u.kind = K_Y5; u.a = ws + WS_A2 + ((size_t)(L >> 2) * 1024 + (L & 3) * 256) * 768; u.b = ws + WS_BT2 + (size_t)(L >> 2) * 256 * 768; return true;
        case L_GLU: { if (L >= 256) return false; int pm, pn; static_order(L, 64, 4, pm, pn); u.pm = pm; u.pn = pn; u.kind = K_GLU; u.a = ws + WS_Y5 + (size_t)pm * 256 * 32; u.b = ws + WS_WGLUT + (size_t)pn * 256 * 2048; return true; }
        case L_GLUS: if (L >= 4) return false; u.pm = 0; u.pn = L; u.kind = K_SGLU; u.a = ws + WS_Y5S; u.b = ws + WS_WGLUT + (size_t)L * 256 * 2048; return true;
        case L_OUT0: { if (L >= 256) return false; int pm, pn; static_order(L, 64, 4, pm, pn); u.pm = pm; u.pn = pn; u.kind = K_OUT0; u.a = (const char*)(outp + O_HGS) + (size_t)pm * 256 * 4096; u.b = ws + WS_WOUT0T + (size_t)pn * 256 * 4096; return true; }
        case L_OUT0S: if (L >= 4) return false; u.pm = 0; u.pn = L; u.kind = K_SOUT0; u.a = ws + WS_MIX0S; u.b = ws + WS_WOUT0T + (size_t)L * 256 * 4096; return true;
        case L_IN1: {
            if (L >= 1024) return false; int pm, pn; static_order(L, 64, 16, pm, pn); u.pm = pm; u.pn = pn;
            if (pn >= 8 && pn < 12) { u.kind = K_IT; u.a = ws + WS_WIN1T + (size_t)(256 * pn) * 2048; u.b = ws + WS_X1B + (size_t)pm * 256 * 2048; }
            else { u.kind = pn < 4 ? K_Q1 : pn < 8 ? K_F : K_G1; u.a = ws + WS_X1B + (size_t)pm * 256 * 2048; u.b = ws + WS_WIN1T + (size_t)pn * 256 * 2048; }
            return true; }
        case L_IN1S: if (L >= 16) return false; u.pm = 0; u.pn = L; u.kind = K_SIN1; u.a = ws + WS_X1SB; u.b = ws + WS_WIN1T + (size_t)L * 256 * 2048; return true;
        case L_OUT1: { if (L >= 256) return false; int pm, pn; static_order(L, 64, 4, pm, pn); u.pm = pm; u.pn = pn; u.kind = K_OUT1; u.a = ws + WS_Q1 + (size_t)pm * 256 * 2048; u.b = ws + WS_WOUT1T + (size_t)pn * 256 * 2048; return true; }
        case L_OUT1S: if (L >= 4) return false; u.pm = 0; u.pn = L; u.kind = K_SOUT1; u.a = ws + WS_O1S; u.b = ws + WS_WOUT1T + (size_t)L * 256 * 2048; return true;
        }
        return false;
    }
};

DEVI void epilogue(const Params& p, const f32x4 (&acc)[2][2][4][2], const Unit& u, int wr, int wc, int fr, int fq) {
    char* ws = p.ws;
    const int kind = u.kind;
    if (kind == K_Q || kind == K_K) {
        const float* rope = (const float*)(ws + WS_ROPE);
        bf16_t* dst = (bf16_t*)(ws + (kind == K_Q ? WS_Q : WS_KN));
        bf16_t* kt = (bf16_t*)(ws + WS_KT);
        const int tq = kind == K_Q ? u.pn : u.pn - 2;
        const float sc = kind == K_Q ? 1.0f : 0.08838834764831845f;
#pragma unroll
        for (int ai = 0; ai < 2; ++ai)
#pragma unroll
            for (int m = 0; m < 4; ++m) {
                const int token = u.pm * 256 + ai * 128 + wr * 64 + m * 16 + fr, pos = token & 2047;
#pragma unroll
                for (int n = 0; n < 2; ++n) {
                    const int w = wc * 32 + n * 16 + fq * 4, hl = w >> 6, j = w & 63, head = 2 * tq + hl;
                    const f32x4 cs = *(const f32x4*)(rope + pos * 128 + j), sn = *(const f32x4*)(rope + pos * 128 + 64 + j);
                    const f32x4 x1 = acc[ai][0][m][n], x2 = acc[ai][1][m][n];
                    const f32x4 y1 = (x1 * cs - x2 * sn) * sc, y2 = (x1 * sn + x2 * cs) * sc;
                    bf16_t* d = dst + (size_t)token * 512 + head * 128 + j;
                    *(u32x2*)d = pack4(y1); *(u32x2*)(d + 64) = pack4(y2);
                    if (kind == K_K) {
                        const int b = token >> 11, t = token & 2047;
                        bf16_t* kk = kt + ((size_t)(b * 4 + head) * 128 + j) * 2048 + t;
#pragma unroll
                        for (int i = 0; i < 4; ++i) { kk[(size_t)i * 2048] = f2bf(y1[i]); kk[(size_t)(64 + i) * 2048] = f2bf(y2[i]); }
                    }
                }
            }
    } else if (kind == K_VT || kind == K_IT) {
        const bool isv = kind == K_VT;
        const float* ssq = (const float*)(ws + WS_SSQ1);
        bf16_t* dst = (bf16_t*)(ws + (isv ? WS_VT : WS_IT));
#pragma unroll
        for (int bj = 0; bj < 2; ++bj)
#pragma unroll
            for (int n = 0; n < 2; ++n) {
                const int token = u.pm * 256 + bj * 128 + wc * 32 + n * 16 + fq * 4, b = token >> 11, t = token & 2047;
                f32x4 rs = {1.f, 1.f, 1.f, 1.f};
                if (!isv) { rs[0] = row_rstd16(ssq, token); rs[1] = row_rstd16(ssq, token + 1); rs[2] = row_rstd16(ssq, token + 2); rs[3] = row_rstd16(ssq, token + 3); }
#pragma unroll
                for (int ai = 0; ai < 2; ++ai)
#pragma unroll
                    for (int m = 0; m < 4; ++m) {
                        const int row = ai * 128 + wr * 64 + m * 16 + fr;
                        size_t off;
                        if (isv) off = ((size_t)(b * 4 + (u.pn - 4)) * 256 + row) * 2048 + t;
                        else { const int eg = (u.pn - 8) * 256 + row; off = ((size_t)(b * 8 + (eg >> 7)) * 128 + (eg & 127)) * 2048 + t; }
                        *(u32x2*)(dst + off) = pack4(acc[ai][bj][m][n] * rs);
                    }
            }
    } else if (kind == K_GA || kind == K_GB || kind == K_U) {
#pragma unroll
        for (int ai = 0; ai < 2; ++ai)
#pragma unroll
            for (int m = 0; m < 4; ++m) {
                const int token = u.pm * 256 + ai * 128 + wr * 64 + m * 16 + fr;
#pragma unroll
                for (int bj = 0; bj < 2; ++bj)
#pragma unroll
                    for (int n = 0; n < 2; ++n) {
                        const int cl = bj * 128 + wc * 32 + n * 16 + fq * 4;
                        f32x4 v = acc[ai][bj][m][n];
                        if (kind == K_U) {
                            const int cu = (u.pn - 12) * 256 + cl, g = cu >> 4, c = cu & 15;
                            bf16_t* d = (bf16_t*)(ws + WS_A2) + ((size_t)g * 1024 + (token >> 4)) * 384 + (token & 15) * 16 + c;
                            *(u32x2*)d = pack4(v);
                        } else {
                            v[0] = silu_(v[0]); v[1] = silu_(v[1]); v[2] = silu_(v[2]); v[3] = silu_(v[3]);
                            bf16_t* d = (bf16_t*)(ws + (kind == K_GA ? WS_SGA : WS_SGB)) + (size_t)token * 1024 + (u.pn - (kind == K_GA ? 8 : 16)) * 256 + cl;
                            *(u32x2*)d = pack4(v);
                        }
                    }
            }
    } else if (kind == K_SIN0) {
        const float* rope = (const float*)(ws + WS_ROPE) + 2048 * 128;
        float* zs = (float*)(ws + WS_ZS);
#pragma unroll
        for (int m = 0; m < 4; ++m) {
            const int row = wr * 64 + m * 16 + fr;
            if (u.pn < 4) {
                const float sc = u.pn < 2 ? 1.0f : 0.08838834764831845f;
#pragma unroll
                for (int n = 0; n < 2; ++n) {
                    const int w = wc * 32 + n * 16 + fq * 4, hl = w >> 6, j = w & 63;
                    const f32x4 cs = *(const f32x4*)(rope + j), sn = *(const f32x4*)(rope + 64 + j);
                    const f32x4 x1 = acc[0][0][m][n], x2 = acc[0][1][m][n];
                    float* d = zs + (size_t)row * 5120 + u.pn * 256 + hl * 128 + j;
                    *(f32x4*)d = (x1 * cs - x2 * sn) * sc; *(f32x4*)(d + 64) = (x1 * sn + x2 * cs) * sc;
                }
            } else {
                const bool gate = (u.pn >= 8 && u.pn < 12) || u.pn >= 16;
#pragma unroll
                for (int bj = 0; bj < 2; ++bj)
#pragma unroll
                    for (int n = 0; n < 2; ++n) {
                        f32x4 v = acc[0][bj][m][n];
                        if (gate) { v[0] = silu_(v[0]); v[1] = silu_(v[1]); v[2] = silu_(v[2]); v[3] = silu_(v[3]); }
                        *(f32x4*)(zs + (size_t)row * 5120 + u.pn * 256 + bj * 128 + wc * 32 + n * 16 + fq * 4) = v;
                    }
            }
        }
    } else if (kind == K_E5) {
        float* e5 = (float*)(p.out + O_HGS);
#pragma unroll
        for (int ai = 0; ai < 2; ++ai)
#pragma unroll
            for (int m = 0; m < 4; ++m) {
                const int row = u.pm * 256 + ai * 128 + wr * 64 + m * 16 + fr;
#pragma unroll
                for (int n = 0; n < 2; ++n) *(f32x4*)(e5 + ((size_t)u.pn * 1024 + row) * 128 + wc * 32 + n * 16 + fq * 4) = acc[ai][0][m][n];
            }
    } else if (kind == K_Y5) {
        const bf16_t* a2 = (const bf16_t*)(ws + WS_A2);
        bf16_t* y5 = (bf16_t*)(ws + WS_Y5);
        const int g = u.pn;
#pragma unroll
        for (int ai = 0; ai < 2; ++ai)
#pragma unroll
            for (int m = 0; m < 4; ++m) {
                const int row = u.pm * 256 + ai * 128 + wr * 64 + m * 16 + fr;
#pragma unroll
                for (int bj = 0; bj < 2; ++bj)
#pragma unroll
                    for (int n = 0; n < 2; ++n) {
                        const int col = bj * 128 + wc * 32 + n * 16 + fq * 4, c = col & 15;
                        const u32x2 uu = *(const u32x2*)(a2 + ((size_t)g * 1024 + row) * 384 + col);
                        const f32x4 dd = *(const f32x4*)(p.s5d + g * 16 + c);
                        f32x4 v = acc[ai][bj][m][n];
                        v[0] = gelu_(v[0] + dd[0] * bflo(uu.x)); v[1] = gelu_(v[1] + dd[1] * bfhi(uu.x));
                        v[2] = gelu_(v[2] + dd[2] * bflo(uu.y)); v[3] = gelu_(v[3] + dd[3] * bfhi(uu.y));
                        *(u32x2*)(y5 + ((size_t)g * 1024 + row) * 256 + col) = pack4(v);
                    }
            }
    } else if (kind == K_GLU || kind == K_SGLU) {
        const bool smp = kind == K_SGLU;
        const bf16_t* y5 = (const bf16_t*)(ws + (smp ? WS_Y5S : WS_Y5));
        const bf16_t* sgb = (const bf16_t*)(ws + WS_SGB);
        const float* zs = (const float*)(ws + WS_ZS);
        bf16_t* mix = smp ? (bf16_t*)(ws + WS_MIX0S) : (bf16_t*)(p.out + O_HGS);
#pragma unroll
        for (int ai = 0; ai < 2; ++ai) {
            if (smp && ai) break;
#pragma unroll
            for (int m = 0; m < 4; ++m) {
                const size_t token = (size_t)u.pm * 256 + ai * 128 + wr * 64 + m * 16 + fr;
#pragma unroll
                for (int bj = 0; bj < 2; ++bj)
#pragma unroll
                    for (int n = 0; n < 2; ++n) {
                        const int col = u.pn * 256 + bj * 128 + wc * 32 + n * 16 + fq * 4;
                        const f32x4 bb = *(const f32x4*)(p.glub + col);
                        const u32x2 yy = smp ? *(const u32x2*)(y5 + token * 1024 + col) : *(const u32x2*)(y5 + ((size_t)(col >> 4) * MP + token) * 16 + (col & 15));
                        f32x4 gg;
                        if (smp) gg = *(const f32x4*)(zs + token * 5120 + 4096 + col);
                        else { const u32x2 t = *(const u32x2*)(sgb + token * 1024 + col); gg[0] = bflo(t.x); gg[1] = bfhi(t.x); gg[2] = bflo(t.y); gg[3] = bfhi(t.y); }
                        f32x4 v = acc[ai][bj][m][n] + bb;
                        v[0] = bflo(yy.x) * sigm(v[0]) * gg[0]; v[1] = bfhi(yy.x) * sigm(v[1]) * gg[1];
                        v[2] = bflo(yy.y) * sigm(v[2]) * gg[2]; v[3] = bfhi(yy.y) * sigm(v[3]) * gg[3];
                        *(u32x2*)(mix + token * 2048 + 1024 + col) = pack4(v);
                    }
            }
        }
    } else if (kind == K_OUT0 || kind == K_SOUT0 || kind == K_OUT1 || kind == K_SOUT1) {
        const bool smp = kind == K_SOUT0 || kind == K_SOUT1, l0 = kind == K_OUT0 || kind == K_SOUT0;
        const float* res = l0 ? (smp ? p.xs : p.xp) : (smp ? (const float*)(ws + WS_X1S) : p.out + O_YP);
        float* dst = l0 ? (smp ? (float*)(ws + WS_X1S) : p.out + O_YP) : (smp ? p.out + O_YS : p.out + O_YP);
        bf16_t* dstb = (bf16_t*)(ws + (smp ? WS_X1SB : WS_X1B));
        float* ssq = (float*)(ws + (l0 ? (smp ? WS_SSQ1S : WS_SSQ1) : (smp ? WS_SSQ2S : WS_SSQ2)));
#pragma unroll
        for (int ai = 0; ai < 2; ++ai) {
            if (smp && ai) break;
#pragma unroll
            for (int m = 0; m < 4; ++m) {
                const size_t token = (size_t)u.pm * 256 + ai * 128 + wr * 64 + m * 16 + fr;
                float s = 0.f;
#pragma unroll
                for (int bj = 0; bj < 2; ++bj)
#pragma unroll
                    for (int n = 0; n < 2; ++n) {
                        const int col = u.pn * 256 + bj * 128 + wc * 32 + n * 16 + fq * 4;
                        const f32x4 v = acc[ai][bj][m][n] + *(const f32x4*)(res + token * 1024 + col);
                        *(f32x4*)(dst + token * 1024 + col) = v;
                        if (l0) *(u32x2*)(dstb + token * 1024 + col) = pack4(v);
                        s += v[0] * v[0] + v[1] * v[1] + v[2] * v[2] + v[3] * v[3];
                    }
                s += __shfl_xor(s, 16); s += __shfl_xor(s, 32);
                if (fq == 0) ssq[((size_t)u.pn * MP + token) * 4 + wc] = s;
            }
        }
    } else if (kind == K_Q1 || kind == K_F || kind == K_G1) {
        const float* ssq = (const float*)(ws + WS_SSQ1);
        const float* lb = (const float*)(ws + WS_LB);
#pragma unroll
        for (int ai = 0; ai < 2; ++ai)
#pragma unroll
            for (int m = 0; m < 4; ++m) {
                const size_t token = (size_t)u.pm * 256 + ai * 128 + wr * 64 + m * 16 + fr;
                const float r = row_rstd16(ssq, token);
#pragma unroll
                for (int bj = 0; bj < 2; ++bj)
#pragma unroll
                    for (int n = 0; n < 2; ++n) {
                        const int cl = (u.pn & 3) * 256 + bj * 128 + wc * 32 + n * 16 + fq * 4;
                        f32x4 v = acc[ai][bj][m][n] * r;
                        if (kind == K_F) {
                            const f32x4 l = *(const f32x4*)(lb + cl);
#pragma unroll
                            for (int i = 0; i < 4; ++i) v[i] = __logf(l[i] + (1.f - l[i]) * sigm(v[i]));
                            *(f32x4*)((float*)(ws + WS_CUM) + token * 1024 + cl) = v;
                        } else {
                            v[0] = silu_(v[0]); v[1] = silu_(v[1]); v[2] = silu_(v[2]); v[3] = silu_(v[3]);
                            *(u32x2*)((bf16_t*)(ws + (kind == K_Q1 ? WS_Q1 : WS_SG1)) + token * 1024 + cl) = pack4(v);
                        }
                    }
            }
    } else if (kind == K_SIN1) {
        const float* ssq = (const float*)(ws + WS_SSQ1S);
        const float* lb = (const float*)(ws + WS_LB);
        float* z1 = (float*)(ws + WS_Z1S);
#pragma unroll
        for (int m = 0; m < 4; ++m) {
            const size_t row = wr * 64 + m * 16 + fr;
            const float r = row_rstd16(ssq, row);
            const int ty = u.pn >> 2;
#pragma unroll
            for (int bj = 0; bj < 2; ++bj)
#pragma unroll
                for (int n = 0; n < 2; ++n) {
                    const int cl = (u.pn & 3) * 256 + bj * 128 + wc * 32 + n * 16 + fq * 4;
                    f32x4 v = acc[0][bj][m][n] * r;
                    if (ty == 1) { const f32x4 l = *(const f32x4*)(lb + cl);
#pragma unroll
                        for (int i = 0; i < 4; ++i) v[i] = l[i] + (1.f - l[i]) * sigm(v[i]); }
                    else if (ty != 2) { v[0] = silu_(v[0]); v[1] = silu_(v[1]); v[2] = silu_(v[2]); v[3] = silu_(v[3]); }
                    *(f32x4*)(z1 + row * 4096 + ty * 1024 + cl) = v;
                }
        }
    }
}

DEVI void gemm_phase(const int TIDX, LAS unsigned char* lds, const int K, const int lda, const int ldb, const bool ga, const Sched S, const Params& P) {
    const int tid = TIDX, wid = __builtin_amdgcn_readfirstlane(tid >> 6), lane = tid & 63, wr = wid >> 2, wc = wid & 3, fr = lane & 15, fq = lane >> 4;
    const int nt = K / BK;
    unsigned voffA[2], voffB[2];
#pragma unroll
    for (int i = 0; i < 2; ++i) { int R, C; stage_rc(tid * 16 + i * 8192, R, C); voffA[i] = ga ? (unsigned)(R * 32 + (C >> 4) * (MP * 32) + (C & 15) * 2) : (unsigned)(R * lda + C) * 2u; voffB[i] = (unsigned)(R * ldb + C) * 2u; }
    const size_t kstep = (size_t)(BK * 2), kstepA = ga ? (size_t)4 * MP * 32 : kstep;
    const size_t hstepA = ga ? (size_t)HALF * 32 : (size_t)HALF * lda * 2, hstepB = (size_t)HALF * ldb * 2;
    const unsigned ldsw = (unsigned)wid * 1024u;
    const int aoff = lds_byte(wr * 64 + fr, fq * 8), boff = lds_byte(wc * 32 + fr, fq * 8);
#define PG8_SA(b, h) (((b) * 2 + (h)) * HTB)
#define PG8_SB(b, h) ((4 + (b) * 2 + (h)) * HTB)
#define PG8_STAGE(bufoff, gbase, voff) do { _Pragma("unroll") for (int _i = 0; _i < 2; ++_i) \
        __builtin_amdgcn_global_load_lds((const unsigned*)((const char*)(gbase) + (voff)[_i]), (LAS unsigned*)(lds + (bufoff) + ldsw + _i * 8192), 16, 0, 0); } while (0)
#define PG8_LDA(dst, b, h) do { _Pragma("unroll") for (int m = 0; m < 4; ++m) _Pragma("unroll") for (int k = 0; k < 2; ++k) dst[m][k] = *(const LAS bf16x8*)(lds + PG8_SA(b, h) + aoff + m * 2048 + k * 1024); } while (0)
#define PG8_LDB(dst, b, h) do { _Pragma("unroll") for (int n = 0; n < 2; ++n) _Pragma("unroll") for (int k = 0; k < 2; ++k) dst[n][k] = *(const LAS bf16x8*)(lds + PG8_SB(b, h) + boff + n * 2048 + k * 1024); } while (0)
#define PG8_MMA(ai, bj, At, Bt) do { __builtin_amdgcn_s_setprio(1); _Pragma("unroll") for (int m = 0; m < 4; ++m) _Pragma("unroll") for (int n = 0; n < 2; ++n) _Pragma("unroll") for (int k = 0; k < 2; ++k) \
        acc[ai][bj][m][n] = __builtin_amdgcn_mfma_f32_16x16x32_bf16(Bt[n][k], At[m][k], acc[ai][bj][m][n], 0, 0, 0); __builtin_amdgcn_s_setprio(0); } while (0)
#define PG8_WAIT_V(n) asm volatile("s_waitcnt vmcnt(" #n ")" ::: "memory")
#define PG8_WAIT_L(n) asm volatile("s_waitcnt lgkmcnt(" #n ")" ::: "memory")
#define PG8_BAR __builtin_amdgcn_s_barrier()
#define PG8_SCHED __builtin_amdgcn_sched_barrier(0)
    Unit cur, nxt; int ui = 0;
    if (!S.next(0, cur)) return;
    f32x4 acc[2][2][4][2];
#pragma unroll
    for (int a = 0; a < 2; ++a)
#pragma unroll
        for (int b = 0; b < 2; ++b)
#pragma unroll
            for (int m = 0; m < 4; ++m)
#pragma unroll
                for (int n = 0; n < 2; ++n) acc[a][b][m][n] = (f32x4){0.f, 0.f, 0.f, 0.f};
    bf16x8 At[4][2], B0[2][2], B1[2][2];
    const char* cA = cur.a; const char* cB = cur.b;
    PG8_STAGE(PG8_SB(0, 0), cB, voffB); PG8_STAGE(PG8_SA(0, 0), cA, voffA); PG8_STAGE(PG8_SB(0, 1), cB + hstepB, voffB); PG8_STAGE(PG8_SA(0, 1), cA + hstepA, voffA);
    if (wr == 1) PG8_BAR;
    PG8_WAIT_V(4); PG8_BAR;
    PG8_STAGE(PG8_SB(1, 0), cB + kstep, voffB); PG8_STAGE(PG8_SA(1, 0), cA + kstepA, voffA); PG8_STAGE(PG8_SB(1, 1), cB + hstepB + kstep, voffB);
    PG8_WAIT_V(6); PG8_BAR;
    for (;;) {
        const bool has_next = S.next(ui + 1, nxt);
        const char* nA = has_next ? nxt.a : cA; const char* nB = has_next ? nxt.b : cB;
        for (int t = 0; t < nt; t += 2) {
            const bool last = (t == nt - 2);
            const char* a1 = cA + (size_t)(t + 1) * kstepA;
            const char* a2 = last ? nA : cA + (size_t)(t + 2) * kstepA; const char* b2 = last ? nB : cB + (size_t)(t + 2) * kstep;
            const char* a3 = a2 + kstepA; const char* b3 = b2 + kstep;
            PG8_LDB(B0, 0, 0); PG8_SCHED; PG8_LDA(At, 0, 0); PG8_STAGE(PG8_SA(1, 1), a1 + hstepA, voffA);
            PG8_WAIT_L(8); PG8_BAR; PG8_WAIT_L(0); PG8_MMA(0, 0, At, B0); PG8_BAR; PG8_SCHED;
            PG8_LDB(B1, 0, 1); PG8_STAGE(PG8_SB(0, 0), b2, voffB);
            PG8_BAR; PG8_WAIT_L(0); PG8_MMA(0, 1, At, B1); PG8_BAR;
            PG8_LDA(At, 0, 1); PG8_STAGE(PG8_SA(0, 0), a2, voffA);
            PG8_BAR; PG8_WAIT_L(0); PG8_MMA(1, 0, At, B0); PG8_BAR; PG8_SCHED;
            PG8_STAGE(PG8_SB(0, 1), b2 + hstepB, voffB);
            PG8_WAIT_V(6); PG8_BAR; PG8_MMA(1, 1, At, B1); PG8_BAR;
            PG8_LDB(B0, 1, 0); PG8_SCHED; PG8_LDA(At, 1, 0); PG8_STAGE(PG8_SA(0, 1), a2 + hstepA, voffA);
            PG8_WAIT_L(8); PG8_BAR; PG8_WAIT_L(0); PG8_MMA(0, 0, At, B0); PG8_BAR; PG8_SCHED;
            PG8_LDB(B1, 1, 1); PG8_STAGE(PG8_SB(1, 0), b3, voffB);
            PG8_BAR; PG8_WAIT_L(0); PG8_MMA(0, 1, At, B1); PG8_BAR;
            PG8_LDA(At, 1, 1); PG8_STAGE(PG8_SA(1, 0), a3, voffA);
            PG8_BAR; PG8_WAIT_L(0); PG8_MMA(1, 0, At, B0); PG8_BAR; PG8_SCHED;
            PG8_STAGE(PG8_SB(1, 1), b3 + hstepB, voffB);
            PG8_WAIT_V(6); PG8_BAR; PG8_MMA(1, 1, At, B1); PG8_BAR;
        }
        { int ozv; asm volatile("v_mov_b32 %0, 0" : "=v"(ozv)); epilogue(P, acc, cur, wr, wc, fr + ozv, fq + ozv); }
        if (!has_next) break;
#pragma unroll
        for (int a = 0; a < 2; ++a)
#pragma unroll
            for (int b = 0; b < 2; ++b)
#pragma unroll
                for (int m = 0; m < 4; ++m)
#pragma unroll
                    for (int n = 0; n < 2; ++n) acc[a][b][m][n] = (f32x4){0.f, 0.f, 0.f, 0.f};
        cur = nxt; cA = nA; cB = nB; ++ui;
    }
    PG8_WAIT_V(0);
    if (wr == 0) PG8_BAR;
    PG8_BAR;
}

DEVI void prep_transpose(const int TIDX, const int BIDX, float* tile  , const float* src, int K, int N, bf16_t* dst, const float* kscale, bool permqk, int job0, int& jobbase, int gsz) {
    const int ntk = K / 64, ntn = N / 64, njobs = ntk * ntn, tid = TIDX;
    for (int jb = job0 - jobbase; jb < njobs; jb += gsz) {
        if (jb < 0) continue;
        const int tn = jb / ntk, tk = jb % ntk, n0 = tn * 64, k0 = tk * 64;
        int c0 = n0;
        if (permqk && n0 < 1024) { const int tile_ = n0 >> 8, cp = n0 & 255, bj = cp >> 7, w = cp & 127; c0 = tile_ * 256 + (w >> 6) * 128 + bj * 64; }
        __syncthreads();
#pragma unroll
        for (int s = 0; s < 2; ++s) {
            const int r = (tid >> 4) + 32 * s, c4 = (tid & 15) * 4;
            f32x4 v = *(const f32x4*)(src + (size_t)(k0 + r) * N + c0 + c4);
            const float sc = kscale ? kscale[k0 + r] : 1.f;
            tile[r * 65 + c4] = v[0] * sc; tile[r * 65 + c4 + 1] = v[1] * sc; tile[r * 65 + c4 + 2] = v[2] * sc; tile[r * 65 + c4 + 3] = v[3] * sc;
        }
        __syncthreads();
        const int n = tid >> 3, k8 = (tid & 7) * 8;
        u32x4 o;
        o.x = pack2(tile[(k8 + 0) * 65 + n], tile[(k8 + 1) * 65 + n]); o.y = pack2(tile[(k8 + 2) * 65 + n], tile[(k8 + 3) * 65 + n]);
        o.z = pack2(tile[(k8 + 4) * 65 + n], tile[(k8 + 5) * 65 + n]); o.w = pack2(tile[(k8 + 6) * 65 + n], tile[(k8 + 7) * 65 + n]);
        *(u32x4*)(dst + (size_t)(n0 + n) * K + k0 + k8) = o;
    }
    jobbase += njobs;
}

DEVI void prep_s5_tables(const int TIDX, const int BIDX, float* L, const Params& p, int g) {
    float* pwr = L;
    float* pwi = pwr + 17 * 64;
    float* bbr = pwi + 17 * 64;
    float* bbi = bbr + 1024;
    float* cr = bbi + 1024;
    float* ci = cr + 1024;
    float* kg = ci + 1024;
    const int tid = TIDX;
    char* ws = p.ws;
    __syncthreads();
    if (tid < 64) {
        const int pp = tid;
        const double dt = exp((double)p.logdt[g]);
        const double lr = p.lamre[g * 64 + pp], li = p.lamim[g * 64 + pp];
        for (int t = 0; t <= 16; ++t) {
            const double mag = exp(lr * dt * t), ang = li * dt * t;
            pwr[t * 64 + pp] = (float)(mag * cos(ang)); pwi[t * 64 + pp] = (float)(mag * sin(ang));
        }
        const double mag = exp(lr * dt), ang = li * dt, lbr = mag * cos(ang), lbi = mag * sin(ang);
        const double nr = lbr - 1.0, den = lr * lr + li * li, fr = (nr * lr + lbi * li) / den, fi = (lbi * lr - nr * li) / den;
        float* lam1 = (float*)(ws + WS_LAM1); float* lam16 = (float*)(ws + WS_LAM16); float* bbg = (float*)(ws + WS_BBG);
        lam1[(g * 64 + pp) * 2] = (float)lbr; lam1[(g * 64 + pp) * 2 + 1] = (float)lbi;
        lam16[(g * 64 + pp) * 2] = pwr[16 * 64 + pp]; lam16[(g * 64 + pp) * 2 + 1] = pwi[16 * 64 + pp];
        for (int c = 0; c < 16; ++c) {
            const double br = p.bre[(g * 64 + pp) * 16 + c], bi = p.bim[(g * 64 + pp) * 16 + c];
            const float xr = (float)(fr * br - fi * bi), xi = (float)(fr * bi + fi * br);
            bbr[pp * 16 + c] = xr; bbi[pp * 16 + c] = xi;
            bbg[((g * 64 + pp) * 16 + c) * 2] = xr; bbg[((g * 64 + pp) * 16 + c) * 2 + 1] = xi;
        }
    }
    for (int i = tid; i < 1024; i += 512) { cr[i] = p.cre[g * 1024 + i]; ci[i] = p.cim[g * 1024 + i]; }
    __syncthreads();
    for (int i = tid; i < 4096; i += 512) {
        const int tau = i >> 8, c = (i >> 4) & 15, cp = i & 15;
        float s = 0.f;
        for (int pp = 0; pp < 64; ++pp) {
            const float a = pwr[tau * 64 + pp], b = pwi[tau * 64 + pp], xr = bbr[pp * 16 + cp], xi = bbi[pp * 16 + cp];
            s += cr[c * 64 + pp] * (a * xr - b * xi) - ci[c * 64 + pp] * (a * xi + b * xr);
        }
        kg[i] = s;
    }
    __syncthreads();
    bf16_t* bt2 = (bf16_t*)(ws + WS_BT2) + (size_t)g * 256 * 384;
    for (int i = tid; i < 256 * 48; i += 512) {
        const int n = i / 48, k8 = (i % 48) * 8, t = n >> 4, c = n & 15;
        float v[8];
#pragma unroll
        for (int j = 0; j < 8; ++j) {
            const int k = k8 + j;
            if (k < 256) { const int s = k >> 4, cp = k & 15; v[j] = t >= s ? kg[(t - s) * 256 + c * 16 + cp] : 0.f; }
            else { const int q = k - 256, pp = q & 63; const float a = pwr[(t + 1) * 64 + pp], b = pwi[(t + 1) * 64 + pp];
                v[j] = q < 64 ? (cr[c * 64 + pp] * a - ci[c * 64 + pp] * b) : -(cr[c * 64 + pp] * b + ci[c * 64 + pp] * a); }
        }
        u32x4 o; o.x = pack2(v[0], v[1]); o.y = pack2(v[2], v[3]); o.z = pack2(v[4], v[5]); o.w = pack2(v[6], v[7]);
        *(u32x4*)(bt2 + (size_t)n * 384 + k8) = o;
    }
    bf16_t* bt1 = (bf16_t*)(ws + WS_BT1) + (size_t)g * 256 * 256;
    for (int i = tid; i < 256 * 32; i += 512) {
        const int n = i >> 5, k8 = (i & 31) * 8;
        float v[8];
#pragma unroll
        for (int j = 0; j < 8; ++j) {
            const int k = k8 + j, s = k >> 4, cp = k & 15;
            if (n >= 128) v[j] = 0.f;
            else { const int pp = n & 63; const float a = pwr[(15 - s) * 64 + pp], b = pwi[(15 - s) * 64 + pp], xr = bbr[pp * 16 + cp], xi = bbi[pp * 16 + cp];
                v[j] = n < 64 ? (a * xr - b * xi) : (a * xi + b * xr); }
        }
        u32x4 o; o.x = pack2(v[0], v[1]); o.y = pack2(v[2], v[3]); o.z = pack2(v[4], v[5]); o.w = pack2(v[6], v[7]);
        *(u32x4*)(bt1 + (size_t)n * 256 + k8) = o;
    }
}

DEVI void phase_prep(const int TIDX, const int BIDX, float* L, const Params& p) {
    const int tid = TIDX, bid = BIDX, G = gridDim.x, lane = tid & 63, wid = tid >> 6;
    char* ws = p.ws;
    for (int g = G - 1 - bid; g < 64; g += G) if (g >= 0) prep_s5_tables(TIDX, BIDX, L, p, g);
    __syncthreads();
    int jobbase = 0;
    prep_transpose(TIDX, BIDX, L, p.win0, 1024, 5120, (bf16_t*)(ws + WS_WIN0T), nullptr, true, bid, jobbase, G);
    prep_transpose(TIDX, BIDX, L, p.gluw, 1024, 1024, (bf16_t*)(ws + WS_WGLUT), nullptr, false, bid, jobbase, G);
    prep_transpose(TIDX, BIDX, L, p.wout0, 2048, 1024, (bf16_t*)(ws + WS_WOUT0T), nullptr, false, bid, jobbase, G);
    prep_transpose(TIDX, BIDX, L, p.win1, 1024, 4096, (bf16_t*)(ws + WS_WIN1T), p.normw + 1024, false, bid, jobbase, G);
    prep_transpose(TIDX, BIDX, L, p.wout1, 1024, 1024, (bf16_t*)(ws + WS_WOUT1T), nullptr, false, bid, jobbase, G);
    bf16_t* h0 = (bf16_t*)(p.out + O_RETS); bf16_t* h0s = (bf16_t*)(ws + WS_H0S);
    for (int row = bid * 8 + wid; row < MP + 256; row += G * 8) {
        bf16_t* d = row < MP ? h0 + (size_t)row * 1024 : h0s + (size_t)(row - MP) * 1024;
        if (row >= MP + MS) { for (int i = 0; i < 4; ++i) *(u32x2*)(d + i * 256 + lane * 4) = (u32x2){0u, 0u}; continue; }
        const float* x = row < MP ? p.xp + (size_t)row * 1024 : p.xs + (size_t)(row - MP) * 1024;
        f32x4 v[4]; float s = 0.f;
#pragma unroll
        for (int i = 0; i < 4; ++i) { v[i] = *(const f32x4*)(x + i * 256 + lane * 4); s += v[i][0] * v[i][0] + v[i][1] * v[i][1] + v[i][2] * v[i][2] + v[i][3] * v[i][3]; }
        s = wave_sum(s);
        const float r = rsqrtf(s * (1.0f / 1024.0f) + 1e-6f);
#pragma unroll
        for (int i = 0; i < 4; ++i) { const f32x4 w = *(const f32x4*)(p.normw + i * 256 + lane * 4); *(u32x2*)(d + i * 256 + lane * 4) = pack4(v[i] * r * w); }
    }
    for (int i = bid * 512 + tid; i < 128 * 1024 / 8; i += G * 512) {
        const u32x4 z = {0u, 0u, 0u, 0u};
        *(u32x4*)((bf16_t*)(ws + WS_Y5S) + 128 * 1024 + (size_t)i * 8) = z;
        *(u32x4*)((bf16_t*)(ws + WS_X1SB) + 128 * 1024 + (size_t)i * 8) = z;
        *(u32x4*)((bf16_t*)(ws + WS_O1S) + 128 * 1024 + (size_t)i * 8) = z;
        *(u32x4*)((bf16_t*)(ws + WS_MIX0S) + 128 * 2048 + (size_t)i * 16) = z;
        *(u32x4*)((bf16_t*)(ws + WS_MIX0S) + 128 * 2048 + (size_t)i * 16 + 8) = z;
    }
    float* rope = (float*)(ws + WS_ROPE);
    for (int i = bid * 512 + tid; i < 2049 * 64; i += G * 512) {
        const int pr = i >> 6, j = i & 63; const double pos = pr == 2048 ? 16384.0 : (double)pr;
        const double inv = exp2(-(double)j * (13.287712379549449 / 64.0));
        const double rev = pos * inv * 0.15915494309189535; const double fr = rev - floor(rev); const double a = fr * 6.283185307179586;
        rope[pr * 128 + j] = (float)cos(a); rope[pr * 128 + 64 + j] = (float)sin(a);
    }
    float* lb = (float*)(ws + WS_LB);
    for (int i = bid * 512 + tid; i < 1024; i += G * 512) lb[i] = 1.f / (1.f + expf(p.hglb[i] - p.hglb[1024 + i]));
}

DEVI float ret_lg(int h) { return log1pf(-exp2f(-5.0f - (float)h)); }

DEVI void phase_R1(const int TIDX, const int BIDX, bf16_t* L, const Params& p) {
    const int tid = TIDX, wid = tid >> 6, lane = tid & 63, r16 = lane & 15, g = lane >> 4;
    const bf16_t* kt = (const bf16_t*)(p.ws + WS_KT); const bf16_t* vt = (const bf16_t*)(p.ws + WS_VT);
    float* kvt = p.out + O_YP;
    for (int it = BIDX; it < 512; it += gridDim.x) {
        const int bh = it >> 4, c = it & 15, h = bh & 3, t0 = c * 128; const float lg = ret_lg(h);
        __syncthreads();
        { const int d = tid >> 2, seg = tid & 3;
#pragma unroll
          for (int q = 0; q < 4; ++q) {
              const int l0 = seg * 32 + q * 8;
              const u32x4 v = *(const u32x4*)(kt + ((size_t)bh * 128 + d) * 2048 + t0 + l0);
              u32x4 o; const unsigned* vv = (const unsigned*)&v; unsigned* oo = (unsigned*)&o;
#pragma unroll
              for (int j = 0; j < 4; ++j) oo[j] = pack2(bflo(vv[j]) * __expf(lg * (float)(127 - l0 - 2 * j)), bfhi(vv[j]) * __expf(lg * (float)(126 - l0 - 2 * j)));
              *(u32x4*)(L + d * 136 + l0) = o; } }
        __syncthreads();
        bf16x8 bfr[2][4];
#pragma unroll
        for (int ct = 0; ct < 2; ++ct)
#pragma unroll
            for (int kk = 0; kk < 4; ++kk) bfr[ct][kk] = *(const bf16x8*)(vt + ((size_t)bh * 256 + wid * 32 + ct * 16 + r16) * 2048 + t0 + kk * 32 + g * 8);
#pragma unroll
        for (int rt = 0; rt < 8; ++rt) {
            f32x4 a0 = {0.f, 0.f, 0.f, 0.f}, a1 = a0;
#pragma unroll
            for (int kk = 0; kk < 4; ++kk) { const bf16x8 a = *(const bf16x8*)(L + (rt * 16 + r16) * 136 + kk * 32 + g * 8); a0 = mfma16(a, bfr[0][kk], a0); a1 = mfma16(a, bfr[1][kk], a1); }
            float* d0 = kvt + (((size_t)bh * 16 + c) * 256 + wid * 32 + r16) * 128 + rt * 16 + g * 4;
            *(f32x4*)d0 = a0; *(f32x4*)(d0 + 16 * 128) = a1;
        }
    }
}

DEVI void phase_R2(const int TIDX, const int BIDX, const Params& p) {
    float* kvt = p.out + O_YP;
    for (int i = BIDX * 512 + TIDX; i < 32 * 256 * 16; i += gridDim.x * 512) {
        const int q = i & 15, e = (i >> 4) & 255, bh = i >> 12, h = bh & 3; const float dec = __expf(ret_lg(h) * 128.f);
        f32x4 s0 = {0.f, 0.f, 0.f, 0.f}, s1 = s0;
#pragma unroll 4
        for (int c = 0; c < 16; ++c) {
            float* ptr = kvt + (((size_t)bh * 16 + c) * 256 + e) * 128 + q * 8;
            const f32x4 v0 = *(const f32x4*)ptr, v1 = *(const f32x4*)(ptr + 4);
            u32x4 o; o.x = pack2(s0[0], s0[1]); o.y = pack2(s0[2], s0[3]); o.z = pack2(s1[0], s1[1]); o.w = pack2(s1[2], s1[3]);
            *(u32x4*)ptr = o;
            s0 = s0 * dec + v0; s1 = s1 * dec + v1;
        }
        float* o = p.out + O_RETP + ((size_t)bh * 128 + q * 8) * 256 + e;
#pragma unroll
        for (int j = 0; j < 4; ++j) { o[(size_t)j * 256] = s0[j]; o[(size_t)(j + 4) * 256] = s1[j]; }
    }
}

DEVI void phase_R3(const int TIDX, const int BIDX, bf16_t* L, const Params& p) {
    const int tid = TIDX, wid = tid >> 6, lane = tid & 63, r16 = lane & 15, g = lane >> 4;
    const bf16_t* Q = (const bf16_t*)(p.ws + WS_Q); const bf16_t* KN = (const bf16_t*)(p.ws + WS_KN); const bf16_t* vt = (const bf16_t*)(p.ws + WS_VT);
    const bf16_t* sga = (const bf16_t*)(p.ws + WS_SGA); bf16_t* mix = (bf16_t*)(p.out + O_HGS);
    const float* kvt = p.out + O_YP;
    bf16_t* strip = L + wid * 16 * 136;
    for (int it = BIDX; it < 512; it += gridDim.x) {
        const int bh = it >> 4, c = it & 15, h = bh & 3, b = bh >> 2, l0 = wid * 16; const size_t tok0 = (size_t)b * 2048 + c * 128; const float lg = ret_lg(h);
        bf16x8 qa[4];
#pragma unroll
        for (int kk = 0; kk < 4; ++kk) qa[kk] = *(const bf16x8*)(Q + (tok0 + l0 + r16) * 512 + h * 128 + kk * 32 + g * 8);
        __syncthreads();
        for (int j = 0; j < 8; ++j) {
            f32x4 s = {0.f, 0.f, 0.f, 0.f};
            if (j <= wid) {
#pragma unroll
                for (int kk = 0; kk < 4; ++kk) s = mfma16(qa[kk], *(const bf16x8*)(KN + (tok0 + j * 16 + r16) * 512 + h * 128 + kk * 32 + g * 8), s);
            }
#pragma unroll
            for (int r = 0; r < 4; ++r) {
                const int li = l0 + g * 4 + r, mi = j * 16 + r16; const float v = (j <= wid && li >= mi) ? s[r] * __expf(lg * (float)(li - mi)) : 0.f;
                strip[(g * 4 + r) * 136 + mi] = f2bf(v);
            }
        }
        f32x4 acc[16];
#pragma unroll
        for (int jt = 0; jt < 16; ++jt) acc[jt] = (f32x4){0.f, 0.f, 0.f, 0.f};
        if (c > 0) {
            const float* sb = kvt + ((size_t)bh * 16 + c) * 256 * 128;
#pragma unroll
            for (int jt = 0; jt < 16; ++jt)
#pragma unroll
                for (int kk = 0; kk < 4; ++kk) acc[jt] = mfma16(qa[kk], *(const bf16x8*)(sb + (size_t)(jt * 16 + r16) * 128 + kk * 32 + g * 8), acc[jt]);
            float qd[4];
#pragma unroll
            for (int r = 0; r < 4; ++r) qd[r] = __expf(lg * (float)(l0 + g * 4 + r + 1));
#pragma unroll
            for (int jt = 0; jt < 16; ++jt)
#pragma unroll
                for (int r = 0; r < 4; ++r) acc[jt][r] *= qd[r];
        }
        __syncthreads();
        for (int kk = 0; kk <= (wid >> 1); ++kk) {
            const bf16x8 a = *(const bf16x8*)(strip + r16 * 136 + kk * 32 + g * 8);
#pragma unroll
            for (int jt = 0; jt < 16; ++jt) acc[jt] = mfma16(a, *(const bf16x8*)(vt + ((size_t)bh * 256 + jt * 16 + r16) * 2048 + c * 128 + kk * 32 + g * 8), acc[jt]);
        }
        float mu[4], rs[4];
#pragma unroll
        for (int r = 0; r < 4; ++r) {
            float s = 0.f;
#pragma unroll
            for (int jt = 0; jt < 16; ++jt) s += acc[jt][r];
            s = grp16_sum(s); mu[r] = s * (1.f / 256.f);
            float q = 0.f;
#pragma unroll
            for (int jt = 0; jt < 16; ++jt) { const float d = acc[jt][r] - mu[r]; q += d * d; }
            q = grp16_sum(q); rs[r] = rsqrtf(q * (1.f / 256.f) + 1e-5f);
        }
#pragma unroll
        for (int jt = 0; jt < 16; ++jt) {
            const int e = jt * 16 + r16; const float gw = p.gnw[h * 256 + e];
#pragma unroll
            for (int r = 0; r < 4; ++r) {
                const size_t token = tok0 + l0 + g * 4 + r;
                const float v = (acc[jt][r] - mu[r]) * rs[r] * gw * bf2f(sga[token * 1024 + h * 256 + e]);
                mix[token * 2048 + h * 256 + e] = f2bf(v);
            }
        }
    }
}

DEVI void phase_s5scan(const int TIDX, const int BIDX, const Params& p) {
    const int wid = TIDX >> 6, lane = TIDX & 63;
    const float* e5 = p.out + O_HGS; bf16_t* a2 = (bf16_t*)(p.ws + WS_A2); const float* lam16 = (const float*)(p.ws + WS_LAM16);
    for (int it = BIDX * 8 + wid; it < 512; it += gridDim.x * 8) {
        const int b = it >> 6, g = it & 63;
        const float ar = lam16[(g * 64 + lane) * 2], ai = lam16[(g * 64 + lane) * 2 + 1];
        float hr = 0.f, hi = 0.f;
        for (int jb = 0; jb < 128; jb += 16) {
            float er[16], ei[16];
#pragma unroll
            for (int j = 0; j < 16; ++j) { const float* ep = e5 + ((size_t)g * 1024 + b * 128 + jb + j) * 128; er[j] = ep[lane]; ei[j] = ep[64 + lane]; }
#pragma unroll
            for (int j = 0; j < 16; ++j) {
                bf16_t* hp = a2 + ((size_t)g * 1024 + b * 128 + jb + j) * 384 + 256;
                hp[lane] = f2bf(hr); hp[64 + lane] = f2bf(hi);
                const float nr = ar * hr - ai * hi + er[j], ni = ar * hi + ai * hr + ei[j];
                hr = nr; hi = ni;
            }
        }
        p.out[O_S5RP + (size_t)(b * 64 + g) * 64 + lane] = hr; p.out[O_S5IP + (size_t)(b * 64 + g) * 64 + lane] = hi;
    }
}

DEVI void phase_H1(const int TIDX, const int BIDX, bf16_t* L, const Params& p) {
    const int tid = TIDX, wid = tid >> 6, lane = tid & 63, r16 = lane & 15, g = lane >> 4;
    float* cum = (float*)(p.ws + WS_CUM); const bf16_t* itp = (const bf16_t*)(p.ws + WS_IT); float* hkv = (float*)(p.ws + WS_HKV);
    float* tot = (float*)(L + 128 * 136);
    for (int it = BIDX; it < 1024; it += gridDim.x) {
        const int bh = it >> 4, c = it & 15, h = bh & 7, b = bh >> 3; const size_t tok0 = (size_t)b * 2048 + c * 128;
        const int d = tid & 127, part = tid >> 7;
        float* col = cum + (tok0 + part * 32) * 1024 + h * 128 + d;
        float lf[32]; float s = 0.f;
#pragma unroll
        for (int l = 0; l < 32; ++l) { lf[l] = col[(size_t)l * 1024]; s += lf[l]; }
        __syncthreads();
        tot[part * 128 + d] = s;
        __syncthreads();
        float off = 0.f, last = 0.f;
#pragma unroll
        for (int pp = 0; pp < 4; ++pp) { const float t = tot[pp * 128 + d]; if (pp < part) off += t; last += t; }
        float cc = off;
#pragma unroll
        for (int l = 0; l < 32; ++l) {
            cc += lf[l]; col[(size_t)l * 1024] = cc;
            L[d * 136 + part * 32 + l] = f2bf((1.f - __expf(lf[l])) * __expf(last - cc));
        }
        __syncthreads();
        bf16x8 bfr[4];
#pragma unroll
        for (int kk = 0; kk < 4; ++kk) bfr[kk] = *(const bf16x8*)(itp + ((size_t)bh * 128 + wid * 16 + r16) * 2048 + c * 128 + kk * 32 + g * 8);
#pragma unroll
        for (int rt = 0; rt < 8; ++rt) {
            f32x4 a0 = {0.f, 0.f, 0.f, 0.f};
#pragma unroll
            for (int kk = 0; kk < 4; ++kk) a0 = mfma16(*(const bf16x8*)(L + (rt * 16 + r16) * 136 + kk * 32 + g * 8), bfr[kk], a0);
            *(f32x4*)(hkv + (((size_t)bh * 16 + c) * 128 + wid * 16 + r16) * 128 + rt * 16 + g * 4) = a0;
        }
    }
}

DEVI void phase_H2(const int TIDX, const int BIDX, const Params& p) {
    float* hkv = (float*)(p.ws + WS_HKV); const float* cum = (const float*)(p.ws + WS_CUM);
    for (int i = BIDX * 512 + TIDX; i < 64 * 128 * 16; i += gridDim.x * 512) {
        const int q = i & 15, e = (i >> 4) & 127, bh = i >> 11, h = bh & 7, b = bh >> 3;
        f32x4 s0 = {0.f, 0.f, 0.f, 0.f}, s1 = s0;
#pragma unroll 4
        for (int c = 0; c < 16; ++c) {
            float* ptr = hkv + (((size_t)bh * 16 + c) * 128 + e) * 128 + q * 8;
            const float* lp = cum + ((size_t)b * 2048 + c * 128 + 127) * 1024 + h * 128 + q * 8;
            const f32x4 v0 = *(const f32x4*)ptr, v1 = *(const f32x4*)(ptr + 4), d0 = *(const f32x4*)lp, d1 = *(const f32x4*)(lp + 4);
            u32x4 o; o.x = pack2(s0[0], s0[1]); o.y = pack2(s0[2], s0[3]); o.z = pack2(s1[0], s1[1]); o.w = pack2(s1[2], s1[3]);
            *(u32x4*)ptr = o;
#pragma unroll
            for (int j = 0; j < 4; ++j) { s0[j] = s0[j] * __expf(d0[j]) + v0[j]; s1[j] = s1[j] * __expf(d1[j]) + v1[j]; }
        }
        float* o = p.out + O_HGP + ((size_t)bh * 128 + q * 8) * 128 + e;
#pragma unroll
        for (int j = 0; j < 4; ++j) { o[(size_t)j * 128] = s0[j]; o[(size_t)(j + 4) * 128] = s1[j]; }
    }
}

DEVI void phase_H3(const int TIDX, const int BIDX, bf16_t* L, const Params& p) {
    const int tid = TIDX, wid = tid >> 6, lane = tid & 63, r16 = lane & 15, g = lane >> 4;
    const float* cum = (const float*)(p.ws + WS_CUM); const bf16_t* itp = (const bf16_t*)(p.ws + WS_IT); const float* hkv = (const float*)(p.ws + WS_HKV);
    bf16_t* q1 = (bf16_t*)(p.ws + WS_Q1); const bf16_t* sg1 = (const bf16_t*)(p.ws + WS_SG1);
    bf16_t* kt = L; bf16_t* strip = L + 128 * 136 + wid * 16 * 136;
    for (int it = BIDX; it < 1024; it += gridDim.x) {
        const int bh = it >> 4, c = it & 15, h = bh & 7, b = bh >> 3, l0 = wid * 16; const size_t tok0 = (size_t)b * 2048 + c * 128;
        const float* refp = cum + (tok0 + 63) * 1024 + h * 128;
        __syncthreads();
        { const int m = tid >> 2, seg = tid & 3; const float* cp = cum + (tok0 + m) * 1024 + h * 128 + seg * 32;
#pragma unroll
          for (int q = 0; q < 8; ++q) {
              const f32x4 cv = *(const f32x4*)(cp + q * 4), rv = *(const f32x4*)(refp + seg * 32 + q * 4);
              f32x4 pv = {0.f, 0.f, 0.f, 0.f}; if (m > 0) pv = *(const f32x4*)(cp - 1024 + q * 4);
              f32x4 o;
#pragma unroll
              for (int j = 0; j < 4; ++j) o[j] = (1.f - __expf(cv[j] - pv[j])) * __expf(rv[j] - cv[j]);
              *(u32x2*)(kt + m * 136 + seg * 32 + q * 4) = pack4(o); } }
        bf16x8 qr[4], qab[4];
#pragma unroll
        for (int kk = 0; kk < 4; ++kk) {
            const size_t o = (tok0 + l0 + r16) * 1024 + h * 128 + kk * 32 + g * 8;
            const u32x4 qq = *(const u32x4*)(q1 + o);
            const f32x4 c0 = *(const f32x4*)(cum + o), c1 = *(const f32x4*)(cum + o + 4), r0 = *(const f32x4*)(refp + kk * 32 + g * 8), r1 = *(const f32x4*)(refp + kk * 32 + g * 8 + 4);
            const unsigned* qv = (const unsigned*)&qq; u32x4 a, bb; unsigned* av = (unsigned*)&a; unsigned* bv = (unsigned*)&bb;
#pragma unroll
            for (int j = 0; j < 4; ++j) {
                const float cl = j < 2 ? c0[2 * j] : c1[2 * j - 4], ch = j < 2 ? c0[2 * j + 1] : c1[2 * j - 3];
                const float rl = j < 2 ? r0[2 * j] : r1[2 * j - 4], rh = j < 2 ? r0[2 * j + 1] : r1[2 * j - 3];
                const float ql = bflo(qv[j]), qh = bfhi(qv[j]);
                av[j] = pack2(ql * __expf(cl - rl), qh * __expf(ch - rh)); bv[j] = pack2(ql * __expf(cl), qh * __expf(ch));
            }
            qr[kk] = *(bf16x8*)&a; qab[kk] = *(bf16x8*)&bb;
        }
        __syncthreads();
        for (int j = 0; j < 8; ++j) {
            f32x4 s = {0.f, 0.f, 0.f, 0.f};
            if (j <= wid) {
#pragma unroll
                for (int kk = 0; kk < 4; ++kk) s = mfma16(qr[kk], *(const bf16x8*)(kt + (j * 16 + r16) * 136 + kk * 32 + g * 8), s);
            }
#pragma unroll
            for (int r = 0; r < 4; ++r) {
                const int li = l0 + g * 4 + r, mi = j * 16 + r16; const float v = (j <= wid && li >= mi) ? s[r] : 0.f;
                strip[(g * 4 + r) * 136 + mi] = f2bf(v);
            }
        }
        f32x4 acc[8];
#pragma unroll
        for (int jt = 0; jt < 8; ++jt) acc[jt] = (f32x4){0.f, 0.f, 0.f, 0.f};
        if (c > 0) {
            const float* sb = hkv + ((size_t)bh * 16 + c) * 128 * 128;
#pragma unroll
            for (int jt = 0; jt < 8; ++jt)
#pragma unroll
                for (int kk = 0; kk < 4; ++kk) acc[jt] = mfma16(qab[kk], *(const bf16x8*)(sb + (size_t)(jt * 16 + r16) * 128 + kk * 32 + g * 8), acc[jt]);
        }
        __syncthreads();
        for (int kk = 0; kk <= (wid >> 1); ++kk) {
            const bf16x8 a = *(const bf16x8*)(strip + r16 * 136 + kk * 32 + g * 8);
#pragma unroll
            for (int jt = 0; jt < 8; ++jt) acc[jt] = mfma16(a, *(const bf16x8*)(itp + ((size_t)bh * 128 + jt * 16 + r16) * 2048 + c * 128 + kk * 32 + g * 8), acc[jt]);
        }
        float rs[4];
#pragma unroll
        for (int r = 0; r < 4; ++r) {
            float q = 0.f;
#pragma unroll
            for (int jt = 0; jt < 8; ++jt) q += acc[jt][r] * acc[jt][r];
            q = grp16_sum(q); rs[r] = rsqrtf(q * (1.f / 128.f) + 1e-6f);
        }
#pragma unroll
        for (int jt = 0; jt < 8; ++jt) {
            const int e = jt * 16 + r16; const float gw = p.hgnw[h * 128 + e];
#pragma unroll
            for (int r = 0; r < 4; ++r) {
                const size_t token = tok0 + l0 + g * 4 + r;
                q1[token * 1024 + h * 128 + e] = f2bf(acc[jt][r] * rs[r] * gw * bf2f(sg1[token * 1024 + h * 128 + e]));
            }
        }
    }
}

DEVI void phase_ss5(const int TIDX, const int BIDX, const Params& p) {
    const int wid = TIDX >> 6, lane = TIDX & 63;
    const float* zs = (const float*)(p.ws + WS_ZS); const float* bbg = (const float*)(p.ws + WS_BBG); const float* lam1 = (const float*)(p.ws + WS_LAM1);
    bf16_t* y5s = (bf16_t*)(p.ws + WS_Y5S);
    for (int it = BIDX * 8 + wid; it < 128 * 64; it += gridDim.x * 8) {
        const int b = it >> 6, g = it & 63;
        float u[16];
#pragma unroll
        for (int c = 0; c < 16; ++c) u[c] = zs[(size_t)b * 5120 + 3072 + g * 16 + c];
        float xr = 0.f, xi = 0.f;
#pragma unroll
        for (int c = 0; c < 16; ++c) { xr += bbg[((g * 64 + lane) * 16 + c) * 2] * u[c]; xi += bbg[((g * 64 + lane) * 16 + c) * 2 + 1] * u[c]; }
        const float ar = lam1[(g * 64 + lane) * 2], ai = lam1[(g * 64 + lane) * 2 + 1];
        const float sr = p.s5r[(size_t)(b * 64 + g) * 64 + lane], si = p.s5i[(size_t)(b * 64 + g) * 64 + lane];
        const float hr = ar * sr - ai * si + xr, hi = ar * si + ai * sr + xi;
        p.out[O_S5RS + (size_t)(b * 64 + g) * 64 + lane] = hr; p.out[O_S5IS + (size_t)(b * 64 + g) * 64 + lane] = hi;
        float mine = 0.f;
#pragma unroll
        for (int c = 0; c < 16; ++c) {
            float v = p.cre[(g * 16 + c) * 64 + lane] * hr - p.cim[(g * 16 + c) * 64 + lane] * hi;
            v = wave_sum(v);
            if (lane == c) mine = v + p.s5d[g * 16 + c] * u[c];
        }
        if (lane < 16) y5s[(size_t)b * 1024 + g * 16 + lane] = f2bf(gelu_(mine));
    }
}

DEVI void phase_sret(const int TIDX, const int BIDX, float* L, const Params& p) {
    const int tid = TIDX, lane = tid & 63, wid = tid >> 6;
    const float* zs = (const float*)(p.ws + WS_ZS); bf16_t* mix = (bf16_t*)(p.ws + WS_MIX0S);
    float* qs = L; float* ks = L + 128; float* red = L + 256; float* st = L + 768;
    for (int it = BIDX; it < 512; it += gridDim.x) {
        const int b = it >> 2, h = it & 3, e = tid & 255, half = tid >> 8; const float gam = 1.0f - exp2f(-5.0f - (float)h);
        __syncthreads();
        if (tid < 128) qs[tid] = zs[(size_t)b * 5120 + h * 128 + tid]; else if (tid < 256) ks[tid - 128] = zs[(size_t)b * 5120 + 512 + h * 128 + tid - 128];
        const float v = zs[(size_t)b * 5120 + 1024 + h * 256 + e];
        __syncthreads();
        const float* s0 = p.sret + ((size_t)it * 128 + half * 64) * 256 + e; float* so = p.out + O_RETS + ((size_t)it * 128 + half * 64) * 256 + e;
        float o = 0.f;
#pragma unroll 8
        for (int d = 0; d < 64; ++d) { const float s = gam * s0[(size_t)d * 256] + ks[half * 64 + d] * v; so[(size_t)d * 256] = s; o += qs[half * 64 + d] * s; }
        red[tid] = o;
        __syncthreads();
        float tot = 0.f;
        if (tid < 256) { tot = red[tid] + red[tid + 256]; const float s = wave_sum(tot); if (lane == 0) st[wid] = s; }
        __syncthreads();
        const float mu = (st[0] + st[1] + st[2] + st[3]) * (1.f / 256.f);
        __syncthreads();
        if (tid < 256) { const float dd = tot - mu; const float s = wave_sum(dd * dd); if (lane == 0) st[wid] = s; }
        __syncthreads();
        const float rs = rsqrtf((st[0] + st[1] + st[2] + st[3]) * (1.f / 256.f) + 1e-5f);
        if (tid < 256) mix[(size_t)b * 2048 + h * 256 + e] = f2bf((tot - mu) * rs * p.gnw[h * 256 + e] * zs[(size_t)b * 5120 + 2048 + h * 256 + e]);
    }
}

DEVI void phase_shg(const int TIDX, const int BIDX, float* L, const Params& p) {
    const int tid = TIDX, lane = tid & 63, wid = tid >> 6;
    const float* z1 = (const float*)(p.ws + WS_Z1S); bf16_t* o1s = (bf16_t*)(p.ws + WS_O1S);
    float* qs = L; float* fs = L + 128; float* red = L + 256; float* st = L + 768;
    for (int it = BIDX; it < 1024; it += gridDim.x) {
        const int b = it >> 3, h = it & 7, e = tid & 127, qt = tid >> 7;
        __syncthreads();
        if (tid < 128) qs[tid] = z1[(size_t)b * 4096 + h * 128 + tid]; else if (tid < 256) fs[tid - 128] = z1[(size_t)b * 4096 + 1024 + h * 128 + tid - 128];
        const float iv = z1[(size_t)b * 4096 + 2048 + h * 128 + e];
        __syncthreads();
        const float* s0 = p.shg + ((size_t)it * 128 + qt * 32) * 128 + e; float* so = p.out + O_HGS + ((size_t)it * 128 + qt * 32) * 128 + e;
        float o = 0.f;
#pragma unroll 8
        for (int d = 0; d < 32; ++d) { const float f = fs[qt * 32 + d]; const float s = f * s0[(size_t)d * 128] + (1.f - f) * iv; so[(size_t)d * 128] = s; o += qs[qt * 32 + d] * s; }
        red[tid] = o;
        __syncthreads();
        float tot = 0.f;
        if (tid < 128) { tot = red[tid] + red[tid + 128] + red[tid + 256] + red[tid + 384]; const float s = wave_sum(tot * tot); if (lane == 0) st[wid] = s; }
        __syncthreads();
        const float rs = rsqrtf((st[0] + st[1]) * (1.f / 128.f) + 1e-6f);
        if (tid < 128) o1s[(size_t)b * 1024 + h * 128 + e] = f2bf(tot * rs * p.hgnw[h * 128 + e] * z1[(size_t)b * 4096 + 3072 + h * 128 + e]);
    }
}

DEVI void phase_final(const int TIDX, const int BIDX, const Params& p) {
    const int wid = TIDX >> 6, lane = TIDX & 63;
    for (int row = BIDX * 8 + wid; row < MP + MS; row += gridDim.x * 8) {
        const bool smp = row >= MP; const size_t r = smp ? row - MP : row;
        float* x = p.out + (smp ? O_YS : O_YP) + r * 1024;
        f32x4 v[4]; float s = 0.f;
#pragma unroll
        for (int i = 0; i < 4; ++i) { v[i] = *(const f32x4*)(x + i * 256 + lane * 4); s += v[i][0] * v[i][0] + v[i][1] * v[i][1] + v[i][2] * v[i][2] + v[i][3] * v[i][3]; }
        s = wave_sum(s);
        const float rs = rsqrtf(s * (1.0f / 1024.0f) + 1e-6f);
#pragma unroll
        for (int i = 0; i < 4; ++i) { const f32x4 w = *(const f32x4*)(p.fnormw + i * 256 + lane * 4); *(f32x4*)(x + i * 256 + lane * 4) = v[i] * rs * w; }
    }
}

#define GRID_SYNC() do { asm volatile("s_waitcnt vmcnt(0) lgkmcnt(0)" ::: "memory"); __syncthreads(); if (threadIdx.x == 0) { __builtin_amdgcn_fence(__ATOMIC_RELEASE, ""); asm volatile("s_waitcnt vmcnt(0)" ::: "memory"); } \
    cg::this_grid().sync(); \
    if (threadIdx.x == 0) { __builtin_amdgcn_fence(__ATOMIC_ACQUIRE, ""); asm volatile("s_waitcnt vmcnt(0)" ::: "memory"); } __syncthreads(); } while (0)
constexpr int NPHASE = 13;
__global__ void __launch_bounds__(512, 2) mega(Params p0) {
    extern __shared__ __attribute__((aligned(16))) unsigned char shm[];
    LAS unsigned char* lds = (LAS unsigned char*)shm;
    const int G = gridDim.x;
#define OPQ int oz; asm volatile("s_mov_b32 %0, 0" : "=s"(oz)); int ozv; asm volatile("v_mov_b32 %0, 0" : "=v"(ozv)); \
    Params p = p0; p.ws = p0.ws + oz; p.out = p0.out + oz; const int TIDX = threadIdx.x + ozv, BIDX = blockIdx.x + oz; (void)TIDX; (void)BIDX;
    int ph_start = p0.ph_lo;
    if (ph_start == 0) {
        { OPQ phase_prep(TIDX, BIDX, (float*)shm, p); }
#if COOP
        GRID_SYNC();
#endif
        ph_start = 1;
    }
    for (int ph = ph_start; ph < p0.ph_hi; ++ph) {
        int la = -1, lb = -1, K = 1024, lda = 1024, ldb = 1024;
        switch (ph) {
        case 1: la = L_IN0; lb = L_IN0S; break;
        case 2: la = L_GA; K = 256; lda = 384; ldb = 256; break;
        case 4: la = L_GB; K = 384; lda = 384; ldb = 384; break;
        case 5: la = L_GLU; lb = L_GLUS; break;
        case 6: la = L_OUT0; lb = L_OUT0S; K = 2048; lda = 2048; ldb = 2048; break;
        case 7: la = L_IN1; lb = L_IN1S; break;
        case 11: la = L_OUT1; lb = L_OUT1S; break;
        default: break;
        }
        for (int jj = 0; jj < 2; ++jj) {
            const int l = jj ? lb : la;
            if (l < 0) continue;
            OPQ
            Sched S; S.list = l; S.G = G; S.c = jj ? G - 1 - BIDX : BIDX; S.wsp = p.ws; S.outp = p.out;
            gemm_phase(TIDX, lds, K, lda, ldb, l == L_GLU, S, p);
        }
        __syncthreads();
        switch (ph) {
        case 2: { { OPQ phase_R1(TIDX, BIDX, (bf16_t*)shm, p); } __syncthreads(); { OPQ phase_sret(TIDX, BIDX, (float*)shm, p); } { OPQ phase_ss5(TIDX, BIDX, p); } } break;
        case 3: { { OPQ phase_s5scan(TIDX, BIDX, p); } { OPQ phase_R2(TIDX, BIDX, p); } } break;
        case 4: { OPQ phase_R3(TIDX, BIDX, (bf16_t*)shm, p); } break;
        case 8: { { OPQ phase_H1(TIDX, BIDX, (bf16_t*)shm, p); } __syncthreads(); { OPQ phase_shg(TIDX, BIDX, (float*)shm, p); } } break;
        case 9: { OPQ phase_H2(TIDX, BIDX, p); } break;
        case 10: { OPQ phase_H3(TIDX, BIDX, (bf16_t*)shm, p); } break;
        case 12: { OPQ phase_final(TIDX, BIDX, p); } break;
        default: break;
        }
#if COOP
        if (ph + 1 < p0.ph_hi) GRID_SYNC();
#endif
    }
}

extern "C" void kernel_launch(void* const* d_in, const int* in_sizes, int n_in, void* d_out, int out_size, void* d_ws, size_t ws_size, hipStream_t stream) {
    constexpr size_t kDynLds = 131072;
    static int grid_blocks = 0;
    if (!grid_blocks) {
        hipFuncSetAttribute((const void*)mega, hipFuncAttributeMaxDynamicSharedMemorySize, (int)kDynLds);
        int dev = 0, cus = 0, per_cu = 0;
        hipGetDevice(&dev);
        hipDeviceGetAttribute(&cus, hipDeviceAttributeMultiprocessorCount, dev);
        hipOccupancyMaxActiveBlocksPerMultiprocessor(&per_cu, mega, 512, kDynLds);
        if (per_cu < 1) per_cu = 1;
        grid_blocks = cus;
        if (grid_blocks > 256) grid_blocks = 256;
    }
    Params p{};
    const float** f = (const float**)&p;
    for (int i = 0; i < 25; ++i) f[i] = (const float*)d_in[i];
    p.out = (float*)d_out; p.ws = (char*)d_ws;
#if COOP
    p.ph_lo = 0; p.ph_hi = PH_MAX;
    void* args[] = {&p};
    hipError_t e = hipLaunchCooperativeKernel((const void*)mega, dim3(grid_blocks), dim3(512), args, kDynLds, stream);
    if (e != hipSuccess) fprintf(stderr, "cooperative launch failed: %s (grid %d)\n", hipGetErrorString(e), grid_blocks);
#else
    for (int ph = 0; ph < NPHASE; ++ph) {
        p.ph_lo = ph; p.ph_hi = ph + 1;
        hipLaunchKernelGGL(mega, dim3(grid_blocks), dim3(512), kDynLds, stream, p);
    }
#endif
}
```

```cpp
#include <hip/hip_runtime.h>
#include <hip/hip_cooperative_groups.h>
#include <cstdio>
namespace cg = cooperative_groups;

#ifndef PH_MAX
#define PH_MAX 13
#endif
#ifndef COOP
#define COOP 1
#endif

typedef unsigned short bf16_t;
typedef short bf16x8 __attribute__((ext_vector_type(8)));
typedef float f32x4 __attribute__((ext_vector_type(4)));
typedef unsigned u32x4 __attribute__((ext_vector_type(4)));
typedef unsigned u32x2 __attribute__((ext_vector_type(2)));
#define LAS __attribute__((address_space(3)))
#define DEVI __device__ __forceinline__

constexpr int TT = 2048, NBP = 8, MP = 16384, MS = 128, DM = 1024;
constexpr size_t MiB = (size_t)1 << 20;
constexpr size_t O_YP = 0, O_YS = 16777216, O_RETP = 16908288, O_RETS = 17956864, O_S5RP = 34734080, O_S5IP = 34766848,
                 O_S5RS = 34799616, O_S5IS = 35323904, O_HGP = 35848192, O_HGS = 36896768;
constexpr size_t WS_WIN0T = 0, WS_BT1 = 10 * MiB, WS_KT = 18 * MiB, WS_WGLUT = 34 * MiB, WS_WOUT0T = 36 * MiB, WS_WIN1T = 40 * MiB,
                 WS_BT2 = 48 * MiB, WS_Q = 60 * MiB, WS_KN = 76 * MiB, WS_VT = 92 * MiB, WS_SGA = 124 * MiB, WS_SGB = 156 * MiB,
                 WS_A2 = 188 * MiB, WS_Y5 = 0, WS_X1B = 60 * MiB, WS_SG1 = 0, WS_Q1 = 96 * MiB, WS_CUM = 128 * MiB, WS_IT = 192 * MiB,
                 WS_HKV = 32 * MiB;
constexpr size_t WS_MISC = 240 * MiB;
constexpr size_t WS_WOUT1T = WS_MISC;
constexpr size_t WS_ROPE = WS_MISC + 2 * MiB;
constexpr size_t WS_SSQ1 = WS_ROPE + 1280 * 1024;
constexpr size_t WS_SSQ2 = WS_SSQ1 + MiB;
constexpr size_t WS_H0S = WS_SSQ2 + MiB;
constexpr size_t WS_ZS = WS_H0S + 512 * 1024;
constexpr size_t WS_Y5S = WS_ZS + 2560 * 1024;
constexpr size_t WS_MIX0S = WS_Y5S + 512 * 1024;
constexpr size_t WS_X1S = WS_MIX0S + MiB;
constexpr size_t WS_X1SB = WS_X1S + 512 * 1024;
constexpr size_t WS_Z1S = WS_X1SB + 512 * 1024;
constexpr size_t WS_O1S = WS_Z1S + 2 * MiB;
constexpr size_t WS_BBG = WS_O1S + 512 * 1024;
constexpr size_t WS_LAM1 = WS_BBG + 512 * 1024;
constexpr size_t WS_LAM16 = WS_LAM1 + 32 * 1024;
constexpr size_t WS_LB = WS_LAM16 + 32 * 1024;
constexpr size_t WS_SSQ1S = WS_LB + 4096;
constexpr size_t WS_SSQ2S = WS_SSQ1S + MiB;
constexpr size_t WS_END = WS_SSQ2S + MiB;
static_assert(WS_END <= 256 * MiB, "workspace overflow");

struct Params {
    const float *xp, *xs, *sret, *s5r, *s5i, *shg, *normw, *fnormw, *win0, *gnw, *lamre, *lamim, *logdt, *bre, *bim, *cre, *cim, *s5d,
        *gluw, *glub, *wout0, *win1, *hglb, *hgnw, *wout1;
    float* out;
    char* ws;
    int ph_lo, ph_hi;
};

DEVI bf16_t f2bf(float f) { unsigned u = __float_as_uint(f); u += 0x7FFFu + ((u >> 16) & 1u); return (bf16_t)(u >> 16); }
DEVI float bf2f(bf16_t b) { return __uint_as_float(((unsigned)b) << 16); }
DEVI unsigned pack2(float lo, float hi) { return (unsigned)f2bf(lo) | ((unsigned)f2bf(hi) << 16); }
DEVI float bflo(unsigned w) { return __uint_as_float(w << 16); }
DEVI float bfhi(unsigned w) { return __uint_as_float(w & 0xffff0000u); }
DEVI float sigm(float x) { return 1.f / (1.f + __expf(-x)); }
DEVI float silu_(float x) { return x * sigm(x); }
DEVI float gelu_(float x) { float u = 1.5957691216f * (x + 0.044715f * x * x * x); return x / (1.f + __expf(-u)); }
DEVI u32x2 pack4(f32x4 v) { u32x2 r; r.x = pack2(v[0], v[1]); r.y = pack2(v[2], v[3]); return r; }
DEVI float wave_sum(float v) {
#pragma unroll
    for (int o = 32; o > 0; o >>= 1) v += __shfl_xor(v, o);
    return v;
}
DEVI float grp16_sum(float v) { v += __shfl_xor(v, 1); v += __shfl_xor(v, 2); v += __shfl_xor(v, 4); v += __shfl_xor(v, 8); return v; }
DEVI f32x4 mfma16(bf16x8 a, bf16x8 b, f32x4 c) { return __builtin_amdgcn_mfma_f32_16x16x32_bf16(a, b, c, 0, 0, 0); }
DEVI float row_rstd16(const float* ssq, size_t row) {
    const f32x4 a = *(const f32x4*)(ssq + row * 4), b = *(const f32x4*)(ssq + (MP + row) * 4), c = *(const f32x4*)(ssq + (2 * (size_t)MP + row) * 4), d = *(const f32x4*)(ssq + (3 * (size_t)MP + row) * 4);
    float s = (a[0] + a[1] + a[2] + a[3]) + (b[0] + b[1] + b[2] + b[3]) + (c[0] + c[1] + c[2] + c[3]) + (d[0] + d[1] + d[2] + d[3]);
    return rsqrtf(s * (1.0f / 1024.0f) + 1e-6f);
}

constexpr int BM = 256, BK = 64, HALF = 128, HTB = HALF * BK * 2, NXCD = 8, WGM = 8;
DEVI int lds_byte(int r, int c) { const int st = (r >> 4) * 2 + (c >> 5), rr = r & 15, cc = c & 31, ob = rr * 64 + cc * 2; return st * 1024 + (ob ^ (((ob >> 9) & 1) << 5)); }
DEVI void stage_rc(int b, int& R, int& C) { const int st = b / 1024, sb = b % 1024, swz = sb ^ (((sb >> 9) & 1) << 5); R = (st >> 1) * 16 + swz / 64; C = (st & 1) * 32 + (swz % 64) / 2; }

enum { K_Q = 0, K_K, K_VT, K_GA, K_U, K_GB, K_SIN0, K_E5, K_Y5, K_GLU, K_SGLU, K_OUT0, K_SOUT0, K_Q1, K_F, K_IT, K_G1, K_SIN1, K_OUT1, K_SOUT1 };
enum { L_IN0 = 0, L_IN0S, L_GA, L_GB, L_GLU, L_GLUS, L_OUT0, L_OUT0S, L_IN1, L_IN1S, L_OUT1, L_OUT1S };

struct Unit { const char* a; const char* b; int kind, pm, pn; };

DEVI void static_order(int L, int nM, int nN, int& pm, int& pn) {
    const int nwg = nM * nN; int wgid = L;
    { const int q = nwg / NXCD, r = nwg % NXCD, xcd = wgid % NXCD, off = wgid / NXCD; wgid = (xcd < r ? xcd * (q + 1) : r * (q + 1) + (xcd - r) * q) + off; }
    const int nig = WGM * nN, gid = wgid / nig, fm = gid * WGM, gsz = (nM - fm) < WGM ? (nM - fm) : WGM;
    pm = fm + ((wgid % nig) % gsz); pn = (wgid % nig) / gsz;
}

struct Sched {
    int list, G, c; char* wsp; float* outp;
    DEVI bool next(int i, Unit& u) const {
        const int L = i * G + c; const char* ws = wsp;
        switch (list) {
        case L_IN0: {
            if (L >= 1280) return false; int pm, pn; static_order(L, 64, 20, pm, pn); u.pm = pm; u.pn = pn;
            const char* h0 = (const char*)(outp + O_RETS);
            if (pn >= 4 && pn < 8) { u.kind = K_VT; u.a = ws + WS_WIN0T + (size_t)(1024 + 256 * (pn - 4)) * 2048; u.b = h0 + (size_t)pm * 256 * 2048; }
            else { u.kind = pn < 2 ? K_Q : pn < 4 ? K_K : pn < 12 ? K_GA : pn < 16 ? K_U : K_GB; u.a = h0 + (size_t)pm * 256 * 2048; u.b = ws + WS_WIN0T + (size_t)pn * 256 * 2048; }
            return true; }
        case L_IN0S: if (L >= 20) return false; u.pm = 0; u.pn = L; u.kind = K_SIN0; u.a = ws + WS_H0S; u.b = ws + WS_WIN0T + (size_t)L * 256 * 2048; return true;
        case L_GA: if (L >= 256) return false; u.pm = L & 3; u.pn = L >> 2; u.kind = K_E5; u.a = ws + WS_A2 + ((size_t)(L >> 2) * 1024 + (L & 3) * 256) * 768; u.b = ws + WS_BT1 + (size_t)(L >> 2) * 256 * 512; return true;
        case L_GB: if (L >= 256) return false; u.pm = L & 3; u.pn = L >> 2; u.kind = K_Y5; u.a = ws + WS_A2 + ((size_t)(L >> 2) * 1024 + (L & 3) * 256) * 768; u.b = ws + WS_BT2 + (size_t)(L >> 2) * 256 * 768; return true;
        case L_GLU: { if (L >= 256) return false; int pm, pn; static_order(L, 64, 4, pm, pn); u.pm = pm; u.pn = pn; u.kind = K_GLU; u.a = ws + WS_Y5 + (size_t)pm * 256 * 32; u.b = ws + WS_WGLUT + (size_t)pn * 256 * 2048; return true; }
        case L_GLUS: if (L >= 4) return false; u.pm = 0; u.pn = L; u.kind = K_SGLU; u.a = ws + WS_Y5S; u.b = ws + WS_WGLUT + (size_t)L * 256 * 2048; return true;
        case L_OUT0: { if (L >= 256) return false; int pm, pn; static_order(L, 64, 4, pm, pn); u.pm = pm; u.pn = pn; u.kind = K_OUT0; u.a = (const char*)(outp + O_HGS) + (size_t)pm * 256 * 4096; u.b = ws + WS_WOUT0T + (size_t)pn * 256 * 4096; return true; }
        case L_OUT0S: if (L >= 4) return false; u.pm = 0; u.pn = L; u.kind = K_SOUT0; u.a = ws + WS_MIX0S; u.b = ws + WS_WOUT0T + (size_t)L * 256 * 4096; return true;
        case L_IN1: {
            if (L >= 1024) return false; int pm, pn; static_order(L, 64, 16, pm, pn); u.pm = pm; u.pn = pn;
            if (pn >= 8 && pn < 12) { u.kind = K_IT; u.a = ws + WS_WIN1T + (size_t)(256 * pn) * 2048; u.b = ws + WS_X1B + (size_t)pm * 256 * 2048; }
            else { u.kind = pn < 4 ? K_Q1 : pn < 8 ? K_F : K_G1; u.a = ws + WS_X1B + (size_t)pm * 256 * 2048; u.b = ws + WS_WIN1T + (size_t)pn * 256 * 2048; }
            return true; }
        case L_IN1S: if (L >= 16) return false; u.pm = 0; u.pn = L; u.kind = K_SIN1; u.a = ws + WS_X1SB; u.b = ws + WS_WIN1T + (size_t)L * 256 * 2048; return true;
        case L_OUT1: { if (L >= 256) return false; int pm, pn; static_order(L, 64, 4, pm, pn); u.pm = pm; u.pn = pn; u.kind = K_OUT1; u.a = ws + WS_Q1 + (size_t)pm * 256 * 2048; u.b = ws + WS_WOUT1T + (size_t)pn * 256 * 2048; return true; }
        case L_OUT1S: if (L >= 4) return false; u.pm = 0; u.pn = L; u.kind = K_SOUT1; u.a = ws + WS_O1S; u.b = ws + WS_WOUT1T + (size_t)L * 256 * 2048; return true;
        }
        return false;
    }
};

DEVI void epilogue(const Params& p, const f32x4 (&acc)[2][2][4][2], const Unit& u, int wr, int wc, int fr, int fq) {
    char* ws = p.ws;
    const int kind = u.kind;
    if (kind == K_Q || kind == K_K) {
        const float* rope = (const float*)(ws + WS_ROPE);
        bf16_t* dst = (bf16_t*)(ws + (kind == K_Q ? WS_Q : WS_KN));
        bf16_t* kt = (bf16_t*)(ws + WS_KT);
        const int tq = kind == K_Q ? u.pn : u.pn - 2;
        const float sc = kind == K_Q ? 1.0f : 0.08838834764831845f;
#pragma unroll
        for (int ai = 0; ai < 2; ++ai)
#pragma unroll
            for (int m = 0; m < 4; ++m) {
                const int token = u.pm * 256 + ai * 128 + wr * 64 + m * 16 + fr, pos = token & 2047;
#pragma unroll
                for (int n = 0; n < 2; ++n) {
                    const int w = wc * 32 + n * 16 + fq * 4, hl = w >> 6, j = w & 63, head = 2 * tq + hl;
                    const f32x4 cs = *(const f32x4*)(rope + pos * 128 + j), sn = *(const f32x4*)(rope + pos * 128 + 64 + j);
                    const f32x4 x1 = acc[ai][0][m][n], x2 = acc[ai][1][m][n];
                    const f32x4 y1 = (x1 * cs - x2 * sn) * sc, y2 = (x1 * sn + x2 * cs) * sc;
                    bf16_t* d = dst + (size_t)token * 512 + head * 128 + j;
                    *(u32x2*)d = pack4(y1); *(u32x2*)(d + 64) = pack4(y2);
                    if (kind == K_K) {
                        const int b = token >> 11, t = token & 2047;
                        bf16_t* kk = kt + ((size_t)(b * 4 + head) * 128 + j) * 2048 + t;
#pragma unroll
                        for (int i = 0; i < 4; ++i) { kk[(size_t)i * 2048] = f2bf(y1[i]); kk[(size_t)(64 + i) * 2048] = f2bf(y2[i]); }
                    }
                }
            }
    } else if (kind == K_VT || kind == K_IT) {
        const bool isv = kind == K_VT;
        const float* ssq = (const float*)(ws + WS_SSQ1);
        bf16_t* dst = (bf16_t*)(ws + (isv ? WS_VT : WS_IT));
#pragma unroll
        for (int bj = 0; bj < 2; ++bj)
#pragma unroll
            for (int n = 0; n < 2; ++n) {
                const int token = u.pm * 256 + bj * 128 + wc * 32 + n * 16 + fq * 4, b = token >> 11, t = token & 2047;
                f32x4 rs = {1.f, 1.f, 1.f, 1.f};
                if (!isv) { rs[0] = row_rstd16(ssq, token); rs[1] = row_rstd16(ssq, token + 1); rs[2] = row_rstd16(ssq, token + 2); rs[3] = row_rstd16(ssq, token + 3); }
#pragma unroll
                for (int ai = 0; ai < 2; ++ai)
#pragma unroll
                    for (int m = 0; m < 4; ++m) {
                        const int row = ai * 128 + wr * 64 + m * 16 + fr;
                        size_t off;
                        if (isv) off = ((size_t)(b * 4 + (u.pn - 4)) * 256 + row) * 2048 + t;
                        else { const int eg = (u.pn - 8) * 256 + row; off = ((size_t)(b * 8 + (eg >> 7)) * 128 + (eg & 127)) * 2048 + t; }
                        *(u32x2*)(dst + off) = pack4(acc[ai][bj][m][n] * rs);
                    }
            }
    } else if (kind == K_GA || kind == K_GB || kind == K_U) {
#pragma unroll
        for (int ai = 0; ai < 2; ++ai)
#pragma unroll
            for (int m = 0; m < 4; ++m) {
                const int token = u.pm * 256 + ai * 128 + wr * 64 + m * 16 + fr;
#pragma unroll
                for (int bj = 0; bj < 2; ++bj)
#pragma unroll
                    for (int n = 0; n < 2; ++n) {
                        const int cl = bj * 128 + wc * 32 + n * 16 + fq * 4;
                        f32x4 v = acc[ai][bj][m][n];
                        if (kind == K_U) {
                            const int cu = (u.pn - 12) * 256 + cl, g = cu >> 4, c = cu & 15;
                            bf16_t* d = (bf16_t*)(ws + WS_A2) + ((size_t)g * 1024 + (token >> 4)) * 384 + (token & 15) * 16 + c;
                            *(u32x2*)d = pack4(v);
                        } else {
                            v[0] = silu_(v[0]); v[1] = silu_(v[1]); v[2] = silu_(v[2]); v[3] = silu_(v[3]);
                            bf16_t* d = (bf16_t*)(ws + (kind == K_GA ? WS_SGA : WS_SGB)) + (size_t)token * 1024 + (u.pn - (kind == K_GA ? 8 : 16)) * 256 + cl;
                            *(u32x2*)d = pack4(v);
                        }
                    }
            }
    } else if (kind == K_SIN0) {
        const float* rope = (const float*)(ws + WS_ROPE) + 2048 * 128;
        float* zs = (float*)(ws + WS_ZS);
#pragma unroll
        for (int m = 0; m < 4; ++m) {
            const int row = wr * 64 + m * 16 + fr;
            if (u.pn < 4) {
                const float sc = u.pn < 2 ? 1.0f : 0.08838834764831845f;
#pragma unroll
                for (int n = 0; n < 2; ++n) {
                    const int w = wc * 32 + n * 16 + fq * 4, hl = w >> 6, j = w & 63;
                    const f32x4 cs = *(const f32x4*)(rope + j), sn = *(const f32x4*)(rope + 64 + j);
                    const f32x4 x1 = acc[0][0][m][n], x2 = acc[0][1][m][n];
                    float* d = zs + (size_t)row * 5120 + u.pn * 256 + hl * 128 + j;
                    *(f32x4*)d = (x1 * cs - x2 * sn) * sc; *(f32x4*)(d + 64) = (x1 * sn + x2 * cs) * sc;
                }
            } else {
                const bool gate = (u.pn >= 8 && u.pn < 12) || u.pn >= 16;
#pragma unroll
                for (int bj = 0; bj < 2; ++bj)
#pragma unroll
                    for (int n = 0; n < 2; ++n) {
                        f32x4 v = acc[0][bj][m][n];
                        if (gate) { v[0] = silu_(v[0]); v[1] = silu_(v[1]); v[2] = silu_(v[2]); v[3] = silu_(v[3]); }
                        *(f32x4*)(zs + (size_t)row * 5120 + u.pn * 256 + bj * 128 + wc * 32 + n * 16 + fq * 4) = v;
                    }
            }
        }
    } else if (kind == K_E5) {
        float* e5 = (float*)(p.out + O_HGS);
#pragma unroll
        for (int ai = 0; ai < 2; ++ai)
#pragma unroll
            for (int m = 0; m < 4; ++m) {
                const int row = u.pm * 256 + ai * 128 + wr * 64 + m * 16 + fr;
#pragma unroll
                for (int n = 0; n < 2; ++n) *(f32x4*)(e5 + ((size_t)u.pn * 1024 + row) * 128 + wc * 32 + n * 16 + fq * 4) = acc[ai][0][m][n];
            }
    } else if (kind == K_Y5) {
        const bf16_t* a2 = (const bf16_t*)(ws + WS_A2);
        bf16_t* y5 = (bf16_t*)(ws + WS_Y5);
        const int g = u.pn;
#pragma unroll
        for (int ai = 0; ai < 2; ++ai)
#pragma unroll
            for (int m = 0; m < 4; ++m) {
                const int row = u.pm * 256 + ai * 128 + wr * 64 + m * 16 + fr;
#pragma unroll
                for (int bj = 0; bj < 2; ++bj)
#pragma unroll
                    for (int n = 0; n < 2; ++n) {
                        const int col = bj * 128 + wc * 32 + n * 16 + fq * 4, c = col & 15;
                        const u32x2 uu = *(const u32x2*)(a2 + ((size_t)g * 1024 + row) * 384 + col);
                        const f32x4 dd = *(const f32x4*)(p.s5d + g * 16 + c);
                        f32x4 v = acc[ai][bj][m][n];
                        v[0] = gelu_(v[0] + dd[0] * bflo(uu.x)); v[1] = gelu_(v[1] + dd[1] * bfhi(uu.x));
                        v[2] = gelu_(v[2] + dd[2] * bflo(uu.y)); v[3] = gelu_(v[3] + dd[3] * bfhi(uu.y));
                        *(u32x2*)(y5 + ((size_t)g * 1024 + row) * 256 + col) = pack4(v);
                    }
            }
    } else if (kind == K_GLU || kind == K_SGLU) {
        const bool smp = kind == K_SGLU;
        const bf16_t* y5 = (const bf16_t*)(ws + (smp ? WS_Y5S : WS_Y5));
        const bf16_t* sgb = (const bf16_t*)(ws + WS_SGB);
        const float* zs = (const float*)(ws + WS_ZS);
        bf16_t* mix = smp ? (bf16_t*)(ws + WS_MIX0S) : (bf16_t*)(p.out + O_HGS);
#pragma unroll
        for (int ai = 0; ai < 2; ++ai) {
            if (smp && ai) break;
#pragma unroll
            for (int m = 0; m < 4; ++m) {
                const size_t token = (size_t)u.pm * 256 + ai * 128 + wr * 64 + m * 16 + fr;
#pragma unroll
                for (int bj = 0; bj < 2; ++bj)
#pragma unroll
                    for (int n = 0; n < 2; ++n) {
                        const int col = u.pn * 256 + bj * 128 + wc * 32 + n * 16 + fq * 4;
                        const f32x4 bb = *(const f32x4*)(p.glub + col);
                        const u32x2 yy = smp ? *(const u32x2*)(y5 + token * 1024 + col) : *(const u32x2*)(y5 + ((size_t)(col >> 4) * MP + token) * 16 + (col & 15));
                        f32x4 gg;
                        if (smp) gg = *(const f32x4*)(zs + token * 5120 + 4096 + col);
                        else { const u32x2 t = *(const u32x2*)(sgb + token * 1024 + col); gg[0] = bflo(t.x); gg[1] = bfhi(t.x); gg[2] = bflo(t.y); gg[3] = bfhi(t.y); }
                        f32x4 v = acc[ai][bj][m][n] + bb;
                        v[0] = bflo(yy.x) * sigm(v[0]) * gg[0]; v[1] = bfhi(yy.x) * sigm(v[1]) * gg[1];
                        v[2] = bflo(yy.y) * sigm(v[2]) * gg[2]; v[3] = bfhi(yy.y) * sigm(v[3]) * gg[3];
                        *(u32x2*)(mix + token * 2048 + 1024 + col) = pack4(v);
                    }
            }
        }
    } else if (kind == K_OUT0 || kind == K_SOUT0 || kind == K_OUT1 || kind == K_SOUT1) {
        const bool smp = kind == K_SOUT0 || kind == K_SOUT1, l0 = kind == K_OUT0 || kind == K_SOUT0;
        const float* res = l0 ? (smp ? p.xs : p.xp) : (smp ? (const float*)(ws + WS_X1S) : p.out + O_YP);
        float* dst = l0 ? (smp ? (float*)(ws + WS_X1S) : p.out + O_YP) : (smp ? p.out + O_YS : p.out + O_YP);
        bf16_t* dstb = (bf16_t*)(ws + (smp ? WS_X1SB : WS_X1B));
        float* ssq = (float*)(ws + (l0 ? (smp ? WS_SSQ1S : WS_SSQ1) : (smp ? WS_SSQ2S : WS_SSQ2)));
#pragma unroll
        for (int ai = 0; ai < 2; ++ai) {
            if (smp && ai) break;
#pragma unroll
            for (int m = 0; m < 4; ++m) {
                const size_t token = (size_t)u.pm * 256 + ai * 128 + wr * 64 + m * 16 + fr;
                float s = 0.f;
#pragma unroll
                for (int bj = 0; bj < 2; ++bj)
#pragma unroll
                    for (int n = 0; n < 2; ++n) {
                        const int col = u.pn * 256 + bj * 128 + wc * 32 + n * 16 + fq * 4;
                        const f32x4 v = acc[ai][bj][m][n] + *(const f32x4*)(res + token * 1024 + col);
                        *(f32x4*)(dst + token * 1024 + col) = v;
                        if (l0) *(u32x2*)(dstb + token * 1024 + col) = pack4(v);
                        s += v[0] * v[0] + v[1] * v[1] + v[2] * v[2] + v[3] * v[3];
                    }
                s += __shfl_xor(s, 16); s += __shfl_xor(s, 32);
                if (fq == 0) ssq[((size_t)u.pn * MP + token) * 4 + wc] = s;
            }
        }
    } else if (kind == K_Q1 || kind == K_F || kind == K_G1) {
        const float* ssq = (const float*)(ws + WS_SSQ1);
        const float* lb = (const float*)(ws + WS_LB);
#pragma unroll
        for (int ai = 0; ai < 2; ++ai)
#pragma unroll
            for (int m = 0; m < 4; ++m) {
                const size_t token = (size_t)u.pm * 256 + ai * 128 + wr * 64 + m * 16 + fr;
                const float r = row_rstd16(ssq, token);
#pragma unroll
                for (int bj = 0; bj < 2; ++bj)
#pragma unroll
                    for (int n = 0; n < 2; ++n) {
                        const int cl = (u.pn & 3) * 256 + bj * 128 + wc * 32 + n * 16 + fq * 4;
                        f32x4 v = acc[ai][bj][m][n] * r;
                        if (kind == K_F) {
                            const f32x4 l = *(const f32x4*)(lb + cl);
#pragma unroll
                            for (int i = 0; i < 4; ++i) v[i] = __logf(l[i] + (1.f - l[i]) * sigm(v[i]));
                            *(f32x4*)((float*)(ws + WS_CUM) + token * 1024 + cl) = v;
                        } else {
                            v[0] = silu_(v[0]); v[1] = silu_(v[1]); v[2] = silu_(v[2]); v[3] = silu_(v[3]);
                            *(u32x2*)((bf16_t*)(ws + (kind == K_Q1 ? WS_Q1 : WS_SG1)) + token * 1024 + cl) = pack4(v);
                        }
                    }
            }
    } else if (kind == K_SIN1) {
        const float* ssq = (const float*)(ws + WS_SSQ1S);
        const float* lb = (const float*)(ws + WS_LB);
        float* z1 = (float*)(ws + WS_Z1S);
#pragma unroll
        for (int m = 0; m < 4; ++m) {
            const size_t row = wr * 64 + m * 16 + fr;
            const float r = row_rstd16(ssq, row);
            const int ty = u.pn >> 2;
#pragma unroll
            for (int bj = 0; bj < 2; ++bj)
#pragma unroll
                for (int n = 0; n < 2; ++n) {
                    const int cl = (u.pn & 3) * 256 + bj * 128 + wc * 32 + n * 16 + fq * 4;
                    f32x4 v = acc[0][bj][m][n] * r;
                    if (ty == 1) { const f32x4 l = *(const f32x4*)(lb + cl);
#pragma unroll
                        for (int i = 0; i < 4; ++i) v[i] = l[i] + (1.f - l[i]) * sigm(v[i]); }
                    else if (ty != 2) { v[0] = silu_(v[0]); v[1] = silu_(v[1]); v[2] = silu_(v[2]); v[3] = silu_(v[3]); }
                    *(f32x4*)(z1 + row * 4096 + ty * 1024 + cl) = v;
                }
        }
    }
}

DEVI void gemm_phase(const int TIDX, LAS unsigned char* lds, const int K, const int lda, const int ldb, const bool ga, const Sched S, const Params& P) {
    const int tid = TIDX, wid = __builtin_amdgcn_readfirstlane(tid >> 6), lane = tid & 63, wr = wid >> 2, wc = wid & 3, fr = lane & 15, fq = lane >> 4;
    const int nt = K / BK;
    unsigned voffA[2], voffB[2];
#pragma unroll
    for (int i = 0; i < 2; ++i) { int R, C; stage_rc(tid * 16 + i * 8192, R, C); voffA[i] = ga ? (unsigned)(R * 32 + (C >> 4) * (MP * 32) + (C & 15) * 2) : (unsigned)(R * lda + C) * 2u; voffB[i] = (unsigned)(R * ldb + C) * 2u; }
    const size_t kstep = (size_t)(BK * 2), kstepA = ga ? (size_t)4 * MP * 32 : kstep;
    const size_t hstepA = ga ? (size_t)HALF * 32 : (size_t)HALF * lda * 2, hstepB = (size_t)HALF * ldb * 2;
    const unsigned ldsw = (unsigned)wid * 1024u;
    const int aoff = lds_byte(wr * 64 + fr, fq * 8), boff = lds_byte(wc * 32 + fr, fq * 8);
#define PG8_SA(b, h) (((b) * 2 + (h)) * HTB)
#define PG8_SB(b, h) ((4 + (b) * 2 + (h)) * HTB)
#define PG8_STAGE(bufoff, gbase, voff) do { _Pragma("unroll") for (int _i = 0; _i < 2; ++_i) \
        __builtin_amdgcn_global_load_lds((const unsigned*)((const char*)(gbase) + (voff)[_i]), (LAS unsigned*)(lds + (bufoff) + ldsw + _i * 8192), 16, 0, 0); } while (0)
#define PG8_LDA(dst, b, h) do { _Pragma("unroll") for (int m = 0; m < 4; ++m) _Pragma("unroll") for (int k = 0; k < 2; ++k) dst[m][k] = *(const LAS bf16x8*)(lds + PG8_SA(b, h) + aoff + m * 2048 + k * 1024); } while (0)
#define PG8_LDB(dst, b, h) do { _Pragma("unroll") for (int n = 0; n < 2; ++n) _Pragma("unroll") for (int k = 0; k < 2; ++k) dst[n][k] = *(const LAS bf16x8*)(lds + PG8_SB(b, h) + boff + n * 2048 + k * 1024); } while (0)
#define PG8_MMA(ai, bj, At, Bt) do { __builtin_amdgcn_s_setprio(1); _Pragma("unroll") for (int m = 0; m < 4; ++m) _Pragma("unroll") for (int n = 0; n < 2; ++n) _Pragma("unroll") for (int k = 0; k < 2; ++k) \
        acc[ai][bj][m][n] = __builtin_amdgcn_mfma_f32_16x16x32_bf16(Bt[n][k], At[m][k], acc[ai][bj][m][n], 0, 0, 0); __builtin_amdgcn_s_setprio(0); } while (0)
#define PG8_WAIT_V(n) asm volatile("s_waitcnt vmcnt(" #n ")" ::: "memory")
#define PG8_WAIT_L(n) asm volatile("s_waitcnt lgkmcnt(" #n ")" ::: "memory")
#define PG8_BAR __builtin_amdgcn_s_barrier()
#define PG8_SCHED __builtin_amdgcn_sched_barrier(0)
    Unit cur, nxt; int ui = 0;
    if (!S.next(0, cur)) return;
    f32x4 acc[2][2][4][2];
#pragma unroll
    for (int a = 0; a < 2; ++a)
#pragma unroll
        for (int b = 0; b < 2; ++b)
#pragma unroll
            for (int m = 0; m < 4; ++m)
#pragma unroll
                for (int n = 0; n < 2; ++n) acc[a][b][m][n] = (f32x4){0.f, 0.f, 0.f, 0.f};
    bf16x8 At[4][2], B0[2][2], B1[2][2];
    const char* cA = cur.a; const char* cB = cur.b;
    PG8_STAGE(PG8_SB(0, 0), cB, voffB); PG8_STAGE(PG8_SA(0, 0), cA, voffA); PG8_STAGE(PG8_SB(0, 1), cB + hstepB, voffB); PG8_STAGE(PG8_SA(0, 1), cA + hstepA, voffA);
    if (wr == 1) PG8_BAR;
    PG8_WAIT_V(4); PG8_BAR;
    PG8_STAGE(PG8_SB(1, 0), cB + kstep, voffB); PG8_STAGE(PG8_SA(1, 0), cA + kstepA, voffA); PG8_STAGE(PG8_SB(1, 1), cB + hstepB + kstep, voffB);
    PG8_WAIT_V(6); PG8_BAR;
    for (;;) {
        const bool has_next = S.next(ui + 1, nxt);
        const char* nA = has_next ? nxt.a : cA; const char* nB = has_next ? nxt.b : cB;
        for (int t = 0; t < nt; t += 2) {
            const bool last = (t == nt - 2);
            const char* a1 = cA + (size_t)(t + 1) * kstepA;
            const char* a2 = last ? nA : cA + (size_t)(t + 2) * kstepA; const char* b2 = last ? nB : cB + (size_t)(t + 2) * kstep;
            const char* a3 = a2 + kstepA; const char* b3 = b2 + kstep;
            PG8_LDB(B0, 0, 0); PG8_SCHED; PG8_LDA(At, 0, 0); PG8_STAGE(PG8_SA(1, 1), a1 + hstepA, voffA);
            PG8_WAIT_L(8); PG8_BAR; PG8_WAIT_L(0); PG8_MMA(0, 0, At, B0); PG8_BAR; PG8_SCHED;
            PG8_LDB(B1, 0, 1); PG8_STAGE(PG8_SB(0, 0), b2, voffB);
            PG8_BAR; PG8_WAIT_L(0); PG8_MMA(0, 1, At, B1); PG8_BAR;
            PG8_LDA(At, 0, 1); PG8_STAGE(PG8_SA(0, 0), a2, voffA);
            PG8_BAR; PG8_WAIT_L(0); PG8_MMA(1, 0, At, B0); PG8_BAR; PG8_SCHED;
            PG8_STAGE(PG8_SB(0, 1), b2 + hstepB, voffB);
            PG8_WAIT_V(6); PG8_BAR; PG8_MMA(1, 1, At, B1); PG8_BAR;
            PG8_LDB(B0, 1, 0); PG8_SCHED; PG8_LDA(At, 1, 0); PG8_STAGE(PG8_SA(0, 1), a2 + hstepA, voffA);
            PG8_WAIT_L(8); PG8_BAR; PG8_WAIT_L(0); PG8_MMA(0, 0, At, B0); PG8_BAR; PG8_SCHED;
            PG8_LDB(B1, 1, 1); PG8_STAGE(PG8_SB(1, 0), b3, voffB);
            PG8_BAR; PG8_WAIT_L(0); PG8_MMA(0, 1, At, B1); PG8_BAR;
            PG8_LDA(At, 1, 1); PG8_STAGE(PG8_SA(1, 0), a3, voffA);
            PG8_BAR; PG8_WAIT_L(0); PG8_MMA(1, 0, At, B0); PG8_BAR; PG8_SCHED;
            PG8_STAGE(PG8_SB(1, 1), b3 + hstepB, voffB);
            PG8_WAIT_V(6); PG8_BAR; PG8_MMA(1, 1, At, B1); PG8_BAR;
        }
        { int ozv; asm volatile("v_mov_b32 %0, 0" : "=v"(ozv)); epilogue(P, acc, cur, wr, wc, fr + ozv, fq + ozv); }
        if (!has_next) break;
#pragma unroll
        for (int a = 0; a < 2; ++a)
#pragma unroll
            for (int b = 0; b < 2; ++b)
#pragma unroll
                for (int m = 0; m < 4; ++m)
#pragma unroll
                    for (int n = 0; n < 2; ++n) acc[a][b][m][n] = (f32x4){0.f, 0.f, 0.f, 0.f};
        cur = nxt; cA = nA; cB = nB; ++ui;
    }
    PG8_WAIT_V(0);
    if (wr == 0) PG8_BAR;
    PG8_BAR;
}

DEVI void prep_transpose(const int TIDX, const int BIDX, float* tile, const float* src, int K, int N, bf16_t* dst, const float* kscale, bool permqk, int job0, int& jobbase, int gsz) {
    (void)tile;
    const int nk8 = K / 8, ntn = N / 64, njobs = ntn * (nk8 / 8), lane = TIDX & 63, wid = TIDX >> 6;
    for (int jb = job0 - jobbase; jb < njobs; jb += gsz) {
        if (jb < 0) continue;
        const int tn = jb / (nk8 / 8), tk = jb % (nk8 / 8), n0 = tn * 64, k0 = tk * 64 + wid * 8;
        int c0 = n0;
        if (permqk && n0 < 1024) { const int tile_ = n0 >> 8, cp = n0 & 255, bj = cp >> 7, w = cp & 127; c0 = tile_ * 256 + (w >> 6) * 128 + bj * 64; }
        float v[8];
#pragma unroll
        for (int j = 0; j < 8; ++j) v[j] = src[(size_t)(k0 + j) * N + c0 + lane] * (kscale ? kscale[k0 + j] : 1.f);
        u32x4 o; o.x = pack2(v[0], v[1]); o.y = pack2(v[2], v[3]); o.z = pack2(v[4], v[5]); o.w = pack2(v[6], v[7]);
        *(u32x4*)(dst + (size_t)(n0 + lane) * K + k0) = o;
    }
    jobbase += njobs;
}

DEVI void prep_s5_tables(const int TIDX, const int BIDX, float* L, const Params& p, int g) {
    float* pwr = L;
    float* pwi = pwr + 17 * 64;
    float* bbr = pwi + 17 * 64;
    float* bbi = bbr + 1024;
    float* cr = bbi + 1024;
    float* ci = cr + 1024;
    float* kg = ci + 1024;
    const int tid = TIDX;
    char* ws = p.ws;
    __syncthreads();
    {
        const double dt = exp((double)p.logdt[g]);
        for (int i = tid; i < 17 * 64; i += 512) {
            const int t = i >> 6, pp = i & 63;
            const double lr = p.lamre[g * 64 + pp], li = p.lamim[g * 64 + pp];
            const double mag = exp(lr * dt * t), ang = li * dt * t;
            pwr[t * 64 + pp] = (float)(mag * cos(ang)); pwi[t * 64 + pp] = (float)(mag * sin(ang));
        }
        for (int i = tid; i < 1024; i += 512) {
            const int pp = i >> 4, c = i & 15;
            const double lr = p.lamre[g * 64 + pp], li = p.lamim[g * 64 + pp];
            const double mag = exp(lr * dt), ang = li * dt, lbr = mag * cos(ang), lbi = mag * sin(ang);
            const double nr = lbr - 1.0, den = lr * lr + li * li, fr = (nr * lr + lbi * li) / den, fi = (lbi * lr - nr * li) / den;
            const double br = p.bre[(g * 64 + pp) * 16 + c], bi = p.bim[(g * 64 + pp) * 16 + c];
            const float xr = (float)(fr * br - fi * bi), xi = (float)(fr * bi + fi * br);
            bbr[i] = xr; bbi[i] = xi;
            float* bbg = (float*)(ws + WS_BBG); bbg[(g * 1024 + i) * 2] = xr; bbg[(g * 1024 + i) * 2 + 1] = xi;
            if (c == 0) { float* lam1 = (float*)(ws + WS_LAM1); lam1[(g * 64 + pp) * 2] = (float)lbr; lam1[(g * 64 + pp) * 2 + 1] = (float)lbi; }
        }
    }
    __syncthreads();
    if (tid < 64) { float* lam16 = (float*)(ws + WS_LAM16); lam16[(g * 64 + tid) * 2] = pwr[16 * 64 + tid]; lam16[(g * 64 + tid) * 2 + 1] = pwi[16 * 64 + tid]; }
    for (int i = tid; i < 1024; i += 512) { cr[i] = p.cre[g * 1024 + i]; ci[i] = p.cim[g * 1024 + i]; }
    __syncthreads();
    for (int i = tid; i < 4096; i += 512) {
        const int tau = i >> 8, c = (i >> 4) & 15, cp = i & 15;
        float s = 0.f;
        for (int pp = 0; pp < 64; ++pp) {
            const float a = pwr[tau * 64 + pp], b = pwi[tau * 64 + pp], xr = bbr[pp * 16 + cp], xi = bbi[pp * 16 + cp];
            s += cr[c * 64 + pp] * (a * xr - b * xi) - ci[c * 64 + pp] * (a * xi + b * xr);
        }
        kg[i] = s;
    }
    __syncthreads();
    bf16_t* bt2 = (bf16_t*)(ws + WS_BT2) + (size_t)g * 256 * 384;
    for (int i = tid; i < 256 * 48; i += 512) {
        const int n = i / 48, k8 = (i % 48) * 8, t = n >> 4, c = n & 15;
        float v[8];
#pragma unroll
        for (int j = 0; j < 8; ++j) {
            const int k = k8 + j;
            if (k < 256) { const int s = k >> 4, cp = k & 15; v[j] = t >= s ? kg[(t - s) * 256 + c * 16 + cp] : 0.f; }
            else { const int q = k - 256, pp = q & 63; const float a = pwr[(t + 1) * 64 + pp], b = pwi[(t + 1) * 64 + pp];
                v[j] = q < 64 ? (cr[c * 64 + pp] * a - ci[c * 64 + pp] * b) : -(cr[c * 64 + pp] * b + ci[c * 64 + pp] * a); }
        }
        u32x4 o; o.x = pack2(v[0], v[1]); o.y = pack2(v[2], v[3]); o.z = pack2(v[4], v[5]); o.w = pack2(v[6], v[7]);
        *(u32x4*)(bt2 + (size_t)n * 384 + k8) = o;
    }
    bf16_t* bt1 = (bf16_t*)(ws + WS_BT1) + (size_t)g * 256 * 256;
    for (int i = tid; i < 256 * 32; i += 512) {
        const int n = i >> 5, k8 = (i & 31) * 8;
        float v[8];
#pragma unroll
        for (int j = 0; j < 8; ++j) {
            const int k = k8 + j, s = k >> 4, cp = k & 15;
            if (n >= 128) v[j] = 0.f;
            else { const int pp = n & 63; const float a = pwr[(15 - s) * 64 + pp], b = pwi[(15 - s) * 64 + pp], xr = bbr[pp * 16 + cp], xi = bbi[pp * 16 + cp];
                v[j] = n < 64 ? (a * xr - b * xi) : (a * xi + b * xr); }
        }
        u32x4 o; o.x = pack2(v[0], v[1]); o.y = pack2(v[2], v[3]); o.z = pack2(v[4], v[5]); o.w = pack2(v[6], v[7]);
        *(u32x4*)(bt1 + (size_t)n * 256 + k8) = o;
    }
}

DEVI void phase_prep(const int TIDX, const int BIDX, float* L, const Params& p) {
    const int tid = TIDX, bid = BIDX, G = gridDim.x, lane = tid & 63, wid = tid >> 6;
    char* ws = p.ws;
    for (int g = G - 1 - bid; g < 64; g += G) if (g >= 0) prep_s5_tables(TIDX, BIDX, L, p, g);
    __syncthreads();
    const int GT = G > 64 ? G - 64 : G;
    const int tb = (G > 64 && bid >= GT) ? (1 << 28) : bid;
    int jobbase = 0;
    prep_transpose(TIDX, BIDX, L, p.win0, 1024, 5120, (bf16_t*)(ws + WS_WIN0T), nullptr, true, tb, jobbase, GT);
    prep_transpose(TIDX, BIDX, L, p.gluw, 1024, 1024, (bf16_t*)(ws + WS_WGLUT), nullptr, false, tb, jobbase, GT);
    prep_transpose(TIDX, BIDX, L, p.wout0, 2048, 1024, (bf16_t*)(ws + WS_WOUT0T), nullptr, false, tb, jobbase, GT);
    prep_transpose(TIDX, BIDX, L, p.win1, 1024, 4096, (bf16_t*)(ws + WS_WIN1T), p.normw + 1024, false, tb, jobbase, GT);
    prep_transpose(TIDX, BIDX, L, p.wout1, 1024, 1024, (bf16_t*)(ws + WS_WOUT1T), nullptr, false, tb, jobbase, GT);
    bf16_t* h0 = (bf16_t*)(p.out + O_RETS); bf16_t* h0s = (bf16_t*)(ws + WS_H0S);
    for (int row = bid * 8 + wid; row < MP + 256; row += G * 8) {
        bf16_t* d = row < MP ? h0 + (size_t)row * 1024 : h0s + (size_t)(row - MP) * 1024;
        if (row >= MP + MS) { for (int i = 0; i < 4; ++i) *(u32x2*)(d + i * 256 + lane * 4) = (u32x2){0u, 0u}; continue; }
        const float* x = row < MP ? p.xp + (size_t)row * 1024 : p.xs + (size_t)(row - MP) * 1024;
        f32x4 v[4]; float s = 0.f;
#pragma unroll
        for (int i = 0; i < 4; ++i) { v[i] = *(const f32x4*)(x + i * 256 + lane * 4); s += v[i][0] * v[i][0] + v[i][1] * v[i][1] + v[i][2] * v[i][2] + v[i][3] * v[i][3]; }
        s = wave_sum(s);
        const float r = rsqrtf(s * (1.0f / 1024.0f) + 1e-6f);
#pragma unroll
        for (int i = 0; i < 4; ++i) { const f32x4 w = *(const f32x4*)(p.normw + i * 256 + lane * 4); *(u32x2*)(d + i * 256 + lane * 4) = pack4(v[i] * r * w); }
    }
    for (int i = bid * 512 + tid; i < 128 * 1024 / 8; i += G * 512) {
        const u32x4 z = {0u, 0u, 0u, 0u};
        *(u32x4*)((bf16_t*)(ws + WS_Y5S) + 128 * 1024 + (size_t)i * 8) = z;
        *(u32x4*)((bf16_t*)(ws + WS_X1SB) + 128 * 1024 + (size_t)i * 8) = z;
        *(u32x4*)((bf16_t*)(ws + WS_O1S) + 128 * 1024 + (size_t)i * 8) = z;
        *(u32x4*)((bf16_t*)(ws + WS_MIX0S) + 128 * 2048 + (size_t)i * 16) = z;
        *(u32x4*)((bf16_t*)(ws + WS_MIX0S) + 128 * 2048 + (size_t)i * 16 + 8) = z;
    }
    float* rope = (float*)(ws + WS_ROPE);
    for (int i = bid * 512 + tid; i < 2049 * 64; i += G * 512) {
        const int pr = i >> 6, j = i & 63; const double pos = pr == 2048 ? 16384.0 : (double)pr;
        const double inv = exp2(-(double)j * (13.287712379549449 / 64.0));
        const double rev = pos * inv * 0.15915494309189535; const double fr = rev - floor(rev); const double a = fr * 6.283185307179586;
        rope[pr * 128 + j] = (float)cos(a); rope[pr * 128 + 64 + j] = (float)sin(a);
    }
    float* lb = (float*)(ws + WS_LB);
    for (int i = bid * 512 + tid; i < 1024; i += G * 512) lb[i] = 1.f / (1.f + expf(p.hglb[i] - p.hglb[1024 + i]));
}

DEVI float ret_lg(int h) { return log1pf(-exp2f(-5.0f - (float)h)); }

DEVI void phase_R1(const int TIDX, const int BIDX, bf16_t* L, const Params& p) {
    const int tid = TIDX, wid = tid >> 6, lane = tid & 63, r16 = lane & 15, g = lane >> 4;
    const bf16_t* kt = (const bf16_t*)(p.ws + WS_KT); const bf16_t* vt = (const bf16_t*)(p.ws + WS_VT);
    float* kvt = p.out + O_YP;
    for (int it = BIDX; it < 512; it += gridDim.x) {
        const int bh = it >> 4, c = it & 15, h = bh & 3, t0 = c * 128; const float lg = ret_lg(h);
        __syncthreads();
        { const int d = tid >> 2, seg = tid & 3;
#pragma unroll
          for (int q = 0; q < 4; ++q) {
              const int l0 = seg * 32 + q * 8;
              const u32x4 v = *(const u32x4*)(kt + ((size_t)bh * 128 + d) * 2048 + t0 + l0);
              u32x4 o; const unsigned* vv = (const unsigned*)&v; unsigned* oo = (unsigned*)&o;
#pragma unroll
              for (int j = 0; j < 4; ++j) oo[j] = pack2(bflo(vv[j]) * __expf(lg * (float)(127 - l0 - 2 * j)), bfhi(vv[j]) * __expf(lg * (float)(126 - l0 - 2 * j)));
              *(u32x4*)(L + d * 136 + l0) = o; } }
        __syncthreads();
        bf16x8 bfr[2][4];
#pragma unroll
        for (int ct = 0; ct < 2; ++ct)
#pragma unroll
            for (int kk = 0; kk < 4; ++kk) bfr[ct][kk] = *(const bf16x8*)(vt + ((size_t)bh * 256 + wid * 32 + ct * 16 + r16) * 2048 + t0 + kk * 32 + g * 8);
#pragma unroll
        for (int rt = 0; rt < 8; ++rt) {
            f32x4 a0 = {0.f, 0.f, 0.f, 0.f}, a1 = a0;
#pragma unroll
            for (int kk = 0; kk < 4; ++kk) { const bf16x8 a = *(const bf16x8*)(L + (rt * 16 + r16) * 136 + kk * 32 + g * 8); a0 = mfma16(a, bfr[0][kk], a0); a1 = mfma16(a, bfr[1][kk], a1); }
            float* d0 = kvt + (((size_t)bh * 16 + c) * 256 + wid * 32 + r16) * 128 + rt * 16 + g * 4;
            *(f32x4*)d0 = a0; *(f32x4*)(d0 + 16 * 128) = a1;
        }
    }
}

DEVI void phase_R2(const int TIDX, const int BIDX, const Params& p) {
    float* kvt = p.out + O_YP;
    for (int i = BIDX * 512 + TIDX; i < 32 * 256 * 16; i += gridDim.x * 512) {
        const int q = i & 15, e = (i >> 4) & 255, bh = i >> 12, h = bh & 3; const float dec = __expf(ret_lg(h) * 128.f);
        f32x4 s0 = {0.f, 0.f, 0.f, 0.f}, s1 = s0;
#pragma unroll 4
        for (int c = 0; c < 16; ++c) {
            float* ptr = kvt + (((size_t)bh * 16 + c) * 256 + e) * 128 + q * 8;
            const f32x4 v0 = *(const f32x4*)ptr, v1 = *(const f32x4*)(ptr + 4);
            u32x4 o; o.x = pack2(s0[0], s0[1]); o.y = pack2(s0[2], s0[3]); o.z = pack2(s1[0], s1[1]); o.w = pack2(s1[2], s1[3]);
            *(u32x4*)ptr = o;
            s0 = s0 * dec + v0; s1 = s1 * dec + v1;
        }
        float* o = p.out + O_RETP + ((size_t)bh * 128 + q * 8) * 256 + e;
#pragma unroll
        for (int j = 0; j < 4; ++j) { o[(size_t)j * 256] = s0[j]; o[(size_t)(j + 4) * 256] = s1[j]; }
    }
}

DEVI void phase_R3(const int TIDX, const int BIDX, bf16_t* L, const Params& p) {
    const int tid = TIDX, wid = tid >> 6, lane = tid & 63, r16 = lane & 15, g = lane >> 4;
    const bf16_t* Q = (const bf16_t*)(p.ws + WS_Q); const bf16_t* KN = (const bf16_t*)(p.ws + WS_KN); const bf16_t* vt = (const bf16_t*)(p.ws + WS_VT);
    const bf16_t* sga = (const bf16_t*)(p.ws + WS_SGA); bf16_t* mix = (bf16_t*)(p.out + O_HGS);
    const float* kvt = p.out + O_YP;
    bf16_t* strip = L + wid * 16 * 136;
    for (int it = BIDX; it < 512; it += gridDim.x) {
        const int bh = it >> 4, c = it & 15, h = bh & 3, b = bh >> 2, l0 = wid * 16; const size_t tok0 = (size_t)b * 2048 + c * 128; const float lg = ret_lg(h);
        bf16x8 qa[4];
#pragma unroll
        for (int kk = 0; kk < 4; ++kk) qa[kk] = *(const bf16x8*)(Q + (tok0 + l0 + r16) * 512 + h * 128 + kk * 32 + g * 8);
        __syncthreads();
        for (int j = 0; j < 8; ++j) {
            f32x4 s = {0.f, 0.f, 0.f, 0.f};
            if (j <= wid) {
#pragma unroll
                for (int kk = 0; kk < 4; ++kk) s = mfma16(qa[kk], *(const bf16x8*)(KN + (tok0 + j * 16 + r16) * 512 + h * 128 + kk * 32 + g * 8), s);
            }
#pragma unroll
            for (int r = 0; r < 4; ++r) {
                const int li = l0 + g * 4 + r, mi = j * 16 + r16; const float v = (j <= wid && li >= mi) ? s[r] * __expf(lg * (float)(li - mi)) : 0.f;
                strip[(g * 4 + r) * 136 + mi] = f2bf(v);
            }
        }
        f32x4 acc[16];
#pragma unroll
        for (int jt = 0; jt < 16; ++jt) acc[jt] = (f32x4){0.f, 0.f, 0.f, 0.f};
        if (c > 0) {
            const float* sb = kvt + ((size_t)bh * 16 + c) * 256 * 128;
#pragma unroll
            for (int jt = 0; jt < 16; ++jt)
#pragma unroll
                for (int kk = 0; kk < 4; ++kk) acc[jt] = mfma16(qa[kk], *(const bf16x8*)(sb + (size_t)(jt * 16 + r16) * 128 + kk * 32 + g * 8), acc[jt]);
            float qd[4];
#pragma unroll
            for (int r = 0; r < 4; ++r) qd[r] = __expf(lg * (float)(l0 + g * 4 + r + 1));
#pragma unroll
            for (int jt = 0; jt < 16; ++jt)
#pragma unroll
                for (int r = 0; r < 4; ++r) acc[jt][r] *= qd[r];
        }
        __syncthreads();
        for (int kk = 0; kk <= (wid >> 1); ++kk) {
            const bf16x8 a = *(const bf16x8*)(strip + r16 * 136 + kk * 32 + g * 8);
#pragma unroll
            for (int jt = 0; jt < 16; ++jt) acc[jt] = mfma16(a, *(const bf16x8*)(vt + ((size_t)bh * 256 + jt * 16 + r16) * 2048 + c * 128 + kk * 32 + g * 8), acc[jt]);
        }
        float mu[4], rs[4];
#pragma unroll
        for (int r = 0; r < 4; ++r) {
            float s = 0.f;
#pragma unroll
            for (int jt = 0; jt < 16; ++jt) s += acc[jt][r];
            s = grp16_sum(s); mu[r] = s * (1.f / 256.f);
            float q = 0.f;
#pragma unroll
            for (int jt = 0; jt < 16; ++jt) { const float d = acc[jt][r] - mu[r]; q += d * d; }
            q = grp16_sum(q); rs[r] = rsqrtf(q * (1.f / 256.f) + 1e-5f);
        }
#pragma unroll
        for (int jt = 0; jt < 16; ++jt) {
            const int e = jt * 16 + r16; const float gw = p.gnw[h * 256 + e];
#pragma unroll
            for (int r = 0; r < 4; ++r) {
                const size_t token = tok0 + l0 + g * 4 + r;
                const float v = (acc[jt][r] - mu[r]) * rs[r] * gw * bf2f(sga[token * 1024 + h * 256 + e]);
                mix[token * 2048 + h * 256 + e] = f2bf(v);
            }
        }
    }
}

DEVI void phase_s5scan(const int TIDX, const int BIDX, const Params& p) {
    const int wid = TIDX >> 6, lane = TIDX & 63;
    const float* e5 = p.out + O_HGS; bf16_t* a2 = (bf16_t*)(p.ws + WS_A2); const float* lam16 = (const float*)(p.ws + WS_LAM16);
    for (int it = BIDX * 8 + wid; it < 512; it += gridDim.x * 8) {
        const int b = it >> 6, g = it & 63;
        const float ar = lam16[(g * 64 + lane) * 2], ai = lam16[(g * 64 + lane) * 2 + 1];
        float hr = 0.f, hi = 0.f;
        for (int jb = 0; jb < 128; jb += 16) {
            float er[16], ei[16];
#pragma unroll
            for (int j = 0; j < 16; ++j) { const float* ep = e5 + ((size_t)g * 1024 + b * 128 + jb + j) * 128; er[j] = ep[lane]; ei[j] = ep[64 + lane]; }
#pragma unroll
            for (int j = 0; j < 16; ++j) {
                bf16_t* hp = a2 + ((size_t)g * 1024 + b * 128 + jb + j) * 384 + 256;
                hp[lane] = f2bf(hr); hp[64 + lane] = f2bf(hi);
                const float nr = ar * hr - ai * hi + er[j], ni = ar * hi + ai * hr + ei[j];
                hr = nr; hi = ni;
            }
        }
        p.out[O_S5RP + (size_t)(b * 64 + g) * 64 + lane] = hr; p.out[O_S5IP + (size_t)(b * 64 + g) * 64 + lane] = hi;
    }
}

DEVI void phase_H1(const int TIDX, const int BIDX, bf16_t* L, const Params& p) {
    const int tid = TIDX, wid = tid >> 6, lane = tid & 63, r16 = lane & 15, g = lane >> 4;
    float* cum = (float*)(p.ws + WS_CUM); const bf16_t* itp = (const bf16_t*)(p.ws + WS_IT); float* hkv = (float*)(p.ws + WS_HKV);
    float* tot = (float*)(L + 128 * 136);
    for (int it = BIDX; it < 1024; it += gridDim.x) {
        const int bh = it >> 4, c = it & 15, h = bh & 7, b = bh >> 3; const size_t tok0 = (size_t)b * 2048 + c * 128;
        const int d = tid & 127, part = tid >> 7;
        float* col = cum + (tok0 + part * 32) * 1024 + h * 128 + d;
        float lf[32]; float s = 0.f;
#pragma unroll
        for (int l = 0; l < 32; ++l) { lf[l] = col[(size_t)l * 1024]; s += lf[l]; }
        __syncthreads();
        tot[part * 128 + d] = s;
        __syncthreads();
        float off = 0.f, last = 0.f;
#pragma unroll
        for (int pp = 0; pp < 4; ++pp) { const float t = tot[pp * 128 + d]; if (pp < part) off += t; last += t; }
        float cc = off;
#pragma unroll
        for (int l = 0; l < 32; ++l) {
            cc += lf[l]; col[(size_t)l * 1024] = cc;
            L[d * 136 + part * 32 + l] = f2bf((1.f - __expf(lf[l])) * __expf(last - cc));
        }
        __syncthreads();
        bf16x8 bfr[4];
#pragma unroll
        for (int kk = 0; kk < 4; ++kk) bfr[kk] = *(const bf16x8*)(itp + ((size_t)bh * 128 + wid * 16 + r16) * 2048 + c * 128 + kk * 32 + g * 8);
#pragma unroll
        for (int rt = 0; rt < 8; ++rt) {
            f32x4 a0 = {0.f, 0.f, 0.f, 0.f};
#pragma unroll
            for (int kk = 0; kk < 4; ++kk) a0 = mfma16(*(const bf16x8*)(L + (rt * 16 + r16) * 136 + kk * 32 + g * 8), bfr[kk], a0);
            *(f32x4*)(hkv + (((size_t)bh * 16 + c) * 128 + wid * 16 + r16) * 128 + rt * 16 + g * 4) = a0;
        }
    }
}

DEVI void phase_H2(const int TIDX, const int BIDX, const Params& p) {
    float* hkv = (float*)(p.ws + WS_HKV); const float* cum = (const float*)(p.ws + WS_CUM);
    for (int i = BIDX * 512 + TIDX; i < 64 * 128 * 16; i += gridDim.x * 512) {
        const int q = i & 15, e = (i >> 4) & 127, bh = i >> 11, h = bh & 7, b = bh >> 3;
        f32x4 s0 = {0.f, 0.f, 0.f, 0.f}, s1 = s0;
#pragma unroll 4
        for (int c = 0; c < 16; ++c) {
            float* ptr = hkv + (((size_t)bh * 16 + c) * 128 + e) * 128 + q * 8;
            const float* lp = cum + ((size_t)b * 2048 + c * 128 + 127) * 1024 + h * 128 + q * 8;
            const f32x4 v0 = *(const f32x4*)ptr, v1 = *(const f32x4*)(ptr + 4), d0 = *(const f32x4*)lp, d1 = *(const f32x4*)(lp + 4);
            u32x4 o; o.x = pack2(s0[0], s0[1]); o.y = pack2(s0[2], s0[3]); o.z = pack2(s1[0], s1[1]); o.w = pack2(s1[2], s1[3]);
            *(u32x4*)ptr = o;
#pragma unroll
            for (int j = 0; j < 4; ++j) { s0[j] = s0[j] * __expf(d0[j]) + v0[j]; s1[j] = s1[j] * __expf(d1[j]) + v1[j]; }
        }
        float* o = p.out + O_HGP + ((size_t)bh * 128 + q * 8) * 128 + e;
#pragma unroll
        for (int j = 0; j < 4; ++j) { o[(size_t)j * 128] = s0[j]; o[(size_t)(j + 4) * 128] = s1[j]; }
    }
}

DEVI void phase_H3(const int TIDX, const int BIDX, bf16_t* L, const Params& p) {
    const int tid = TIDX, wid = tid >> 6, lane = tid & 63, r16 = lane & 15, g = lane >> 4;
    const float* cum = (const float*)(p.ws + WS_CUM); const bf16_t* itp = (const bf16_t*)(p.ws + WS_IT); const float* hkv = (const float*)(p.ws + WS_HKV);
    bf16_t* q1 = (bf16_t*)(p.ws + WS_Q1); const bf16_t* sg1 = (const bf16_t*)(p.ws + WS_SG1);
    bf16_t* kt = L; bf16_t* strip = L + 128 * 136 + wid * 16 * 136;
    for (int it = BIDX; it < 1024; it += gridDim.x) {
        const int bh = it >> 4, c = it & 15, h = bh & 7, b = bh >> 3, l0 = wid * 16; const size_t tok0 = (size_t)b * 2048 + c * 128;
        const float* refp = cum + (tok0 + 63) * 1024 + h * 128;
        __syncthreads();
        { const int m = tid >> 2, seg = tid & 3; const float* cp = cum + (tok0 + m) * 1024 + h * 128 + seg * 32;
#pragma unroll
          for (int q = 0; q < 8; ++q) {
              const f32x4 cv = *(const f32x4*)(cp + q * 4), rv = *(const f32x4*)(refp + seg * 32 + q * 4);
              f32x4 pv = {0.f, 0.f, 0.f, 0.f}; if (m > 0) pv = *(const f32x4*)(cp - 1024 + q * 4);
              f32x4 o;
#pragma unroll
              for (int j = 0; j < 4; ++j) o[j] = (1.f - __expf(cv[j] - pv[j])) * __expf(rv[j] - cv[j]);
              *(u32x2*)(kt + m * 136 + seg * 32 + q * 4) = pack4(o); } }
        bf16x8 qr[4], qab[4];
#pragma unroll
        for (int kk = 0; kk < 4; ++kk) {
            const size_t o = (tok0 + l0 + r16) * 1024 + h * 128 + kk * 32 + g * 8;
            const u32x4 qq = *(const u32x4*)(q1 + o);
            const f32x4 c0 = *(const f32x4*)(cum + o), c1 = *(const f32x4*)(cum + o + 4), r0 = *(const f32x4*)(refp + kk * 32 + g * 8), r1 = *(const f32x4*)(refp + kk * 32 + g * 8 + 4);
            const unsigned* qv = (const unsigned*)&qq; u32x4 a, bb; unsigned* av = (unsigned*)&a; unsigned* bv = (unsigned*)&bb;
#pragma unroll
            for (int j = 0; j < 4; ++j) {
                const float cl = j < 2 ? c0[2 * j] : c1[2 * j - 4], ch = j < 2 ? c0[2 * j + 1] : c1[2 * j - 3];
                const float rl = j < 2 ? r0[2 * j] : r1[2 * j - 4], rh = j < 2 ? r0[2 * j + 1] : r1[2 * j - 3];
                const float ql = bflo(qv[j]), qh = bfhi(qv[j]);
                av[j] = pack2(ql * __expf(cl - rl), qh * __expf(ch - rh)); bv[j] = pack2(ql * __expf(cl), qh * __expf(ch));
            }
            qr[kk] = *(bf16x8*)&a; qab[kk] = *(bf16x8*)&bb;
        }
        __syncthreads();
        for (int j = 0; j < 8; ++j) {
            f32x4 s = {0.f, 0.f, 0.f, 0.f};
            if (j <= wid) {
#pragma unroll
                for (int kk = 0; kk < 4; ++kk) s = mfma16(qr[kk], *(const bf16x8*)(kt + (j * 16 + r16) * 136 + kk * 32 + g * 8), s);
            }
#pragma unroll
            for (int r = 0; r < 4; ++r) {
                const int li = l0 + g * 4 + r, mi = j * 16 + r16; const float v = (j <= wid && li >= mi) ? s[r] : 0.f;
                strip[(g * 4 + r) * 136 + mi] = f2bf(v);
            }
        }
        f32x4 acc[8];
#pragma unroll
        for (int jt = 0; jt < 8; ++jt) acc[jt] = (f32x4){0.f, 0.f, 0.f, 0.f};
        if (c > 0) {
            const float* sb = hkv + ((size_t)bh * 16 + c) * 128 * 128;
#pragma unroll
            for (int jt = 0; jt < 8; ++jt)
#pragma unroll
                for (int kk = 0; kk < 4; ++kk) acc[jt] = mfma16(qab[kk], *(const bf16x8*)(sb + (size_t)(jt * 16 + r16) * 128 + kk * 32 + g * 8), acc[jt]);
        }
        __syncthreads();
        for (int kk = 0; kk <= (wid >> 1); ++kk) {
            const bf16x8 a = *(const bf16x8*)(strip + r16 * 136 + kk * 32 + g * 8);
#pragma unroll
            for (int jt = 0; jt < 8; ++jt) acc[jt] = mfma16(a, *(const bf16x8*)(itp + ((size_t)bh * 128 + jt * 16 + r16) * 2048 + c * 128 + kk * 32 + g * 8), acc[jt]);
        }
        float rs[4];
#pragma unroll
        for (int r = 0; r < 4; ++r) {
            float q = 0.f;
#pragma unroll
            for (int jt = 0; jt < 8; ++jt) q += acc[jt][r] * acc[jt][r];
            q = grp16_sum(q); rs[r] = rsqrtf(q * (1.f / 128.f) + 1e-6f);
        }
#pragma unroll
        for (int jt = 0; jt < 8; ++jt) {
            const int e = jt * 16 + r16; const float gw = p.hgnw[h * 128 + e];
#pragma unroll
            for (int r = 0; r < 4; ++r) {
                const size_t token = tok0 + l0 + g * 4 + r;
                q1[token * 1024 + h * 128 + e] = f2bf(acc[jt][r] * rs[r] * gw * bf2f(sg1[token * 1024 + h * 128 + e]));
            }
        }
    }
}

DEVI void phase_ss5(const int TIDX, const int BIDX, const Params& p) {
    const int wid = TIDX >> 6, lane = TIDX & 63;
    const float* zs = (const float*)(p.ws + WS_ZS); const float* bbg = (const float*)(p.ws + WS_BBG); const float* lam1 = (const float*)(p.ws + WS_LAM1);
    bf16_t* y5s = (bf16_t*)(p.ws + WS_Y5S);
    for (int it = BIDX * 8 + wid; it < 128 * 64; it += gridDim.x * 8) {
        const int b = it >> 6, g = it & 63;
        float u[16];
#pragma unroll
        for (int c = 0; c < 16; ++c) u[c] = zs[(size_t)b * 5120 + 3072 + g * 16 + c];
        float xr = 0.f, xi = 0.f;
#pragma unroll
        for (int c = 0; c < 16; ++c) { xr += bbg[((g * 64 + lane) * 16 + c) * 2] * u[c]; xi += bbg[((g * 64 + lane) * 16 + c) * 2 + 1] * u[c]; }
        const float ar = lam1[(g * 64 + lane) * 2], ai = lam1[(g * 64 + lane) * 2 + 1];
        const float sr = p.s5r[(size_t)(b * 64 + g) * 64 + lane], si = p.s5i[(size_t)(b * 64 + g) * 64 + lane];
        const float hr = ar * sr - ai * si + xr, hi = ar * si + ai * sr + xi;
        p.out[O_S5RS + (size_t)(b * 64 + g) * 64 + lane] = hr; p.out[O_S5IS + (size_t)(b * 64 + g) * 64 + lane] = hi;
        float mine = 0.f;
#pragma unroll
        for (int c = 0; c < 16; ++c) {
            float v = p.cre[(g * 16 + c) * 64 + lane] * hr - p.cim[(g * 16 + c) * 64 + lane] * hi;
            v = wave_sum(v);
            if (lane == c) mine = v + p.s5d[g * 16 + c] * u[c];
        }
        if (lane < 16) y5s[(size_t)b * 1024 + g * 16 + lane] = f2bf(gelu_(mine));
    }
}

DEVI void phase_sret(const int TIDX, const int BIDX, float* L, const Params& p) {
    const int tid = TIDX, lane = tid & 63, wid = tid >> 6;
    const float* zs = (const float*)(p.ws + WS_ZS); bf16_t* mix = (bf16_t*)(p.ws + WS_MIX0S);
    float* qs = L; float* ks = L + 128; float* red = L + 256; float* st = L + 768;
    for (int it = BIDX; it < 512; it += gridDim.x) {
        const int b = it >> 2, h = it & 3, e = tid & 255, half = tid >> 8; const float gam = 1.0f - exp2f(-5.0f - (float)h);
        __syncthreads();
        if (tid < 128) qs[tid] = zs[(size_t)b * 5120 + h * 128 + tid]; else if (tid < 256) ks[tid - 128] = zs[(size_t)b * 5120 + 512 + h * 128 + tid - 128];
        const float v = zs[(size_t)b * 5120 + 1024 + h * 256 + e];
        __syncthreads();
        const float* s0 = p.sret + ((size_t)it * 128 + half * 64) * 256 + e; float* so = p.out + O_RETS + ((size_t)it * 128 + half * 64) * 256 + e;
        float o = 0.f;
#pragma unroll 8
        for (int d = 0; d < 64; ++d) { const float s = gam * s0[(size_t)d * 256] + ks[half * 64 + d] * v; so[(size_t)d * 256] = s; o += qs[half * 64 + d] * s; }
        red[tid] = o;
        __syncthreads();
        float tot = 0.f;
        if (tid < 256) { tot = red[tid] + red[tid + 256]; const float s = wave_sum(tot); if (lane == 0) st[wid] = s; }
        __syncthreads();
        const float mu = (st[0] + st[1] + st[2] + st[3]) * (1.f / 256.f);
        __syncthreads();
        if (tid < 256) { const float dd = tot - mu; const float s = wave_sum(dd * dd); if (lane == 0) st[wid] = s; }
        __syncthreads();
        const float rs = rsqrtf((st[0] + st[1] + st[2] + st[3]) * (1.f / 256.f) + 1e-5f);
        if (tid < 256) mix[(size_t)b * 2048 + h * 256 + e] = f2bf((tot - mu) * rs * p.gnw[h * 256 + e] * zs[(size_t)b * 5120 + 2048 + h * 256 + e]);
    }
}

DEVI void phase_shg(const int TIDX, const int BIDX, float* L, const Params& p) {
    const int tid = TIDX, lane = tid & 63, wid = tid >> 6;
    const float* z1 = (const float*)(p.ws + WS_Z1S); bf16_t* o1s = (bf16_t*)(p.ws + WS_O1S);
    float* qs = L; float* fs = L + 128; float* red = L + 256; float* st = L + 768;
    for (int it = BIDX; it < 1024; it += gridDim.x) {
        const int b = it >> 3, h = it & 7, e = tid & 127, qt = tid >> 7;
        __syncthreads();
        if (tid < 128) qs[tid] = z1[(size_t)b * 4096 + h * 128 + tid]; else if (tid < 256) fs[tid - 128] = z1[(size_t)b * 4096 + 1024 + h * 128 + tid - 128];
        const float iv = z1[(size_t)b * 4096 + 2048 + h * 128 + e];
        __syncthreads();
        const float* s0 = p.shg + ((size_t)it * 128 + qt * 32) * 128 + e; float* so = p.out + O_HGS + ((size_t)it * 128 + qt * 32) * 128 + e;
        float o = 0.f;
#pragma unroll 8
        for (int d = 0; d < 32; ++d) { const float f = fs[qt * 32 + d]; const float s = f * s0[(size_t)d * 128] + (1.f - f) * iv; so[(size_t)d * 128] = s; o += qs[qt * 32 + d] * s; }
        red[tid] = o;
        __syncthreads();
        float tot = 0.f;
        if (tid < 128) { tot = red[tid] + red[tid + 128] + red[tid + 256] + red[tid + 384]; const float s = wave_sum(tot * tot); if (lane == 0) st[wid] = s; }
        __syncthreads();
        const float rs = rsqrtf((st[0] + st[1]) * (1.f / 128.f) + 1e-6f);
        if (tid < 128) o1s[(size_t)b * 1024 + h * 128 + e] = f2bf(tot * rs * p.hgnw[h * 128 + e] * z1[(size_t)b * 4096 + 3072 + h * 128 + e]);
    }
}

DEVI void phase_final(const int TIDX, const int BIDX, const Params& p) {
    const int wid = TIDX >> 6, lane = TIDX & 63;
    for (int row = BIDX * 8 + wid; row < MP + MS; row += gridDim.x * 8) {
        const bool smp = row >= MP; const size_t r = smp ? row - MP : row;
        float* x = p.out + (smp ? O_YS : O_YP) + r * 1024;
        f32x4 v[4]; float s = 0.f;
#pragma unroll
        for (int i = 0; i < 4; ++i) { v[i] = *(const f32x4*)(x + i * 256 + lane * 4); s += v[i][0] * v[i][0] + v[i][1] * v[i][1] + v[i][2] * v[i][2] + v[i][3] * v[i][3]; }
        s = wave_sum(s);
        const float rs = rsqrtf(s * (1.0f / 1024.0f) + 1e-6f);
#pragma unroll
        for (int i = 0; i < 4; ++i) { const f32x4 w = *(const f32x4*)(p.fnormw + i * 256 + lane * 4); *(f32x4*)(x + i * 256 + lane * 4) = v[i] * rs * w; }
    }
}

#define GRID_SYNC() do { asm volatile("s_waitcnt vmcnt(0) lgkmcnt(0)" ::: "memory"); __syncthreads(); if (threadIdx.x == 0) { __builtin_amdgcn_fence(__ATOMIC_RELEASE, ""); asm volatile("s_waitcnt vmcnt(0)" ::: "memory"); } \
    cg::this_grid().sync(); \
    if (threadIdx.x == 0) { __builtin_amdgcn_fence(__ATOMIC_ACQUIRE, ""); asm volatile("s_waitcnt vmcnt(0)" ::: "memory"); } __syncthreads(); } while (0)
constexpr int NPHASE = 13;
__global__ void __launch_bounds__(512, 2) mega(Params p0) {
    extern __shared__ __attribute__((aligned(16))) unsigned char shm[];
    LAS unsigned char* lds = (LAS unsigned char*)shm;
    const int G = gridDim.x;
#define OPQ int oz; asm volatile("s_mov_b32 %0, 0" : "=s"(oz)); int ozv; asm volatile("v_mov_b32 %0, 0" : "=v"(ozv)); \
    Params p = p0; p.ws = p0.ws + oz; p.out = p0.out + oz; const int TIDX = threadIdx.x + ozv, BIDX = blockIdx.x + oz; (void)TIDX; (void)BIDX;
    int ph_start = p0.ph_lo;
    if (ph_start == 0) {
        { OPQ phase_prep(TIDX, BIDX, (float*)shm, p); }
#if COOP
        GRID_SYNC();
#endif
        ph_start = 1;
    }
    for (int ph = ph_start; ph < p0.ph_hi; ++ph) {
        int la = -1, lb = -1, K = 1024, lda = 1024, ldb = 1024;
        switch (ph) {
        case 1: la = L_IN0; lb = L_IN0S; break;
        case 2: la = L_GA; K = 256; lda = 384; ldb = 256; break;
        case 4: la = L_GB; K = 384; lda = 384; ldb = 384; break;
        case 5: la = L_GLU; lb = L_GLUS; break;
        case 6: la = L_OUT0; lb = L_OUT0S; K = 2048; lda = 2048; ldb = 2048; break;
        case 7: la = L_IN1; lb = L_IN1S; break;
        case 11: la = L_OUT1; lb = L_OUT1S; break;
        default: break;
        }
        for (int jj = 0; jj < 2; ++jj) {
            const int l = jj ? lb : la;
            if (l < 0) continue;
            OPQ
            Sched S; S.list = l; S.G = G; S.c = jj ? G - 1 - BIDX : BIDX; S.wsp = p.ws; S.outp = p.out;
            gemm_phase(TIDX, lds, K, lda, ldb, l == L_GLU, S, p);
        }
        __syncthreads();
        switch (ph) {
        case 2: { { OPQ phase_R1(TIDX, BIDX, (bf16_t*)shm, p); } __syncthreads(); { OPQ phase_sret(TIDX, BIDX, (float*)shm, p); } { OPQ phase_ss5(TIDX, BIDX, p); } } break;
        case 3: { { OPQ phase_s5scan(TIDX, BIDX, p); } { OPQ phase_R2(TIDX, BIDX, p); } } break;
        case 4: { OPQ phase_R3(TIDX, BIDX, (bf16_t*)shm, p); } break;
        case 8: { { OPQ phase_H1(TIDX, BIDX, (bf16_t*)shm, p); } __syncthreads(); { OPQ phase_shg(TIDX, BIDX, (float*)shm, p); } } break;
        case 9: { OPQ phase_H2(TIDX, BIDX, p); } break;
        case 10: { OPQ phase_H3(TIDX, BIDX, (bf16_t*)shm, p); } break;
        case 12: { OPQ phase_final(TIDX, BIDX, p); } break;
        default: break;
        }
#if COOP
        if (ph + 1 < p0.ph_hi) GRID_SYNC();
#endif
    }
}

extern "C" void kernel_launch(void* const* d_in, const int* in_sizes, int n_in, void* d_out, int out_size, void* d_ws, size_t ws_size, hipStream_t stream) {
    constexpr size_t kDynLds = 131072;
    static int grid_blocks = 0;
    if (!grid_blocks) {
        hipFuncSetAttribute((const void*)mega, hipFuncAttributeMaxDynamicSharedMemorySize, (int)kDynLds);
        int dev = 0, cus = 0, per_cu = 0;
        hipGetDevice(&dev);
        hipDeviceGetAttribute(&cus, hipDeviceAttributeMultiprocessorCount, dev);
        hipOccupancyMaxActiveBlocksPerMultiprocessor(&per_cu, mega, 512, kDynLds);
        if (per_cu < 1) per_cu = 1;
        grid_blocks = cus;
        if (grid_blocks > 256) grid_blocks = 256;
    }
    Params p{};
    const float** f = (const float**)&p;
    for (int i = 0; i < 25; ++i) f[i] = (const float*)d_in[i];
    p.out = (float*)d_out; p.ws = (char*)d_ws;
#if COOP
    p.ph_lo = 0; p.ph_hi = PH_MAX;
    void* args[] = {&p};
    hipError_t e = hipLaunchCooperativeKernel((const void*)mega, dim3(grid_blocks), dim3(512), args, kDynLds, stream);
    if (e != hipSuccess) fprintf(stderr, "cooperative launch failed: %s (grid %d)\n", hipGetErrorString(e), grid_blocks);
#else
    for (int ph = 0; ph < NPHASE; ++ph) {
        p.ph_lo = ph; p.ph_hi = ph + 1;
        hipLaunchKernelGGL(mega, dim3(grid_blocks), dim3(512), kDynLds, stream, p);
    }
#endif
}
```

```cpp
#include <hip/hip_runtime.h>
#include <hip/hip_cooperative_groups.h>
#include <cstdio>
namespace cg = cooperative_groups;

#ifndef PH_MAX
#define PH_MAX 13
#endif
#ifndef COOP
#define COOP 1
#endif

typedef unsigned short bf16_t;
typedef short bf16x8 __attribute__((ext_vector_type(8)));
typedef float f32x4 __attribute__((ext_vector_type(4)));
typedef unsigned u32x4 __attribute__((ext_vector_type(4)));
typedef unsigned u32x2 __attribute__((ext_vector_type(2)));
#define LAS __attribute__((address_space(3)))
#define DEVI __device__ __forceinline__

constexpr int TT = 2048, NBP = 8, MP = 16384, MS = 128, DM = 1024;
constexpr size_t MiB = (size_t)1 << 20;
constexpr size_t O_YP = 0, O_YS = 16777216, O_RETP = 16908288, O_RETS = 17956864, O_S5RP = 34734080, O_S5IP = 34766848,
                 O_S5RS = 34799616, O_S5IS = 35323904, O_HGP = 35848192, O_HGS = 36896768;
constexpr size_t WS_WIN0T = 0, WS_BT1 = 10 * MiB, WS_KT = 18 * MiB, WS_WGLUT = 34 * MiB, WS_WOUT0T = 36 * MiB, WS_WIN1T = 40 * MiB,
                 WS_BT2 = 48 * MiB, WS_Q = 60 * MiB, WS_KN = 76 * MiB, WS_VT = 92 * MiB, WS_SGA = 124 * MiB, WS_SGB = 156 * MiB,
                 WS_A2 = 188 * MiB, WS_Y5 = 0, WS_X1B = 60 * MiB, WS_SG1 = 0, WS_Q1 = 96 * MiB, WS_CUM = 128 * MiB, WS_IT = 192 * MiB,
                 WS_HKV = 32 * MiB;
constexpr size_t WS_MISC = 240 * MiB;
constexpr size_t WS_WOUT1T = WS_MISC;
constexpr size_t WS_ROPE = WS_MISC + 2 * MiB;
constexpr size_t WS_SSQ1 = WS_ROPE + 1280 * 1024;
constexpr size_t WS_SSQ2 = WS_SSQ1 + MiB;
constexpr size_t WS_H0S = WS_SSQ2 + MiB;
constexpr size_t WS_ZS = WS_H0S + 512 * 1024;
constexpr size_t WS_Y5S = WS_ZS + 2560 * 1024;
constexpr size_t WS_MIX0S = WS_Y5S + 512 * 1024;
constexpr size_t WS_X1S = WS_MIX0S + MiB;
constexpr size_t WS_X1SB = WS_X1S + 512 * 1024;
constexpr size_t WS_Z1S = WS_X1SB + 512 * 1024;
constexpr size_t WS_O1S = WS_Z1S + 2 * MiB;
constexpr size_t WS_BBG = WS_O1S + 512 * 1024;
constexpr size_t WS_LAM1 = WS_BBG + 512 * 1024;
constexpr size_t WS_LAM16 = WS_LAM1 + 32 * 1024;
constexpr size_t WS_LB = WS_LAM16 + 32 * 1024;
constexpr size_t WS_SSQ1S = WS_LB + 4096;
constexpr size_t WS_SSQ2S = WS_SSQ1S + MiB;
constexpr size_t WS_END = WS_SSQ2S + MiB;
constexpr size_t WS_XCNT = WS_END;
static_assert(WS_XCNT + 1024 <= 256 * MiB, "workspace overflow");

struct Params {
    const float *xp, *xs, *sret, *s5r, *s5i, *shg, *normw, *fnormw, *win0, *gnw, *lamre, *lamim, *logdt, *bre, *bim, *cre, *cim, *s5d,
        *gluw, *glub, *wout0, *win1, *hglb, *hgnw, *wout1;
    float* out;
    char* ws;
    int ph_lo, ph_hi;
};

DEVI bf16_t f2bf(float f) { unsigned u = __float_as_uint(f); u += 0x7FFFu + ((u >> 16) & 1u); return (bf16_t)(u >> 16); }
DEVI float bf2f(bf16_t b) { return __uint_as_float(((unsigned)b) << 16); }
DEVI unsigned pack2(float lo, float hi) { return (unsigned)f2bf(lo) | ((unsigned)f2bf(hi) << 16); }
DEVI float bflo(unsigned w) { return __uint_as_float(w << 16); }
DEVI float bfhi(unsigned w) { return __uint_as_float(w & 0xffff0000u); }
DEVI float sigm(float x) { return 1.f / (1.f + __expf(-x)); }
DEVI float silu_(float x) { return x * sigm(x); }
DEVI float gelu_(float x) { float u = 1.5957691216f * (x + 0.044715f * x * x * x); return x / (1.f + __expf(-u)); }
DEVI u32x2 pack4(f32x4 v) { u32x2 r; r.x = pack2(v[0], v[1]); r.y = pack2(v[2], v[3]); return r; }
DEVI float wave_sum(float v) {
#pragma unroll
    for (int o = 32; o > 0; o >>= 1) v += __shfl_xor(v, o);
    return v;
}
DEVI float grp16_sum(float v) { v += __shfl_xor(v, 1); v += __shfl_xor(v, 2); v += __shfl_xor(v, 4); v += __shfl_xor(v, 8); return v; }
DEVI f32x4 mfma16(bf16x8 a, bf16x8 b, f32x4 c) { return __builtin_amdgcn_mfma_f32_16x16x32_bf16(a, b, c, 0, 0, 0); }
DEVI float row_rstd16(const float* ssq, size_t row) {
    const f32x4 a = *(const f32x4*)(ssq + row * 4), b = *(const f32x4*)(ssq + (MP + row) * 4), c = *(const f32x4*)(ssq + (2 * (size_t)MP + row) * 4), d = *(const f32x4*)(ssq + (3 * (size_t)MP + row) * 4);
    float s = (a[0] + a[1] + a[2] + a[3]) + (b[0] + b[1] + b[2] + b[3]) + (c[0] + c[1] + c[2] + c[3]) + (d[0] + d[1] + d[2] + d[3]);
    return rsqrtf(s * (1.0f / 1024.0f) + 1e-6f);
}

constexpr int BM = 256, BK = 64, HALF = 128, HTB = HALF * BK * 2, NXCD = 8, WGM = 8;
DEVI int lds_byte(int r, int c) { const int st = (r >> 4) * 2 + (c >> 5), rr = r & 15, cc = c & 31, ob = rr * 64 + cc * 2; return st * 1024 + (ob ^ (((ob >> 9) & 1) << 5)); }
DEVI void stage_rc(int b, int& R, int& C) { const int st = b / 1024, sb = b % 1024, swz = sb ^ (((sb >> 9) & 1) << 5); R = (st >> 1) * 16 + swz / 64; C = (st & 1) * 32 + (swz % 64) / 2; }

enum { K_Q = 0, K_K, K_VT, K_GA, K_U, K_GB, K_SIN0, K_E5, K_Y5, K_GLU, K_SGLU, K_OUT0, K_SOUT0, K_Q1, K_F, K_IT, K_G1, K_SIN1, K_OUT1, K_SOUT1 };
enum { L_IN0 = 0, L_IN0S, L_GA, L_GB, L_GLU, L_GLUS, L_OUT0, L_OUT0S, L_IN1, L_IN1S, L_OUT1, L_OUT1S };

struct Unit { const char* a; const char* b; int kind, pm, pn; };

DEVI void static_order(int L, int nM, int nN, int& pm, int& pn) {
    const int nwg = nM * nN; int wgid = L;
    { const int q = nwg / NXCD, r = nwg % NXCD, xcd = wgid % NXCD, off = wgid / NXCD; wgid = (xcd < r ? xcd * (q + 1) : r * (q + 1) + (xcd - r) * q) + off; }
    const int nig = WGM * nN, gid = wgid / nig, fm = gid * WGM, gsz = (nM - fm) < WGM ? (nM - fm) : WGM;
    pm = fm + ((wgid % nig) % gsz); pn = (wgid % nig) / gsz;
}

struct Sched {
    int list, G, c; char* wsp; float* outp;
    DEVI bool next(int i, Unit& u) const {
        const int L = i * G + c; const char* ws = wsp;
        switch (list) {
        case L_IN0: {
            if (L >= 1280) return false; int pm, pn; static_order(L, 64, 20, pm, pn); u.pm = pm; u.pn = pn;
            const char* h0 = (const char*)(outp + O_RETS);
            if (pn >= 4 && pn < 8) { u.kind = K_VT; u.a = ws + WS_WIN0T + (size_t)(1024 + 256 * (pn - 4)) * 2048; u.b = h0 + (size_t)pm * 256 * 2048; }
            else { u.kind = pn < 2 ? K_Q : pn < 4 ? K_K : pn < 12 ? K_GA : pn < 16 ? K_U : K_GB; u.a = h0 + (size_t)pm * 256 * 2048; u.b = ws + WS_WIN0T + (size_t)pn * 256 * 2048; }
            return true; }
        case L_IN0S: if (L >= 20) return false; u.pm = 0; u.pn = L; u.kind = K_SIN0; u.a = ws + WS_H0S; u.b = ws + WS_WIN0T + (size_t)L * 256 * 2048; return true;
        case L_GA: if (L >= 256) return false; u.pm = L & 3; u.pn = L >> 2; u.kind = K_E5; u.a = ws + WS_A2 + ((size_t)(L >> 2) * 1024 + (L & 3) * 256) * 768; u.b = ws + WS_BT1 + (size_t)(L >> 2) * 256 * 512; return true;
        case L_GB: if (L >= 256) return false; u.pm = L & 3; u.pn = L >> 2; u.kind = K_Y5; u.a = ws + WS_A2 + ((size_t)(L >> 2) * 1024 + (L & 3) * 256) * 768; u.b = ws + WS_BT2 + (size_t)(L >> 2) * 256 * 768; return true;
        case L_GLU: { if (L >= 256) return false; int pm, pn; static_order(L, 64, 4, pm, pn); u.pm = pm; u.pn = pn; u.kind = K_GLU; u.a = ws + WS_Y5 + (size_t)pm * 256 * 32; u.b = ws + WS_WGLUT + (size_t)pn * 256 * 2048; return true; }
        case L_GLUS: if (L >= 4) return false; u.pm = 0; u.pn = L; u.kind = K_SGLU; u.a = ws + WS_Y5S; u.b = ws + WS_WGLUT + (size_t)L * 256 * 2048; return true;
        case L_OUT0: { if (L >= 256) return false; int pm, pn; static_order(L, 64, 4, pm, pn); u.pm = pm; u.pn = pn; u.kind = K_OUT0; u.a = (const char*)(outp + O_HGS) + (size_t)pm * 256 * 4096; u.b = ws + WS_WOUT0T + (size_t)pn * 256 * 4096; return true; }
        case L_OUT0S: if (L >= 4) return false; u.pm = 0; u.pn = L; u.kind = K_SOUT0; u.a = ws + WS_MIX0S; u.b = ws + WS_WOUT0T + (size_t)L * 256 * 4096; return true;
        case L_IN1: {
            if (L >= 1024) return false; int pm, pn; static_order(L, 64, 16, pm, pn); u.pm = pm; u.pn = pn;
            if (pn >= 8 && pn < 12) { u.kind = K_IT; u.a = ws + WS_WIN1T + (size_t)(256 * pn) * 2048; u.b = ws + WS_X1B + (size_t)pm * 256 * 2048; }
            else { u.kind = pn < 4 ? K_Q1 : pn < 8 ? K_F : K_G1; u.a = ws + WS_X1B + (size_t)pm * 256 * 2048; u.b = ws + WS_WIN1T + (size_t)pn * 256 * 2048; }
            return true; }
        case L_IN1S: if (L >= 16) return false; u.pm = 0; u.pn = L; u.kind = K_SIN1; u.a = ws + WS_X1SB; u.b = ws + WS_WIN1T + (size_t)L * 256 * 2048; return true;
        case L_OUT1: { if (L >= 256) return false; int pm, pn; static_order(L, 64, 4, pm, pn); u.pm = pm; u.pn = pn; u.kind = K_OUT1; u.a = ws + WS_Q1 + (size_t)pm * 256 * 2048; u.b = ws + WS_WOUT1T + (size_t)pn * 256 * 2048; return true; }
        case L_OUT1S: if (L >= 4) return false; u.pm = 0; u.pn = L; u.kind = K_SOUT1; u.a = ws + WS_O1S; u.b = ws + WS_WOUT1T + (size_t)L * 256 * 2048; return true;
        }
        return false;
    }
};

DEVI void epilogue(const Params& p, const f32x4 (&acc)[2][2][4][2], const Unit& u, int wr, int wc, int fr, int fq) {
    char* ws = p.ws;
    const int kind = u.kind;
    if (kind == K_Q || kind == K_K) {
        const float* rope = (const float*)(ws + WS_ROPE);
        bf16_t* dst = (bf16_t*)(ws + (kind == K_Q ? WS_Q : WS_KN));
        bf16_t* kt = (bf16_t*)(ws + WS_KT);
        const int tq = kind == K_Q ? u.pn : u.pn - 2;
        const float sc = kind == K_Q ? 1.0f : 0.08838834764831845f;
#pragma unroll
        for (int ai = 0; ai < 2; ++ai)
#pragma unroll
            for (int m = 0; m < 4; ++m) {
                const int token = u.pm * 256 + ai * 128 + wr * 64 + m * 16 + fr, pos = token & 2047;
#pragma unroll
                for (int n = 0; n < 2; ++n) {
                    const int w = wc * 32 + n * 16 + fq * 4, hl = w >> 6, j = w & 63, head = 2 * tq + hl;
                    const f32x4 cs = *(const f32x4*)(rope + pos * 128 + j), sn = *(const f32x4*)(rope + pos * 128 + 64 + j);
                    const f32x4 x1 = acc[ai][0][m][n], x2 = acc[ai][1][m][n];
                    const f32x4 y1 = (x1 * cs - x2 * sn) * sc, y2 = (x1 * sn + x2 * cs) * sc;
                    bf16_t* d = dst + (size_t)token * 512 + head * 128 + j;
                    *(u32x2*)d = pack4(y1); *(u32x2*)(d + 64) = pack4(y2);
                    if (kind == K_K) {
                        const int b = token >> 11, t = token & 2047;
                        bf16_t* kk = kt + ((size_t)(b * 4 + head) * 128 + j) * 2048 + t;
#pragma unroll
                        for (int i = 0; i < 4; ++i) { kk[(size_t)i * 2048] = f2bf(y1[i]); kk[(size_t)(64 + i) * 2048] = f2bf(y2[i]); }
                    }
                }
            }
    } else if (kind == K_VT || kind == K_IT) {
        const bool isv = kind == K_VT;
        const float* ssq = (const float*)(ws + WS_SSQ1);
        bf16_t* dst = (bf16_t*)(ws + (isv ? WS_VT : WS_IT));
#pragma unroll
        for (int bj = 0; bj < 2; ++bj)
#pragma unroll
            for (int n = 0; n < 2; ++n) {
                const int token = u.pm * 256 + bj * 128 + wc * 32 + n * 16 + fq * 4, b = token >> 11, t = token & 2047;
                f32x4 rs = {1.f, 1.f, 1.f, 1.f};
                if (!isv) { rs[0] = row_rstd16(ssq, token); rs[1] = row_rstd16(ssq, token + 1); rs[2] = row_rstd16(ssq, token + 2); rs[3] = row_rstd16(ssq, token + 3); }
#pragma unroll
                for (int ai = 0; ai < 2; ++ai)
#pragma unroll
                    for (int m = 0; m < 4; ++m) {
                        const int row = ai * 128 + wr * 64 + m * 16 + fr;
                        size_t off;
                        if (isv) off = ((size_t)(b * 4 + (u.pn - 4)) * 256 + row) * 2048 + t;
                        else { const int eg = (u.pn - 8) * 256 + row; off = ((size_t)(b * 8 + (eg >> 7)) * 128 + (eg & 127)) * 2048 + t; }
                        *(u32x2*)(dst + off) = pack4(acc[ai][bj][m][n] * rs);
                    }
            }
    } else if (kind == K_GA || kind == K_GB || kind == K_U) {
#pragma unroll
        for (int ai = 0; ai < 2; ++ai)
#pragma unroll
            for (int m = 0; m < 4; ++m) {
                const int token = u.pm * 256 + ai * 128 + wr * 64 + m * 16 + fr;
#pragma unroll
                for (int bj = 0; bj < 2; ++bj)
#pragma unroll
                    for (int n = 0; n < 2; ++n) {
                        const int cl = bj * 128 + wc * 32 + n * 16 + fq * 4;
                        f32x4 v = acc[ai][bj][m][n];
                        if (kind == K_U) {
                            const int cu = (u.pn - 12) * 256 + cl, g = cu >> 4, c = cu & 15;
                            bf16_t* d = (bf16_t*)(ws + WS_A2) + ((size_t)g * 1024 + (token >> 4)) * 384 + (token & 15) * 16 + c;
                            *(u32x2*)d = pack4(v);
                        } else {
                            v[0] = silu_(v[0]); v[1] = silu_(v[1]); v[2] = silu_(v[2]); v[3] = silu_(v[3]);
                            bf16_t* d = (bf16_t*)(ws + (kind == K_GA ? WS_SGA : WS_SGB)) + (size_t)token * 1024 + (u.pn - (kind == K_GA ? 8 : 16)) * 256 + cl;
                            *(u32x2*)d = pack4(v);
                        }
                    }
            }
    } else if (kind == K_SIN0) {
        const float* rope = (const float*)(ws + WS_ROPE) + 2048 * 128;
        float* zs = (float*)(ws + WS_ZS);
#pragma unroll
        for (int m = 0; m < 4; ++m) {
            const int row = wr * 64 + m * 16 + fr;
            if (u.pn < 4) {
                const float sc = u.pn < 2 ? 1.0f : 0.08838834764831845f;
#pragma unroll
                for (int n = 0; n < 2; ++n) {
                    const int w = wc * 32 + n * 16 + fq * 4, hl = w >> 6, j = w & 63;
                    const f32x4 cs = *(const f32x4*)(rope + j), sn = *(const f32x4*)(rope + 64 + j);
                    const f32x4 x1 = acc[0][0][m][n], x2 = acc[0][1][m][n];
                    float* d = zs + (size_t)row * 5120 + u.pn * 256 + hl * 128 + j;
                    *(f32x4*)d = (x1 * cs - x2 * sn) * sc; *(f32x4*)(d + 64) = (x1 * sn + x2 * cs) * sc;
                }
            } else {
                const bool gate = (u.pn >= 8 && u.pn < 12) || u.pn >= 16;
#pragma unroll
                for (int bj = 0; bj < 2; ++bj)
#pragma unroll
                    for (int n = 0; n < 2; ++n) {
                        f32x4 v = acc[0][bj][m][n];
                        if (gate) { v[0] = silu_(v[0]); v[1] = silu_(v[1]); v[2] = silu_(v[2]); v[3] = silu_(v[3]); }
                        *(f32x4*)(zs + (size_t)row * 5120 + u.pn * 256 + bj * 128 + wc * 32 + n * 16 + fq * 4) = v;
                    }
            }
        }
    } else if (kind == K_E5) {
        float* e5 = (float*)(p.out + O_HGS);
#pragma unroll
        for (int ai = 0; ai < 2; ++ai)
#pragma unroll
            for (int m = 0; m < 4; ++m) {
                const int row = u.pm * 256 + ai * 128 + wr * 64 + m * 16 + fr;
#pragma unroll
                for (int n = 0; n < 2; ++n) *(f32x4*)(e5 + ((size_t)u.pn * 1024 + row) * 128 + wc * 32 + n * 16 + fq * 4) = acc[ai][0][m][n];
            }
    } else if (kind == K_Y5) {
        const bf16_t* a2 = (const bf16_t*)(ws + WS_A2);
        bf16_t* y5 = (bf16_t*)(ws + WS_Y5);
        const int g = u.pn;
#pragma unroll
        for (int ai = 0; ai < 2; ++ai)
#pragma unroll
            for (int m = 0; m < 4; ++m) {
                const int row = u.pm * 256 + ai * 128 + wr * 64 + m * 16 + fr;
#pragma unroll
                for (int bj = 0; bj < 2; ++bj)
#pragma unroll
                    for (int n = 0; n < 2; ++n) {
                        const int col = bj * 128 + wc * 32 + n * 16 + fq * 4, c = col & 15;
                        const u32x2 uu = *(const u32x2*)(a2 + ((size_t)g * 1024 + row) * 384 + col);
                        const f32x4 dd = *(const f32x4*)(p.s5d + g * 16 + c);
                        f32x4 v = acc[ai][bj][m][n];
                        v[0] = gelu_(v[0] + dd[0] * bflo(uu.x)); v[1] = gelu_(v[1] + dd[1] * bfhi(uu.x));
                        v[2] = gelu_(v[2] + dd[2] * bflo(uu.y)); v[3] = gelu_(v[3] + dd[3] * bfhi(uu.y));
                        *(u32x2*)(y5 + ((size_t)g * 1024 + row) * 256 + col) = pack4(v);
                    }
            }
    } else if (kind == K_GLU || kind == K_SGLU) {
        const bool smp = kind == K_SGLU;
        const bf16_t* y5 = (const bf16_t*)(ws + (smp ? WS_Y5S : WS_Y5));
        const bf16_t* sgb = (const bf16_t*)(ws + WS_SGB);
        const float* zs = (const float*)(ws + WS_ZS);
        bf16_t* mix = smp ? (bf16_t*)(ws + WS_MIX0S) : (bf16_t*)(p.out + O_HGS);
#pragma unroll
        for (int ai = 0; ai < 2; ++ai) {
            if (smp && ai) break;
#pragma unroll
            for (int m = 0; m < 4; ++m) {
                const size_t token = (size_t)u.pm * 256 + ai * 128 + wr * 64 + m * 16 + fr;
#pragma unroll
                for (int bj = 0; bj < 2; ++bj)
#pragma unroll
                    for (int n = 0; n < 2; ++n) {
                        const int col = u.pn * 256 + bj * 128 + wc * 32 + n * 16 + fq * 4;
                        const f32x4 bb = *(const f32x4*)(p.glub + col);
                        const u32x2 yy = smp ? *(const u32x2*)(y5 + token * 1024 + col) : *(const u32x2*)(y5 + ((size_t)(col >> 4) * MP + token) * 16 + (col & 15));
                        f32x4 gg;
                        if (smp) gg = *(const f32x4*)(zs + token * 5120 + 4096 + col);
                        else { const u32x2 t = *(const u32x2*)(sgb + token * 1024 + col); gg[0] = bflo(t.x); gg[1] = bfhi(t.x); gg[2] = bflo(t.y); gg[3] = bfhi(t.y); }
                        f32x4 v = acc[ai][bj][m][n] + bb;
                        v[0] = bflo(yy.x) * sigm(v[0]) * gg[0]; v[1] = bfhi(yy.x) * sigm(v[1]) * gg[1];
                        v[2] = bflo(yy.y) * sigm(v[2]) * gg[2]; v[3] = bfhi(yy.y) * sigm(v[3]) * gg[3];
                        *(u32x2*)(mix + token * 2048 + 1024 + col) = pack4(v);
                    }
            }
        }
    } else if (kind == K_OUT0 || kind == K_SOUT0 || kind == K_OUT1 || kind == K_SOUT1) {
        const bool smp = kind == K_SOUT0 || kind == K_SOUT1, l0 = kind == K_OUT0 || kind == K_SOUT0;
        const float* res = l0 ? (smp ? p.xs : p.xp) : (smp ? (const float*)(ws + WS_X1S) : p.out + O_YP);
        float* dst = l0 ? (smp ? (float*)(ws + WS_X1S) : p.out + O_YP) : (smp ? p.out + O_YS : p.out + O_YP);
        bf16_t* dstb = (bf16_t*)(ws + (smp ? WS_X1SB : WS_X1B));
        float* ssq = (float*)(ws + (l0 ? (smp ? WS_SSQ1S : WS_SSQ1) : (smp ? WS_SSQ2S : WS_SSQ2)));
#pragma unroll
        for (int ai = 0; ai < 2; ++ai) {
            if (smp && ai) break;
#pragma unroll
            for (int m = 0; m < 4; ++m) {
                const size_t token = (size_t)u.pm * 256 + ai * 128 + wr * 64 + m * 16 + fr;
                float s = 0.f;
#pragma unroll
                for (int bj = 0; bj < 2; ++bj)
#pragma unroll
                    for (int n = 0; n < 2; ++n) {
                        const int col = u.pn * 256 + bj * 128 + wc * 32 + n * 16 + fq * 4;
                        const f32x4 v = acc[ai][bj][m][n] + *(const f32x4*)(res + token * 1024 + col);
                        *(f32x4*)(dst + token * 1024 + col) = v;
                        if (l0) *(u32x2*)(dstb + token * 1024 + col) = pack4(v);
                        s += v[0] * v[0] + v[1] * v[1] + v[2] * v[2] + v[3] * v[3];
                    }
                s += __shfl_xor(s, 16); s += __shfl_xor(s, 32);
                if (fq == 0) ssq[((size_t)u.pn * MP + token) * 4 + wc] = s;
            }
        }
    } else if (kind == K_Q1 || kind == K_F || kind == K_G1) {
        const float* ssq = (const float*)(ws + WS_SSQ1);
        const float* lb = (const float*)(ws + WS_LB);
#pragma unroll
        for (int ai = 0; ai < 2; ++ai)
#pragma unroll
            for (int m = 0; m < 4; ++m) {
                const size_t token = (size_t)u.pm * 256 + ai * 128 + wr * 64 + m * 16 + fr;
                const float r = row_rstd16(ssq, token);
#pragma unroll
                for (int bj = 0; bj < 2; ++bj)
#pragma unroll
                    for (int n = 0; n < 2; ++n) {
                        const int cl = (u.pn & 3) * 256 + bj * 128 + wc * 32 + n * 16 + fq * 4;
                        f32x4 v = acc[ai][bj][m][n] * r;
                        if (kind == K_F) {
                            const f32x4 l = *(const f32x4*)(lb + cl);
#pragma unroll
                            for (int i = 0; i < 4; ++i) v[i] = __logf(l[i] + (1.f - l[i]) * sigm(v[i]));
                            *(f32x4*)((float*)(ws + WS_CUM) + token * 1024 + cl) = v;
                        } else {
                            v[0] = silu_(v[0]); v[1] = silu_(v[1]); v[2] = silu_(v[2]); v[3] = silu_(v[3]);
                            *(u32x2*)((bf16_t*)(ws + (kind == K_Q1 ? WS_Q1 : WS_SG1)) + token * 1024 + cl) = pack4(v);
                        }
                    }
            }
    } else if (kind == K_SIN1) {
        const float* ssq = (const float*)(ws + WS_SSQ1S);
        const float* lb = (const float*)(ws + WS_LB);
        float* z1 = (float*)(ws + WS_Z1S);
#pragma unroll
        for (int m = 0; m < 4; ++m) {
            const size_t row = wr * 64 + m * 16 + fr;
            const float r = row_rstd16(ssq, row);
            const int ty = u.pn >> 2;
#pragma unroll
            for (int bj = 0; bj < 2; ++bj)
#pragma unroll
                for (int n = 0; n < 2; ++n) {
                    const int cl = (u.pn & 3) * 256 + bj * 128 + wc * 32 + n * 16 + fq * 4;
                    f32x4 v = acc[0][bj][m][n] * r;
                    if (ty == 1) { const f32x4 l = *(const f32x4*)(lb + cl);
#pragma unroll
                        for (int i = 0; i < 4; ++i) v[i] = l[i] + (1.f - l[i]) * sigm(v[i]); }
                    else if (ty != 2) { v[0] = silu_(v[0]); v[1] = silu_(v[1]); v[2] = silu_(v[2]); v[3] = silu_(v[3]); }
                    *(f32x4*)(z1 + row * 4096 + ty * 1024 + cl) = v;
                }
        }
    }
}

DEVI void gemm_phase(const int TIDX, LAS unsigned char* lds, const int K, const int lda, const int ldb, const bool ga, const Sched S, const Params& P) {
    const int tid = TIDX, wid = __builtin_amdgcn_readfirstlane(tid >> 6), lane = tid & 63, wr = wid >> 2, wc = wid & 3, fr = lane & 15, fq = lane >> 4;
    const int nt = K / BK;
    unsigned voffA[2], voffB[2];
#pragma unroll
    for (int i = 0; i < 2; ++i) { int R, C; stage_rc(tid * 16 + i * 8192, R, C); voffA[i] = ga ? (unsigned)(R * 32 + (C >> 4) * (MP * 32) + (C & 15) * 2) : (unsigned)(R * lda + C) * 2u; voffB[i] = (unsigned)(R * ldb + C) * 2u; }
    const size_t kstep = (size_t)(BK * 2), kstepA = ga ? (size_t)4 * MP * 32 : kstep;
    const size_t hstepA = ga ? (size_t)HALF * 32 : (size_t)HALF * lda * 2, hstepB = (size_t)HALF * ldb * 2;
    const unsigned ldsw = (unsigned)wid * 1024u;
    const int aoff = lds_byte(wr * 64 + fr, fq * 8), boff = lds_byte(wc * 32 + fr, fq * 8);
#define PG8_SA(b, h) (((b) * 2 + (h)) * HTB)
#define PG8_SB(b, h) ((4 + (b) * 2 + (h)) * HTB)
#define PG8_STAGE(bufoff, gbase, voff) do { _Pragma("unroll") for (int _i = 0; _i < 2; ++_i) \
        __builtin_amdgcn_global_load_lds((const unsigned*)((const char*)(gbase) + (voff)[_i]), (LAS unsigned*)(lds + (bufoff) + ldsw + _i * 8192), 16, 0, 0); } while (0)
#define PG8_LDA(dst, b, h) do { _Pragma("unroll") for (int m = 0; m < 4; ++m) _Pragma("unroll") for (int k = 0; k < 2; ++k) dst[m][k] = *(const LAS bf16x8*)(lds + PG8_SA(b, h) + aoff + m * 2048 + k * 1024); } while (0)
#define PG8_LDB(dst, b, h) do { _Pragma("unroll") for (int n = 0; n < 2; ++n) _Pragma("unroll") for (int k = 0; k < 2; ++k) dst[n][k] = *(const LAS bf16x8*)(lds + PG8_SB(b, h) + boff + n * 2048 + k * 1024); } while (0)
#define PG8_MMA(ai, bj, At, Bt) do { __builtin_amdgcn_s_setprio(1); _Pragma("unroll") for (int m = 0; m < 4; ++m) _Pragma("unroll") for (int n = 0; n < 2; ++n) _Pragma("unroll") for (int k = 0; k < 2; ++k) \
        acc[ai][bj][m][n] = __builtin_amdgcn_mfma_f32_16x16x32_bf16(Bt[n][k], At[m][k], acc[ai][bj][m][n], 0, 0, 0); __builtin_amdgcn_s_setprio(0); } while (0)
#define PG8_WAIT_V(n) asm volatile("s_waitcnt vmcnt(" #n ")" ::: "memory")
#define PG8_WAIT_L(n) asm volatile("s_waitcnt lgkmcnt(" #n ")" ::: "memory")
#define PG8_BAR __builtin_amdgcn_s_barrier()
#define PG8_SCHED __builtin_amdgcn_sched_barrier(0)
    Unit cur, nxt; int ui = 0;
    if (!S.next(0, cur)) return;
    f32x4 acc[2][2][4][2];
#pragma unroll
    for (int a = 0; a < 2; ++a)
#pragma unroll
        for (int b = 0; b < 2; ++b)
#pragma unroll
            for (int m = 0; m < 4; ++m)
#pragma unroll
                for (int n = 0; n < 2; ++n) acc[a][b][m][n] = (f32x4){0.f, 0.f, 0.f, 0.f};
    bf16x8 At[4][2], B0[2][2], B1[2][2];
    const char* cA = cur.a; const char* cB = cur.b;
    PG8_STAGE(PG8_SB(0, 0), cB, voffB); PG8_STAGE(PG8_SA(0, 0), cA, voffA); PG8_STAGE(PG8_SB(0, 1), cB + hstepB, voffB); PG8_STAGE(PG8_SA(0, 1), cA + hstepA, voffA);
    if (wr == 1) PG8_BAR;
    PG8_WAIT_V(4); PG8_BAR;
    PG8_STAGE(PG8_SB(1, 0), cB + kstep, voffB); PG8_STAGE(PG8_SA(1, 0), cA + kstepA, voffA); PG8_STAGE(PG8_SB(1, 1), cB + hstepB + kstep, voffB);
    PG8_WAIT_V(6); PG8_BAR;
    for (;;) {
        const bool has_next = S.next(ui + 1, nxt);
        const char* nA = has_next ? nxt.a : cA; const char* nB = has_next ? nxt.b : cB;
        for (int t = 0; t < nt; t += 2) {
            const bool last = (t == nt - 2);
            const char* a1 = cA + (size_t)(t + 1) * kstepA;
            const char* a2 = last ? nA : cA + (size_t)(t + 2) * kstepA; const char* b2 = last ? nB : cB + (size_t)(t + 2) * kstep;
            const char* a3 = a2 + kstepA; const char* b3 = b2 + kstep;
            PG8_LDB(B0, 0, 0); PG8_SCHED; PG8_LDA(At, 0, 0); PG8_STAGE(PG8_SA(1, 1), a1 + hstepA, voffA);
            PG8_WAIT_L(8); PG8_BAR; PG8_WAIT_L(0); PG8_MMA(0, 0, At, B0); PG8_BAR; PG8_SCHED;
            PG8_LDB(B1, 0, 1); PG8_STAGE(PG8_SB(0, 0), b2, voffB);
            PG8_BAR; PG8_WAIT_L(0); PG8_MMA(0, 1, At, B1); PG8_BAR;
            PG8_LDA(At, 0, 1); PG8_STAGE(PG8_SA(0, 0), a2, voffA);
            PG8_BAR; PG8_WAIT_L(0); PG8_MMA(1, 0, At, B0); PG8_BAR; PG8_SCHED;
            PG8_STAGE(PG8_SB(0, 1), b2 + hstepB, voffB);
            PG8_WAIT_V(6); PG8_BAR; PG8_MMA(1, 1, At, B1); PG8_BAR;
            PG8_LDB(B0, 1, 0); PG8_SCHED; PG8_LDA(At, 1, 0); PG8_STAGE(PG8_SA(0, 1), a2 + hstepA, voffA);
            PG8_WAIT_L(8); PG8_BAR; PG8_WAIT_L(0); PG8_MMA(0, 0, At, B0); PG8_BAR; PG8_SCHED;
            PG8_LDB(B1, 1, 1); PG8_STAGE(PG8_SB(1, 0), b3, voffB);
            PG8_BAR; PG8_WAIT_L(0); PG8_MMA(0, 1, At, B1); PG8_BAR;
            PG8_LDA(At, 1, 1); PG8_STAGE(PG8_SA(1, 0), a3, voffA);
            PG8_BAR; PG8_WAIT_L(0); PG8_MMA(1, 0, At, B0); PG8_BAR; PG8_SCHED;
            PG8_STAGE(PG8_SB(1, 1), b3 + hstepB, voffB);
            PG8_WAIT_V(6); PG8_BAR; PG8_MMA(1, 1, At, B1); PG8_BAR;
        }
        { int ozv; asm volatile("v_mov_b32 %0, 0" : "=v"(ozv)); epilogue(P, acc, cur, wr, wc, fr + ozv, fq + ozv); }
        if (!has_next) break;
#pragma unroll
        for (int a = 0; a < 2; ++a)
#pragma unroll
            for (int b = 0; b < 2; ++b)
#pragma unroll
                for (int m = 0; m < 4; ++m)
#pragma unroll
                    for (int n = 0; n < 2; ++n) acc[a][b][m][n] = (f32x4){0.f, 0.f, 0.f, 0.f};
        cur = nxt; cA = nA; cB = nB; ++ui;
    }
    PG8_WAIT_V(0);
    if (wr == 0) PG8_BAR;
    PG8_BAR;
}

DEVI void prep_transpose(const int TIDX, const int BIDX, float* tile, const float* src, int K, int N, bf16_t* dst, const float* kscale, bool permqk, int job0, int& jobbase, int gsz) {
    (void)tile;
    const int nk8 = K / 8, ntn = N / 64, njobs = ntn * (nk8 / 8), lane = TIDX & 63, wid = TIDX >> 6;
    for (int jb = job0 - jobbase; jb < njobs; jb += gsz) {
        if (jb < 0) continue;
        const int tn = jb / (nk8 / 8), tk = jb % (nk8 / 8), n0 = tn * 64, k0 = tk * 64 + wid * 8;
        int c0 = n0;
        if (permqk && n0 < 1024) { const int tile_ = n0 >> 8, cp = n0 & 255, bj = cp >> 7, w = cp & 127; c0 = tile_ * 256 + (w >> 6) * 128 + bj * 64; }
        float v[8];
#pragma unroll
        for (int j = 0; j < 8; ++j) v[j] = src[(size_t)(k0 + j) * N + c0 + lane] * (kscale ? kscale[k0 + j] : 1.f);
        u32x4 o; o.x = pack2(v[0], v[1]); o.y = pack2(v[2], v[3]); o.z = pack2(v[4], v[5]); o.w = pack2(v[6], v[7]);
        *(u32x4*)(dst + (size_t)(n0 + lane) * K + k0) = o;
    }
    jobbase += njobs;
}

DEVI void prep_s5_tables(const int TIDX, const int BIDX, float* L, const Params& p, int g) {
    float* pwr = L;
    float* pwi = pwr + 17 * 64;
    float* bbr = pwi + 17 * 64;
    float* bbi = bbr + 1024;
    float* cr = bbi + 1024;
    float* ci = cr + 1024;
    float* kg = ci + 1024;
    const int tid = TIDX;
    char* ws = p.ws;
    __syncthreads();
    {
        const double dt = exp((double)p.logdt[g]);
        for (int i = tid; i < 17 * 64; i += 512) {
            const int t = i >> 6, pp = i & 63;
            const double lr = p.lamre[g * 64 + pp], li = p.lamim[g * 64 + pp];
            const double mag = exp(lr * dt * t), ang = li * dt * t;
            pwr[t * 64 + pp] = (float)(mag * cos(ang)); pwi[t * 64 + pp] = (float)(mag * sin(ang));
        }
        for (int i = tid; i < 1024; i += 512) {
            const int pp = i >> 4, c = i & 15;
            const double lr = p.lamre[g * 64 + pp], li = p.lamim[g * 64 + pp];
            const double mag = exp(lr * dt), ang = li * dt, lbr = mag * cos(ang), lbi = mag * sin(ang);
            const double nr = lbr - 1.0, den = lr * lr + li * li, fr = (nr * lr + lbi * li) / den, fi = (lbi * lr - nr * li) / den;
            const double br = p.bre[(g * 64 + pp) * 16 + c], bi = p.bim[(g * 64 + pp) * 16 + c];
            const float xr = (float)(fr * br - fi * bi), xi = (float)(fr * bi + fi * br);
            bbr[i] = xr; bbi[i] = xi;
            float* bbg = (float*)(ws + WS_BBG); bbg[(g * 1024 + i) * 2] = xr; bbg[(g * 1024 + i) * 2 + 1] = xi;
            if (c == 0) { float* lam1 = (float*)(ws + WS_LAM1); lam1[(g * 64 + pp) * 2] = (float)lbr; lam1[(g * 64 + pp) * 2 + 1] = (float)lbi; }
        }
    }
    __syncthreads();
    if (tid < 64) { float* lam16 = (float*)(ws + WS_LAM16); lam16[(g * 64 + tid) * 2] = pwr[16 * 64 + tid]; lam16[(g * 64 + tid) * 2 + 1] = pwi[16 * 64 + tid]; }
    for (int i = tid; i < 1024; i += 512) { cr[i] = p.cre[g * 1024 + i]; ci[i] = p.cim[g * 1024 + i]; }
    __syncthreads();
    for (int i = tid; i < 4096; i += 512) {
        const int tau = i >> 8, c = (i >> 4) & 15, cp = i & 15;
        float s = 0.f;
        for (int pp = 0; pp < 64; ++pp) {
            const float a = pwr[tau * 64 + pp], b = pwi[tau * 64 + pp], xr = bbr[pp * 16 + cp], xi = bbi[pp * 16 + cp];
            s += cr[c * 64 + pp] * (a * xr - b * xi) - ci[c * 64 + pp] * (a * xi + b * xr);
        }
        kg[i] = s;
    }
    __syncthreads();
    bf16_t* bt2 = (bf16_t*)(ws + WS_BT2) + (size_t)g * 256 * 384;
    for (int i = tid; i < 256 * 48; i += 512) {
        const int n = i / 48, k8 = (i % 48) * 8, t = n >> 4, c = n & 15;
        float v[8];
#pragma unroll
        for (int j = 0; j < 8; ++j) {
            const int k = k8 + j;
            if (k < 256) { const int s = k >> 4, cp = k & 15; v[j] = t >= s ? kg[(t - s) * 256 + c * 16 + cp] : 0.f; }
            else { const int q = k - 256, pp = q & 63; const float a = pwr[(t + 1) * 64 + pp], b = pwi[(t + 1) * 64 + pp];
                v[j] = q < 64 ? (cr[c * 64 + pp] * a - ci[c * 64 + pp] * b) : -(cr[c * 64 + pp] * b + ci[c * 64 + pp] * a); }
        }
        u32x4 o; o.x = pack2(v[0], v[1]); o.y = pack2(v[2], v[3]); o.z = pack2(v[4], v[5]); o.w = pack2(v[6], v[7]);
        *(u32x4*)(bt2 + (size_t)n * 384 + k8) = o;
    }
    bf16_t* bt1 = (bf16_t*)(ws + WS_BT1) + (size_t)g * 256 * 256;
    for (int i = tid; i < 256 * 32; i += 512) {
        const int n = i >> 5, k8 = (i & 31) * 8;
        float v[8];
#pragma unroll
        for (int j = 0; j < 8; ++j) {
            const int k = k8 + j, s = k >> 4, cp = k & 15;
            if (n >= 128) v[j] = 0.f;
            else { const int pp = n & 63; const float a = pwr[(15 - s) * 64 + pp], b = pwi[(15 - s) * 64 + pp], xr = bbr[pp * 16 + cp], xi = bbi[pp * 16 + cp];
                v[j] = n < 64 ? (a * xr - b * xi) : (a * xi + b * xr); }
        }
        u32x4 o; o.x = pack2(v[0], v[1]); o.y = pack2(v[2], v[3]); o.z = pack2(v[4], v[5]); o.w = pack2(v[6], v[7]);
        *(u32x4*)(bt1 + (size_t)n * 256 + k8) = o;
    }
}

DEVI void phase_prep(const int TIDX, const int BIDX, float* L, const Params& p) {
    const int tid = TIDX, bid = BIDX, G = gridDim.x, lane = tid & 63, wid = tid >> 6;
    char* ws = p.ws;
    for (int g = G - 1 - bid; g < 64; g += G) if (g >= 0) prep_s5_tables(TIDX, BIDX, L, p, g);
    __syncthreads();
    const int GT = G > 64 ? G - 64 : G;
    const int tb = (G > 64 && bid >= GT) ? (1 << 28) : bid;
    int jobbase = 0;
    prep_transpose(TIDX, BIDX, L, p.win0, 1024, 5120, (bf16_t*)(ws + WS_WIN0T), nullptr, true, tb, jobbase, GT);
    prep_transpose(TIDX, BIDX, L, p.gluw, 1024, 1024, (bf16_t*)(ws + WS_WGLUT), nullptr, false, tb, jobbase, GT);
    prep_transpose(TIDX, BIDX, L, p.wout0, 2048, 1024, (bf16_t*)(ws + WS_WOUT0T), nullptr, false, tb, jobbase, GT);
    prep_transpose(TIDX, BIDX, L, p.win1, 1024, 4096, (bf16_t*)(ws + WS_WIN1T), p.normw + 1024, false, tb, jobbase, GT);
    prep_transpose(TIDX, BIDX, L, p.wout1, 1024, 1024, (bf16_t*)(ws + WS_WOUT1T), nullptr, false, tb, jobbase, GT);
    bf16_t* h0 = (bf16_t*)(p.out + O_RETS); bf16_t* h0s = (bf16_t*)(ws + WS_H0S);
    for (int row = bid * 8 + wid; row < MP + 256; row += G * 8) {
        bf16_t* d = row < MP ? h0 + (size_t)row * 1024 : h0s + (size_t)(row - MP) * 1024;
        if (row >= MP + MS) { for (int i = 0; i < 4; ++i) *(u32x2*)(d + i * 256 + lane * 4) = (u32x2){0u, 0u}; continue; }
        const float* x = row < MP ? p.xp + (size_t)row * 1024 : p.xs + (size_t)(row - MP) * 1024;
        f32x4 v[4]; float s = 0.f;
#pragma unroll
        for (int i = 0; i < 4; ++i) { v[i] = *(const f32x4*)(x + i * 256 + lane * 4); s += v[i][0] * v[i][0] + v[i][1] * v[i][1] + v[i][2] * v[i][2] + v[i][3] * v[i][3]; }
        s = wave_sum(s);
        const float r = rsqrtf(s * (1.0f / 1024.0f) + 1e-6f);
#pragma unroll
        for (int i = 0; i < 4; ++i) { const f32x4 w = *(const f32x4*)(p.normw + i * 256 + lane * 4); *(u32x2*)(d + i * 256 + lane * 4) = pack4(v[i] * r * w); }
    }
    for (int i = bid * 512 + tid; i < 128 * 1024 / 8; i += G * 512) {
        const u32x4 z = {0u, 0u, 0u, 0u};
        *(u32x4*)((bf16_t*)(ws + WS_Y5S) + 128 * 1024 + (size_t)i * 8) = z;
        *(u32x4*)((bf16_t*)(ws + WS_X1SB) + 128 * 1024 + (size_t)i * 8) = z;
        *(u32x4*)((bf16_t*)(ws + WS_O1S) + 128 * 1024 + (size_t)i * 8) = z;
        *(u32x4*)((bf16_t*)(ws + WS_MIX0S) + 128 * 2048 + (size_t)i * 16) = z;
        *(u32x4*)((bf16_t*)(ws + WS_MIX0S) + 128 * 2048 + (size_t)i * 16 + 8) = z;
    }
    float* rope = (float*)(ws + WS_ROPE);
    for (int i = bid * 512 + tid; i < 2049 * 64; i += G * 512) {
        const int pr = i >> 6, j = i & 63; const double pos = pr == 2048 ? 16384.0 : (double)pr;
        const double inv = exp2(-(double)j * (13.287712379549449 / 64.0));
        const double rev = pos * inv * 0.15915494309189535; const double fr = rev - floor(rev); const double a = fr * 6.283185307179586;
        rope[pr * 128 + j] = (float)cos(a); rope[pr * 128 + 64 + j] = (float)sin(a);
    }
    float* lb = (float*)(ws + WS_LB);
    for (int i = bid * 512 + tid; i < 1024; i += G * 512) lb[i] = 1.f / (1.f + expf(p.hglb[i] - p.hglb[1024 + i]));
}

DEVI float ret_lg(int h) { return log1pf(-exp2f(-5.0f - (float)h)); }

DEVI void phase_R1(const int TIDX, const int BIDX, bf16_t* L, const Params& p) {
    const int tid = TIDX, wid = tid >> 6, lane = tid & 63, r16 = lane & 15, g = lane >> 4;
    const bf16_t* kt = (const bf16_t*)(p.ws + WS_KT); const bf16_t* vt = (const bf16_t*)(p.ws + WS_VT);
    float* kvt = p.out + O_YP;
    for (int it = BIDX; it < 512; it += gridDim.x) {
        const int bh = it >> 4, c = it & 15, h = bh & 3, t0 = c * 128; const float lg = ret_lg(h);
        __syncthreads();
        { const int d = tid >> 2, seg = tid & 3;
#pragma unroll
          for (int q = 0; q < 4; ++q) {
              const int l0 = seg * 32 + q * 8;
              const u32x4 v = *(const u32x4*)(kt + ((size_t)bh * 128 + d) * 2048 + t0 + l0);
              u32x4 o; const unsigned* vv = (const unsigned*)&v; unsigned* oo = (unsigned*)&o;
#pragma unroll
              for (int j = 0; j < 4; ++j) oo[j] = pack2(bflo(vv[j]) * __expf(lg * (float)(127 - l0 - 2 * j)), bfhi(vv[j]) * __expf(lg * (float)(126 - l0 - 2 * j)));
              *(u32x4*)(L + d * 136 + l0) = o; } }
        __syncthreads();
        bf16x8 bfr[2][4];
#pragma unroll
        for (int ct = 0; ct < 2; ++ct)
#pragma unroll
            for (int kk = 0; kk < 4; ++kk) bfr[ct][kk] = *(const bf16x8*)(vt + ((size_t)bh * 256 + wid * 32 + ct * 16 + r16) * 2048 + t0 + kk * 32 + g * 8);
#pragma unroll
        for (int rt = 0; rt < 8; ++rt) {
            f32x4 a0 = {0.f, 0.f, 0.f, 0.f}, a1 = a0;
#pragma unroll
            for (int kk = 0; kk < 4; ++kk) { const bf16x8 a = *(const bf16x8*)(L + (rt * 16 + r16) * 136 + kk * 32 + g * 8); a0 = mfma16(a, bfr[0][kk], a0); a1 = mfma16(a, bfr[1][kk], a1); }
            float* d0 = kvt + (((size_t)bh * 16 + c) * 256 + wid * 32 + r16) * 128 + rt * 16 + g * 4;
            *(f32x4*)d0 = a0; *(f32x4*)(d0 + 16 * 128) = a1;
        }
    }
}

DEVI void phase_R2(const int TIDX, const int BIDX, const Params& p) {
    float* kvt = p.out + O_YP;
    for (int i = BIDX * 512 + TIDX; i < 32 * 256 * 16; i += gridDim.x * 512) {
        const int q = i & 15, e = (i >> 4) & 255, bh = i >> 12, h = bh & 3; const float dec = __expf(ret_lg(h) * 128.f);
        f32x4 s0 = {0.f, 0.f, 0.f, 0.f}, s1 = s0;
#pragma unroll 4
        for (int c = 0; c < 16; ++c) {
            float* ptr = kvt + (((size_t)bh * 16 + c) * 256 + e) * 128 + q * 8;
            const f32x4 v0 = *(const f32x4*)ptr, v1 = *(const f32x4*)(ptr + 4);
            u32x4 o; o.x = pack2(s0[0], s0[1]); o.y = pack2(s0[2], s0[3]); o.z = pack2(s1[0], s1[1]); o.w = pack2(s1[2], s1[3]);
            *(u32x4*)ptr = o;
            s0 = s0 * dec + v0; s1 = s1 * dec + v1;
        }
        float* o = p.out + O_RETP + ((size_t)bh * 128 + q * 8) * 256 + e;
#pragma unroll
        for (int j = 0; j < 4; ++j) { o[(size_t)j * 256] = s0[j]; o[(size_t)(j + 4) * 256] = s1[j]; }
    }
}

DEVI void phase_R3(const int TIDX, const int BIDX, bf16_t* L, const Params& p) {
    const int tid = TIDX, wid = tid >> 6, lane = tid & 63, r16 = lane & 15, g = lane >> 4;
    const bf16_t* Q = (const bf16_t*)(p.ws + WS_Q); const bf16_t* KN = (const bf16_t*)(p.ws + WS_KN); const bf16_t* vt = (const bf16_t*)(p.ws + WS_VT);
    const bf16_t* sga = (const bf16_t*)(p.ws + WS_SGA); bf16_t* mix = (bf16_t*)(p.out + O_HGS);
    const float* kvt = p.out + O_YP;
    bf16_t* S = L;
    float* st = (float*)(L + 128 * 136);
    float* mr = st + 128 * 16;
    for (int it = BIDX; it < 512; it += gridDim.x) {
        const int bh = it >> 4, c = it & 15, h = bh & 3, b = bh >> 2, l0 = wid * 16; const size_t tok0 = (size_t)b * 2048 + c * 128; const float lg = ret_lg(h);
        bf16x8 qa[4];
#pragma unroll
        for (int kk = 0; kk < 4; ++kk) qa[kk] = *(const bf16x8*)(Q + (tok0 + l0 + r16) * 512 + h * 128 + kk * 32 + g * 8);
        __syncthreads();
        for (int j = 0; j < 8; ++j) {
            f32x4 sc = {0.f, 0.f, 0.f, 0.f};
            if (j <= wid) {
#pragma unroll
                for (int kk = 0; kk < 4; ++kk) sc = mfma16(qa[kk], *(const bf16x8*)(KN + (tok0 + j * 16 + r16) * 512 + h * 128 + kk * 32 + g * 8), sc);
            }
#pragma unroll
            for (int r = 0; r < 4; ++r) {
                const int li = l0 + g * 4 + r, mi = j * 16 + r16; const float v = (j <= wid && li >= mi) ? sc[r] * __expf(lg * (float)(li - mi)) : 0.f;
                S[li * 136 + mi] = f2bf(v);
            }
        }
        f32x4 acc[8][2];
#pragma unroll
        for (int rt = 0; rt < 8; ++rt) { acc[rt][0] = (f32x4){0.f, 0.f, 0.f, 0.f}; acc[rt][1] = (f32x4){0.f, 0.f, 0.f, 0.f}; }
        if (c > 0) {
            bf16x8 bs[2][4];
#pragma unroll
            for (int ct = 0; ct < 2; ++ct)
#pragma unroll
                for (int kk = 0; kk < 4; ++kk) bs[ct][kk] = *(const bf16x8*)(kvt + (((size_t)bh * 16 + c) * 256 + wid * 32 + ct * 16 + r16) * 128 + kk * 32 + g * 8);
#pragma unroll
            for (int rt = 0; rt < 8; ++rt) {
                f32x4 a0 = {0.f, 0.f, 0.f, 0.f}, a1 = a0;
#pragma unroll
                for (int kk = 0; kk < 4; ++kk) {
                    const bf16x8 q = *(const bf16x8*)(Q + (tok0 + rt * 16 + r16) * 512 + h * 128 + kk * 32 + g * 8);
                    a0 = mfma16(q, bs[0][kk], a0); a1 = mfma16(q, bs[1][kk], a1);
                }
#pragma unroll
                for (int r = 0; r < 4; ++r) { const float qd = __expf(lg * (float)(rt * 16 + g * 4 + r + 1)); a0[r] *= qd; a1[r] *= qd; }
                acc[rt][0] = a0; acc[rt][1] = a1;
                __builtin_amdgcn_sched_barrier(0);
            }
        }
        bf16x8 bv[2][4];
#pragma unroll
        for (int ct = 0; ct < 2; ++ct)
#pragma unroll
            for (int kk = 0; kk < 4; ++kk) bv[ct][kk] = *(const bf16x8*)(vt + ((size_t)bh * 256 + wid * 32 + ct * 16 + r16) * 2048 + c * 128 + kk * 32 + g * 8);
        __syncthreads();
#pragma unroll
        for (int rt = 0; rt < 8; ++rt) {
            f32x4 a0 = acc[rt][0], a1 = acc[rt][1];
#pragma unroll
            for (int kk = 0; kk < 4; ++kk) {
                if (kk <= (rt >> 1)) {
                    const bf16x8 a = *(const bf16x8*)(S + (rt * 16 + r16) * 136 + kk * 32 + g * 8);
                    a0 = mfma16(a, bv[0][kk], a0); a1 = mfma16(a, bv[1][kk], a1);
                }
            }
            acc[rt][0] = a0; acc[rt][1] = a1;
#pragma unroll
            for (int r = 0; r < 4; ++r) {
                float s1 = a0[r] + a1[r], s2 = a0[r] * a0[r] + a1[r] * a1[r];
                s1 = grp16_sum(s1); s2 = grp16_sum(s2);
                if (r16 == 0) { st[((rt * 16 + g * 4 + r) * 8 + wid) * 2] = s1; st[((rt * 16 + g * 4 + r) * 8 + wid) * 2 + 1] = s2; }
            }
            __builtin_amdgcn_sched_barrier(0);
        }
        __syncthreads();
        if (tid < 128) {
            float s1 = 0.f, s2 = 0.f;
#pragma unroll
            for (int w = 0; w < 8; ++w) { s1 += st[(tid * 8 + w) * 2]; s2 += st[(tid * 8 + w) * 2 + 1]; }
            const float mu = s1 * (1.f / 256.f), var = fmaxf(s2 * (1.f / 256.f) - mu * mu, 0.f);
            mr[tid * 2] = mu; mr[tid * 2 + 1] = rsqrtf(var + 1e-5f);
        }
        __syncthreads();
        const float gw0 = p.gnw[h * 256 + wid * 32 + r16], gw1 = p.gnw[h * 256 + wid * 32 + 16 + r16];
#pragma unroll
        for (int rt = 0; rt < 8; ++rt)
#pragma unroll
            for (int r = 0; r < 4; ++r) {
                const int row = rt * 16 + g * 4 + r; const size_t token = tok0 + row; const float mu = mr[row * 2], rs = mr[row * 2 + 1];
                const size_t o = token * 1024 + h * 256 + wid * 32 + r16;
                const float v0 = (acc[rt][0][r] - mu) * rs * gw0 * bf2f(sga[o]), v1 = (acc[rt][1][r] - mu) * rs * gw1 * bf2f(sga[o + 16]);
                mix[token * 2048 + h * 256 + wid * 32 + r16] = f2bf(v0); mix[token * 2048 + h * 256 + wid * 32 + 16 + r16] = f2bf(v1);
            }
    }
}

DEVI void phase_s5scan(const int TIDX, const int BIDX, const Params& p) {
    const int wid = TIDX >> 6, lane = TIDX & 63;
    const float* e5 = p.out + O_HGS; bf16_t* a2 = (bf16_t*)(p.ws + WS_A2); const float* lam16 = (const float*)(p.ws + WS_LAM16);
    for (int it = BIDX * 8 + wid; it < 512; it += gridDim.x * 8) {
        const int b = it >> 6, g = it & 63;
        const float ar = lam16[(g * 64 + lane) * 2], ai = lam16[(g * 64 + lane) * 2 + 1];
        float hr = 0.f, hi = 0.f;
        for (int jb = 0; jb < 128; jb += 16) {
            float er[16], ei[16];
#pragma unroll
            for (int j = 0; j < 16; ++j) { const float* ep = e5 + ((size_t)g * 1024 + b * 128 + jb + j) * 128; er[j] = ep[lane]; ei[j] = ep[64 + lane]; }
#pragma unroll
            for (int j = 0; j < 16; ++j) {
                bf16_t* hp = a2 + ((size_t)g * 1024 + b * 128 + jb + j) * 384 + 256;
                hp[lane] = f2bf(hr); hp[64 + lane] = f2bf(hi);
                const float nr = ar * hr - ai * hi + er[j], ni = ar * hi + ai * hr + ei[j];
                hr = nr; hi = ni;
            }
        }
        p.out[O_S5RP + (size_t)(b * 64 + g) * 64 + lane] = hr; p.out[O_S5IP + (size_t)(b * 64 + g) * 64 + lane] = hi;
    }
}

DEVI void phase_H1(const int TIDX, const int BIDX, bf16_t* L, const Params& p) {
    const int tid = TIDX, wid = tid >> 6, lane = tid & 63, r16 = lane & 15, g = lane >> 4;
    float* cum = (float*)(p.ws + WS_CUM); const bf16_t* itp = (const bf16_t*)(p.ws + WS_IT); float* hkv = (float*)(p.ws + WS_HKV);
    float* tot = (float*)(L + 128 * 136);
    for (int it = BIDX; it < 1024; it += gridDim.x) {
        const int bh = it >> 4, c = it & 15, h = bh & 7, b = bh >> 3; const size_t tok0 = (size_t)b * 2048 + c * 128;
        const int d = tid & 127, part = tid >> 7;
        float* col = cum + (tok0 + part * 32) * 1024 + h * 128 + d;
        float lf[32]; float s = 0.f;
#pragma unroll
        for (int l = 0; l < 32; ++l) { lf[l] = col[(size_t)l * 1024]; s += lf[l]; }
        __syncthreads();
        tot[part * 128 + d] = s;
        __syncthreads();
        float off = 0.f, last = 0.f;
#pragma unroll
        for (int pp = 0; pp < 4; ++pp) { const float t = tot[pp * 128 + d]; if (pp < part) off += t; last += t; }
        float cc = off;
#pragma unroll
        for (int l = 0; l < 32; ++l) {
            cc += lf[l]; col[(size_t)l * 1024] = cc;
            L[d * 136 + part * 32 + l] = f2bf((1.f - __expf(lf[l])) * __expf(last - cc));
        }
        __syncthreads();
        bf16x8 bfr[4];
#pragma unroll
        for (int kk = 0; kk < 4; ++kk) bfr[kk] = *(const bf16x8*)(itp + ((size_t)bh * 128 + wid * 16 + r16) * 2048 + c * 128 + kk * 32 + g * 8);
#pragma unroll
        for (int rt = 0; rt < 8; ++rt) {
            f32x4 a0 = {0.f, 0.f, 0.f, 0.f};
#pragma unroll
            for (int kk = 0; kk < 4; ++kk) a0 = mfma16(*(const bf16x8*)(L + (rt * 16 + r16) * 136 + kk * 32 + g * 8), bfr[kk], a0);
            *(f32x4*)(hkv + (((size_t)bh * 16 + c) * 128 + wid * 16 + r16) * 128 + rt * 16 + g * 4) = a0;
        }
    }
}

DEVI void phase_H2(const int TIDX, const int BIDX, const Params& p) {
    float* hkv = (float*)(p.ws + WS_HKV); const float* cum = (const float*)(p.ws + WS_CUM);
    for (int i = BIDX * 512 + TIDX; i < 64 * 128 * 16; i += gridDim.x * 512) {
        const int q = i & 15, e = (i >> 4) & 127, bh = i >> 11, h = bh & 7, b = bh >> 3;
        f32x4 s0 = {0.f, 0.f, 0.f, 0.f}, s1 = s0;
#pragma unroll 4
        for (int c = 0; c < 16; ++c) {
            float* ptr = hkv + (((size_t)bh * 16 + c) * 128 + e) * 128 + q * 8;
            const float* lp = cum + ((size_t)b * 2048 + c * 128 + 127) * 1024 + h * 128 + q * 8;
            const f32x4 v0 = *(const f32x4*)ptr, v1 = *(const f32x4*)(ptr + 4), d0 = *(const f32x4*)lp, d1 = *(const f32x4*)(lp + 4);
            u32x4 o; o.x = pack2(s0[0], s0[1]); o.y = pack2(s0[2], s0[3]); o.z = pack2(s1[0], s1[1]); o.w = pack2(s1[2], s1[3]);
            *(u32x4*)ptr = o;
#pragma unroll
            for (int j = 0; j < 4; ++j) { s0[j] = s0[j] * __expf(d0[j]) + v0[j]; s1[j] = s1[j] * __expf(d1[j]) + v1[j]; }
        }
        float* o = p.out + O_HGP + ((size_t)bh * 128 + q * 8) * 128 + e;
#pragma unroll
        for (int j = 0; j < 4; ++j) { o[(size_t)j * 128] = s0[j]; o[(size_t)(j + 4) * 128] = s1[j]; }
    }
}

DEVI void phase_H3(const int TIDX, const int BIDX, bf16_t* L, const Params& p) {
    const int tid = TIDX, wid = tid >> 6, lane = tid & 63, r16 = lane & 15, g = lane >> 4;
    const float* cum = (const float*)(p.ws + WS_CUM); const bf16_t* itp = (const bf16_t*)(p.ws + WS_IT); const float* hkv = (const float*)(p.ws + WS_HKV);
    bf16_t* q1 = (bf16_t*)(p.ws + WS_Q1); const bf16_t* sg1 = (const bf16_t*)(p.ws + WS_SG1);
    bf16_t* kt = L; bf16_t* strip = L + 128 * 136 + wid * 16 * 136;
    for (int it = BIDX; it < 1024; it += gridDim.x) {
        const int bh = it >> 4, c = it & 15, h = bh & 7, b = bh >> 3, l0 = wid * 16; const size_t tok0 = (size_t)b * 2048 + c * 128;
        const float* refp = cum + (tok0 + 63) * 1024 + h * 128;
        __syncthreads();
        { const int m = tid >> 2, seg = tid & 3; const float* cp = cum + (tok0 + m) * 1024 + h * 128 + seg * 32;
#pragma unroll
          for (int q = 0; q < 8; ++q) {
              const f32x4 cv = *(const f32x4*)(cp + q * 4), rv = *(const f32x4*)(refp + seg * 32 + q * 4);
              f32x4 pv = {0.f, 0.f, 0.f, 0.f}; if (m > 0) pv = *(const f32x4*)(cp - 1024 + q * 4);
              f32x4 o;
#pragma unroll
              for (int j = 0; j < 4; ++j) o[j] = (1.f - __expf(cv[j] - pv[j])) * __expf(rv[j] - cv[j]);
              *(u32x2*)(kt + m * 136 + seg * 32 + q * 4) = pack4(o); } }
        bf16x8 qr[4], qab[4];
#pragma unroll
        for (int kk = 0; kk < 4; ++kk) {
            const size_t o = (tok0 + l0 + r16) * 1024 + h * 128 + kk * 32 + g * 8;
            const u32x4 qq = *(const u32x4*)(q1 + o);
            const f32x4 c0 = *(const f32x4*)(cum + o), c1 = *(const f32x4*)(cum + o + 4), r0 = *(const f32x4*)(refp + kk * 32 + g * 8), r1 = *(const f32x4*)(refp + kk * 32 + g * 8 + 4);
            const unsigned* qv = (const unsigned*)&qq; u32x4 a, bb; unsigned* av = (unsigned*)&a; unsigned* bv = (unsigned*)&bb;
#pragma unroll
            for (int j = 0; j < 4; ++j) {
                const float cl = j < 2 ? c0[2 * j] : c1[2 * j - 4], ch = j < 2 ? c0[2 * j + 1] : c1[2 * j - 3];
                const float rl = j < 2 ? r0[2 * j] : r1[2 * j - 4], rh = j < 2 ? r0[2 * j + 1] : r1[2 * j - 3];
                const float ql = bflo(qv[j]), qh = bfhi(qv[j]);
                av[j] = pack2(ql * __expf(cl - rl), qh * __expf(ch - rh)); bv[j] = pack2(ql * __expf(cl), qh * __expf(ch));
            }
            qr[kk] = *(bf16x8*)&a; qab[kk] = *(bf16x8*)&bb;
        }
        __syncthreads();
        for (int j = 0; j < 8; ++j) {
            f32x4 s = {0.f, 0.f, 0.f, 0.f};
            if (j <= wid) {
#pragma unroll
                for (int kk = 0; kk < 4; ++kk) s = mfma16(qr[kk], *(const bf16x8*)(kt + (j * 16 + r16) * 136 + kk * 32 + g * 8), s);
            }
#pragma unroll
            for (int r = 0; r < 4; ++r) {
                const int li = l0 + g * 4 + r, mi = j * 16 + r16; const float v = (j <= wid && li >= mi) ? s[r] : 0.f;
                strip[(g * 4 + r) * 136 + mi] = f2bf(v);
            }
        }
        f32x4 acc[8];
#pragma unroll
        for (int jt = 0; jt < 8; ++jt) acc[jt] = (f32x4){0.f, 0.f, 0.f, 0.f};
        if (c > 0) {
            const float* sb = hkv + ((size_t)bh * 16 + c) * 128 * 128;
#pragma unroll
            for (int jt = 0; jt < 8; ++jt)
#pragma unroll
                for (int kk = 0; kk < 4; ++kk) acc[jt] = mfma16(qab[kk], *(const bf16x8*)(sb + (size_t)(jt * 16 + r16) * 128 + kk * 32 + g * 8), acc[jt]);
        }
        __syncthreads();
        for (int kk = 0; kk <= (wid >> 1); ++kk) {
            const bf16x8 a = *(const bf16x8*)(strip + r16 * 136 + kk * 32 + g * 8);
#pragma unroll
            for (int jt = 0; jt < 8; ++jt) acc[jt] = mfma16(a, *(const bf16x8*)(itp + ((size_t)bh * 128 + jt * 16 + r16) * 2048 + c * 128 + kk * 32 + g * 8), acc[jt]);
        }
        float rs[4];
#pragma unroll
        for (int r = 0; r < 4; ++r) {
            float q = 0.f;
#pragma unroll
            for (int jt = 0; jt < 8; ++jt) q += acc[jt][r] * acc[jt][r];
            q = grp16_sum(q); rs[r] = rsqrtf(q * (1.f / 128.f) + 1e-6f);
        }
#pragma unroll
        for (int jt = 0; jt < 8; ++jt) {
            const int e = jt * 16 + r16; const float gw = p.hgnw[h * 128 + e];
#pragma unroll
            for (int r = 0; r < 4; ++r) {
                const size_t token = tok0 + l0 + g * 4 + r;
                q1[token * 1024 + h * 128 + e] = f2bf(acc[jt][r] * rs[r] * gw * bf2f(sg1[token * 1024 + h * 128 + e]));
            }
        }
    }
}

DEVI void phase_ss5(const int TIDX, const int BIDX, const Params& p) {
    const int wid = TIDX >> 6, lane = TIDX & 63;
    const float* zs = (const float*)(p.ws + WS_ZS); const float* bbg = (const float*)(p.ws + WS_BBG); const float* lam1 = (const float*)(p.ws + WS_LAM1);
    bf16_t* y5s = (bf16_t*)(p.ws + WS_Y5S);
    for (int it = BIDX * 8 + wid; it < 128 * 64; it += gridDim.x * 8) {
        const int b = it >> 6, g = it & 63;
        float u[16];
#pragma unroll
        for (int c = 0; c < 16; ++c) u[c] = zs[(size_t)b * 5120 + 3072 + g * 16 + c];
        float xr = 0.f, xi = 0.f;
#pragma unroll
        for (int c = 0; c < 16; ++c) { xr += bbg[((g * 64 + lane) * 16 + c) * 2] * u[c]; xi += bbg[((g * 64 + lane) * 16 + c) * 2 + 1] * u[c]; }
        const float ar = lam1[(g * 64 + lane) * 2], ai = lam1[(g * 64 + lane) * 2 + 1];
        const float sr = p.s5r[(size_t)(b * 64 + g) * 64 + lane], si = p.s5i[(size_t)(b * 64 + g) * 64 + lane];
        const float hr = ar * sr - ai * si + xr, hi = ar * si + ai * sr + xi;
        p.out[O_S5RS + (size_t)(b * 64 + g) * 64 + lane] = hr; p.out[O_S5IS + (size_t)(b * 64 + g) * 64 + lane] = hi;
        float mine = 0.f;
#pragma unroll
        for (int c = 0; c < 16; ++c) {
            float v = p.cre[(g * 16 + c) * 64 + lane] * hr - p.cim[(g * 16 + c) * 64 + lane] * hi;
            v = wave_sum(v);
            if (lane == c) mine = v + p.s5d[g * 16 + c] * u[c];
        }
        if (lane < 16) y5s[(size_t)b * 1024 + g * 16 + lane] = f2bf(gelu_(mine));
    }
}

DEVI void phase_sret(const int TIDX, const int BIDX, float* L, const Params& p) {
    const int tid = TIDX, lane = tid & 63, wid = tid >> 6;
    const float* zs = (const float*)(p.ws + WS_ZS); bf16_t* mix = (bf16_t*)(p.ws + WS_MIX0S);
    float* qs = L; float* ks = L + 128; float* red = L + 256; float* st = L + 768;
    for (int it = BIDX; it < 512; it += gridDim.x) {
        const int b = it >> 2, h = it & 3, e = tid & 255, half = tid >> 8; const float gam = 1.0f - exp2f(-5.0f - (float)h);
        __syncthreads();
        if (tid < 128) qs[tid] = zs[(size_t)b * 5120 + h * 128 + tid]; else if (tid < 256) ks[tid - 128] = zs[(size_t)b * 5120 + 512 + h * 128 + tid - 128];
        const float v = zs[(size_t)b * 5120 + 1024 + h * 256 + e];
        __syncthreads();
        const float* s0 = p.sret + ((size_t)it * 128 + half * 64) * 256 + e; float* so = p.out + O_RETS + ((size_t)it * 128 + half * 64) * 256 + e;
        float o = 0.f;
#pragma unroll 8
        for (int d = 0; d < 64; ++d) { const float s = gam * s0[(size_t)d * 256] + ks[half * 64 + d] * v; so[(size_t)d * 256] = s; o += qs[half * 64 + d] * s; }
        red[tid] = o;
        __syncthreads();
        float tot = 0.f;
        if (tid < 256) { tot = red[tid] + red[tid + 256]; const float s = wave_sum(tot); if (lane == 0) st[wid] = s; }
        __syncthreads();
        const float mu = (st[0] + st[1] + st[2] + st[3]) * (1.f / 256.f);
        __syncthreads();
        if (tid < 256) { const float dd = tot - mu; const float s = wave_sum(dd * dd); if (lane == 0) st[wid] = s; }
        __syncthreads();
        const float rs = rsqrtf((st[0] + st[1] + st[2] + st[3]) * (1.f / 256.f) + 1e-5f);
        if (tid < 256) mix[(size_t)b * 2048 + h * 256 + e] = f2bf((tot - mu) * rs * p.gnw[h * 256 + e] * zs[(size_t)b * 5120 + 2048 + h * 256 + e]);
    }
}

DEVI void phase_shg(const int TIDX, const int BIDX, float* L, const Params& p) {
    const int tid = TIDX, lane = tid & 63, wid = tid >> 6;
    const float* z1 = (const float*)(p.ws + WS_Z1S); bf16_t* o1s = (bf16_t*)(p.ws + WS_O1S);
    float* qs = L; float* fs = L + 128; float* red = L + 256; float* st = L + 768;
    for (int it = BIDX; it < 1024; it += gridDim.x) {
        const int b = it >> 3, h = it & 7, e = tid & 127, qt = tid >> 7;
        __syncthreads();
        if (tid < 128) qs[tid] = z1[(size_t)b * 4096 + h * 128 + tid]; else if (tid < 256) fs[tid - 128] = z1[(size_t)b * 4096 + 1024 + h * 128 + tid - 128];
        const float iv = z1[(size_t)b * 4096 + 2048 + h * 128 + e];
        __syncthreads();
        const float* s0 = p.shg + ((size_t)it * 128 + qt * 32) * 128 + e; float* so = p.out + O_HGS + ((size_t)it * 128 + qt * 32) * 128 + e;
        float o = 0.f;
#pragma unroll 8
        for (int d = 0; d < 32; ++d) { const float f = fs[qt * 32 + d]; const float s = f * s0[(size_t)d * 128] + (1.f - f) * iv; so[(size_t)d * 128] = s; o += qs[qt * 32 + d] * s; }
        red[tid] = o;
        __syncthreads();
        float tot = 0.f;
        if (tid < 128) { tot = red[tid] + red[tid + 128] + red[tid + 256] + red[tid + 384]; const float s = wave_sum(tot * tot); if (lane == 0) st[wid] = s; }
        __syncthreads();
        const float rs = rsqrtf((st[0] + st[1]) * (1.f / 128.f) + 1e-6f);
        if (tid < 128) o1s[(size_t)b * 1024 + h * 128 + e] = f2bf(tot * rs * p.hgnw[h * 128 + e] * z1[(size_t)b * 4096 + 3072 + h * 128 + e]);
    }
}

DEVI void phase_final(const int TIDX, const int BIDX, const Params& p) {
    const int wid = TIDX >> 6, lane = TIDX & 63;
    for (int row = BIDX * 8 + wid; row < MP + MS; row += gridDim.x * 8) {
        const bool smp = row >= MP; const size_t r = smp ? row - MP : row;
        float* x = p.out + (smp ? O_YS : O_YP) + r * 1024;
        f32x4 v[4]; float s = 0.f;
#pragma unroll
        for (int i = 0; i < 4; ++i) { v[i] = *(const f32x4*)(x + i * 256 + lane * 4); s += v[i][0] * v[i][0] + v[i][1] * v[i][1] + v[i][2] * v[i][2] + v[i][3] * v[i][3]; }
        s = wave_sum(s);
        const float rs = rsqrtf(s * (1.0f / 1024.0f) + 1e-6f);
#pragma unroll
        for (int i = 0; i < 4; ++i) { const f32x4 w = *(const f32x4*)(p.fnormw + i * 256 + lane * 4); *(f32x4*)(x + i * 256 + lane * 4) = v[i] * rs * w; }
    }
}

#define GRID_SYNC() do { asm volatile("s_waitcnt vmcnt(0) lgkmcnt(0)" ::: "memory"); __syncthreads(); if (threadIdx.x == 0) { __builtin_amdgcn_fence(__ATOMIC_RELEASE, ""); asm volatile("s_waitcnt vmcnt(0)" ::: "memory"); } \
    cg::this_grid().sync(); \
    if (threadIdx.x == 0) { __builtin_amdgcn_fence(__ATOMIC_ACQUIRE, ""); asm volatile("s_waitcnt vmcnt(0)" ::: "memory"); } __syncthreads(); } while (0)
constexpr int NPHASE = 13;
__global__ void __launch_bounds__(512, 2) mega(Params p0) {
    extern __shared__ __attribute__((aligned(16))) unsigned char shm[];
    LAS unsigned char* lds = (LAS unsigned char*)shm;
    const int G = gridDim.x;
#define OPQ int oz; asm volatile("s_mov_b32 %0, 0" : "=s"(oz)); int ozv; asm volatile("v_mov_b32 %0, 0" : "=v"(ozv)); \
    Params p = p0; p.ws = p0.ws + oz; p.out = p0.out + oz; const int TIDX = threadIdx.x + ozv, BIDX = blockIdx.x + oz; (void)TIDX; (void)BIDX;
    int my_xcc, my_rank;
    {
        int* sh = (int*)shm;
        if (threadIdx.x == 0) {
            const unsigned x = (unsigned)__builtin_amdgcn_s_getreg((3 << 11) | 20) & 7u;
            sh[0] = (int)x; sh[1] = (int)__hip_atomic_fetch_add((unsigned*)(p0.ws + WS_XCNT) + x * 32, 1u, __ATOMIC_RELAXED, __HIP_MEMORY_SCOPE_AGENT);
        }
        __syncthreads();
        my_xcc = __builtin_amdgcn_readfirstlane(sh[0]); my_rank = __builtin_amdgcn_readfirstlane(sh[1]);
        __syncthreads();
    }
    int gc = blockIdx.x;
    int ph_start = p0.ph_lo;
    if (ph_start == 0) {
        { OPQ phase_prep(TIDX, BIDX, (float*)shm, p); }
#if COOP
        GRID_SYNC();
        {
            bool ok = gridDim.x == 256;
            for (int x = 0; x < 8; ++x) ok = ok && (__hip_atomic_load((unsigned*)(p0.ws + WS_XCNT) + x * 32, __ATOMIC_RELAXED, __HIP_MEMORY_SCOPE_AGENT) == 32u);
            if (ok) gc = my_rank * 8 + my_xcc;
        }
#endif
        ph_start = 1;
    }
    for (int ph = ph_start; ph < p0.ph_hi; ++ph) {
        int la = -1, lb = -1, K = 1024, lda = 1024, ldb = 1024;
        switch (ph) {
        case 1: la = L_IN0; lb = L_IN0S; break;
        case 2: la = L_GA; K = 256; lda = 384; ldb = 256; break;
        case 4: la = L_GB; K = 384; lda = 384; ldb = 384; break;
        case 5: la = L_GLU; lb = L_GLUS; break;
        case 6: la = L_OUT0; lb = L_OUT0S; K = 2048; lda = 2048; ldb = 2048; break;
        case 7: la = L_IN1; lb = L_IN1S; break;
        case 11: la = L_OUT1; lb = L_OUT1S; break;
        default: break;
        }
        for (int jj = 0; jj < 2; ++jj) {
            const int l = jj ? lb : la;
            if (l < 0) continue;
            OPQ
            Sched S; S.list = l; S.G = G; S.c = jj ? G - 1 - gc : gc + oz; S.wsp = p.ws; S.outp = p.out;
            gemm_phase(TIDX, lds, K, lda, ldb, l == L_GLU, S, p);
        }
        __syncthreads();
        switch (ph) {
        case 2: { { OPQ phase_R1(TIDX, BIDX, (bf16_t*)shm, p); } __syncthreads(); { OPQ phase_sret(TIDX, BIDX, (float*)shm, p); } { OPQ phase_ss5(TIDX, BIDX, p); } } break;
        case 3: { { OPQ phase_s5scan(TIDX, BIDX, p); } { OPQ phase_R2(TIDX, BIDX, p); } } break;
        case 4: { OPQ phase_R3(TIDX, BIDX, (bf16_t*)shm, p); } break;
        case 8: { { OPQ phase_H1(TIDX, BIDX, (bf16_t*)shm, p); } __syncthreads(); { OPQ phase_shg(TIDX, BIDX, (float*)shm, p); } } break;
        case 9: { OPQ phase_H2(TIDX, BIDX, p); } break;
        case 10: { OPQ phase_H3(TIDX, BIDX, (bf16_t*)shm, p); } break;
        case 12: { OPQ phase_final(TIDX, BIDX, p); } break;
        default: break;
        }
#if COOP
        if (ph + 1 < p0.ph_hi) GRID_SYNC();
#endif
    }
}

extern "C" void kernel_launch(void* const* d_in, const int* in_sizes, int n_in, void* d_out, int out_size, void* d_ws, size_t ws_size, hipStream_t stream) {
    constexpr size_t kDynLds = 131072;
    static int grid_blocks = 0;
    if (!grid_blocks) {
        hipFuncSetAttribute((const void*)mega, hipFuncAttributeMaxDynamicSharedMemorySize, (int)kDynLds);
        int dev = 0, cus = 0, per_cu = 0;
        hipGetDevice(&dev);
        hipDeviceGetAttribute(&cus, hipDeviceAttributeMultiprocessorCount, dev);
        hipOccupancyMaxActiveBlocksPerMultiprocessor(&per_cu, mega, 512, kDynLds);
        if (per_cu < 1) per_cu = 1;
        grid_blocks = cus;
        if (grid_blocks > 256) grid_blocks = 256;
    }
    Params p{};
    const float** f = (const float**)&p;
    for (int i = 0; i < 25; ++i) f[i] = (const float*)d_in[i];
    p.out = (float*)d_out; p.ws = (char*)d_ws;
#if COOP
    p.ph_lo = 0; p.ph_hi = PH_MAX;
    hipMemsetAsync((char*)d_ws + WS_XCNT, 0, 1024, stream);
    void* args[] = {&p};
    hipError_t e = hipLaunchCooperativeKernel((const void*)mega, dim3(grid_blocks), dim3(512), args, kDynLds, stream);
    if (e != hipSuccess) fprintf(stderr, "cooperative launch failed: %s (grid %d)\n", hipGetErrorString(e), grid_blocks);
#else
    for (int ph = 0; ph < NPHASE; ++ph) {
        p.ph_lo = ph; p.ph_hi = ph + 1;
        hipLaunchKernelGGL(mega, dim3(grid_blocks), dim3(512), kDynLds, stream, p);
    }
#endif
}
```

```cpp
#include <hip/hip_runtime.h>
#include <hip/hip_cooperative_groups.h>
#include <cstdio>
namespace cg = cooperative_groups;

#ifndef PH_MAX
#define PH_MAX 13
#endif
#ifndef COOP
#define COOP 1
#endif

typedef unsigned short bf16_t;
typedef short bf16x8 __attribute__((ext_vector_type(8)));
typedef float f32x4 __attribute__((ext_vector_type(4)));
typedef unsigned u32x4 __attribute__((ext_vector_type(4)));
typedef unsigned u32x2 __attribute__((ext_vector_type(2)));
#define LAS __attribute__((address_space(3)))
#define DEVI __device__ __forceinline__

constexpr int TT = 2048, NBP = 8, MP = 16384, MS = 128, DM = 1024;
constexpr size_t MiB = (size_t)1 << 20;
constexpr size_t O_YP = 0, O_YS = 16777216, O_RETP = 16908288, O_RETS = 17956864, O_S5RP = 34734080, O_S5IP = 34766848,
                 O_S5RS = 34799616, O_S5IS = 35323904, O_HGP = 35848192, O_HGS = 36896768;
constexpr size_t WS_WIN0T = 0, WS_BT1 = 10 * MiB, WS_KT = 18 * MiB, WS_WGLUT = 34 * MiB, WS_WOUT0T = 36 * MiB, WS_WIN1T = 40 * MiB,
                 WS_BT2 = 48 * MiB, WS_Q = 60 * MiB, WS_KN = 76 * MiB, WS_VT = 92 * MiB, WS_SGA = 124 * MiB, WS_SGB = 156 * MiB,
                 WS_A2 = 188 * MiB, WS_Y5 = 0, WS_X1B = 60 * MiB, WS_SG1 = 0, WS_Q1 = 96 * MiB, WS_CUM = 128 * MiB, WS_IT = 192 * MiB,
                 WS_HKV = 32 * MiB;
constexpr size_t WS_MISC = 240 * MiB;
constexpr size_t WS_WOUT1T = WS_MISC;
constexpr size_t WS_ROPE = WS_MISC + 2 * MiB;
constexpr size_t WS_SSQ1 = WS_ROPE + 1280 * 1024;
constexpr size_t WS_SSQ2 = WS_SSQ1 + MiB;
constexpr size_t WS_H0S = WS_SSQ2 + MiB;
constexpr size_t WS_ZS = WS_H0S + 512 * 1024;
constexpr size_t WS_Y5S = WS_ZS + 2560 * 1024;
constexpr size_t WS_MIX0S = WS_Y5S + 512 * 1024;
constexpr size_t WS_X1S = WS_MIX0S + MiB;
constexpr size_t WS_X1SB = WS_X1S + 512 * 1024;
constexpr size_t WS_Z1S = WS_X1SB + 512 * 1024;
constexpr size_t WS_O1S = WS_Z1S + 2 * MiB;
constexpr size_t WS_BBG = WS_O1S + 512 * 1024;
constexpr size_t WS_LAM1 = WS_BBG + 512 * 1024;
constexpr size_t WS_LAM16 = WS_LAM1 + 32 * 1024;
constexpr size_t WS_LB = WS_LAM16 + 32 * 1024;
constexpr size_t WS_SSQ1S = WS_LB + 4096;
constexpr size_t WS_SSQ2S = WS_SSQ1S + MiB;
constexpr size_t WS_END = WS_SSQ2S + MiB;
constexpr size_t WS_XCNT = WS_END;
static_assert(WS_XCNT + 1024 <= 256 * MiB, "workspace overflow");

struct Params {
    const float *xp, *xs, *sret, *s5r, *s5i, *shg, *normw, *fnormw, *win0, *gnw, *lamre, *lamim, *logdt, *bre, *bim, *cre, *cim, *s5d,
        *gluw, *glub, *wout0, *win1, *hglb, *hgnw, *wout1;
    float* out;
    char* ws;
    int ph_lo, ph_hi;
};

DEVI bf16_t f2bf(float f) { unsigned u = __float_as_uint(f); u += 0x7FFFu + ((u >> 16) & 1u); return (bf16_t)(u >> 16); }
DEVI float bf2f(bf16_t b) { return __uint_as_float(((unsigned)b) << 16); }
DEVI unsigned pack2(float lo, float hi) { unsigned r; asm("v_cvt_pk_bf16_f32 %0, %1, %2" : "=v"(r) : "v"(lo), "v"(hi)); return r; }
DEVI float bflo(unsigned w) { return __uint_as_float(w << 16); }
DEVI float bfhi(unsigned w) { return __uint_as_float(w & 0xffff0000u); }
DEVI float sigm(float x) { return __builtin_amdgcn_rcpf(1.f + __builtin_amdgcn_exp2f(-1.4426950408889634f * x)); }
DEVI float silu_(float x) { return x * sigm(x); }
DEVI float gelu_(float x) { const float u = 1.5957691216f * (x + 0.044715f * x * x * x); return x * __builtin_amdgcn_rcpf(1.f + __builtin_amdgcn_exp2f(-1.4426950408889634f * u)); }
DEVI u32x2 pack4(f32x4 v) { u32x2 r; r.x = pack2(v[0], v[1]); r.y = pack2(v[2], v[3]); return r; }
DEVI float wave_sum(float v) {
#pragma unroll
    for (int o = 32; o > 0; o >>= 1) v += __shfl_xor(v, o);
    return v;
}
DEVI float grp16_sum(float v) { v += __shfl_xor(v, 1); v += __shfl_xor(v, 2); v += __shfl_xor(v, 4); v += __shfl_xor(v, 8); return v; }
DEVI f32x4 mfma16(bf16x8 a, bf16x8 b, f32x4 c) { return __builtin_amdgcn_mfma_f32_16x16x32_bf16(a, b, c, 0, 0, 0); }
DEVI float row_rstd16(const float* ssq, size_t row) {
    const f32x4 a = *(const f32x4*)(ssq + row * 4), b = *(const f32x4*)(ssq + (MP + row) * 4), c = *(const f32x4*)(ssq + (2 * (size_t)MP + row) * 4), d = *(const f32x4*)(ssq + (3 * (size_t)MP + row) * 4);
    float s = (a[0] + a[1] + a[2] + a[3]) + (b[0] + b[1] + b[2] + b[3]) + (c[0] + c[1] + c[2] + c[3]) + (d[0] + d[1] + d[2] + d[3]);
    return rsqrtf(s * (1.0f / 1024.0f) + 1e-6f);
}

constexpr int BM = 256, BK = 64, HALF = 128, HTB = HALF * BK * 2, NXCD = 8, WGM = 8;
DEVI int lds_byte(int r, int c) { const int st = (r >> 4) * 2 + (c >> 5), rr = r & 15, cc = c & 31, ob = rr * 64 + cc * 2; return st * 1024 + (ob ^ (((ob >> 9) & 1) << 5)); }
DEVI void stage_rc(int b, int& R, int& C) { const int st = b / 1024, sb = b % 1024, swz = sb ^ (((sb >> 9) & 1) << 5); R = (st >> 1) * 16 + swz / 64; C = (st & 1) * 32 + (swz % 64) / 2; }

enum { K_Q = 0, K_K, K_VT, K_GA, K_U, K_GB, K_SIN0, K_E5, K_Y5, K_GLU, K_SGLU, K_OUT0, K_SOUT0, K_Q1, K_F, K_IT, K_G1, K_SIN1, K_OUT1, K_SOUT1 };
enum { L_IN0 = 0, L_IN0S, L_GA, L_GB, L_GLU, L_GLUS, L_OUT0, L_OUT0S, L_IN1, L_IN1S, L_OUT1, L_OUT1S };

struct Unit { const char* a; const char* b; int kind, pm, pn; };

DEVI void static_order(int L, int nM, int nN, int& pm, int& pn) {
    const int nwg = nM * nN; int wgid = L;
    { const int q = nwg / NXCD, r = nwg % NXCD, xcd = wgid % NXCD, off = wgid / NXCD; wgid = (xcd < r ? xcd * (q + 1) : r * (q + 1) + (xcd - r) * q) + off; }
    const int nig = WGM * nN, gid = wgid / nig, fm = gid * WGM, gsz = (nM - fm) < WGM ? (nM - fm) : WGM;
    pm = fm + ((wgid % nig) % gsz); pn = (wgid % nig) / gsz;
}

struct Sched {
    int list, G, c; char* wsp; float* outp;
    DEVI bool next(int i, Unit& u) const {
        const int L = i * G + c; const char* ws = wsp;
        switch (list) {
        case L_IN0: {
            if (L >= 1280) return false; int pm, pn; static_order(L, 64, 20, pm, pn); u.pm = pm; u.pn = pn;
            const char* h0 = (const char*)(outp + O_RETS);
            if (pn >= 4 && pn < 8) { u.kind = K_VT; u.a = ws + WS_WIN0T + (size_t)(1024 + 256 * (pn - 4)) * 2048; u.b = h0 + (size_t)pm * 256 * 2048; }
            else { u.kind = pn < 2 ? K_Q : pn < 4 ? K_K : pn < 12 ? K_GA : pn < 16 ? K_U : K_GB; u.a = h0 + (size_t)pm * 256 * 2048; u.b = ws + WS_WIN0T + (size_t)pn * 256 * 2048; }
            return true; }
        case L_IN0S: if (L >= 20) return false; u.pm = 0; u.pn = L; u.kind = K_SIN0; u.a = ws + WS_H0S; u.b = ws + WS_WIN0T + (size_t)L * 256 * 2048; return true;
        case L_GA: if (L >= 256) return false; u.pm = L & 3; u.pn = L >> 2; u.kind = K_E5; u.a = ws + WS_A2 + ((size_t)(L >> 2) * 1024 + (L & 3) * 256) * 768; u.b = ws + WS_BT1 + (size_t)(L >> 2) * 256 * 512; return true;
        case L_GB: if (L >= 256) return false; u.pm = L & 3; u.pn = L >> 2; u.kind = K_Y5; u.a = ws + WS_A2 + ((size_t)(L >> 2) * 1024 + (L & 3) * 256) * 768; u.b = ws + WS_BT2 + (size_t)(L >> 2) * 256 * 768; return true;
        case L_GLU: { if (L >= 256) return false; int pm, pn; static_order(L, 64, 4, pm, pn); u.pm = pm; u.pn = pn; u.kind = K_GLU; u.a = ws + WS_Y5 + (size_t)pm * 256 * 32; u.b = ws + WS_WGLUT + (size_t)pn * 256 * 2048; return true; }
        case L_GLUS: if (L >= 4) return false; u.pm = 0; u.pn = L; u.kind = K_SGLU; u.a = ws + WS_Y5S; u.b = ws + WS_WGLUT + (size_t)L * 256 * 2048; return true;
        case L_OUT0: { if (L >= 256) return false; int pm, pn; static_order(L, 64, 4, pm, pn); u.pm = pm; u.pn = pn; u.kind = K_OUT0; u.a = (const char*)(outp + O_HGS) + (size_t)pm * 256 * 4096; u.b = ws + WS_WOUT0T + (size_t)pn * 256 * 4096; return true; }
        case L_OUT0S: if (L >= 4) return false; u.pm = 0; u.pn = L; u.kind = K_SOUT0; u.a = ws + WS_MIX0S; u.b = ws + WS_WOUT0T + (size_t)L * 256 * 4096; return true;
        case L_IN1: {
            if (L >= 1024) return false; int pm, pn; static_order(L, 64, 16, pm, pn); u.pm = pm; u.pn = pn;
            if (pn >= 8 && pn < 12) { u.kind = K_IT; u.a = ws + WS_WIN1T + (size_t)(256 * pn) * 2048; u.b = ws + WS_X1B + (size_t)pm * 256 * 2048; }
            else { u.kind = pn < 4 ? K_Q1 : pn < 8 ? K_F : K_G1; u.a = ws + WS_X1B + (size_t)pm * 256 * 2048; u.b = ws + WS_WIN1T + (size_t)pn * 256 * 2048; }
            return true; }
        case L_IN1S: if (L >= 16) return false; u.pm = 0; u.pn = L; u.kind = K_SIN1; u.a = ws + WS_X1SB; u.b = ws + WS_WIN1T + (size_t)L * 256 * 2048; return true;
        case L_OUT1: { if (L >= 256) return false; int pm, pn; static_order(L, 64, 4, pm, pn); u.pm = pm; u.pn = pn; u.kind = K_OUT1; u.a = ws + WS_Q1 + (size_t)pm * 256 * 2048; u.b = ws + WS_WOUT1T + (size_t)pn * 256 * 2048; return true; }
        case L_OUT1S: if (L >= 4) return false; u.pm = 0; u.pn = L; u.kind = K_SOUT1; u.a = ws + WS_O1S; u.b = ws + WS_WOUT1T + (size_t)L * 256 * 2048; return true;
        }
        return false;
    }
};

DEVI void epilogue(const Params& p, const f32x4 (&acc)[2][2][4][2], const Unit& u, int wr, int wc, int fr, int fq) {
    char* ws = p.ws;
    const int kind = u.kind;
    if (kind == K_Q || kind == K_K) {
        const float* rope = (const float*)(ws + WS_ROPE);
        bf16_t* dst = (bf16_t*)(ws + (kind == K_Q ? WS_Q : WS_KN));
        bf16_t* kt = (bf16_t*)(ws + WS_KT);
        const int tq = kind == K_Q ? u.pn : u.pn - 2;
        const float sc = kind == K_Q ? 1.0f : 0.08838834764831845f;
#pragma unroll
        for (int ai = 0; ai < 2; ++ai) {
#pragma unroll
          for (int mh = 0; mh < 2; ++mh) {
            f32x4 cs[4][2], sn[4][2];
#pragma unroll
            for (int m = mh * 2; m < mh * 2 + 2; ++m)
#pragma unroll
                for (int n = 0; n < 2; ++n) {
                    const int token = u.pm * 256 + ai * 128 + wr * 64 + m * 16 + fr, pos = token & 2047, j = (wc * 32 + n * 16 + fq * 4) & 63;
                    cs[m][n] = *(const f32x4*)(rope + pos * 128 + j); sn[m][n] = *(const f32x4*)(rope + pos * 128 + 64 + j);
                }
#pragma unroll
            for (int m = mh * 2; m < mh * 2 + 2; ++m) {
                const int token = u.pm * 256 + ai * 128 + wr * 64 + m * 16 + fr;
#pragma unroll
                for (int n = 0; n < 2; ++n) {
                    const int w = wc * 32 + n * 16 + fq * 4, hl = w >> 6, j = w & 63, head = 2 * tq + hl;
                    const f32x4 x1 = acc[ai][0][m][n], x2 = acc[ai][1][m][n];
                    const f32x4 y1 = (x1 * cs[m][n] - x2 * sn[m][n]) * sc, y2 = (x1 * sn[m][n] + x2 * cs[m][n]) * sc;
                    bf16_t* d = dst + (size_t)token * 512 + head * 128 + j;
                    *(u32x2*)d = pack4(y1); *(u32x2*)(d + 64) = pack4(y2);
                    if (kind == K_K) {
                        const int b = token >> 11, t = token & 2047;
                        bf16_t* kk = kt + ((size_t)(b * 4 + head) * 128 + j) * 2048 + t;
#pragma unroll
                        for (int i = 0; i < 4; ++i) { kk[(size_t)i * 2048] = f2bf(y1[i]); kk[(size_t)(64 + i) * 2048] = f2bf(y2[i]); }
                    }
                }
            }
          }
        }
    } else if (kind == K_VT || kind == K_IT) {
        const bool isv = kind == K_VT;
        const float* ssq = (const float*)(ws + WS_SSQ1);
        bf16_t* dst = (bf16_t*)(ws + (isv ? WS_VT : WS_IT));
        f32x4 rsa[2][2];
#pragma unroll
        for (int bj = 0; bj < 2; ++bj)
#pragma unroll
            for (int n = 0; n < 2; ++n) {
                const int token = u.pm * 256 + bj * 128 + wc * 32 + n * 16 + fq * 4;
                f32x4 rs = {1.f, 1.f, 1.f, 1.f};
                if (!isv) { rs[0] = row_rstd16(ssq, token); rs[1] = row_rstd16(ssq, token + 1); rs[2] = row_rstd16(ssq, token + 2); rs[3] = row_rstd16(ssq, token + 3); }
                rsa[bj][n] = rs;
            }
#pragma unroll
        for (int bj = 0; bj < 2; ++bj)
#pragma unroll
            for (int n = 0; n < 2; ++n) {
                const int token = u.pm * 256 + bj * 128 + wc * 32 + n * 16 + fq * 4, b = token >> 11, t = token & 2047;
                const f32x4 rs = rsa[bj][n];
#pragma unroll
                for (int ai = 0; ai < 2; ++ai)
#pragma unroll
                    for (int m = 0; m < 4; ++m) {
                        const int row = ai * 128 + wr * 64 + m * 16 + fr;
                        size_t off;
                        if (isv) off = ((size_t)(b * 4 + (u.pn - 4)) * 256 + row) * 2048 + t;
                        else { const int eg = (u.pn - 8) * 256 + row; off = ((size_t)(b * 8 + (eg >> 7)) * 128 + (eg & 127)) * 2048 + t; }
                        *(u32x2*)(dst + off) = pack4(acc[ai][bj][m][n] * rs);
                    }
            }
    } else if (kind == K_GA || kind == K_GB || kind == K_U) {
#pragma unroll
        for (int ai = 0; ai < 2; ++ai)
#pragma unroll
            for (int m = 0; m < 4; ++m) {
                const int token = u.pm * 256 + ai * 128 + wr * 64 + m * 16 + fr;
#pragma unroll
                for (int bj = 0; bj < 2; ++bj)
#pragma unroll
                    for (int n = 0; n < 2; ++n) {
                        const int cl = bj * 128 + wc * 32 + n * 16 + fq * 4;
                        f32x4 v = acc[ai][bj][m][n];
                        if (kind == K_U) {
                            const int cu = (u.pn - 12) * 256 + cl, g = cu >> 4, c = cu & 15;
                            bf16_t* d = (bf16_t*)(ws + WS_A2) + ((size_t)g * 1024 + (token >> 4)) * 384 + (token & 15) * 16 + c;
                            *(u32x2*)d = pack4(v);
                        } else {
                            v[0] = silu_(v[0]); v[1] = silu_(v[1]); v[2] = silu_(v[2]); v[3] = silu_(v[3]);
                            bf16_t* d = (bf16_t*)(ws + (kind == K_GA ? WS_SGA : WS_SGB)) + (size_t)token * 1024 + (u.pn - (kind == K_GA ? 8 : 16)) * 256 + cl;
                            *(u32x2*)d = pack4(v);
                        }
                    }
            }
    } else if (kind == K_SIN0) {
        const float* rope = (const float*)(ws + WS_ROPE) + 2048 * 128;
        float* zs = (float*)(ws + WS_ZS);
#pragma unroll
        for (int m = 0; m < 4; ++m) {
            const int row = wr * 64 + m * 16 + fr;
            if (u.pn < 4) {
                const float sc = u.pn < 2 ? 1.0f : 0.08838834764831845f;
#pragma unroll
                for (int n = 0; n < 2; ++n) {
                    const int w = wc * 32 + n * 16 + fq * 4, hl = w >> 6, j = w & 63;
                    const f32x4 cs = *(const f32x4*)(rope + j), sn = *(const f32x4*)(rope + 64 + j);
                    const f32x4 x1 = acc[0][0][m][n], x2 = acc[0][1][m][n];
                    float* d = zs + (size_t)row * 5120 + u.pn * 256 + hl * 128 + j;
                    *(f32x4*)d = (x1 * cs - x2 * sn) * sc; *(f32x4*)(d + 64) = (x1 * sn + x2 * cs) * sc;
                }
            } else {
                const bool gate = (u.pn >= 8 && u.pn < 12) || u.pn >= 16;
#pragma unroll
                for (int bj = 0; bj < 2; ++bj)
#pragma unroll
                    for (int n = 0; n < 2; ++n) {
                        f32x4 v = acc[0][bj][m][n];
                        if (gate) { v[0] = silu_(v[0]); v[1] = silu_(v[1]); v[2] = silu_(v[2]); v[3] = silu_(v[3]); }
                        *(f32x4*)(zs + (size_t)row * 5120 + u.pn * 256 + bj * 128 + wc * 32 + n * 16 + fq * 4) = v;
                    }
            }
        }
    } else if (kind == K_E5) {
        float* e5 = (float*)(p.out + O_HGS);
#pragma unroll
        for (int ai = 0; ai < 2; ++ai)
#pragma unroll
            for (int m = 0; m < 4; ++m) {
                const int row = u.pm * 256 + ai * 128 + wr * 64 + m * 16 + fr;
#pragma unroll
                for (int n = 0; n < 2; ++n) *(f32x4*)(e5 + ((size_t)u.pn * 1024 + row) * 128 + wc * 32 + n * 16 + fq * 4) = acc[ai][0][m][n];
            }
    } else if (kind == K_Y5) {
        const bf16_t* a2 = (const bf16_t*)(ws + WS_A2);
        bf16_t* y5 = (bf16_t*)(ws + WS_Y5);
        const int g = u.pn;
        f32x4 ddv[2][2];
#pragma unroll
        for (int bj = 0; bj < 2; ++bj)
#pragma unroll
            for (int n = 0; n < 2; ++n) ddv[bj][n] = *(const f32x4*)(p.s5d + g * 16 + ((bj * 128 + wc * 32 + n * 16 + fq * 4) & 15));
#pragma unroll
        for (int ai = 0; ai < 2; ++ai) {
#pragma unroll
          for (int mh = 0; mh < 2; ++mh) {
            u32x2 uv[4][2][2];
#pragma unroll
            for (int m = mh * 2; m < mh * 2 + 2; ++m)
#pragma unroll
                for (int bj = 0; bj < 2; ++bj)
#pragma unroll
                    for (int n = 0; n < 2; ++n) uv[m][bj][n] = *(const u32x2*)(a2 + ((size_t)g * 1024 + u.pm * 256 + ai * 128 + wr * 64 + m * 16 + fr) * 384 + bj * 128 + wc * 32 + n * 16 + fq * 4);
#pragma unroll
            for (int m = mh * 2; m < mh * 2 + 2; ++m) {
                const int row = u.pm * 256 + ai * 128 + wr * 64 + m * 16 + fr;
#pragma unroll
                for (int bj = 0; bj < 2; ++bj)
#pragma unroll
                    for (int n = 0; n < 2; ++n) {
                        const int col = bj * 128 + wc * 32 + n * 16 + fq * 4;
                        const u32x2 uu = uv[m][bj][n]; const f32x4 dd = ddv[bj][n];
                        f32x4 v = acc[ai][bj][m][n];
                        v[0] = gelu_(v[0] + dd[0] * bflo(uu.x)); v[1] = gelu_(v[1] + dd[1] * bfhi(uu.x));
                        v[2] = gelu_(v[2] + dd[2] * bflo(uu.y)); v[3] = gelu_(v[3] + dd[3] * bfhi(uu.y));
                        *(u32x2*)(y5 + ((size_t)g * 1024 + row) * 256 + col) = pack4(v);
                    }
            }
          }
        }
    } else if (kind == K_SGLU) {
        const bf16_t* y5 = (const bf16_t*)(ws + WS_Y5S);
        const float* zs = (const float*)(ws + WS_ZS);
        bf16_t* mix = (bf16_t*)(ws + WS_MIX0S);
#pragma unroll
        for (int m = 0; m < 4; ++m) {
            const size_t token = (size_t)wr * 64 + m * 16 + fr;
#pragma unroll
            for (int bj = 0; bj < 2; ++bj)
#pragma unroll
                for (int n = 0; n < 2; ++n) {
                    const int col = u.pn * 256 + bj * 128 + wc * 32 + n * 16 + fq * 4;
                    const f32x4 bb = *(const f32x4*)(p.glub + col);
                    const u32x2 yy = *(const u32x2*)(y5 + token * 1024 + col);
                    const f32x4 gg = *(const f32x4*)(zs + token * 5120 + 4096 + col);
                    f32x4 v = acc[0][bj][m][n] + bb;
                    v[0] = bflo(yy.x) * sigm(v[0]) * gg[0]; v[1] = bfhi(yy.x) * sigm(v[1]) * gg[1];
                    v[2] = bflo(yy.y) * sigm(v[2]) * gg[2]; v[3] = bfhi(yy.y) * sigm(v[3]) * gg[3];
                    *(u32x2*)(mix + token * 2048 + 1024 + col) = pack4(v);
                }
        }
    } else if (kind == K_GLU) {
        const bf16_t* y5 = (const bf16_t*)(ws + WS_Y5);
        const bf16_t* sgb = (const bf16_t*)(ws + WS_SGB);
        bf16_t* mix = (bf16_t*)(p.out + O_HGS);
        f32x4 bbv[2][2];
#pragma unroll
        for (int bj = 0; bj < 2; ++bj)
#pragma unroll
            for (int n = 0; n < 2; ++n) bbv[bj][n] = *(const f32x4*)(p.glub + u.pn * 256 + bj * 128 + wc * 32 + n * 16 + fq * 4);
#pragma unroll
        for (int ai = 0; ai < 2; ++ai)
#pragma unroll
          for (int mh = 0; mh < 2; ++mh) {
            u32x2 yv[4][2][2], gp[4][2][2];
#pragma unroll
            for (int m = mh * 2; m < mh * 2 + 2; ++m)
#pragma unroll
                for (int bj = 0; bj < 2; ++bj)
#pragma unroll
                    for (int n = 0; n < 2; ++n) {
                        const size_t token = (size_t)u.pm * 256 + ai * 128 + wr * 64 + m * 16 + fr; const int col = u.pn * 256 + bj * 128 + wc * 32 + n * 16 + fq * 4;
                        yv[m][bj][n] = *(const u32x2*)(y5 + ((size_t)(col >> 4) * MP + token) * 16 + (col & 15));
                        gp[m][bj][n] = *(const u32x2*)(sgb + token * 1024 + col);
                    }
#pragma unroll
            for (int m = mh * 2; m < mh * 2 + 2; ++m) {
                const size_t token = (size_t)u.pm * 256 + ai * 128 + wr * 64 + m * 16 + fr;
#pragma unroll
                for (int bj = 0; bj < 2; ++bj)
#pragma unroll
                    for (int n = 0; n < 2; ++n) {
                        const int col = u.pn * 256 + bj * 128 + wc * 32 + n * 16 + fq * 4;
                        const u32x2 yy = yv[m][bj][n], t = gp[m][bj][n];
                        f32x4 v = acc[ai][bj][m][n] + bbv[bj][n];
                        v[0] = bflo(yy.x) * sigm(v[0]) * bflo(t.x); v[1] = bfhi(yy.x) * sigm(v[1]) * bfhi(t.x);
                        v[2] = bflo(yy.y) * sigm(v[2]) * bflo(t.y); v[3] = bfhi(yy.y) * sigm(v[3]) * bfhi(t.y);
                        *(u32x2*)(mix + token * 2048 + 1024 + col) = pack4(v);
                    }
            }
          }
    } else if (kind == K_OUT0 || kind == K_SOUT0 || kind == K_OUT1 || kind == K_SOUT1) {
        const bool smp = kind == K_SOUT0 || kind == K_SOUT1, l0 = kind == K_OUT0 || kind == K_SOUT0;
        const float* res = l0 ? (smp ? p.xs : p.xp) : (smp ? (const float*)(ws + WS_X1S) : p.out + O_YP);
        float* dst = l0 ? (smp ? (float*)(ws + WS_X1S) : p.out + O_YP) : (smp ? p.out + O_YS : p.out + O_YP);
        bf16_t* dstb = (bf16_t*)(ws + (smp ? WS_X1SB : WS_X1B));
        float* ssq = (float*)(ws + (l0 ? (smp ? WS_SSQ1S : WS_SSQ1) : (smp ? WS_SSQ2S : WS_SSQ2)));
#pragma unroll
        for (int ai = 0; ai < 2; ++ai) {
            if (smp && ai) break;
#pragma unroll
          for (int mh = 0; mh < 2; ++mh) {
            f32x4 rv[4][2][2];
#pragma unroll
            for (int m = mh * 2; m < mh * 2 + 2; ++m)
#pragma unroll
                for (int bj = 0; bj < 2; ++bj)
#pragma unroll
                    for (int n = 0; n < 2; ++n) rv[m][bj][n] = *(const f32x4*)(res + ((size_t)u.pm * 256 + ai * 128 + wr * 64 + m * 16 + fr) * 1024 + u.pn * 256 + bj * 128 + wc * 32 + n * 16 + fq * 4);
#pragma unroll
            for (int m = mh * 2; m < mh * 2 + 2; ++m) {
                const size_t token = (size_t)u.pm * 256 + ai * 128 + wr * 64 + m * 16 + fr;
                float s = 0.f;
#pragma unroll
                for (int bj = 0; bj < 2; ++bj)
#pragma unroll
                    for (int n = 0; n < 2; ++n) {
                        const int col = u.pn * 256 + bj * 128 + wc * 32 + n * 16 + fq * 4;
                        const f32x4 v = acc[ai][bj][m][n] + rv[m][bj][n];
                        *(f32x4*)(dst + token * 1024 + col) = v;
                        if (l0) *(u32x2*)(dstb + token * 1024 + col) = pack4(v);
                        s += v[0] * v[0] + v[1] * v[1] + v[2] * v[2] + v[3] * v[3];
                    }
                s += __shfl_xor(s, 16); s += __shfl_xor(s, 32);
                if (fq == 0) ssq[((size_t)u.pn * MP + token) * 4 + wc] = s;
            }
          }
        }
    } else if (kind == K_Q1 || kind == K_F || kind == K_G1) {
        const float* ssq = (const float*)(ws + WS_SSQ1);
        const float* lb = (const float*)(ws + WS_LB);
#pragma unroll
        for (int ai = 0; ai < 2; ++ai) {
            float rr[4];
#pragma unroll
            for (int m = 0; m < 4; ++m) rr[m] = row_rstd16(ssq, (size_t)u.pm * 256 + ai * 128 + wr * 64 + m * 16 + fr);
            __builtin_amdgcn_sched_barrier(0);
#pragma unroll
            for (int m = 0; m < 4; ++m) {
                const size_t token = (size_t)u.pm * 256 + ai * 128 + wr * 64 + m * 16 + fr;
                const float r = rr[m];
#pragma unroll
                for (int bj = 0; bj < 2; ++bj)
#pragma unroll
                    for (int n = 0; n < 2; ++n) {
                        const int cl = (u.pn & 3) * 256 + bj * 128 + wc * 32 + n * 16 + fq * 4;
                        f32x4 v = acc[ai][bj][m][n] * r;
                        if (kind == K_F) {
                            const f32x4 l = *(const f32x4*)(lb + cl);
#pragma unroll
                            for (int i = 0; i < 4; ++i) v[i] = __logf(l[i] + (1.f - l[i]) * sigm(v[i]));
                            *(f32x4*)((float*)(ws + WS_CUM) + token * 1024 + cl) = v;
                        } else {
                            v[0] = silu_(v[0]); v[1] = silu_(v[1]); v[2] = silu_(v[2]); v[3] = silu_(v[3]);
                            *(u32x2*)((bf16_t*)(ws + (kind == K_Q1 ? WS_Q1 : WS_SG1)) + token * 1024 + cl) = pack4(v);
                        }
                    }
            }
        }
    } else if (kind == K_SIN1) {
        const float* ssq = (const float*)(ws + WS_SSQ1S);
        const float* lb = (const float*)(ws + WS_LB);
        float* z1 = (float*)(ws + WS_Z1S);
#pragma unroll
        for (int m = 0; m < 4; ++m) {
            const size_t row = wr * 64 + m * 16 + fr;
            const float r = row_rstd16(ssq, row);
            const int ty = u.pn >> 2;
#pragma unroll
            for (int bj = 0; bj < 2; ++bj)
#pragma unroll
                for (int n = 0; n < 2; ++n) {
                    const int cl = (u.pn & 3) * 256 + bj * 128 + wc * 32 + n * 16 + fq * 4;
                    f32x4 v = acc[0][bj][m][n] * r;
                    if (ty == 1) { const f32x4 l = *(const f32x4*)(lb + cl);
#pragma unroll
                        for (int i = 0; i < 4; ++i) v[i] = l[i] + (1.f - l[i]) * sigm(v[i]); }
                    else if (ty != 2) { v[0] = silu_(v[0]); v[1] = silu_(v[1]); v[2] = silu_(v[2]); v[3] = silu_(v[3]); }
                    *(f32x4*)(z1 + row * 4096 + ty * 1024 + cl) = v;
                }
        }
    }
}

DEVI void gemm_phase(const int TIDX, LAS unsigned char* lds, const int K, const int lda, const int ldb, const bool ga, const Sched S, const Params& P) {
    const int tid = TIDX, wid = __builtin_amdgcn_readfirstlane(tid >> 6), lane = tid & 63, wr = wid >> 2, wc = wid & 3, fr = lane & 15, fq = lane >> 4;
    const int nt = K / BK;
    unsigned voffA[2], voffB[2];
#pragma unroll
    for (int i = 0; i < 2; ++i) { int R, C; stage_rc(tid * 16 + i * 8192, R, C); voffA[i] = ga ? (unsigned)(R * 32 + (C >> 4) * (MP * 32) + (C & 15) * 2) : (unsigned)(R * lda + C) * 2u; voffB[i] = (unsigned)(R * ldb + C) * 2u; }
    const size_t kstep = (size_t)(BK * 2), kstepA = ga ? (size_t)4 * MP * 32 : kstep;
    const size_t hstepA = ga ? (size_t)HALF * 32 : (size_t)HALF * lda * 2, hstepB = (size_t)HALF * ldb * 2;
    const unsigned ldsw = (unsigned)wid * 1024u;
    const int aoff = lds_byte(wr * 64 + fr, fq * 8), boff = lds_byte(wc * 32 + fr, fq * 8);
#define PG8_SA(b, h) (((b) * 2 + (h)) * HTB)
#define PG8_SB(b, h) ((4 + (b) * 2 + (h)) * HTB)
#define PG8_STAGE(bufoff, gbase, voff) do { _Pragma("unroll") for (int _i = 0; _i < 2; ++_i) \
        __builtin_amdgcn_global_load_lds((const unsigned*)((const char*)(gbase) + (voff)[_i]), (LAS unsigned*)(lds + (bufoff) + ldsw + _i * 8192), 16, 0, 0); } while (0)
#define PG8_LDA(dst, b, h) do { _Pragma("unroll") for (int m = 0; m < 4; ++m) _Pragma("unroll") for (int k = 0; k < 2; ++k) dst[m][k] = *(const LAS bf16x8*)(lds + PG8_SA(b, h) + aoff + m * 2048 + k * 1024); } while (0)
#define PG8_LDB(dst, b, h) do { _Pragma("unroll") for (int n = 0; n < 2; ++n) _Pragma("unroll") for (int k = 0; k < 2; ++k) dst[n][k] = *(const LAS bf16x8*)(lds + PG8_SB(b, h) + boff + n * 2048 + k * 1024); } while (0)
#define PG8_MMA(ai, bj, At, Bt) do { __builtin_amdgcn_s_setprio(1); _Pragma("unroll") for (int m = 0; m < 4; ++m) _Pragma("unroll") for (int n = 0; n < 2; ++n) _Pragma("unroll") for (int k = 0; k < 2; ++k) \
        acc[ai][bj][m][n] = __builtin_amdgcn_mfma_f32_16x16x32_bf16(Bt[n][k], At[m][k], acc[ai][bj][m][n], 0, 0, 0); __builtin_amdgcn_s_setprio(0); } while (0)
#define PG8_WAIT_V(n) asm volatile("s_waitcnt vmcnt(" #n ")" ::: "memory")
#define PG8_WAIT_L(n) asm volatile("s_waitcnt lgkmcnt(" #n ")" ::: "memory")
#define PG8_BAR __builtin_amdgcn_s_barrier()
#define PG8_SCHED __builtin_amdgcn_sched_barrier(0)
    Unit cur, nxt; int ui = 0;
    if (!S.next(0, cur)) return;
    f32x4 acc[2][2][4][2];
#pragma unroll
    for (int a = 0; a < 2; ++a)
#pragma unroll
        for (int b = 0; b < 2; ++b)
#pragma unroll
            for (int m = 0; m < 4; ++m)
#pragma unroll
                for (int n = 0; n < 2; ++n) acc[a][b][m][n] = (f32x4){0.f, 0.f, 0.f, 0.f};
    bf16x8 At[4][2], B0[2][2], B1[2][2];
    const char* cA = cur.a; const char* cB = cur.b;
    PG8_STAGE(PG8_SB(0, 0), cB, voffB); PG8_STAGE(PG8_SA(0, 0), cA, voffA); PG8_STAGE(PG8_SB(0, 1), cB + hstepB, voffB); PG8_STAGE(PG8_SA(0, 1), cA + hstepA, voffA);
    if (wr == 1) PG8_BAR;
    PG8_WAIT_V(4); PG8_BAR;
    PG8_STAGE(PG8_SB(1, 0), cB + kstep, voffB); PG8_STAGE(PG8_SA(1, 0), cA + kstepA, voffA); PG8_STAGE(PG8_SB(1, 1), cB + hstepB + kstep, voffB);
    PG8_WAIT_V(6); PG8_BAR;
    for (;;) {
        const bool has_next = S.next(ui + 1, nxt);
        const char* nA = has_next ? nxt.a : cA; const char* nB = has_next ? nxt.b : cB;
        for (int t = 0; t < nt; t += 2) {
            const bool last = (t == nt - 2);
            const char* a1 = cA + (size_t)(t + 1) * kstepA;
            const char* a2 = last ? nA : cA + (size_t)(t + 2) * kstepA; const char* b2 = last ? nB : cB + (size_t)(t + 2) * kstep;
            const char* a3 = a2 + kstepA; const char* b3 = b2 + kstep;
            PG8_LDB(B0, 0, 0); PG8_SCHED; PG8_LDA(At, 0, 0); PG8_STAGE(PG8_SA(1, 1), a1 + hstepA, voffA);
            PG8_WAIT_L(8); PG8_BAR; PG8_WAIT_L(0); PG8_MMA(0, 0, At, B0); PG8_BAR; PG8_SCHED;
            PG8_LDB(B1, 0, 1); PG8_STAGE(PG8_SB(0, 0), b2, voffB);
            PG8_BAR; PG8_WAIT_L(0); PG8_MMA(0, 1, At, B1); PG8_BAR;
            PG8_LDA(At, 0, 1); PG8_STAGE(PG8_SA(0, 0), a2, voffA);
            PG8_BAR; PG8_WAIT_L(0); PG8_MMA(1, 0, At, B0); PG8_BAR; PG8_SCHED;
            PG8_STAGE(PG8_SB(0, 1), b2 + hstepB, voffB);
            PG8_WAIT_V(6); PG8_BAR; PG8_MMA(1, 1, At, B1); PG8_BAR;
            PG8_LDB(B0, 1, 0); PG8_SCHED; PG8_LDA(At, 1, 0); PG8_STAGE(PG8_SA(0, 1), a2 + hstepA, voffA);
            PG8_WAIT_L(8); PG8_BAR; PG8_WAIT_L(0); PG8_MMA(0, 0, At, B0); PG8_BAR; PG8_SCHED;
            PG8_LDB(B1, 1, 1); PG8_STAGE(PG8_SB(1, 0), b3, voffB);
            PG8_BAR; PG8_WAIT_L(0); PG8_MMA(0, 1, At, B1); PG8_BAR;
            PG8_LDA(At, 1, 1); PG8_STAGE(PG8_SA(1, 0), a3, voffA);
            PG8_BAR; PG8_WAIT_L(0); PG8_MMA(1, 0, At, B0); PG8_BAR; PG8_SCHED;
            PG8_STAGE(PG8_SB(1, 1), b3 + hstepB, voffB);
            PG8_WAIT_V(6); PG8_BAR; PG8_MMA(1, 1, At, B1); PG8_BAR;
        }
        { int ozv; asm volatile("v_mov_b32 %0, 0" : "=v"(ozv)); epilogue(P, acc, cur, wr, wc, fr + ozv, fq + ozv); }
        if (!has_next) break;
#pragma unroll
        for (int a = 0; a < 2; ++a)
#pragma unroll
            for (int b = 0; b < 2; ++b)
#pragma unroll
                for (int m = 0; m < 4; ++m)
#pragma unroll
                    for (int n = 0; n < 2; ++n) acc[a][b][m][n] = (f32x4){0.f, 0.f, 0.f, 0.f};
        cur = nxt; cA = nA; cB = nB; ++ui;
    }
    PG8_WAIT_V(0);
    if (wr == 0) PG8_BAR;
    PG8_BAR;
}

DEVI void prep_transpose(const int TIDX, const int BIDX, float* tile, const float* src, int K, int N, bf16_t* dst, const float* kscale, bool permqk, int job0, int& jobbase, int gsz) {
    (void)tile;
    const int nk8 = K / 8, ntn = N / 64, njobs = ntn * (nk8 / 8), lane = TIDX & 63, wid = TIDX >> 6;
    for (int jb = job0 - jobbase; jb < njobs; jb += gsz) {
        if (jb < 0) continue;
        const int tn = jb / (nk8 / 8), tk = jb % (nk8 / 8), n0 = tn * 64, k0 = tk * 64 + wid * 8;
        int c0 = n0;
        if (permqk && n0 < 1024) { const int tile_ = n0 >> 8, cp = n0 & 255, bj = cp >> 7, w = cp & 127; c0 = tile_ * 256 + (w >> 6) * 128 + bj * 64; }
        float v[8];
#pragma unroll
        for (int j = 0; j < 8; ++j) v[j] = src[(size_t)(k0 + j) * N + c0 + lane] * (kscale ? kscale[k0 + j] : 1.f);
        u32x4 o; o.x = pack2(v[0], v[1]); o.y = pack2(v[2], v[3]); o.z = pack2(v[4], v[5]); o.w = pack2(v[6], v[7]);
        *(u32x4*)(dst + (size_t)(n0 + lane) * K + k0) = o;
    }
    jobbase += njobs;
}

DEVI void prep_s5_tables(const int TIDX, const int BIDX, float* L, const Params& p, int g) {
    float* pwr = L;
    float* pwi = pwr + 17 * 64;
    float* bbr = pwi + 17 * 64;
    float* bbi = bbr + 1024;
    float* cr = bbi + 1024;
    float* ci = cr + 1024;
    float* kg = ci + 1024;
    const int tid = TIDX;
    char* ws = p.ws;
    __syncthreads();
    {
        const double dt = exp((double)p.logdt[g]);
        for (int i = tid; i < 17 * 64; i += 512) {
            const int t = i >> 6, pp = i & 63;
            const double lr = p.lamre[g * 64 + pp], li = p.lamim[g * 64 + pp];
            const double mag = exp(lr * dt * t), ang = li * dt * t;
            pwr[t * 64 + pp] = (float)(mag * cos(ang)); pwi[t * 64 + pp] = (float)(mag * sin(ang));
        }
        for (int i = tid; i < 1024; i += 512) {
            const int pp = i >> 4, c = i & 15;
            const double lr = p.lamre[g * 64 + pp], li = p.lamim[g * 64 + pp];
            const double mag = exp(lr * dt), ang = li * dt, lbr = mag * cos(ang), lbi = mag * sin(ang);
            const double nr = lbr - 1.0, den = lr * lr + li * li, fr = (nr * lr + lbi * li) / den, fi = (lbi * lr - nr * li) / den;
            const double br = p.bre[(g * 64 + pp) * 16 + c], bi = p.bim[(g * 64 + pp) * 16 + c];
            const float xr = (float)(fr * br - fi * bi), xi = (float)(fr * bi + fi * br);
            bbr[i] = xr; bbi[i] = xi;
            float* bbg = (float*)(ws + WS_BBG); bbg[(g * 1024 + i) * 2] = xr; bbg[(g * 1024 + i) * 2 + 1] = xi;
            if (c == 0) { float* lam1 = (float*)(ws + WS_LAM1); lam1[(g * 64 + pp) * 2] = (float)lbr; lam1[(g * 64 + pp) * 2 + 1] = (float)lbi; }
        }
    }
    __syncthreads();
    if (tid < 64) { float* lam16 = (float*)(ws + WS_LAM16); lam16[(g * 64 + tid) * 2] = pwr[16 * 64 + tid]; lam16[(g * 64 + tid) * 2 + 1] = pwi[16 * 64 + tid]; }
    for (int i = tid; i < 1024; i += 512) { cr[i] = p.cre[g * 1024 + i]; ci[i] = p.cim[g * 1024 + i]; }
    __syncthreads();
    for (int i = tid; i < 4096; i += 512) {
        const int tau = i >> 8, c = (i >> 4) & 15, cp = i & 15;
        float s = 0.f;
        for (int pp = 0; pp < 64; ++pp) {
            const float a = pwr[tau * 64 + pp], b = pwi[tau * 64 + pp], xr = bbr[pp * 16 + cp], xi = bbi[pp * 16 + cp];
            s += cr[c * 64 + pp] * (a * xr - b * xi) - ci[c * 64 + pp] * (a * xi + b * xr);
        }
        kg[i] = s;
    }
    __syncthreads();
    bf16_t* bt2 = (bf16_t*)(ws + WS_BT2) + (size_t)g * 256 * 384;
    for (int i = tid; i < 256 * 48; i += 512) {
        const int n = i / 48, k8 = (i % 48) * 8, t = n >> 4, c = n & 15;
        float v[8];
#pragma unroll
        for (int j = 0; j < 8; ++j) {
            const int k = k8 + j;
            if (k < 256) { const int s = k >> 4, cp = k & 15; v[j] = t >= s ? kg[(t - s) * 256 + c * 16 + cp] : 0.f; }
            else { const int q = k - 256, pp = q & 63; const float a = pwr[(t + 1) * 64 + pp], b = pwi[(t + 1) * 64 + pp];
                v[j] = q < 64 ? (cr[c * 64 + pp] * a - ci[c * 64 + pp] * b) : -(cr[c * 64 + pp] * b + ci[c * 64 + pp] * a); }
        }
        u32x4 o; o.x = pack2(v[0], v[1]); o.y = pack2(v[2], v[3]); o.z = pack2(v[4], v[5]); o.w = pack2(v[6], v[7]);
        *(u32x4*)(bt2 + (size_t)n * 384 + k8) = o;
    }
    bf16_t* bt1 = (bf16_t*)(ws + WS_BT1) + (size_t)g * 256 * 256;
    for (int i = tid; i < 256 * 32; i += 512) {
        const int n = i >> 5, k8 = (i & 31) * 8;
        float v[8];
#pragma unroll
        for (int j = 0; j < 8; ++j) {
            const int k = k8 + j, s = k >> 4, cp = k & 15;
            if (n >= 128) v[j] = 0.f;
            else { const int pp = n & 63; const float a = pwr[(15 - s) * 64 + pp], b = pwi[(15 - s) * 64 + pp], xr = bbr[pp * 16 + cp], xi = bbi[pp * 16 + cp];
                v[j] = n < 64 ? (a * xr - b * xi) : (a * xi + b * xr); }
        }
        u32x4 o; o.x = pack2(v[0], v[1]); o.y = pack2(v[2], v[3]); o.z = pack2(v[4], v[5]); o.w = pack2(v[6], v[7]);
        *(u32x4*)(bt1 + (size_t)n * 256 + k8) = o;
    }
}

DEVI void phase_prep(const int TIDX, const int BIDX, float* L, const Params& p) {
    const int tid = TIDX, bid = BIDX, G = gridDim.x, lane = tid & 63, wid = tid >> 6;
    char* ws = p.ws;
    for (int g = G - 1 - bid; g < 64; g += G) if (g >= 0) prep_s5_tables(TIDX, BIDX, L, p, g);
    __syncthreads();
    const int GT = G > 64 ? G - 64 : G;
    const int tb = (G > 64 && bid >= GT) ? (1 << 28) : bid;
    int jobbase = 0;
    prep_transpose(TIDX, BIDX, L, p.win0, 1024, 5120, (bf16_t*)(ws + WS_WIN0T), nullptr, true, tb, jobbase, GT);
    prep_transpose(TIDX, BIDX, L, p.gluw, 1024, 1024, (bf16_t*)(ws + WS_WGLUT), nullptr, false, tb, jobbase, GT);
    prep_transpose(TIDX, BIDX, L, p.wout0, 2048, 1024, (bf16_t*)(ws + WS_WOUT0T), nullptr, false, tb, jobbase, GT);
    prep_transpose(TIDX, BIDX, L, p.win1, 1024, 4096, (bf16_t*)(ws + WS_WIN1T), p.normw + 1024, false, tb, jobbase, GT);
    prep_transpose(TIDX, BIDX, L, p.wout1, 1024, 1024, (bf16_t*)(ws + WS_WOUT1T), nullptr, false, tb, jobbase, GT);
    bf16_t* h0 = (bf16_t*)(p.out + O_RETS); bf16_t* h0s = (bf16_t*)(ws + WS_H0S);
    for (int row = bid * 8 + wid; row < MP + 256; row += G * 8) {
        bf16_t* d = row < MP ? h0 + (size_t)row * 1024 : h0s + (size_t)(row - MP) * 1024;
        if (row >= MP + MS) { for (int i = 0; i < 4; ++i) *(u32x2*)(d + i * 256 + lane * 4) = (u32x2){0u, 0u}; continue; }
        const float* x = row < MP ? p.xp + (size_t)row * 1024 : p.xs + (size_t)(row - MP) * 1024;
        f32x4 v[4]; float s = 0.f;
#pragma unroll
        for (int i = 0; i < 4; ++i) { v[i] = *(const f32x4*)(x + i * 256 + lane * 4); s += v[i][0] * v[i][0] + v[i][1] * v[i][1] + v[i][2] * v[i][2] + v[i][3] * v[i][3]; }
        s = wave_sum(s);
        const float r = rsqrtf(s * (1.0f / 1024.0f) + 1e-6f);
#pragma unroll
        for (int i = 0; i < 4; ++i) { const f32x4 w = *(const f32x4*)(p.normw + i * 256 + lane * 4); *(u32x2*)(d + i * 256 + lane * 4) = pack4(v[i] * r * w); }
    }
    for (int i = bid * 512 + tid; i < 128 * 1024 / 8; i += G * 512) {
        const u32x4 z = {0u, 0u, 0u, 0u};
        *(u32x4*)((bf16_t*)(ws + WS_Y5S) + 128 * 1024 + (size_t)i * 8) = z;
        *(u32x4*)((bf16_t*)(ws + WS_X1SB) + 128 * 1024 + (size_t)i * 8) = z;
        *(u32x4*)((bf16_t*)(ws + WS_O1S) + 128 * 1024 + (size_t)i * 8) = z;
        *(u32x4*)((bf16_t*)(ws + WS_MIX0S) + 128 * 2048 + (size_t)i * 16) = z;
        *(u32x4*)((bf16_t*)(ws + WS_MIX0S) + 128 * 2048 + (size_t)i * 16 + 8) = z;
    }
    float* rope = (float*)(ws + WS_ROPE);
    for (int i = bid * 512 + tid; i < 2049 * 64; i += G * 512) {
        const int pr = i >> 6, j = i & 63; const double pos = pr == 2048 ? 16384.0 : (double)pr;
        const double inv = exp2(-(double)j * (13.287712379549449 / 64.0));
        const double rev = pos * inv * 0.15915494309189535; const double fr = rev - floor(rev); const double a = fr * 6.283185307179586;
        rope[pr * 128 + j] = (float)cos(a); rope[pr * 128 + 64 + j] = (float)sin(a);
    }
    float* lb = (float*)(ws + WS_LB);
    for (int i = bid * 512 + tid; i < 1024; i += G * 512) lb[i] = 1.f / (1.f + expf(p.hglb[i] - p.hglb[1024 + i]));
}

DEVI float ret_lg(int h) { return log1pf(-exp2f(-5.0f - (float)h)); }

DEVI void phase_R1(const int TIDX, const int BIDX, bf16_t* L, const Params& p) {
    const int tid = TIDX, wid = tid >> 6, lane = tid & 63, r16 = lane & 15, g = lane >> 4;
    const bf16_t* kt = (const bf16_t*)(p.ws + WS_KT); const bf16_t* vt = (const bf16_t*)(p.ws + WS_VT);
    float* kvt = p.out + O_YP;
    for (int it = BIDX; it < 512; it += gridDim.x) {
        const int bh = it >> 4, c = it & 15, h = bh & 3, t0 = c * 128; const float lg = ret_lg(h);
        __syncthreads();
        { const int d = tid >> 2, seg = tid & 3;
#pragma unroll
          for (int q = 0; q < 4; ++q) {
              const int l0 = seg * 32 + q * 8;
              const u32x4 v = *(const u32x4*)(kt + ((size_t)bh * 128 + d) * 2048 + t0 + l0);
              u32x4 o; const unsigned* vv = (const unsigned*)&v; unsigned* oo = (unsigned*)&o;
#pragma unroll
              for (int j = 0; j < 4; ++j) oo[j] = pack2(bflo(vv[j]) * __expf(lg * (float)(127 - l0 - 2 * j)), bfhi(vv[j]) * __expf(lg * (float)(126 - l0 - 2 * j)));
              *(u32x4*)(L + d * 136 + l0) = o; } }
        __syncthreads();
        bf16x8 bfr[2][4];
#pragma unroll
        for (int ct = 0; ct < 2; ++ct)
#pragma unroll
            for (int kk = 0; kk < 4; ++kk) bfr[ct][kk] = *(const bf16x8*)(vt + ((size_t)bh * 256 + wid * 32 + ct * 16 + r16) * 2048 + t0 + kk * 32 + g * 8);
#pragma unroll
        for (int rt = 0; rt < 8; ++rt) {
            f32x4 a0 = {0.f, 0.f, 0.f, 0.f}, a1 = a0;
#pragma unroll
            for (int kk = 0; kk < 4; ++kk) { const bf16x8 a = *(const bf16x8*)(L + (rt * 16 + r16) * 136 + kk * 32 + g * 8); a0 = mfma16(a, bfr[0][kk], a0); a1 = mfma16(a, bfr[1][kk], a1); }
            float* d0 = kvt + (((size_t)bh * 16 + c) * 256 + wid * 32 + r16) * 128 + rt * 16 + g * 4;
            *(f32x4*)d0 = a0; *(f32x4*)(d0 + 16 * 128) = a1;
        }
    }
}

DEVI void phase_R2(const int TIDX, const int BIDX, const Params& p) {
    float* kvt = p.out + O_YP;
    for (int i = BIDX * 512 + TIDX; i < 32 * 256 * 16; i += gridDim.x * 512) {
        const int q = i & 15, e = (i >> 4) & 255, bh = i >> 12, h = bh & 3; const float dec = __expf(ret_lg(h) * 128.f);
        f32x4 s0 = {0.f, 0.f, 0.f, 0.f}, s1 = s0;
#pragma unroll 4
        for (int c = 0; c < 16; ++c) {
            float* ptr = kvt + (((size_t)bh * 16 + c) * 256 + e) * 128 + q * 8;
            const f32x4 v0 = *(const f32x4*)ptr, v1 = *(const f32x4*)(ptr + 4);
            u32x4 o; o.x = pack2(s0[0], s0[1]); o.y = pack2(s0[2], s0[3]); o.z = pack2(s1[0], s1[1]); o.w = pack2(s1[2], s1[3]);
            *(u32x4*)ptr = o;
            s0 = s0 * dec + v0; s1 = s1 * dec + v1;
        }
        float* o = p.out + O_RETP + ((size_t)bh * 128 + q * 8) * 256 + e;
#pragma unroll
        for (int j = 0; j < 4; ++j) { o[(size_t)j * 256] = s0[j]; o[(size_t)(j + 4) * 256] = s1[j]; }
    }
}

DEVI void phase_R3(const int TIDX, const int BIDX, bf16_t* L, const Params& p) {
    const int tid = TIDX, wid = tid >> 6, lane = tid & 63, r16 = lane & 15, g = lane >> 4;
    const bf16_t* Q = (const bf16_t*)(p.ws + WS_Q); const bf16_t* KN = (const bf16_t*)(p.ws + WS_KN); const bf16_t* vt = (const bf16_t*)(p.ws + WS_VT);
    const bf16_t* sga = (const bf16_t*)(p.ws + WS_SGA); bf16_t* mix = (bf16_t*)(p.out + O_HGS);
    const float* kvt = p.out + O_YP;
    bf16_t* S = L;
    float* st = (float*)(L + 128 * 136);
    float* mr = st + 128 * 16;
    for (int it = BIDX; it < 512; it += gridDim.x) {
        const int bh = it >> 4, c = it & 15, h = bh & 3, b = bh >> 2, l0 = wid * 16; const size_t tok0 = (size_t)b * 2048 + c * 128; const float lg = ret_lg(h);
        bf16x8 qa[4];
#pragma unroll
        for (int kk = 0; kk < 4; ++kk) qa[kk] = *(const bf16x8*)(Q + (tok0 + l0 + r16) * 512 + h * 128 + kk * 32 + g * 8);
        __syncthreads();
        for (int j = 0; j < 8; ++j) {
            f32x4 sc = {0.f, 0.f, 0.f, 0.f};
            if (j <= wid) {
#pragma unroll
                for (int kk = 0; kk < 4; ++kk) sc = mfma16(qa[kk], *(const bf16x8*)(KN + (tok0 + j * 16 + r16) * 512 + h * 128 + kk * 32 + g * 8), sc);
            }
#pragma unroll
            for (int r = 0; r < 4; ++r) {
                const int li = l0 + g * 4 + r, mi = j * 16 + r16; const float v = (j <= wid && li >= mi) ? sc[r] * __expf(lg * (float)(li - mi)) : 0.f;
                S[li * 136 + mi] = f2bf(v);
            }
        }
        f32x4 acc[8][2];
#pragma unroll
        for (int rt = 0; rt < 8; ++rt) { acc[rt][0] = (f32x4){0.f, 0.f, 0.f, 0.f}; acc[rt][1] = (f32x4){0.f, 0.f, 0.f, 0.f}; }
        if (c > 0) {
            bf16x8 bs[2][4];
#pragma unroll
            for (int ct = 0; ct < 2; ++ct)
#pragma unroll
                for (int kk = 0; kk < 4; ++kk) bs[ct][kk] = *(const bf16x8*)(kvt + (((size_t)bh * 16 + c) * 256 + wid * 32 + ct * 16 + r16) * 128 + kk * 32 + g * 8);
#pragma unroll
            for (int rt = 0; rt < 8; ++rt) {
                f32x4 a0 = {0.f, 0.f, 0.f, 0.f}, a1 = a0;
#pragma unroll
                for (int kk = 0; kk < 4; ++kk) {
                    const bf16x8 q = *(const bf16x8*)(Q + (tok0 + rt * 16 + r16) * 512 + h * 128 + kk * 32 + g * 8);
                    a0 = mfma16(q, bs[0][kk], a0); a1 = mfma16(q, bs[1][kk], a1);
                }
#pragma unroll
                for (int r = 0; r < 4; ++r) { const float qd = __expf(lg * (float)(rt * 16 + g * 4 + r + 1)); a0[r] *= qd; a1[r] *= qd; }
                acc[rt][0] = a0; acc[rt][1] = a1;
                __builtin_amdgcn_sched_barrier(0);
            }
        }
        bf16x8 bv[2][4];
#pragma unroll
        for (int ct = 0; ct < 2; ++ct)
#pragma unroll
            for (int kk = 0; kk < 4; ++kk) bv[ct][kk] = *(const bf16x8*)(vt + ((size_t)bh * 256 + wid * 32 + ct * 16 + r16) * 2048 + c * 128 + kk * 32 + g * 8);
        __syncthreads();
#pragma unroll
        for (int rt = 0; rt < 8; ++rt) {
            f32x4 a0 = acc[rt][0], a1 = acc[rt][1];
#pragma unroll
            for (int kk = 0; kk < 4; ++kk) {
                if (kk <= (rt >> 1)) {
                    const bf16x8 a = *(const bf16x8*)(S + (rt * 16 + r16) * 136 + kk * 32 + g * 8);
                    a0 = mfma16(a, bv[0][kk], a0); a1 = mfma16(a, bv[1][kk], a1);
                }
            }
            acc[rt][0] = a0; acc[rt][1] = a1;
#pragma unroll
            for (int r = 0; r < 4; ++r) {
                float s1 = a0[r] + a1[r], s2 = a0[r] * a0[r] + a1[r] * a1[r];
                s1 = grp16_sum(s1); s2 = grp16_sum(s2);
                if (r16 == 0) { st[((rt * 16 + g * 4 + r) * 8 + wid) * 2] = s1; st[((rt * 16 + g * 4 + r) * 8 + wid) * 2 + 1] = s2; }
            }
            __builtin_amdgcn_sched_barrier(0);
        }
        __syncthreads();
        if (tid < 128) {
            float s1 = 0.f, s2 = 0.f;
#pragma unroll
            for (int w = 0; w < 8; ++w) { s1 += st[(tid * 8 + w) * 2]; s2 += st[(tid * 8 + w) * 2 + 1]; }
            const float mu = s1 * (1.f / 256.f), var = fmaxf(s2 * (1.f / 256.f) - mu * mu, 0.f);
            mr[tid * 2] = mu; mr[tid * 2 + 1] = rsqrtf(var + 1e-5f);
        }
        __syncthreads();
        const float gw0 = p.gnw[h * 256 + wid * 32 + r16], gw1 = p.gnw[h * 256 + wid * 32 + 16 + r16];
#pragma unroll
        for (int rt = 0; rt < 8; ++rt)
#pragma unroll
            for (int r = 0; r < 4; ++r) {
                const int row = rt * 16 + g * 4 + r; const size_t token = tok0 + row; const float mu = mr[row * 2], rs = mr[row * 2 + 1];
                const size_t o = token * 1024 + h * 256 + wid * 32 + r16;
                const float v0 = (acc[rt][0][r] - mu) * rs * gw0 * bf2f(sga[o]), v1 = (acc[rt][1][r] - mu) * rs * gw1 * bf2f(sga[o + 16]);
                mix[token * 2048 + h * 256 + wid * 32 + r16] = f2bf(v0); mix[token * 2048 + h * 256 + wid * 32 + 16 + r16] = f2bf(v1);
            }
    }
}

DEVI void phase_s5scan(const int TIDX, const int BIDX, const Params& p) {
    const int wid = TIDX >> 6, lane = TIDX & 63;
    const float* e5 = p.out + O_HGS; bf16_t* a2 = (bf16_t*)(p.ws + WS_A2); const float* lam16 = (const float*)(p.ws + WS_LAM16);
    for (int it = BIDX * 8 + wid; it < 512; it += gridDim.x * 8) {
        const int b = it >> 6, g = it & 63;
        const float ar = lam16[(g * 64 + lane) * 2], ai = lam16[(g * 64 + lane) * 2 + 1];
        float hr = 0.f, hi = 0.f;
        for (int jb = 0; jb < 128; jb += 16) {
            float er[16], ei[16];
#pragma unroll
            for (int j = 0; j < 16; ++j) { const float* ep = e5 + ((size_t)g * 1024 + b * 128 + jb + j) * 128; er[j] = ep[lane]; ei[j] = ep[64 + lane]; }
#pragma unroll
            for (int j = 0; j < 16; ++j) {
                bf16_t* hp = a2 + ((size_t)g * 1024 + b * 128 + jb + j) * 384 + 256;
                hp[lane] = f2bf(hr); hp[64 + lane] = f2bf(hi);
                const float nr = ar * hr - ai * hi + er[j], ni = ar * hi + ai * hr + ei[j];
                hr = nr; hi = ni;
            }
        }
        p.out[O_S5RP + (size_t)(b * 64 + g) * 64 + lane] = hr; p.out[O_S5IP + (size_t)(b * 64 + g) * 64 + lane] = hi;
    }
}

DEVI void phase_H1(const int TIDX, const int BIDX, bf16_t* L, const Params& p) {
    const int tid = TIDX, wid = tid >> 6, lane = tid & 63, r16 = lane & 15, g = lane >> 4;
    float* cum = (float*)(p.ws + WS_CUM); const bf16_t* itp = (const bf16_t*)(p.ws + WS_IT); float* hkv = (float*)(p.ws + WS_HKV);
    float* tot = (float*)(L + 128 * 136);
    for (int it = BIDX; it < 1024; it += gridDim.x) {
        const int bh = it >> 4, c = it & 15, h = bh & 7, b = bh >> 3; const size_t tok0 = (size_t)b * 2048 + c * 128;
        const int d = tid & 127, part = tid >> 7;
        float* col = cum + (tok0 + part * 32) * 1024 + h * 128 + d;
        float lf[32]; float s = 0.f;
#pragma unroll
        for (int l = 0; l < 32; ++l) { lf[l] = col[(size_t)l * 1024]; s += lf[l]; }
        __syncthreads();
        tot[part * 128 + d] = s;
        __syncthreads();
        float off = 0.f, last = 0.f;
#pragma unroll
        for (int pp = 0; pp < 4; ++pp) { const float t = tot[pp * 128 + d]; if (pp < part) off += t; last += t; }
        float cc = off;
#pragma unroll
        for (int l = 0; l < 32; ++l) {
            cc += lf[l]; col[(size_t)l * 1024] = cc;
            L[d * 136 + part * 32 + l] = f2bf((1.f - __expf(lf[l])) * __expf(last - cc));
        }
        __syncthreads();
        bf16x8 bfr[4];
#pragma unroll
        for (int kk = 0; kk < 4; ++kk) bfr[kk] = *(const bf16x8*)(itp + ((size_t)bh * 128 + wid * 16 + r16) * 2048 + c * 128 + kk * 32 + g * 8);
#pragma unroll
        for (int rt = 0; rt < 8; ++rt) {
            f32x4 a0 = {0.f, 0.f, 0.f, 0.f};
#pragma unroll
            for (int kk = 0; kk < 4; ++kk) a0 = mfma16(*(const bf16x8*)(L + (rt * 16 + r16) * 136 + kk * 32 + g * 8), bfr[kk], a0);
            *(f32x4*)(hkv + (((size_t)bh * 16 + c) * 128 + wid * 16 + r16) * 128 + rt * 16 + g * 4) = a0;
        }
    }
}

DEVI void phase_H2(const int TIDX, const int BIDX, const Params& p) {
    float* hkv = (float*)(p.ws + WS_HKV); const float* cum = (const float*)(p.ws + WS_CUM);
    for (int i = BIDX * 512 + TIDX; i < 64 * 128 * 16; i += gridDim.x * 512) {
        const int q = i & 15, e = (i >> 4) & 127, bh = i >> 11, h = bh & 7, b = bh >> 3;
        f32x4 s0 = {0.f, 0.f, 0.f, 0.f}, s1 = s0;
#pragma unroll 4
        for (int c = 0; c < 16; ++c) {
            float* ptr = hkv + (((size_t)bh * 16 + c) * 128 + e) * 128 + q * 8;
            const float* lp = cum + ((size_t)b * 2048 + c * 128 + 127) * 1024 + h * 128 + q * 8;
            const f32x4 v0 = *(const f32x4*)ptr, v1 = *(const f32x4*)(ptr + 4), d0 = *(const f32x4*)lp, d1 = *(const f32x4*)(lp + 4);
            u32x4 o; o.x = pack2(s0[0], s0[1]); o.y = pack2(s0[2], s0[3]); o.z = pack2(s1[0], s1[1]); o.w = pack2(s1[2], s1[3]);
            *(u32x4*)ptr = o;
#pragma unroll
            for (int j = 0; j < 4; ++j) { s0[j] = s0[j] * __expf(d0[j]) + v0[j]; s1[j] = s1[j] * __expf(d1[j]) + v1[j]; }
        }
        float* o = p.out + O_HGP + ((size_t)bh * 128 + q * 8) * 128 + e;
#pragma unroll
        for (int j = 0; j < 4; ++j) { o[(size_t)j * 128] = s0[j]; o[(size_t)(j + 4) * 128] = s1[j]; }
    }
}

DEVI void phase_H3(const int TIDX, const int BIDX, bf16_t* L, const Params& p) {
    const int tid = TIDX, wid = tid >> 6, lane = tid & 63, r16 = lane & 15, g = lane >> 4;
    const float* cum = (const float*)(p.ws + WS_CUM); const bf16_t* itp = (const bf16_t*)(p.ws + WS_IT); const float* hkv = (const float*)(p.ws + WS_HKV);
    bf16_t* q1 = (bf16_t*)(p.ws + WS_Q1); const bf16_t* sg1 = (const bf16_t*)(p.ws + WS_SG1);
    bf16_t* kt = L; bf16_t* strip = L + 128 * 136 + wid * 16 * 136;
    for (int it = BIDX; it < 1024; it += gridDim.x) {
        const int bh = it >> 4, c = it & 15, h = bh & 7, b = bh >> 3, l0 = wid * 16; const size_t tok0 = (size_t)b * 2048 + c * 128;
        const float* refp = cum + (tok0 + 63) * 1024 + h * 128;
        __syncthreads();
        { const int m = tid >> 2, seg = tid & 3; const float* cp = cum + (tok0 + m) * 1024 + h * 128 + seg * 32;
#pragma unroll
          for (int q = 0; q < 8; ++q) {
              const f32x4 cv = *(const f32x4*)(cp + q * 4), rv = *(const f32x4*)(refp + seg * 32 + q * 4);
              f32x4 pv = {0.f, 0.f, 0.f, 0.f}; if (m > 0) pv = *(const f32x4*)(cp - 1024 + q * 4);
              f32x4 o;
#pragma unroll
              for (int j = 0; j < 4; ++j) o[j] = (1.f - __expf(cv[j] - pv[j])) * __expf(rv[j] - cv[j]);
              *(u32x2*)(kt + m * 136 + seg * 32 + q * 4) = pack4(o); } }
        bf16x8 qr[4], qab[4];
#pragma unroll
        for (int kk = 0; kk < 4; ++kk) {
            const size_t o = (tok0 + l0 + r16) * 1024 + h * 128 + kk * 32 + g * 8;
            const u32x4 qq = *(const u32x4*)(q1 + o);
            const f32x4 c0 = *(const f32x4*)(cum + o), c1 = *(const f32x4*)(cum + o + 4), r0 = *(const f32x4*)(refp + kk * 32 + g * 8), r1 = *(const f32x4*)(refp + kk * 32 + g * 8 + 4);
            const unsigned* qv = (const unsigned*)&qq; u32x4 a, bb; unsigned* av = (unsigned*)&a; unsigned* bv = (unsigned*)&bb;
#pragma unroll
            for (int j = 0; j < 4; ++j) {
                const float cl = j < 2 ? c0[2 * j] : c1[2 * j - 4], ch = j < 2 ? c0[2 * j + 1] : c1[2 * j - 3];
                const float rl = j < 2 ? r0[2 * j] : r1[2 * j - 4], rh = j < 2 ? r0[2 * j + 1] : r1[2 * j - 3];
                const float ql = bflo(qv[j]), qh = bfhi(qv[j]);
                av[j] = pack2(ql * __expf(cl - rl), qh * __expf(ch - rh)); bv[j] = pack2(ql * __expf(cl), qh * __expf(ch));
            }
            qr[kk] = *(bf16x8*)&a; qab[kk] = *(bf16x8*)&bb;
        }
        __syncthreads();
        for (int j = 0; j < 8; ++j) {
            f32x4 s = {0.f, 0.f, 0.f, 0.f};
            if (j <= wid) {
#pragma unroll
                for (int kk = 0; kk < 4; ++kk) s = mfma16(qr[kk], *(const bf16x8*)(kt + (j * 16 + r16) * 136 + kk * 32 + g * 8), s);
            }
#pragma unroll
            for (int r = 0; r < 4; ++r) {
                const int li = l0 + g * 4 + r, mi = j * 16 + r16; const float v = (j <= wid && li >= mi) ? s[r] : 0.f;
                strip[(g * 4 + r) * 136 + mi] = f2bf(v);
            }
        }
        f32x4 acc[8];
#pragma unroll
        for (int jt = 0; jt < 8; ++jt) acc[jt] = (f32x4){0.f, 0.f, 0.f, 0.f};
        if (c > 0) {
            const float* sb = hkv + ((size_t)bh * 16 + c) * 128 * 128;
#pragma unroll
            for (int jt = 0; jt < 8; ++jt)
#pragma unroll
                for (int kk = 0; kk < 4; ++kk) acc[jt] = mfma16(qab[kk], *(const bf16x8*)(sb + (size_t)(jt * 16 + r16) * 128 + kk * 32 + g * 8), acc[jt]);
        }
        __syncthreads();
        for (int kk = 0; kk <= (wid >> 1); ++kk) {
            const bf16x8 a = *(const bf16x8*)(strip + r16 * 136 + kk * 32 + g * 8);
#pragma unroll
            for (int jt = 0; jt < 8; ++jt) acc[jt] = mfma16(a, *(const bf16x8*)(itp + ((size_t)bh * 128 + jt * 16 + r16) * 2048 + c * 128 + kk * 32 + g * 8), acc[jt]);
        }
        float rs[4];
#pragma unroll
        for (int r = 0; r < 4; ++r) {
            float q = 0.f;
#pragma unroll
            for (int jt = 0; jt < 8; ++jt) q += acc[jt][r] * acc[jt][r];
            q = grp16_sum(q); rs[r] = rsqrtf(q * (1.f / 128.f) + 1e-6f);
        }
#pragma unroll
        for (int jt = 0; jt < 8; ++jt) {
            const int e = jt * 16 + r16; const float gw = p.hgnw[h * 128 + e];
#pragma unroll
            for (int r = 0; r < 4; ++r) {
                const size_t token = tok0 + l0 + g * 4 + r;
                q1[token * 1024 + h * 128 + e] = f2bf(acc[jt][r] * rs[r] * gw * bf2f(sg1[token * 1024 + h * 128 + e]));
            }
        }
    }
}

DEVI void phase_ss5(const int TIDX, const int BIDX, const Params& p) {
    const int wid = TIDX >> 6, lane = TIDX & 63;
    const float* zs = (const float*)(p.ws + WS_ZS); const float* bbg = (const float*)(p.ws + WS_BBG); const float* lam1 = (const float*)(p.ws + WS_LAM1);
    bf16_t* y5s = (bf16_t*)(p.ws + WS_Y5S);
    for (int it = BIDX * 8 + wid; it < 128 * 64; it += gridDim.x * 8) {
        const int b = it >> 6, g = it & 63;
        float u[16];
#pragma unroll
        for (int c = 0; c < 16; ++c) u[c] = zs[(size_t)b * 5120 + 3072 + g * 16 + c];
        float xr = 0.f, xi = 0.f;
#pragma unroll
        for (int c = 0; c < 16; ++c) { xr += bbg[((g * 64 + lane) * 16 + c) * 2] * u[c]; xi += bbg[((g * 64 + lane) * 16 + c) * 2 + 1] * u[c]; }
        const float ar = lam1[(g * 64 + lane) * 2], ai = lam1[(g * 64 + lane) * 2 + 1];
        const float sr = p.s5r[(size_t)(b * 64 + g) * 64 + lane], si = p.s5i[(size_t)(b * 64 + g) * 64 + lane];
        const float hr = ar * sr - ai * si + xr, hi = ar * si + ai * sr + xi;
        p.out[O_S5RS + (size_t)(b * 64 + g) * 64 + lane] = hr; p.out[O_S5IS + (size_t)(b * 64 + g) * 64 + lane] = hi;
        float mine = 0.f;
#pragma unroll
        for (int c = 0; c < 16; ++c) {
            float v = p.cre[(g * 16 + c) * 64 + lane] * hr - p.cim[(g * 16 + c) * 64 + lane] * hi;
            v = wave_sum(v);
            if (lane == c) mine = v + p.s5d[g * 16 + c] * u[c];
        }
        if (lane < 16) y5s[(size_t)b * 1024 + g * 16 + lane] = f2bf(gelu_(mine));
    }
}

DEVI void phase_sret(const int TIDX, const int BIDX, float* L, const Params& p) {
    const int tid = TIDX, lane = tid & 63, wid = tid >> 6;
    const float* zs = (const float*)(p.ws + WS_ZS); bf16_t* mix = (bf16_t*)(p.ws + WS_MIX0S);
    float* qs = L; float* ks = L + 128; float* red = L + 256; float* st = L + 768;
    for (int it = BIDX; it < 512; it += gridDim.x) {
        const int b = it >> 2, h = it & 3, e = tid & 255, half = tid >> 8; const float gam = 1.0f - exp2f(-5.0f - (float)h);
        __syncthreads();
        if (tid < 128) qs[tid] = zs[(size_t)b * 5120 + h * 128 + tid]; else if (tid < 256) ks[tid - 128] = zs[(size_t)b * 5120 + 512 + h * 128 + tid - 128];
        const float v = zs[(size_t)b * 5120 + 1024 + h * 256 + e];
        __syncthreads();
        const float* s0 = p.sret + ((size_t)it * 128 + half * 64) * 256 + e; float* so = p.out + O_RETS + ((size_t)it * 128 + half * 64) * 256 + e;
        float o = 0.f;
#pragma unroll 8
        for (int d = 0; d < 64; ++d) { const float s = gam * s0[(size_t)d * 256] + ks[half * 64 + d] * v; so[(size_t)d * 256] = s; o += qs[half * 64 + d] * s; }
        red[tid] = o;
        __syncthreads();
        float tot = 0.f;
        if (tid < 256) { tot = red[tid] + red[tid + 256]; const float s = wave_sum(tot); if (lane == 0) st[wid] = s; }
        __syncthreads();
        const float mu = (st[0] + st[1] + st[2] + st[3]) * (1.f / 256.f);
        __syncthreads();
        if (tid < 256) { const float dd = tot - mu; const float s = wave_sum(dd * dd); if (lane == 0) st[wid] = s; }
        __syncthreads();
        const float rs = rsqrtf((st[0] + st[1] + st[2] + st[3]) * (1.f / 256.f) + 1e-5f);
        if (tid < 256) mix[(size_t)b * 2048 + h * 256 + e] = f2bf((tot - mu) * rs * p.gnw[h * 256 + e] * zs[(size_t)b * 5120 + 2048 + h * 256 + e]);
    }
}

DEVI void phase_shg(const int TIDX, const int BIDX, float* L, const Params& p) {
    const int tid = TIDX, lane = tid & 63, wid = tid >> 6;
    const float* z1 = (const float*)(p.ws + WS_Z1S); bf16_t* o1s = (bf16_t*)(p.ws + WS_O1S);
    float* qs = L; float* fs = L + 128; float* red = L + 256; float* st = L + 768;
    for (int it = BIDX; it < 1024; it += gridDim.x) {
        const int b = it >> 3, h = it & 7, e = tid & 127, qt = tid >> 7;
        __syncthreads();
        if (tid < 128) qs[tid] = z1[(size_t)b * 4096 + h * 128 + tid]; else if (tid < 256) fs[tid - 128] = z1[(size_t)b * 4096 + 1024 + h * 128 + tid - 128];
        const float iv = z1[(size_t)b * 4096 + 2048 + h * 128 + e];
        __syncthreads();
        const float* s0 = p.shg + ((size_t)it * 128 + qt * 32) * 128 + e; float* so = p.out + O_HGS + ((size_t)it * 128 + qt * 32) * 128 + e;
        float o = 0.f;
#pragma unroll 8
        for (int d = 0; d < 32; ++d) { const float f = fs[qt * 32 + d]; const float s = f * s0[(size_t)d * 128] + (1.f - f) * iv; so[(size_t)d * 128] = s; o += qs[qt * 32 + d] * s; }
        red[tid] = o;
        __syncthreads();
        float tot = 0.f;
        if (tid < 128) { tot = red[tid] + red[tid + 128] + red[tid + 256] + red[tid + 384]; const float s = wave_sum(tot * tot); if (lane == 0) st[wid] = s; }
        __syncthreads();
        const float rs = rsqrtf((st[0] + st[1]) * (1.f / 128.f) + 1e-6f);
        if (tid < 128) o1s[(size_t)b * 1024 + h * 128 + e] = f2bf(tot * rs * p.hgnw[h * 128 + e] * z1[(size_t)b * 4096 + 3072 + h * 128 + e]);
    }
}

DEVI void phase_final(const int TIDX, const int BIDX, const Params& p) {
    const int wid = TIDX >> 6, lane = TIDX & 63;
    for (int row = BIDX * 8 + wid; row < MP + MS; row += gridDim.x * 8) {
        const bool smp = row >= MP; const size_t r = smp ? row - MP : row;
        float* x = p.out + (smp ? O_YS : O_YP) + r * 1024;
        f32x4 v[4]; float s = 0.f;
#pragma unroll
        for (int i = 0; i < 4; ++i) { v[i] = *(const f32x4*)(x + i * 256 + lane * 4); s += v[i][0] * v[i][0] + v[i][1] * v[i][1] + v[i][2] * v[i][2] + v[i][3] * v[i][3]; }
        s = wave_sum(s);
        const float rs = rsqrtf(s * (1.0f / 1024.0f) + 1e-6f);
#pragma unroll
        for (int i = 0; i < 4; ++i) { const f32x4 w = *(const f32x4*)(p.fnormw + i * 256 + lane * 4); *(f32x4*)(x + i * 256 + lane * 4) = v[i] * rs * w; }
    }
}

#define GRID_SYNC() do { asm volatile("s_waitcnt vmcnt(0) lgkmcnt(0)" ::: "memory"); cg::this_grid().sync(); } while (0)
constexpr int NPHASE = 13;
__global__ void __launch_bounds__(512, 2) mega(Params p0) {
    extern __shared__ __attribute__((aligned(16))) unsigned char shm[];
    LAS unsigned char* lds = (LAS unsigned char*)shm;
    const int G = gridDim.x;
#define OPQ int oz; asm volatile("s_mov_b32 %0, 0" : "=s"(oz)); int ozv; asm volatile("v_mov_b32 %0, 0" : "=v"(ozv)); \
    Params p = p0; p.ws = p0.ws + oz; p.out = p0.out + oz; const int TIDX = threadIdx.x + ozv, BIDX = blockIdx.x + oz; (void)TIDX; (void)BIDX;
    int my_xcc, my_rank;
    {
        int* sh = (int*)shm;
        if (threadIdx.x == 0) {
            const unsigned x = (unsigned)__builtin_amdgcn_s_getreg((3 << 11) | 20) & 7u;
            sh[0] = (int)x; sh[1] = (int)__hip_atomic_fetch_add((unsigned*)(p0.ws + WS_XCNT) + x * 32, 1u, __ATOMIC_RELAXED, __HIP_MEMORY_SCOPE_AGENT);
        }
        __syncthreads();
        my_xcc = __builtin_amdgcn_readfirstlane(sh[0]); my_rank = __builtin_amdgcn_readfirstlane(sh[1]);
        __syncthreads();
    }
    int gc = blockIdx.x;
    int ph_start = p0.ph_lo;
    if (ph_start == 0) {
        { OPQ phase_prep(TIDX, BIDX, (float*)shm, p); }
#if COOP
        GRID_SYNC();
        {
            bool ok = gridDim.x == 256;
            for (int x = 0; x < 8; ++x) ok = ok && (__hip_atomic_load((unsigned*)(p0.ws + WS_XCNT) + x * 32, __ATOMIC_RELAXED, __HIP_MEMORY_SCOPE_AGENT) == 32u);
            if (ok) gc = my_rank * 8 + my_xcc;
        }
#endif
        ph_start = 1;
    }
    for (int ph = ph_start; ph < p0.ph_hi; ++ph) {
        int la = -1, lb = -1, K = 1024, lda = 1024, ldb = 1024;
        switch (ph) {
        case 1: la = L_IN0; lb = L_IN0S; break;
        case 2: la = L_GA; K = 256; lda = 384; ldb = 256; break;
        case 4: la = L_GB; K = 384; lda = 384; ldb = 384; break;
        case 5: la = L_GLU; lb = L_GLUS; break;
        case 6: la = L_OUT0; lb = L_OUT0S; K = 2048; lda = 2048; ldb = 2048; break;
        case 7: la = L_IN1; lb = L_IN1S; break;
        case 11: la = L_OUT1; lb = L_OUT1S; break;
        default: break;
        }
        for (int jj = 0; jj < 2; ++jj) {
            const int l = jj ? lb : la;
            if (l < 0) continue;
            OPQ
            Sched S; S.list = l; S.G = G; S.c = jj ? G - 1 - gc : gc + oz; S.wsp = p.ws; S.outp = p.out;
            gemm_phase(TIDX, lds, K, lda, ldb, l == L_GLU, S, p);
        }
        __syncthreads();
        switch (ph) {
        case 2: { { OPQ phase_R1(TIDX, BIDX, (bf16_t*)shm, p); } __syncthreads(); { OPQ phase_sret(TIDX, BIDX, (float*)shm, p); } { OPQ phase_ss5(TIDX, BIDX, p); } } break;
        case 3: { { OPQ phase_s5scan(TIDX, BIDX, p); } { OPQ phase_R2(TIDX, BIDX, p); } } break;
        case 4: { OPQ phase_R3(TIDX, BIDX, (bf16_t*)shm, p); } break;
        case 8: { { OPQ phase_H1(TIDX, BIDX, (bf16_t*)shm, p); } __syncthreads(); { OPQ phase_shg(TIDX, BIDX, (float*)shm, p); } } break;
        case 9: { OPQ phase_H2(TIDX, BIDX, p); } break;
        case 10: { OPQ phase_H3(TIDX, BIDX, (bf16_t*)shm, p); } break;
        case 12: { OPQ phase_final(TIDX, BIDX, p); } break;
        default: break;
        }
#if COOP
        if (ph + 1 < p0.ph_hi) GRID_SYNC();
#endif
    }
}

extern "C" void kernel_launch(void* const* d_in, const int* in_sizes, int n_in, void* d_out, int out_size, void* d_ws, size_t ws_size, hipStream_t stream) {
    constexpr size_t kDynLds = 131072;
    static int grid_blocks = 0;
    if (!grid_blocks) {
        hipFuncSetAttribute((const void*)mega, hipFuncAttributeMaxDynamicSharedMemorySize, (int)kDynLds);
        int dev = 0, cus = 0, per_cu = 0;
        hipGetDevice(&dev);
        hipDeviceGetAttribute(&cus, hipDeviceAttributeMultiprocessorCount, dev);
        hipOccupancyMaxActiveBlocksPerMultiprocessor(&per_cu, mega, 512, kDynLds);
        if (per_cu < 1) per_cu = 1;
        grid_blocks = cus;
        if (grid_blocks > 256) grid_blocks = 256;
    }
    Params p{};
    const float** f = (const float**)&p;
    for (int i = 0; i < 25; ++i) f[i] = (const float*)d_in[i];
    p.out = (float*)d_out; p.ws = (char*)d_ws;
#if COOP
    p.ph_lo = 0; p.ph_hi = PH_MAX;
    hipMemsetAsync((char*)d_ws + WS_XCNT, 0, 1024, stream);
    void* args[] = {&p};
    hipError_t e = hipLaunchCooperativeKernel((const void*)mega, dim3(grid_blocks), dim3(512), args, kDynLds, stream);
    if (e != hipSuccess) fprintf(stderr, "cooperative launch failed: %s (grid %d)\n", hipGetErrorString(e), grid_blocks);
#else
    for (int ph = 0; ph < NPHASE; ++ph) {
        p.ph_lo = ph; p.ph_hi = ph + 1;
        hipLaunchKernelGGL(mega, dim3(grid_blocks), dim3(512), kDynLds, stream, p);
    }
#endif
}
```

```cpp
#include <hip/hip_runtime.h>
#include <hip/hip_cooperative_groups.h>
#include <cstdio>
namespace cg = cooperative_groups;

#ifndef PH_MAX
#define PH_MAX 13
#endif
#ifndef COOP
#define COOP 1
#endif

typedef unsigned short bf16_t;
typedef short bf16x8 __attribute__((ext_vector_type(8)));
typedef float f32x4 __attribute__((ext_vector_type(4)));
typedef unsigned u32x4 __attribute__((ext_vector_type(4)));
typedef unsigned u32x2 __attribute__((ext_vector_type(2)));
#define LAS __attribute__((address_space(3)))
#define DEVI __device__ __forceinline__

constexpr int TT = 2048, NBP = 8, MP = 16384, MS = 128, DM = 1024;
constexpr size_t MiB = (size_t)1 << 20;
constexpr size_t O_YP = 0, O_YS = 16777216, O_RETP = 16908288, O_RETS = 17956864, O_S5RP = 34734080, O_S5IP = 34766848,
                 O_S5RS = 34799616, O_S5IS = 35323904, O_HGP = 35848192, O_HGS = 36896768;
constexpr size_t WS_WIN0T = 0, WS_BT1 = 10 * MiB, WS_KT = 18 * MiB, WS_WGLUT = 34 * MiB, WS_WOUT0T = 36 * MiB, WS_WIN1T = 40 * MiB,
                 WS_BT2 = 48 * MiB, WS_Q = 60 * MiB, WS_KN = 76 * MiB, WS_VT = 92 * MiB, WS_SGA = 124 * MiB, WS_SGB = 156 * MiB,
                 WS_A2 = 188 * MiB, WS_Y5 = 0, WS_X1B = 60 * MiB, WS_SG1 = 0, WS_Q1 = 96 * MiB, WS_CUM = 128 * MiB, WS_IT = 192 * MiB,
                 WS_HKV = 32 * MiB;
constexpr size_t WS_MISC = 240 * MiB;
constexpr size_t WS_WOUT1T = WS_MISC;
constexpr size_t WS_ROPE = WS_MISC + 2 * MiB;
constexpr size_t WS_SSQ1 = WS_ROPE + 1280 * 1024;
constexpr size_t WS_SSQ2 = WS_SSQ1 + MiB;
constexpr size_t WS_H0S = WS_SSQ2 + MiB;
constexpr size_t WS_ZS = WS_H0S + 512 * 1024;
constexpr size_t WS_Y5S = WS_ZS + 2560 * 1024;
constexpr size_t WS_MIX0S = WS_Y5S + 512 * 1024;
constexpr size_t WS_X1S = WS_MIX0S + MiB;
constexpr size_t WS_X1SB = WS_X1S + 512 * 1024;
constexpr size_t WS_Z1S = WS_X1SB + 512 * 1024;
constexpr size_t WS_O1S = WS_Z1S + 2 * MiB;
constexpr size_t WS_BBG = WS_O1S + 512 * 1024;
constexpr size_t WS_LAM1 = WS_BBG + 512 * 1024;
constexpr size_t WS_LAM16 = WS_LAM1 + 32 * 1024;
constexpr size_t WS_LB = WS_LAM16 + 32 * 1024;
constexpr size_t WS_SSQ1S = WS_LB + 4096;
constexpr size_t WS_SSQ2S = WS_SSQ1S + MiB;
constexpr size_t WS_END = WS_SSQ2S + MiB;
constexpr size_t WS_XCNT = WS_END;
static_assert(WS_XCNT + 1024 <= 256 * MiB, "workspace overflow");

struct Params {
    const float *xp, *xs, *sret, *s5r, *s5i, *shg, *normw, *fnormw, *win0, *gnw, *lamre, *lamim, *logdt, *bre, *bim, *cre, *cim, *s5d,
        *gluw, *glub, *wout0, *win1, *hglb, *hgnw, *wout1;
    float* out;
    char* ws;
    int ph_lo, ph_hi;
};

DEVI bf16_t f2bf(float f) { unsigned u = __float_as_uint(f); u += 0x7FFFu + ((u >> 16) & 1u); return (bf16_t)(u >> 16); }
DEVI float bf2f(bf16_t b) { return __uint_as_float(((unsigned)b) << 16); }
DEVI unsigned pack2(float lo, float hi) { unsigned r; asm("v_cvt_pk_bf16_f32 %0, %1, %2" : "=v"(r) : "v"(lo), "v"(hi)); return r; }
DEVI float bflo(unsigned w) { return __uint_as_float(w << 16); }
DEVI float bfhi(unsigned w) { return __uint_as_float(w & 0xffff0000u); }
DEVI float sigm(float x) { return __builtin_amdgcn_rcpf(1.f + __builtin_amdgcn_exp2f(-1.4426950408889634f * x)); }
DEVI float silu_(float x) { return x * sigm(x); }
DEVI float gelu_(float x) { const float u = 1.5957691216f * (x + 0.044715f * x * x * x); return x * __builtin_amdgcn_rcpf(1.f + __builtin_amdgcn_exp2f(-1.4426950408889634f * u)); }
DEVI u32x2 pack4(f32x4 v) { u32x2 r; r.x = pack2(v[0], v[1]); r.y = pack2(v[2], v[3]); return r; }
DEVI float wave_sum(float v) {
#pragma unroll
    for (int o = 32; o > 0; o >>= 1) v += __shfl_xor(v, o);
    return v;
}
DEVI float grp16_sum(float v) { v += __shfl_xor(v, 1); v += __shfl_xor(v, 2); v += __shfl_xor(v, 4); v += __shfl_xor(v, 8); return v; }
DEVI f32x4 mfma16(bf16x8 a, bf16x8 b, f32x4 c) { return __builtin_amdgcn_mfma_f32_16x16x32_bf16(a, b, c, 0, 0, 0); }
DEVI float row_rstd16(const float* ssq, size_t row) {
    const f32x4 a = *(const f32x4*)(ssq + row * 4), b = *(const f32x4*)(ssq + (MP + row) * 4), c = *(const f32x4*)(ssq + (2 * (size_t)MP + row) * 4), d = *(const f32x4*)(ssq + (3 * (size_t)MP + row) * 4);
    float s = (a[0] + a[1] + a[2] + a[3]) + (b[0] + b[1] + b[2] + b[3]) + (c[0] + c[1] + c[2] + c[3]) + (d[0] + d[1] + d[2] + d[3]);
    return rsqrtf(s * (1.0f / 1024.0f) + 1e-6f);
}

constexpr int BM = 256, BK = 64, HALF = 128, HTB = HALF * BK * 2, NXCD = 8, WGM = 8;
DEVI int lds_byte(int r, int c) { const int st = (r >> 4) * 2 + (c >> 5), rr = r & 15, cc = c & 31, ob = rr * 64 + cc * 2; return st * 1024 + (ob ^ (((ob >> 9) & 1) << 5)); }
DEVI void stage_rc(int b, int& R, int& C) { const int st = b / 1024, sb = b % 1024, swz = sb ^ (((sb >> 9) & 1) << 5); R = (st >> 1) * 16 + swz / 64; C = (st & 1) * 32 + (swz % 64) / 2; }

enum { K_Q = 0, K_K, K_VT, K_GA, K_U, K_GB, K_SIN0, K_E5, K_Y5, K_GLU, K_SGLU, K_OUT0, K_SOUT0, K_Q1, K_F, K_IT, K_G1, K_SIN1, K_OUT1, K_SOUT1 };
enum { L_IN0 = 0, L_IN0S, L_GA, L_GB, L_GLU, L_GLUS, L_OUT0, L_OUT0S, L_IN1, L_IN1S, L_OUT1, L_OUT1S };

struct Unit { const char* a; const char* b; int kind, pm, pn; };

DEVI void static_order(int L, int nM, int nN, int& pm, int& pn) {
    const int nwg = nM * nN; int wgid = L;
    { const int q = nwg / NXCD, r = nwg % NXCD, xcd = wgid % NXCD, off = wgid / NXCD; wgid = (xcd < r ? xcd * (q + 1) : r * (q + 1) + (xcd - r) * q) + off; }
    const int nig = WGM * nN, gid = wgid / nig, fm = gid * WGM, gsz = (nM - fm) < WGM ? (nM - fm) : WGM;
    pm = fm + ((wgid % nig) % gsz); pn = (wgid % nig) / gsz;
}

struct Sched {
    int list, G, c; char* wsp; float* outp;
    DEVI bool next(int i, Unit& u) const {
        const int L = i * G + c; const char* ws = wsp;
        switch (list) {
        case L_IN0: {
            if (L >= 1280) return false; int pm, pn; static_order(L, 64, 20, pm, pn); u.pm = pm; u.pn = pn;
            const char* h0 = (const char*)(outp + O_RETS);
            if (pn >= 4 && pn < 8) { u.kind = K_VT; u.a = ws + WS_WIN0T + (size_t)(1024 + 256 * (pn - 4)) * 2048; u.b = h0 + (size_t)pm * 256 * 2048; }
            else { u.kind = pn < 2 ? K_Q : pn < 4 ? K_K : pn < 12 ? K_GA : pn < 16 ? K_U : K_GB; u.a = h0 + (size_t)pm * 256 * 2048; u.b = ws + WS_WIN0T + (size_t)pn * 256 * 2048; }
            return true; }
        case L_IN0S: if (L >= 20) return false; u.pm = 0; u.pn = L; u.kind = K_SIN0; u.a = ws + WS_H0S; u.b = ws + WS_WIN0T + (size_t)L * 256 * 2048; return true;
        case L_GA: if (L >= 256) return false; u.pm = L & 3; u.pn = L >> 2; u.kind = K_E5; u.a = ws + WS_A2 + ((size_t)(L >> 2) * 1024 + (L & 3) * 256) * 768; u.b = ws + WS_BT1 + (size_t)(L >> 2) * 256 * 512; return true;
        case L_GB: if (L >= 256) return false; u.pm = L & 3; u.pn = L >> 2; u.kind = K_Y5; u.a = ws + WS_A2 + ((size_t)(L >> 2) * 1024 + (L & 3) * 256) * 768; u.b = ws + WS_BT2 + (size_t)(L >> 2) * 256 * 768; return true;
        case L_GLU: { if (L >= 256) return false; int pm, pn; static_order(L, 64, 4, pm, pn); u.pm = pm; u.pn = pn; u.kind = K_GLU; u.a = ws + WS_Y5 + (size_t)pm * 256 * 32; u.b = ws + WS_WGLUT + (size_t)pn * 256 * 2048; return true; }
        case L_GLUS: if (L >= 4) return false; u.pm = 0; u.pn = L; u.kind = K_SGLU; u.a = ws + WS_Y5S; u.b = ws + WS_WGLUT + (size_t)L * 256 * 2048; return true;
        case L_OUT0: { if (L >= 256) return false; int pm, pn; static_order(L, 64, 4, pm, pn); u.pm = pm; u.pn = pn; u.kind = K_OUT0; u.a = (const char*)(outp + O_HGS) + (size_t)pm * 256 * 4096; u.b = ws + WS_WOUT0T + (size_t)pn * 256 * 4096; return true; }
        case L_OUT0S: if (L >= 4) return false; u.pm = 0; u.pn = L; u.kind = K_SOUT0; u.a = ws + WS_MIX0S; u.b = ws + WS_WOUT0T + (size_t)L * 256 * 4096; return true;
        case L_IN1: {
            if (L >= 1024) return false; int pm, pn; static_order(L, 64, 16, pm, pn); u.pm = pm; u.pn = pn;
            if (pn >= 8 && pn < 12) { u.kind = K_IT; u.a = ws + WS_WIN1T + (size_t)(256 * pn) * 2048; u.b = ws + WS_X1B + (size_t)pm * 256 * 2048; }
            else { u.kind = pn < 4 ? K_Q1 : pn < 8 ? K_F : K_G1; u.a = ws + WS_X1B + (size_t)pm * 256 * 2048; u.b = ws + WS_WIN1T + (size_t)pn * 256 * 2048; }
            return true; }
        case L_IN1S: if (L >= 16) return false; u.pm = 0; u.pn = L; u.kind = K_SIN1; u.a = ws + WS_X1SB; u.b = ws + WS_WIN1T + (size_t)L * 256 * 2048; return true;
        case L_OUT1: { if (L >= 256) return false; int pm, pn; static_order(L, 64, 4, pm, pn); u.pm = pm; u.pn = pn; u.kind = K_OUT1; u.a = ws + WS_Q1 + (size_t)pm * 256 * 2048; u.b = ws + WS_WOUT1T + (size_t)pn * 256 * 2048; return true; }
        case L_OUT1S: if (L >= 4) return false; u.pm = 0; u.pn = L; u.kind = K_SOUT1; u.a = ws + WS_O1S; u.b = ws + WS_WOUT1T + (size_t)L * 256 * 2048; return true;
        }
        return false;
    }
};

DEVI void epilogue(const Params& p, const f32x4 (&acc)[2][2][4][2], const Unit& u, int wr, int wc, int fr, int fq) {
    char* ws = p.ws;
    const int kind = u.kind;
    if (kind == K_Q || kind == K_K) {
        const float* rope = (const float*)(ws + WS_ROPE);
        bf16_t* dst = (bf16_t*)(ws + (kind == K_Q ? WS_Q : WS_KN));
        bf16_t* kt = (bf16_t*)(ws + WS_KT);
        const int tq = kind == K_Q ? u.pn : u.pn - 2;
        const float sc = kind == K_Q ? 1.0f : 0.08838834764831845f;
#pragma unroll
        for (int ai = 0; ai < 2; ++ai) {
#pragma unroll
          for (int mh = 0; mh < 2; ++mh) {
            f32x4 cs[4][2], sn[4][2];
#pragma unroll
            for (int m = mh * 2; m < mh * 2 + 2; ++m)
#pragma unroll
                for (int n = 0; n < 2; ++n) {
                    const int token = u.pm * 256 + ai * 128 + wr * 64 + m * 16 + fr, pos = token & 2047, j = (wc * 32 + n * 16 + fq * 4) & 63;
                    cs[m][n] = *(const f32x4*)(rope + pos * 128 + j); sn[m][n] = *(const f32x4*)(rope + pos * 128 + 64 + j);
                }
#pragma unroll
            for (int m = mh * 2; m < mh * 2 + 2; ++m) {
                const int token = u.pm * 256 + ai * 128 + wr * 64 + m * 16 + fr;
#pragma unroll
                for (int n = 0; n < 2; ++n) {
                    const int w = wc * 32 + n * 16 + fq * 4, hl = w >> 6, j = w & 63, head = 2 * tq + hl;
                    const f32x4 x1 = acc[ai][0][m][n], x2 = acc[ai][1][m][n];
                    const f32x4 y1 = (x1 * cs[m][n] - x2 * sn[m][n]) * sc, y2 = (x1 * sn[m][n] + x2 * cs[m][n]) * sc;
                    bf16_t* d = dst + (size_t)token * 512 + head * 128 + j;
                    *(u32x2*)d = pack4(y1); *(u32x2*)(d + 64) = pack4(y2);
                    if (kind == K_K) {
                        const int b = token >> 11, t = token & 2047;
                        bf16_t* kk = kt + ((size_t)(b * 4 + head) * 128 + j) * 2048 + t;
#pragma unroll
                        for (int i = 0; i < 4; ++i) { kk[(size_t)i * 2048] = f2bf(y1[i]); kk[(size_t)(64 + i) * 2048] = f2bf(y2[i]); }
                    }
                }
            }
          }
        }
    } else if (kind == K_VT || kind == K_IT) {
        const bool isv = kind == K_VT;
        const float* ssq = (const float*)(ws + WS_SSQ1);
        bf16_t* dst = (bf16_t*)(ws + (isv ? WS_VT : WS_IT));
        f32x4 rsa[2][2];
#pragma unroll
        for (int bj = 0; bj < 2; ++bj)
#pragma unroll
            for (int n = 0; n < 2; ++n) {
                const int token = u.pm * 256 + bj * 128 + wc * 32 + n * 16 + fq * 4;
                f32x4 rs = {1.f, 1.f, 1.f, 1.f};
                if (!isv) { rs[0] = row_rstd16(ssq, token); rs[1] = row_rstd16(ssq, token + 1); rs[2] = row_rstd16(ssq, token + 2); rs[3] = row_rstd16(ssq, token + 3); }
                rsa[bj][n] = rs;
            }
#pragma unroll
        for (int bj = 0; bj < 2; ++bj)
#pragma unroll
            for (int n = 0; n < 2; ++n) {
                const int token = u.pm * 256 + bj * 128 + wc * 32 + n * 16 + fq * 4, b = token >> 11, t = token & 2047;
                const f32x4 rs = rsa[bj][n];
#pragma unroll
                for (int ai = 0; ai < 2; ++ai)
#pragma unroll
                    for (int m = 0; m < 4; ++m) {
                        const int row = ai * 128 + wr * 64 + m * 16 + fr;
                        size_t off;
                        if (isv) off = ((size_t)(b * 4 + (u.pn - 4)) * 256 + row) * 2048 + t;
                        else { const int eg = (u.pn - 8) * 256 + row; off = ((size_t)(b * 8 + (eg >> 7)) * 128 + (eg & 127)) * 2048 + t; }
                        *(u32x2*)(dst + off) = pack4(acc[ai][bj][m][n] * rs);
                    }
            }
    } else if (kind == K_GA || kind == K_GB || kind == K_U) {
#pragma unroll
        for (int ai = 0; ai < 2; ++ai)
#pragma unroll
            for (int m = 0; m < 4; ++m) {
                const int token = u.pm * 256 + ai * 128 + wr * 64 + m * 16 + fr;
#pragma unroll
                for (int bj = 0; bj < 2; ++bj)
#pragma unroll
                    for (int n = 0; n < 2; ++n) {
                        const int cl = bj * 128 + wc * 32 + n * 16 + fq * 4;
                        f32x4 v = acc[ai][bj][m][n];
                        if (kind == K_U) {
                            const int cu = (u.pn - 12) * 256 + cl, g = cu >> 4, c = cu & 15;
                            bf16_t* d = (bf16_t*)(ws + WS_A2) + ((size_t)g * 1024 + (token >> 4)) * 384 + (token & 15) * 16 + c;
                            *(u32x2*)d = pack4(v);
                        } else {
                            v[0] = silu_(v[0]); v[1] = silu_(v[1]); v[2] = silu_(v[2]); v[3] = silu_(v[3]);
                            bf16_t* d = (bf16_t*)(ws + (kind == K_GA ? WS_SGA : WS_SGB)) + (size_t)token * 1024 + (u.pn - (kind == K_GA ? 8 : 16)) * 256 + cl;
                            *(u32x2*)d = pack4(v);
                        }
                    }
            }
    } else if (kind == K_SIN0) {
        const float* rope = (const float*)(ws + WS_ROPE) + 2048 * 128;
        float* zs = (float*)(ws + WS_ZS);
#pragma unroll
        for (int m = 0; m < 4; ++m) {
            const int row = wr * 64 + m * 16 + fr;
            if (u.pn < 4) {
                const float sc = u.pn < 2 ? 1.0f : 0.08838834764831845f;
#pragma unroll
                for (int n = 0; n < 2; ++n) {
                    const int w = wc * 32 + n * 16 + fq * 4, hl = w >> 6, j = w & 63;
                    const f32x4 cs = *(const f32x4*)(rope + j), sn = *(const f32x4*)(rope + 64 + j);
                    const f32x4 x1 = acc[0][0][m][n], x2 = acc[0][1][m][n];
                    float* d = zs + (size_t)row * 5120 + u.pn * 256 + hl * 128 + j;
                    *(f32x4*)d = (x1 * cs - x2 * sn) * sc; *(f32x4*)(d + 64) = (x1 * sn + x2 * cs) * sc;
                }
            } else {
                const bool gate = (u.pn >= 8 && u.pn < 12) || u.pn >= 16;
#pragma unroll
                for (int bj = 0; bj < 2; ++bj)
#pragma unroll
                    for (int n = 0; n < 2; ++n) {
                        f32x4 v = acc[0][bj][m][n];
                        if (gate) { v[0] = silu_(v[0]); v[1] = silu_(v[1]); v[2] = silu_(v[2]); v[3] = silu_(v[3]); }
                        *(f32x4*)(zs + (size_t)row * 5120 + u.pn * 256 + bj * 128 + wc * 32 + n * 16 + fq * 4) = v;
                    }
            }
        }
    } else if (kind == K_E5) {
        float* e5 = (float*)(p.out + O_HGS);
#pragma unroll
        for (int ai = 0; ai < 2; ++ai)
#pragma unroll
            for (int m = 0; m < 4; ++m) {
                const int row = u.pm * 256 + ai * 128 + wr * 64 + m * 16 + fr;
#pragma unroll
                for (int n = 0; n < 2; ++n) *(f32x4*)(e5 + ((size_t)u.pn * 1024 + row) * 128 + wc * 32 + n * 16 + fq * 4) = acc[ai][0][m][n];
            }
    } else if (kind == K_Y5) {
        const bf16_t* a2 = (const bf16_t*)(ws + WS_A2);
        bf16_t* y5 = (bf16_t*)(ws + WS_Y5);
        const int g = u.pn;
        f32x4 ddv[2][2];
#pragma unroll
        for (int bj = 0; bj < 2; ++bj)
#pragma unroll
            for (int n = 0; n < 2; ++n) ddv[bj][n] = *(const f32x4*)(p.s5d + g * 16 + ((bj * 128 + wc * 32 + n * 16 + fq * 4) & 15));
#pragma unroll
        for (int ai = 0; ai < 2; ++ai) {
#pragma unroll
          for (int mh = 0; mh < 2; ++mh) {
            u32x2 uv[4][2][2];
#pragma unroll
            for (int m = mh * 2; m < mh * 2 + 2; ++m)
#pragma unroll
                for (int bj = 0; bj < 2; ++bj)
#pragma unroll
                    for (int n = 0; n < 2; ++n) uv[m][bj][n] = *(const u32x2*)(a2 + ((size_t)g * 1024 + u.pm * 256 + ai * 128 + wr * 64 + m * 16 + fr) * 384 + bj * 128 + wc * 32 + n * 16 + fq * 4);
#pragma unroll
            for (int m = mh * 2; m < mh * 2 + 2; ++m) {
                const int row = u.pm * 256 + ai * 128 + wr * 64 + m * 16 + fr;
#pragma unroll
                for (int bj = 0; bj < 2; ++bj)
#pragma unroll
                    for (int n = 0; n < 2; ++n) {
                        const int col = bj * 128 + wc * 32 + n * 16 + fq * 4;
                        const u32x2 uu = uv[m][bj][n]; const f32x4 dd = ddv[bj][n];
                        f32x4 v = acc[ai][bj][m][n];
                        v[0] = gelu_(v[0] + dd[0] * bflo(uu.x)); v[1] = gelu_(v[1] + dd[1] * bfhi(uu.x));
                        v[2] = gelu_(v[2] + dd[2] * bflo(uu.y)); v[3] = gelu_(v[3] + dd[3] * bfhi(uu.y));
                        *(u32x2*)(y5 + ((size_t)g * 1024 + row) * 256 + col) = pack4(v);
                    }
            }
          }
        }
    } else if (kind == K_SGLU) {
        const bf16_t* y5 = (const bf16_t*)(ws + WS_Y5S);
        const float* zs = (const float*)(ws + WS_ZS);
        bf16_t* mix = (bf16_t*)(ws + WS_MIX0S);
#pragma unroll
        for (int m = 0; m < 4; ++m) {
            const size_t token = (size_t)wr * 64 + m * 16 + fr;
#pragma unroll
            for (int bj = 0; bj < 2; ++bj)
#pragma unroll
                for (int n = 0; n < 2; ++n) {
                    const int col = u.pn * 256 + bj * 128 + wc * 32 + n * 16 + fq * 4;
                    const f32x4 bb = *(const f32x4*)(p.glub + col);
                    const u32x2 yy = *(const u32x2*)(y5 + token * 1024 + col);
                    const f32x4 gg = *(const f32x4*)(zs + token * 5120 + 4096 + col);
                    f32x4 v = acc[0][bj][m][n] + bb;
                    v[0] = bflo(yy.x) * sigm(v[0]) * gg[0]; v[1] = bfhi(yy.x) * sigm(v[1]) * gg[1];
                    v[2] = bflo(yy.y) * sigm(v[2]) * gg[2]; v[3] = bfhi(yy.y) * sigm(v[3]) * gg[3];
                    *(u32x2*)(mix + token * 2048 + 1024 + col) = pack4(v);
                }
        }
    } else if (kind == K_GLU) {
        const bf16_t* y5 = (const bf16_t*)(ws + WS_Y5);
        const bf16_t* sgb = (const bf16_t*)(ws + WS_SGB);
        bf16_t* mix = (bf16_t*)(p.out + O_HGS);
        f32x4 bbv[2][2];
#pragma unroll
        for (int bj = 0; bj < 2; ++bj)
#pragma unroll
            for (int n = 0; n < 2; ++n) bbv[bj][n] = *(const f32x4*)(p.glub + u.pn * 256 + bj * 128 + wc * 32 + n * 16 + fq * 4);
#pragma unroll
        for (int ai = 0; ai < 2; ++ai)
#pragma unroll
          for (int mh = 0; mh < 2; ++mh) {
            u32x2 yv[4][2][2], gp[4][2][2];
#pragma unroll
            for (int m = mh * 2; m < mh * 2 + 2; ++m)
#pragma unroll
                for (int bj = 0; bj < 2; ++bj)
#pragma unroll
                    for (int n = 0; n < 2; ++n) {
                        const size_t token = (size_t)u.pm * 256 + ai * 128 + wr * 64 + m * 16 + fr; const int col = u.pn * 256 + bj * 128 + wc * 32 + n * 16 + fq * 4;
                        yv[m][bj][n] = *(const u32x2*)(y5 + ((size_t)(col >> 4) * MP + token) * 16 + (col & 15));
                        gp[m][bj][n] = *(const u32x2*)(sgb + token * 1024 + col);
                    }
#pragma unroll
            for (int m = mh * 2; m < mh * 2 + 2; ++m) {
                const size_t token = (size_t)u.pm * 256 + ai * 128 + wr * 64 + m * 16 + fr;
#pragma unroll
                for (int bj = 0; bj < 2; ++bj)
#pragma unroll
                    for (int n = 0; n < 2; ++n) {
                        const int col = u.pn * 256 + bj * 128 + wc * 32 + n * 16 + fq * 4;
                        const u32x2 yy = yv[m][bj][n], t = gp[m][bj][n];
                        f32x4 v = acc[ai][bj][m][n] + bbv[bj][n];
                        v[0] = bflo(yy.x) * sigm(v[0]) * bflo(t.x); v[1] = bfhi(yy.x) * sigm(v[1]) * bfhi(t.x);
                        v[2] = bflo(yy.y) * sigm(v[2]) * bflo(t.y); v[3] = bfhi(yy.y) * sigm(v[3]) * bfhi(t.y);
                        *(u32x2*)(mix + token * 2048 + 1024 + col) = pack4(v);
                    }
            }
          }
    } else if (kind == K_OUT0 || kind == K_SOUT0 || kind == K_OUT1 || kind == K_SOUT1) {
        const bool smp = kind == K_SOUT0 || kind == K_SOUT1, l0 = kind == K_OUT0 || kind == K_SOUT0;
        const float* res = l0 ? (smp ? p.xs : p.xp) : (smp ? (const float*)(ws + WS_X1S) : p.out + O_YP);
        float* dst = l0 ? (smp ? (float*)(ws + WS_X1S) : p.out + O_YP) : (smp ? p.out + O_YS : p.out + O_YP);
        bf16_t* dstb = (bf16_t*)(ws + (smp ? WS_X1SB : WS_X1B));
        float* ssq = (float*)(ws + (l0 ? (smp ? WS_SSQ1S : WS_SSQ1) : (smp ? WS_SSQ2S : WS_SSQ2)));
#pragma unroll
        for (int ai = 0; ai < 2; ++ai) {
            if (smp && ai) break;
#pragma unroll
          for (int mh = 0; mh < 2; ++mh) {
            f32x4 rv[4][2][2];
#pragma unroll
            for (int m = mh * 2; m < mh * 2 + 2; ++m)
#pragma unroll
                for (int bj = 0; bj < 2; ++bj)
#pragma unroll
                    for (int n = 0; n < 2; ++n) rv[m][bj][n] = *(const f32x4*)(res + ((size_t)u.pm * 256 + ai * 128 + wr * 64 + m * 16 + fr) * 1024 + u.pn * 256 + bj * 128 + wc * 32 + n * 16 + fq * 4);
#pragma unroll
            for (int m = mh * 2; m < mh * 2 + 2; ++m) {
                const size_t token = (size_t)u.pm * 256 + ai * 128 + wr * 64 + m * 16 + fr;
                float s = 0.f;
#pragma unroll
                for (int bj = 0; bj < 2; ++bj)
#pragma unroll
                    for (int n = 0; n < 2; ++n) {
                        const int col = u.pn * 256 + bj * 128 + wc * 32 + n * 16 + fq * 4;
                        const f32x4 v = acc[ai][bj][m][n] + rv[m][bj][n];
                        *(f32x4*)(dst + token * 1024 + col) = v;
                        if (l0) *(u32x2*)(dstb + token * 1024 + col) = pack4(v);
                        s += v[0] * v[0] + v[1] * v[1] + v[2] * v[2] + v[3] * v[3];
                    }
                s += __shfl_xor(s, 16); s += __shfl_xor(s, 32);
                if (fq == 0) ssq[((size_t)u.pn * MP + token) * 4 + wc] = s;
            }
          }
        }
    } else if (kind == K_Q1 || kind == K_F || kind == K_G1) {
        const float* ssq = (const float*)(ws + WS_SSQ1);
        const float* lb = (const float*)(ws + WS_LB);
#pragma unroll
        for (int ai = 0; ai < 2; ++ai) {
            float rr[4];
#pragma unroll
            for (int m = 0; m < 4; ++m) rr[m] = row_rstd16(ssq, (size_t)u.pm * 256 + ai * 128 + wr * 64 + m * 16 + fr);
            __builtin_amdgcn_sched_barrier(0);
#pragma unroll
            for (int m = 0; m < 4; ++m) {
                const size_t token = (size_t)u.pm * 256 + ai * 128 + wr * 64 + m * 16 + fr;
                const float r = rr[m];
#pragma unroll
                for (int bj = 0; bj < 2; ++bj)
#pragma unroll
                    for (int n = 0; n < 2; ++n) {
                        const int cl = (u.pn & 3) * 256 + bj * 128 + wc * 32 + n * 16 + fq * 4;
                        f32x4 v = acc[ai][bj][m][n] * r;
                        if (kind == K_F) {
                            const f32x4 l = *(const f32x4*)(lb + cl);
#pragma unroll
                            for (int i = 0; i < 4; ++i) v[i] = __logf(l[i] + (1.f - l[i]) * sigm(v[i]));
                            *(f32x4*)((float*)(ws + WS_CUM) + token * 1024 + cl) = v;
                        } else {
                            v[0] = silu_(v[0]); v[1] = silu_(v[1]); v[2] = silu_(v[2]); v[3] = silu_(v[3]);
                            *(u32x2*)((bf16_t*)(ws + (kind == K_Q1 ? WS_Q1 : WS_SG1)) + token * 1024 + cl) = pack4(v);
                        }
                    }
            }
        }
    } else if (kind == K_SIN1) {
        const float* ssq = (const float*)(ws + WS_SSQ1S);
        const float* lb = (const float*)(ws + WS_LB);
        float* z1 = (float*)(ws + WS_Z1S);
#pragma unroll
        for (int m = 0; m < 4; ++m) {
            const size_t row = wr * 64 + m * 16 + fr;
            const float r = row_rstd16(ssq, row);
            const int ty = u.pn >> 2;
#pragma unroll
            for (int bj = 0; bj < 2; ++bj)
#pragma unroll
                for (int n = 0; n < 2; ++n) {
                    const int cl = (u.pn & 3) * 256 + bj * 128 + wc * 32 + n * 16 + fq * 4;
                    f32x4 v = acc[0][bj][m][n] * r;
                    if (ty == 1) { const f32x4 l = *(const f32x4*)(lb + cl);
#pragma unroll
                        for (int i = 0; i < 4; ++i) v[i] = l[i] + (1.f - l[i]) * sigm(v[i]); }
                    else if (ty != 2) { v[0] = silu_(v[0]); v[1] = silu_(v[1]); v[2] = silu_(v[2]); v[3] = silu_(v[3]); }
                    *(f32x4*)(z1 + row * 4096 + ty * 1024 + cl) = v;
                }
        }
    }
}

DEVI void gemm_phase(const int TIDX, LAS unsigned char* lds, const int K, const int lda, const int ldb, const bool ga, const Sched S, const Params& P) {
    const int tid = TIDX, wid = __builtin_amdgcn_readfirstlane(tid >> 6), lane = tid & 63, wr = wid >> 2, wc = wid & 3, fr = lane & 15, fq = lane >> 4;
    const int nt = K / BK;
    unsigned voffA[2], voffB[2];
#pragma unroll
    for (int i = 0; i < 2; ++i) { int R, C; stage_rc(tid * 16 + i * 8192, R, C); voffA[i] = ga ? (unsigned)(R * 32 + (C >> 4) * (MP * 32) + (C & 15) * 2) : (unsigned)(R * lda + C) * 2u; voffB[i] = (unsigned)(R * ldb + C) * 2u; }
    const size_t kstep = (size_t)(BK * 2), kstepA = ga ? (size_t)4 * MP * 32 : kstep;
    const size_t hstepA = ga ? (size_t)HALF * 32 : (size_t)HALF * lda * 2, hstepB = (size_t)HALF * ldb * 2;
    const unsigned ldsw = (unsigned)wid * 1024u;
    const int aoff = lds_byte(wr * 64 + fr, fq * 8), boff = lds_byte(wc * 32 + fr, fq * 8);
#define PG8_SA(b, h) (((b) * 2 + (h)) * HTB)
#define PG8_SB(b, h) ((4 + (b) * 2 + (h)) * HTB)
#define PG8_STAGE(bufoff, gbase, voff) do { _Pragma("unroll") for (int _i = 0; _i < 2; ++_i) \
        __builtin_amdgcn_global_load_lds((const unsigned*)((const char*)(gbase) + (voff)[_i]), (LAS unsigned*)(lds + (bufoff) + ldsw + _i * 8192), 16, 0, 0); } while (0)
#define PG8_LDA(dst, b, h) do { _Pragma("unroll") for (int m = 0; m < 4; ++m) _Pragma("unroll") for (int k = 0; k < 2; ++k) dst[m][k] = *(const LAS bf16x8*)(lds + PG8_SA(b, h) + aoff + m * 2048 + k * 1024); } while (0)
#define PG8_LDB(dst, b, h) do { _Pragma("unroll") for (int n = 0; n < 2; ++n) _Pragma("unroll") for (int k = 0; k < 2; ++k) dst[n][k] = *(const LAS bf16x8*)(lds + PG8_SB(b, h) + boff + n * 2048 + k * 1024); } while (0)
#define PG8_MMA(ai, bj, At, Bt) do { __builtin_amdgcn_s_setprio(1); _Pragma("unroll") for (int m = 0; m < 4; ++m) _Pragma("unroll") for (int n = 0; n < 2; ++n) _Pragma("unroll") for (int k = 0; k < 2; ++k) \
        acc[ai][bj][m][n] = __builtin_amdgcn_mfma_f32_16x16x32_bf16(Bt[n][k], At[m][k], acc[ai][bj][m][n], 0, 0, 0); __builtin_amdgcn_s_setprio(0); } while (0)
#define PG8_WAIT_V(n) asm volatile("s_waitcnt vmcnt(" #n ")" ::: "memory")
#define PG8_WAIT_L(n) asm volatile("s_waitcnt lgkmcnt(" #n ")" ::: "memory")
#define PG8_BAR __builtin_amdgcn_s_barrier()
#define PG8_SCHED __builtin_amdgcn_sched_barrier(0)
    Unit cur, nxt; int ui = 0;
    if (!S.next(0, cur)) return;
    f32x4 acc[2][2][4][2];
#pragma unroll
    for (int a = 0; a < 2; ++a)
#pragma unroll
        for (int b = 0; b < 2; ++b)
#pragma unroll
            for (int m = 0; m < 4; ++m)
#pragma unroll
                for (int n = 0; n < 2; ++n) acc[a][b][m][n] = (f32x4){0.f, 0.f, 0.f, 0.f};
    bf16x8 At[4][2], B0[2][2], B1[2][2];
    const char* cA = cur.a; const char* cB = cur.b;
    PG8_STAGE(PG8_SB(0, 0), cB, voffB); PG8_STAGE(PG8_SA(0, 0), cA, voffA); PG8_STAGE(PG8_SB(0, 1), cB + hstepB, voffB); PG8_STAGE(PG8_SA(0, 1), cA + hstepA, voffA);
    if (wr == 1) PG8_BAR;
    PG8_WAIT_V(4); PG8_BAR;
    PG8_STAGE(PG8_SB(1, 0), cB + kstep, voffB); PG8_STAGE(PG8_SA(1, 0), cA + kstepA, voffA); PG8_STAGE(PG8_SB(1, 1), cB + hstepB + kstep, voffB);
    PG8_WAIT_V(6); PG8_BAR;
    for (;;) {
        const bool has_next = S.next(ui + 1, nxt);
        const char* nA = has_next ? nxt.a : cA; const char* nB = has_next ? nxt.b : cB;
        for (int t = 0; t < nt; t += 2) {
            const bool last = (t == nt - 2);
            const char* a1 = cA + (size_t)(t + 1) * kstepA;
            const char* a2 = last ? nA : cA + (size_t)(t + 2) * kstepA; const char* b2 = last ? nB : cB + (size_t)(t + 2) * kstep;
            const char* a3 = a2 + kstepA; const char* b3 = b2 + kstep;
            PG8_LDB(B0, 0, 0); PG8_SCHED; PG8_LDA(At, 0, 0); PG8_STAGE(PG8_SA(1, 1), a1 + hstepA, voffA);
            PG8_WAIT_L(8); PG8_BAR; PG8_WAIT_L(0); PG8_MMA(0, 0, At, B0); PG8_BAR; PG8_SCHED;
            PG8_LDB(B1, 0, 1); PG8_STAGE(PG8_SB(0, 0), b2, voffB);
            PG8_BAR; PG8_WAIT_L(0); PG8_MMA(0, 1, At, B1); PG8_BAR;
            PG8_LDA(At, 0, 1); PG8_STAGE(PG8_SA(0, 0), a2, voffA);
            PG8_BAR; PG8_WAIT_L(0); PG8_MMA(1, 0, At, B0); PG8_BAR; PG8_SCHED;
            PG8_STAGE(PG8_SB(0, 1), b2 + hstepB, voffB);
            PG8_WAIT_V(6); PG8_BAR; PG8_MMA(1, 1, At, B1); PG8_BAR;
            PG8_LDB(B0, 1, 0); PG8_SCHED; PG8_LDA(At, 1, 0); PG8_STAGE(PG8_SA(0, 1), a2 + hstepA, voffA);
            PG8_WAIT_L(8); PG8_BAR; PG8_WAIT_L(0); PG8_MMA(0, 0, At, B0); PG8_BAR; PG8_SCHED;
            PG8_LDB(B1, 1, 1); PG8_STAGE(PG8_SB(1, 0), b3, voffB);
            PG8_BAR; PG8_WAIT_L(0); PG8_MMA(0, 1, At, B1); PG8_BAR;
            PG8_LDA(At, 1, 1); PG8_STAGE(PG8_SA(1, 0), a3, voffA);
            PG8_BAR; PG8_WAIT_L(0); PG8_MMA(1, 0, At, B0); PG8_BAR; PG8_SCHED;
            PG8_STAGE(PG8_SB(1, 1), b3 + hstepB, voffB);
            PG8_WAIT_V(6); PG8_BAR; PG8_MMA(1, 1, At, B1); PG8_BAR;
        }
        { int ozv; asm volatile("v_mov_b32 %0, 0" : "=v"(ozv)); epilogue(P, acc, cur, wr, wc, fr + ozv, fq + ozv); }
        if (!has_next) break;
#pragma unroll
        for (int a = 0; a < 2; ++a)
#pragma unroll
            for (int b = 0; b < 2; ++b)
#pragma unroll
                for (int m = 0; m < 4; ++m)
#pragma unroll
                    for (int n = 0; n < 2; ++n) acc[a][b][m][n] = (f32x4){0.f, 0.f, 0.f, 0.f};
        cur = nxt; cA = nA; cB = nB; ++ui;
    }
    PG8_WAIT_V(0);
    if (wr == 0) PG8_BAR;
    PG8_BAR;
}

DEVI void prep_transpose(const int TIDX, const int BIDX, float* tile, const float* src, int K, int N, bf16_t* dst, const float* kscale, bool permqk, int job0, int& jobbase, int gsz) {
    (void)tile;
    const int nk8 = K / 8, ntn = N / 64, njobs = ntn * (nk8 / 8), lane = TIDX & 63, wid = TIDX >> 6;
    for (int jb = job0 - jobbase; jb < njobs; jb += gsz) {
        if (jb < 0) continue;
        const int tn = jb / (nk8 / 8), tk = jb % (nk8 / 8), n0 = tn * 64, k0 = tk * 64 + wid * 8;
        int c0 = n0;
        if (permqk && n0 < 1024) { const int tile_ = n0 >> 8, cp = n0 & 255, bj = cp >> 7, w = cp & 127; c0 = tile_ * 256 + (w >> 6) * 128 + bj * 64; }
        float v[8];
#pragma unroll
        for (int j = 0; j < 8; ++j) v[j] = src[(size_t)(k0 + j) * N + c0 + lane] * (kscale ? kscale[k0 + j] : 1.f);
        u32x4 o; o.x = pack2(v[0], v[1]); o.y = pack2(v[2], v[3]); o.z = pack2(v[4], v[5]); o.w = pack2(v[6], v[7]);
        *(u32x4*)(dst + (size_t)(n0 + lane) * K + k0) = o;
    }
    jobbase += njobs;
}

DEVI void prep_s5_tables(const int TIDX, const int BIDX, float* L, const Params& p, int g) {
    float* pwr = L;
    float* pwi = pwr + 17 * 64;
    float* bbr = pwi + 17 * 64;
    float* bbi = bbr + 1024;
    float* cr = bbi + 1024;
    float* ci = cr + 1024;
    float* kg = ci + 1024;
    const int tid = TIDX;
    char* ws = p.ws;
    __syncthreads();
    {
        const double dt = exp((double)p.logdt[g]);
        for (int i = tid; i < 17 * 64; i += 512) {
            const int t = i >> 6, pp = i & 63;
            const double lr = p.lamre[g * 64 + pp], li = p.lamim[g * 64 + pp];
            const double mag = exp(lr * dt * t), ang = li * dt * t;
            pwr[t * 64 + pp] = (float)(mag * cos(ang)); pwi[t * 64 + pp] = (float)(mag * sin(ang));
        }
        for (int i = tid; i < 1024; i += 512) {
            const int pp = i >> 4, c = i & 15;
            const double lr = p.lamre[g * 64 + pp], li = p.lamim[g * 64 + pp];
            const double mag = exp(lr * dt), ang = li * dt, lbr = mag * cos(ang), lbi = mag * sin(ang);
            const double nr = lbr - 1.0, den = lr * lr + li * li, fr = (nr * lr + lbi * li) / den, fi = (lbi * lr - nr * li) / den;
            const double br = p.bre[(g * 64 + pp) * 16 + c], bi = p.bim[(g * 64 + pp) * 16 + c];
            const float xr = (float)(fr * br - fi * bi), xi = (float)(fr * bi + fi * br);
            bbr[i] = xr; bbi[i] = xi;
            float* bbg = (float*)(ws + WS_BBG); bbg[(g * 1024 + i) * 2] = xr; bbg[(g * 1024 + i) * 2 + 1] = xi;
            if (c == 0) { float* lam1 = (float*)(ws + WS_LAM1); lam1[(g * 64 + pp) * 2] = (float)lbr; lam1[(g * 64 + pp) * 2 + 1] = (float)lbi; }
        }
    }
    __syncthreads();
    if (tid < 64) { float* lam16 = (float*)(ws + WS_LAM16); lam16[(g * 64 + tid) * 2] = pwr[16 * 64 + tid]; lam16[(g * 64 + tid) * 2 + 1] = pwi[16 * 64 + tid]; }
    for (int i = tid; i < 1024; i += 512) { cr[i] = p.cre[g * 1024 + i]; ci[i] = p.cim[g * 1024 + i]; }
    __syncthreads();
    for (int i = tid; i < 4096; i += 512) {
        const int tau = i >> 8, c = (i >> 4) & 15, cp = i & 15;
        float s = 0.f;
        for (int pp = 0; pp < 64; ++pp) {
            const float a = pwr[tau * 64 + pp], b = pwi[tau * 64 + pp], xr = bbr[pp * 16 + cp], xi = bbi[pp * 16 + cp];
            s += cr[c * 64 + pp] * (a * xr - b * xi) - ci[c * 64 + pp] * (a * xi + b * xr);
        }
        kg[i] = s;
    }
    __syncthreads();
    bf16_t* bt2 = (bf16_t*)(ws + WS_BT2) + (size_t)g * 256 * 384;
    for (int i = tid; i < 256 * 48; i += 512) {
        const int n = i / 48, k8 = (i % 48) * 8, t = n >> 4, c = n & 15;
        float v[8];
#pragma unroll
        for (int j = 0; j < 8; ++j) {
            const int k = k8 + j;
            if (k < 256) { const int s = k >> 4, cp = k & 15; v[j] = t >= s ? kg[(t - s) * 256 + c * 16 + cp] : 0.f; }
            else { const int q = k - 256, pp = q & 63; const float a = pwr[(t + 1) * 64 + pp], b = pwi[(t + 1) * 64 + pp];
                v[j] = q < 64 ? (cr[c * 64 + pp] * a - ci[c * 64 + pp] * b) : -(cr[c * 64 + pp] * b + ci[c * 64 + pp] * a); }
        }
        u32x4 o; o.x = pack2(v[0], v[1]); o.y = pack2(v[2], v[3]); o.z = pack2(v[4], v[5]); o.w = pack2(v[6], v[7]);
        *(u32x4*)(bt2 + (size_t)n * 384 + k8) = o;
    }
    bf16_t* bt1 = (bf16_t*)(ws + WS_BT1) + (size_t)g * 256 * 256;
    for (int i = tid; i < 256 * 32; i += 512) {
        const int n = i >> 5, k8 = (i & 31) * 8;
        float v[8];
#pragma unroll
        for (int j = 0; j < 8; ++j) {
            const int k = k8 + j, s = k >> 4, cp = k & 15;
            if (n >= 128) v[j] = 0.f;
            else { const int pp = n & 63; const float a = pwr[(15 - s) * 64 + pp], b = pwi[(15 - s) * 64 + pp], xr = bbr[pp * 16 + cp], xi = bbi[pp * 16 + cp];
                v[j] = n < 64 ? (a * xr - b * xi) : (a * xi + b * xr); }
        }
        u32x4 o; o.x = pack2(v[0], v[1]); o.y = pack2(v[2], v[3]); o.z = pack2(v[4], v[5]); o.w = pack2(v[6], v[7]);
        *(u32x4*)(bt1 + (size_t)n * 256 + k8) = o;
    }
}

DEVI void phase_prep(const int TIDX, const int BIDX, float* L, const Params& p) {
    const int tid = TIDX, bid = BIDX, G = gridDim.x, lane = tid & 63, wid = tid >> 6;
    char* ws = p.ws;
    for (int g = G - 1 - bid; g < 64; g += G) if (g >= 0) prep_s5_tables(TIDX, BIDX, L, p, g);
    __syncthreads();
    const int GT = G > 64 ? G - 64 : G;
    const int tb = (G > 64 && bid >= GT) ? (1 << 28) : bid;
    int jobbase = 0;
    prep_transpose(TIDX, BIDX, L, p.win0, 1024, 5120, (bf16_t*)(ws + WS_WIN0T), nullptr, true, tb, jobbase, GT);
    prep_transpose(TIDX, BIDX, L, p.gluw, 1024, 1024, (bf16_t*)(ws + WS_WGLUT), nullptr, false, tb, jobbase, GT);
    prep_transpose(TIDX, BIDX, L, p.wout0, 2048, 1024, (bf16_t*)(ws + WS_WOUT0T), nullptr, false, tb, jobbase, GT);
    prep_transpose(TIDX, BIDX, L, p.win1, 1024, 4096, (bf16_t*)(ws + WS_WIN1T), p.normw + 1024, false, tb, jobbase, GT);
    prep_transpose(TIDX, BIDX, L, p.wout1, 1024, 1024, (bf16_t*)(ws + WS_WOUT1T), nullptr, false, tb, jobbase, GT);
    bf16_t* h0 = (bf16_t*)(p.out + O_RETS); bf16_t* h0s = (bf16_t*)(ws + WS_H0S);
    for (int row = bid * 8 + wid; row < MP + 256; row += G * 8) {
        bf16_t* d = row < MP ? h0 + (size_t)row * 1024 : h0s + (size_t)(row - MP) * 1024;
        if (row >= MP + MS) { for (int i = 0; i < 4; ++i) *(u32x2*)(d + i * 256 + lane * 4) = (u32x2){0u, 0u}; continue; }
        const float* x = row < MP ? p.xp + (size_t)row * 1024 : p.xs + (size_t)(row - MP) * 1024;
        f32x4 v[4]; float s = 0.f;
#pragma unroll
        for (int i = 0; i < 4; ++i) { v[i] = *(const f32x4*)(x + i * 256 + lane * 4); s += v[i][0] * v[i][0] + v[i][1] * v[i][1] + v[i][2] * v[i][2] + v[i][3] * v[i][3]; }
        s = wave_sum(s);
        const float r = rsqrtf(s * (1.0f / 1024.0f) + 1e-6f);
#pragma unroll
        for (int i = 0; i < 4; ++i) { const f32x4 w = *(const f32x4*)(p.normw + i * 256 + lane * 4); *(u32x2*)(d + i * 256 + lane * 4) = pack4(v[i] * r * w); }
    }
    for (int i = bid * 512 + tid; i < 128 * 1024 / 8; i += G * 512) {
        const u32x4 z = {0u, 0u, 0u, 0u};
        *(u32x4*)((bf16_t*)(ws + WS_Y5S) + 128 * 1024 + (size_t)i * 8) = z;
        *(u32x4*)((bf16_t*)(ws + WS_X1SB) + 128 * 1024 + (size_t)i * 8) = z;
        *(u32x4*)((bf16_t*)(ws + WS_O1S) + 128 * 1024 + (size_t)i * 8) = z;
        *(u32x4*)((bf16_t*)(ws + WS_MIX0S) + 128 * 2048 + (size_t)i * 16) = z;
        *(u32x4*)((bf16_t*)(ws + WS_MIX0S) + 128 * 2048 + (size_t)i * 16 + 8) = z;
    }
    float* rope = (float*)(ws + WS_ROPE);
    for (int i = bid * 512 + tid; i < 2049 * 64; i += G * 512) {
        const int pr = i >> 6, j = i & 63; const double pos = pr == 2048 ? 16384.0 : (double)pr;
        const double inv = exp2(-(double)j * (13.287712379549449 / 64.0));
        const double rev = pos * inv * 0.15915494309189535; const double fr = rev - floor(rev); const double a = fr * 6.283185307179586;
        rope[pr * 128 + j] = (float)cos(a); rope[pr * 128 + 64 + j] = (float)sin(a);
    }
    float* lb = (float*)(ws + WS_LB);
    for (int i = bid * 512 + tid; i < 1024; i += G * 512) lb[i] = 1.f / (1.f + expf(p.hglb[i] - p.hglb[1024 + i]));
}

DEVI float ret_lg(int h) { return log1pf(-exp2f(-5.0f - (float)h)); }

DEVI void phase_R1(const int TIDX, const int BIDX, bf16_t* L, const Params& p) {
    const int tid = TIDX, wid = tid >> 6, lane = tid & 63, r16 = lane & 15, g = lane >> 4;
    const bf16_t* kt = (const bf16_t*)(p.ws + WS_KT); const bf16_t* vt = (const bf16_t*)(p.ws + WS_VT);
    float* kvt = p.out + O_YP;
    for (int it = BIDX; it < 512; it += gridDim.x) {
        const int bh = it >> 4, c = it & 15, h = bh & 3, t0 = c * 128; const float lg = ret_lg(h);
        __syncthreads();
        { const int d = tid >> 2, seg = tid & 3;
#pragma unroll
          for (int q = 0; q < 4; ++q) {
              const int l0 = seg * 32 + q * 8;
              const u32x4 v = *(const u32x4*)(kt + ((size_t)bh * 128 + d) * 2048 + t0 + l0);
              u32x4 o; const unsigned* vv = (const unsigned*)&v; unsigned* oo = (unsigned*)&o;
#pragma unroll
              for (int j = 0; j < 4; ++j) oo[j] = pack2(bflo(vv[j]) * __expf(lg * (float)(127 - l0 - 2 * j)), bfhi(vv[j]) * __expf(lg * (float)(126 - l0 - 2 * j)));
              *(u32x4*)(L + d * 136 + l0) = o; } }
        __syncthreads();
        bf16x8 bfr[2][4];
#pragma unroll
        for (int ct = 0; ct < 2; ++ct)
#pragma unroll
            for (int kk = 0; kk < 4; ++kk) bfr[ct][kk] = *(const bf16x8*)(vt + ((size_t)bh * 256 + wid * 32 + ct * 16 + r16) * 2048 + t0 + kk * 32 + g * 8);
#pragma unroll
        for (int rt = 0; rt < 8; ++rt) {
            f32x4 a0 = {0.f, 0.f, 0.f, 0.f}, a1 = a0;
#pragma unroll
            for (int kk = 0; kk < 4; ++kk) { const bf16x8 a = *(const bf16x8*)(L + (rt * 16 + r16) * 136 + kk * 32 + g * 8); a0 = mfma16(a, bfr[0][kk], a0); a1 = mfma16(a, bfr[1][kk], a1); }
            float* d0 = kvt + (((size_t)bh * 16 + c) * 256 + wid * 32 + r16) * 128 + rt * 16 + g * 4;
            *(f32x4*)d0 = a0; *(f32x4*)(d0 + 16 * 128) = a1;
        }
    }
}

DEVI void phase_R2(const int TIDX, const int BIDX, const Params& p) {
    float* kvt = p.out + O_YP;
    for (int i = BIDX * 512 + TIDX; i < 32 * 256 * 16; i += gridDim.x * 512) {
        const int q = i & 15, e = (i >> 4) & 255, bh = i >> 12, h = bh & 3; const float dec = __expf(ret_lg(h) * 128.f);
        f32x4 s0 = {0.f, 0.f, 0.f, 0.f}, s1 = s0;
#pragma unroll 4
        for (int c = 0; c < 16; ++c) {
            float* ptr = kvt + (((size_t)bh * 16 + c) * 256 + e) * 128 + q * 8;
            const f32x4 v0 = *(const f32x4*)ptr, v1 = *(const f32x4*)(ptr + 4);
            u32x4 o; o.x = pack2(s0[0], s0[1]); o.y = pack2(s0[2], s0[3]); o.z = pack2(s1[0], s1[1]); o.w = pack2(s1[2], s1[3]);
            *(u32x4*)ptr = o;
            s0 = s0 * dec + v0; s1 = s1 * dec + v1;
        }
        float* o = p.out + O_RETP + ((size_t)bh * 128 + q * 8) * 256 + e;
#pragma unroll
        for (int j = 0; j < 4; ++j) { o[(size_t)j * 256] = s0[j]; o[(size_t)(j + 4) * 256] = s1[j]; }
    }
}

DEVI void phase_R3(const int TIDX, const int BIDX, bf16_t* L, const Params& p) {
    const int tid = TIDX, wid = tid >> 6, lane = tid & 63, r16 = lane & 15, g = lane >> 4;
    const bf16_t* Q = (const bf16_t*)(p.ws + WS_Q); const bf16_t* KN = (const bf16_t*)(p.ws + WS_KN); const bf16_t* vt = (const bf16_t*)(p.ws + WS_VT);
    const bf16_t* sga = (const bf16_t*)(p.ws + WS_SGA); bf16_t* mix = (bf16_t*)(p.out + O_HGS);
    const float* kvt = p.out + O_YP;
    bf16_t* S = L;
    float* st = (float*)(L + 128 * 136);
    float* mr = st + 128 * 16;
    for (int it = BIDX; it < 512; it += gridDim.x) {
        const int bh = it >> 4, c = it & 15, h = bh & 3, b = bh >> 2, l0 = wid * 16; const size_t tok0 = (size_t)b * 2048 + c * 128; const float lg = ret_lg(h);
        bf16x8 qa[4];
#pragma unroll
        for (int kk = 0; kk < 4; ++kk) qa[kk] = *(const bf16x8*)(Q + (tok0 + l0 + r16) * 512 + h * 128 + kk * 32 + g * 8);
        __syncthreads();
        for (int j = 0; j < 8; ++j) {
            f32x4 sc = {0.f, 0.f, 0.f, 0.f};
            if (j <= wid) {
#pragma unroll
                for (int kk = 0; kk < 4; ++kk) sc = mfma16(qa[kk], *(const bf16x8*)(KN + (tok0 + j * 16 + r16) * 512 + h * 128 + kk * 32 + g * 8), sc);
            }
#pragma unroll
            for (int r = 0; r < 4; ++r) {
                const int li = l0 + g * 4 + r, mi = j * 16 + r16; const float v = (j <= wid && li >= mi) ? sc[r] * __expf(lg * (float)(li - mi)) : 0.f;
                S[li * 136 + mi] = f2bf(v);
            }
        }
        f32x4 acc[8][2];
#pragma unroll
        for (int rt = 0; rt < 8; ++rt) { acc[rt][0] = (f32x4){0.f, 0.f, 0.f, 0.f}; acc[rt][1] = (f32x4){0.f, 0.f, 0.f, 0.f}; }
        if (c > 0) {
            bf16x8 bs[2][4];
#pragma unroll
            for (int ct = 0; ct < 2; ++ct)
#pragma unroll
                for (int kk = 0; kk < 4; ++kk) bs[ct][kk] = *(const bf16x8*)(kvt + (((size_t)bh * 16 + c) * 256 + wid * 32 + ct * 16 + r16) * 128 + kk * 32 + g * 8);
#pragma unroll
            for (int rt = 0; rt < 8; ++rt) {
                f32x4 a0 = {0.f, 0.f, 0.f, 0.f}, a1 = a0;
#pragma unroll
                for (int kk = 0; kk < 4; ++kk) {
                    const bf16x8 q = *(const bf16x8*)(Q + (tok0 + rt * 16 + r16) * 512 + h * 128 + kk * 32 + g * 8);
                    a0 = mfma16(q, bs[0][kk], a0); a1 = mfma16(q, bs[1][kk], a1);
                }
#pragma unroll
                for (int r = 0; r < 4; ++r) { const float qd = __expf(lg * (float)(rt * 16 + g * 4 + r + 1)); a0[r] *= qd; a1[r] *= qd; }
                acc[rt][0] = a0; acc[rt][1] = a1;
                __builtin_amdgcn_sched_barrier(0);
            }
        }
        bf16x8 bv[2][4];
#pragma unroll
        for (int ct = 0; ct < 2; ++ct)
#pragma unroll
            for (int kk = 0; kk < 4; ++kk) bv[ct][kk] = *(const bf16x8*)(vt + ((size_t)bh * 256 + wid * 32 + ct * 16 + r16) * 2048 + c * 128 + kk * 32 + g * 8);
        __syncthreads();
#pragma unroll
        for (int rt = 0; rt < 8; ++rt) {
            f32x4 a0 = acc[rt][0], a1 = acc[rt][1];
#pragma unroll
            for (int kk = 0; kk < 4; ++kk) {
                if (kk <= (rt >> 1)) {
                    const bf16x8 a = *(const bf16x8*)(S + (rt * 16 + r16) * 136 + kk * 32 + g * 8);
                    a0 = mfma16(a, bv[0][kk], a0); a1 = mfma16(a, bv[1][kk], a1);
                }
            }
            acc[rt][0] = a0; acc[rt][1] = a1;
#pragma unroll
            for (int r = 0; r < 4; ++r) {
                float s1 = a0[r] + a1[r], s2 = a0[r] * a0[r] + a1[r] * a1[r];
                s1 = grp16_sum(s1); s2 = grp16_sum(s2);
                if (r16 == 0) { st[((rt * 16 + g * 4 + r) * 8 + wid) * 2] = s1; st[((rt * 16 + g * 4 + r) * 8 + wid) * 2 + 1] = s2; }
            }
            __builtin_amdgcn_sched_barrier(0);
        }
        __syncthreads();
        if (tid < 128) {
            float s1 = 0.f, s2 = 0.f;
#pragma unroll
            for (int w = 0; w < 8; ++w) { s1 += st[(tid * 8 + w) * 2]; s2 += st[(tid * 8 + w) * 2 + 1]; }
            const float mu = s1 * (1.f / 256.f), var = fmaxf(s2 * (1.f / 256.f) - mu * mu, 0.f);
            mr[tid * 2] = mu; mr[tid * 2 + 1] = rsqrtf(var + 1e-5f);
        }
        __syncthreads();
        const float gw0 = p.gnw[h * 256 + wid * 32 + r16], gw1 = p.gnw[h * 256 + wid * 32 + 16 + r16];
#pragma unroll
        for (int rt = 0; rt < 8; ++rt)
#pragma unroll
            for (int r = 0; r < 4; ++r) {
                const int row = rt * 16 + g * 4 + r; const size_t token = tok0 + row; const float mu = mr[row * 2], rs = mr[row * 2 + 1];
                const size_t o = token * 1024 + h * 256 + wid * 32 + r16;
                const float v0 = (acc[rt][0][r] - mu) * rs * gw0 * bf2f(sga[o]), v1 = (acc[rt][1][r] - mu) * rs * gw1 * bf2f(sga[o + 16]);
                mix[token * 2048 + h * 256 + wid * 32 + r16] = f2bf(v0); mix[token * 2048 + h * 256 + wid * 32 + 16 + r16] = f2bf(v1);
            }
    }
}

DEVI void phase_s5scan(const int TIDX, const int BIDX, const Params& p) {
    const int wid = TIDX >> 6, lane = TIDX & 63;
    const float* e5 = p.out + O_HGS; bf16_t* a2 = (bf16_t*)(p.ws + WS_A2); const float* lam16 = (const float*)(p.ws + WS_LAM16);
    for (int it = BIDX * 8 + wid; it < 512; it += gridDim.x * 8) {
        const int b = it >> 6, g = it & 63;
        const float ar = lam16[(g * 64 + lane) * 2], ai = lam16[(g * 64 + lane) * 2 + 1];
        float hr = 0.f, hi = 0.f;
        for (int jb = 0; jb < 128; jb += 16) {
            float er[16], ei[16];
#pragma unroll
            for (int j = 0; j < 16; ++j) { const float* ep = e5 + ((size_t)g * 1024 + b * 128 + jb + j) * 128; er[j] = ep[lane]; ei[j] = ep[64 + lane]; }
#pragma unroll
            for (int j = 0; j < 16; ++j) {
                bf16_t* hp = a2 + ((size_t)g * 1024 + b * 128 + jb + j) * 384 + 256;
                hp[lane] = f2bf(hr); hp[64 + lane] = f2bf(hi);
                const float nr = ar * hr - ai * hi + er[j], ni = ar * hi + ai * hr + ei[j];
                hr = nr; hi = ni;
            }
        }
        p.out[O_S5RP + (size_t)(b * 64 + g) * 64 + lane] = hr; p.out[O_S5IP + (size_t)(b * 64 + g) * 64 + lane] = hi;
    }
}

DEVI void phase_H1(const int TIDX, const int BIDX, bf16_t* L, const Params& p) {
    const int tid = TIDX, wid = tid >> 6, lane = tid & 63, r16 = lane & 15, g = lane >> 4;
    float* cum = (float*)(p.ws + WS_CUM); const bf16_t* itp = (const bf16_t*)(p.ws + WS_IT); float* hkv = (float*)(p.ws + WS_HKV);
    float* tot = (float*)(L + 128 * 136);
    for (int it = BIDX; it < 1024; it += gridDim.x) {
        const int bh = it >> 4, c = it & 15, h = bh & 7, b = bh >> 3; const size_t tok0 = (size_t)b * 2048 + c * 128;
        const int d = tid & 127, part = tid >> 7;
        float* col = cum + (tok0 + part * 32) * 1024 + h * 128 + d;
        float lf[32]; float s = 0.f;
#pragma unroll
        for (int l = 0; l < 32; ++l) { lf[l] = col[(size_t)l * 1024]; s += lf[l]; }
        __syncthreads();
        tot[part * 128 + d] = s;
        __syncthreads();
        float off = 0.f, last = 0.f;
#pragma unroll
        for (int pp = 0; pp < 4; ++pp) { const float t = tot[pp * 128 + d]; if (pp < part) off += t; last += t; }
        float cc = off;
#pragma unroll
        for (int l = 0; l < 32; ++l) {
            cc += lf[l]; col[(size_t)l * 1024] = cc;
            L[d * 136 + part * 32 + l] = f2bf((1.f - __expf(lf[l])) * __expf(last - cc));
        }
        __syncthreads();
        bf16x8 bfr[4];
#pragma unroll
        for (int kk = 0; kk < 4; ++kk) bfr[kk] = *(const bf16x8*)(itp + ((size_t)bh * 128 + wid * 16 + r16) * 2048 + c * 128 + kk * 32 + g * 8);
#pragma unroll
        for (int rt = 0; rt < 8; ++rt) {
            f32x4 a0 = {0.f, 0.f, 0.f, 0.f};
#pragma unroll
            for (int kk = 0; kk < 4; ++kk) a0 = mfma16(*(const bf16x8*)(L + (rt * 16 + r16) * 136 + kk * 32 + g * 8), bfr[kk], a0);
            *(f32x4*)(hkv + (((size_t)bh * 16 + c) * 128 + wid * 16 + r16) * 128 + rt * 16 + g * 4) = a0;
        }
    }
}

DEVI void phase_H2(const int TIDX, const int BIDX, const Params& p) {
    float* hkv = (float*)(p.ws + WS_HKV); const float* cum = (const float*)(p.ws + WS_CUM);
    for (int i = BIDX * 512 + TIDX; i < 64 * 128 * 16; i += gridDim.x * 512) {
        const int q = i & 15, e = (i >> 4) & 127, bh = i >> 11, h = bh & 7, b = bh >> 3;
        f32x4 s0 = {0.f, 0.f, 0.f, 0.f}, s1 = s0;
#pragma unroll 4
        for (int c = 0; c < 16; ++c) {
            float* ptr = hkv + (((size_t)bh * 16 + c) * 128 + e) * 128 + q * 8;
            const float* lp = cum + ((size_t)b * 2048 + c * 128 + 127) * 1024 + h * 128 + q * 8;
            const f32x4 v0 = *(const f32x4*)ptr, v1 = *(const f32x4*)(ptr + 4), d0 = *(const f32x4*)lp, d1 = *(const f32x4*)(lp + 4);
            u32x4 o; o.x = pack2(s0[0], s0[1]); o.y = pack2(s0[2], s0[3]); o.z = pack2(s1[0], s1[1]); o.w = pack2(s1[2], s1[3]);
            *(u32x4*)ptr = o;
#pragma unroll
            for (int j = 0; j < 4; ++j) { s0[j] = s0[j] * __expf(d0[j]) + v0[j]; s1[j] = s1[j] * __expf(d1[j]) + v1[j]; }
        }
        float* o = p.out + O_HGP + ((size_t)bh * 128 + q * 8) * 128 + e;
#pragma unroll
        for (int j = 0; j < 4; ++j) { o[(size_t)j * 128] = s0[j]; o[(size_t)(j + 4) * 128] = s1[j]; }
    }
}

DEVI void phase_H3(const int TIDX, const int BIDX, bf16_t* L, const Params& p) {
    const int tid = TIDX, wid = tid >> 6, lane = tid & 63, r16 = lane & 15, g = lane >> 4;
    const float* cum = (const float*)(p.ws + WS_CUM); const bf16_t* itp = (const bf16_t*)(p.ws + WS_IT); const float* hkv = (const float*)(p.ws + WS_HKV);
    bf16_t* q1 = (bf16_t*)(p.ws + WS_Q1); const bf16_t* sg1 = (const bf16_t*)(p.ws + WS_SG1);
    bf16_t* kt = L; bf16_t* S = L + 128 * 136; bf16_t* QA = L + 2 * 128 * 136;
    float* st = (float*)(L + 3 * 128 * 136);
    float* rsn = st + 128 * 8;
    for (int it = BIDX; it < 1024; it += gridDim.x) {
        const int bh = it >> 4, c = it & 15, h = bh & 7, b = bh >> 3, l0 = wid * 16; const size_t tok0 = (size_t)b * 2048 + c * 128;
        const float* refp = cum + (tok0 + 63) * 1024 + h * 128;
        __syncthreads();
        { const int m = tid >> 2, seg = tid & 3; const float* cp = cum + (tok0 + m) * 1024 + h * 128 + seg * 32;
#pragma unroll
          for (int q = 0; q < 8; ++q) {
              const f32x4 cv = *(const f32x4*)(cp + q * 4), rv = *(const f32x4*)(refp + seg * 32 + q * 4);
              f32x4 pv = {0.f, 0.f, 0.f, 0.f}; if (m > 0) pv = *(const f32x4*)(cp - 1024 + q * 4);
              f32x4 o;
#pragma unroll
              for (int j = 0; j < 4; ++j) o[j] = (1.f - __expf(cv[j] - pv[j])) * __expf(rv[j] - cv[j]);
              *(u32x2*)(kt + m * 136 + seg * 32 + q * 4) = pack4(o); } }
        bf16x8 qr[4];
#pragma unroll
        for (int kk = 0; kk < 4; ++kk) {
            const size_t o = (tok0 + l0 + r16) * 1024 + h * 128 + kk * 32 + g * 8;
            const u32x4 qq = *(const u32x4*)(q1 + o);
            const f32x4 c0 = *(const f32x4*)(cum + o), c1 = *(const f32x4*)(cum + o + 4), r0 = *(const f32x4*)(refp + kk * 32 + g * 8), r1 = *(const f32x4*)(refp + kk * 32 + g * 8 + 4);
            const unsigned* qv = (const unsigned*)&qq; u32x4 a, bb; unsigned* av = (unsigned*)&a; unsigned* bv = (unsigned*)&bb;
#pragma unroll
            for (int j = 0; j < 4; ++j) {
                const float cl = j < 2 ? c0[2 * j] : c1[2 * j - 4], ch = j < 2 ? c0[2 * j + 1] : c1[2 * j - 3];
                const float rl = j < 2 ? r0[2 * j] : r1[2 * j - 4], rh = j < 2 ? r0[2 * j + 1] : r1[2 * j - 3];
                const float ql = bflo(qv[j]), qh = bfhi(qv[j]);
                av[j] = pack2(ql * __expf(cl - rl), qh * __expf(ch - rh)); bv[j] = pack2(ql * __expf(cl), qh * __expf(ch));
            }
            qr[kk] = *(bf16x8*)&a;
            *(u32x4*)(QA + (l0 + r16) * 136 + kk * 32 + g * 8) = bb;
        }
        bf16x8 bi[4], bs[4];
#pragma unroll
        for (int kk = 0; kk < 4; ++kk) {
            bi[kk] = *(const bf16x8*)(itp + ((size_t)bh * 128 + wid * 16 + r16) * 2048 + c * 128 + kk * 32 + g * 8);
            bs[kk] = *(const bf16x8*)(hkv + (((size_t)bh * 16 + c) * 128 + wid * 16 + r16) * 128 + kk * 32 + g * 8);
        }
        __syncthreads();
        for (int j = 0; j < 8; ++j) {
            f32x4 sc = {0.f, 0.f, 0.f, 0.f};
            if (j <= wid) {
#pragma unroll
                for (int kk = 0; kk < 4; ++kk) sc = mfma16(qr[kk], *(const bf16x8*)(kt + (j * 16 + r16) * 136 + kk * 32 + g * 8), sc);
            }
#pragma unroll
            for (int r = 0; r < 4; ++r) {
                const int li = l0 + g * 4 + r, mi = j * 16 + r16; const float v = (j <= wid && li >= mi) ? sc[r] : 0.f;
                S[li * 136 + mi] = f2bf(v);
            }
        }
        __syncthreads();
        f32x4 acc[8];
#pragma unroll
        for (int rt = 0; rt < 8; ++rt) {
            f32x4 a0 = {0.f, 0.f, 0.f, 0.f};
            if (c > 0) {
#pragma unroll
                for (int kk = 0; kk < 4; ++kk) a0 = mfma16(*(const bf16x8*)(QA + (rt * 16 + r16) * 136 + kk * 32 + g * 8), bs[kk], a0);
            }
#pragma unroll
            for (int kk = 0; kk < 4; ++kk) {
                if (kk <= (rt >> 1)) a0 = mfma16(*(const bf16x8*)(S + (rt * 16 + r16) * 136 + kk * 32 + g * 8), bi[kk], a0);
            }
            acc[rt] = a0;
#pragma unroll
            for (int r = 0; r < 4; ++r) {
                const float s2 = grp16_sum(a0[r] * a0[r]);
                if (r16 == 0) st[(rt * 16 + g * 4 + r) * 8 + wid] = s2;
            }
        }
        __syncthreads();
        if (tid < 128) {
            float s2 = 0.f;
#pragma unroll
            for (int w = 0; w < 8; ++w) s2 += st[tid * 8 + w];
            rsn[tid] = rsqrtf(s2 * (1.f / 128.f) + 1e-6f);
        }
        __syncthreads();
        const float gw = p.hgnw[h * 128 + wid * 16 + r16];
#pragma unroll
        for (int rt = 0; rt < 8; ++rt)
#pragma unroll
            for (int r = 0; r < 4; ++r) {
                const int row = rt * 16 + g * 4 + r; const unsigned o = ((unsigned)tok0 + row) * 1024u + h * 128 + wid * 16 + r16;
                q1[o] = f2bf(acc[rt][r] * rsn[row] * gw * bf2f(sg1[o]));
            }
    }
}

DEVI void phase_ss5(const int TIDX, const int BIDX, const Params& p) {
    const int wid = TIDX >> 6, lane = TIDX & 63;
    const float* zs = (const float*)(p.ws + WS_ZS); const float* bbg = (const float*)(p.ws + WS_BBG); const float* lam1 = (const float*)(p.ws + WS_LAM1);
    bf16_t* y5s = (bf16_t*)(p.ws + WS_Y5S);
    for (int it = BIDX * 8 + wid; it < 128 * 64; it += gridDim.x * 8) {
        const int b = it >> 6, g = it & 63;
        float u[16];
#pragma unroll
        for (int c = 0; c < 16; ++c) u[c] = zs[(size_t)b * 5120 + 3072 + g * 16 + c];
        float xr = 0.f, xi = 0.f;
#pragma unroll
        for (int c = 0; c < 16; ++c) { xr += bbg[((g * 64 + lane) * 16 + c) * 2] * u[c]; xi += bbg[((g * 64 + lane) * 16 + c) * 2 + 1] * u[c]; }
        const float ar = lam1[(g * 64 + lane) * 2], ai = lam1[(g * 64 + lane) * 2 + 1];
        const float sr = p.s5r[(size_t)(b * 64 + g) * 64 + lane], si = p.s5i[(size_t)(b * 64 + g) * 64 + lane];
        const float hr = ar * sr - ai * si + xr, hi = ar * si + ai * sr + xi;
        p.out[O_S5RS + (size_t)(b * 64 + g) * 64 + lane] = hr; p.out[O_S5IS + (size_t)(b * 64 + g) * 64 + lane] = hi;
        float mine = 0.f;
#pragma unroll
        for (int c = 0; c < 16; ++c) {
            float v = p.cre[(g * 16 + c) * 64 + lane] * hr - p.cim[(g * 16 + c) * 64 + lane] * hi;
            v = wave_sum(v);
            if (lane == c) mine = v + p.s5d[g * 16 + c] * u[c];
        }
        if (lane < 16) y5s[(size_t)b * 1024 + g * 16 + lane] = f2bf(gelu_(mine));
    }
}

DEVI void phase_sret(const int TIDX, const int BIDX, float* L, const Params& p) {
    const int tid = TIDX, lane = tid & 63, wid = tid >> 6;
    const float* zs = (const float*)(p.ws + WS_ZS); bf16_t* mix = (bf16_t*)(p.ws + WS_MIX0S);
    float* qs = L; float* ks = L + 128; float* red = L + 256; float* st = L + 768;
    for (int it = BIDX; it < 512; it += gridDim.x) {
        const int b = it >> 2, h = it & 3, e = tid & 255, half = tid >> 8; const float gam = 1.0f - exp2f(-5.0f - (float)h);
        __syncthreads();
        if (tid < 128) qs[tid] = zs[(size_t)b * 5120 + h * 128 + tid]; else if (tid < 256) ks[tid - 128] = zs[(size_t)b * 5120 + 512 + h * 128 + tid - 128];
        const float v = zs[(size_t)b * 5120 + 1024 + h * 256 + e];
        __syncthreads();
        const float* s0 = p.sret + ((size_t)it * 128 + half * 64) * 256 + e; float* so = p.out + O_RETS + ((size_t)it * 128 + half * 64) * 256 + e;
        float o = 0.f;
#pragma unroll 8
        for (int d = 0; d < 64; ++d) { const float s = gam * s0[(size_t)d * 256] + ks[half * 64 + d] * v; so[(size_t)d * 256] = s; o += qs[half * 64 + d] * s; }
        red[tid] = o;
        __syncthreads();
        float tot = 0.f;
        if (tid < 256) { tot = red[tid] + red[tid + 256]; const float s = wave_sum(tot); if (lane == 0) st[wid] = s; }
        __syncthreads();
        const float mu = (st[0] + st[1] + st[2] + st[3]) * (1.f / 256.f);
        __syncthreads();
        if (tid < 256) { const float dd = tot - mu; const float s = wave_sum(dd * dd); if (lane == 0) st[wid] = s; }
        __syncthreads();
        const float rs = rsqrtf((st[0] + st[1] + st[2] + st[3]) * (1.f / 256.f) + 1e-5f);
        if (tid < 256) mix[(size_t)b * 2048 + h * 256 + e] = f2bf((tot - mu) * rs * p.gnw[h * 256 + e] * zs[(size_t)b * 5120 + 2048 + h * 256 + e]);
    }
}

DEVI void phase_shg(const int TIDX, const int BIDX, float* L, const Params& p) {
    const int tid = TIDX, lane = tid & 63, wid = tid >> 6;
    const float* z1 = (const float*)(p.ws + WS_Z1S); bf16_t* o1s = (bf16_t*)(p.ws + WS_O1S);
    float* qs = L; float* fs = L + 128; float* red = L + 256; float* st = L + 768;
    for (int it = BIDX; it < 1024; it += gridDim.x) {
        const int b = it >> 3, h = it & 7, e = tid & 127, qt = tid >> 7;
        __syncthreads();
        if (tid < 128) qs[tid] = z1[(size_t)b * 4096 + h * 128 + tid]; else if (tid < 256) fs[tid - 128] = z1[(size_t)b * 4096 + 1024 + h * 128 + tid - 128];
        const float iv = z1[(size_t)b * 4096 + 2048 + h * 128 + e];
        __syncthreads();
        const float* s0 = p.shg + ((size_t)it * 128 + qt * 32) * 128 + e; float* so = p.out + O_HGS + ((size_t)it * 128 + qt * 32) * 128 + e;
        float o = 0.f;
#pragma unroll 8
        for (int d = 0; d < 32; ++d) { const float f = fs[qt * 32 + d]; const float s = f * s0[(size_t)d * 128] + (1.f - f) * iv; so[(size_t)d * 128] = s; o += qs[qt * 32 + d] * s; }
        red[tid] = o;
        __syncthreads();
        float tot = 0.f;
        if (tid < 128) { tot = red[tid] + red[tid + 128] + red[tid + 256] + red[tid + 384]; const float s = wave_sum(tot * tot); if (lane == 0) st[wid] = s; }
        __syncthreads();
        const float rs = rsqrtf((st[0] + st[1]) * (1.f / 128.f) + 1e-6f);
        if (tid < 128) o1s[(size_t)b * 1024 + h * 128 + e] = f2bf(tot * rs * p.hgnw[h * 128 + e] * z1[(size_t)b * 4096 + 3072 + h * 128 + e]);
    }
}

DEVI void phase_final(const int TIDX, const int BIDX, const Params& p) {
    const int wid = TIDX >> 6, lane = TIDX & 63;
    for (int row = BIDX * 8 + wid; row < MP + MS; row += gridDim.x * 8) {
        const bool smp = row >= MP; const size_t r = smp ? row - MP : row;
        float* x = p.out + (smp ? O_YS : O_YP) + r * 1024;
        f32x4 v[4]; float s = 0.f;
#pragma unroll
        for (int i = 0; i < 4; ++i) { v[i] = *(const f32x4*)(x + i * 256 + lane * 4); s += v[i][0] * v[i][0] + v[i][1] * v[i][1] + v[i][2] * v[i][2] + v[i][3] * v[i][3]; }
        s = wave_sum(s);
        const float rs = rsqrtf(s * (1.0f / 1024.0f) + 1e-6f);
#pragma unroll
        for (int i = 0; i < 4; ++i) { const f32x4 w = *(const f32x4*)(p.fnormw + i * 256 + lane * 4); *(f32x4*)(x + i * 256 + lane * 4) = v[i] * rs * w; }
    }
}

#define GRID_SYNC() do { asm volatile("s_waitcnt vmcnt(0) lgkmcnt(0)" ::: "memory"); cg::this_grid().sync(); } while (0)
constexpr int NPHASE = 13;
__global__ void __launch_bounds__(512, 2) mega(Params p0) {
    extern __shared__ __attribute__((aligned(16))) unsigned char shm[];
    LAS unsigned char* lds = (LAS unsigned char*)shm;
    const int G = gridDim.x;
#define OPQ int oz; asm volatile("s_mov_b32 %0, 0" : "=s"(oz)); int ozv; asm volatile("v_mov_b32 %0, 0" : "=v"(ozv)); \
    Params p = p0; p.ws = p0.ws + oz; p.out = p0.out + oz; const int TIDX = threadIdx.x + ozv, BIDX = blockIdx.x + oz; (void)TIDX; (void)BIDX;
    int my_xcc, my_rank;
    {
        int* sh = (int*)shm;
        if (threadIdx.x == 0) {
            const unsigned x = (unsigned)__builtin_amdgcn_s_getreg((3 << 11) | 20) & 7u;
            sh[0] = (int)x; sh[1] = (int)__hip_atomic_fetch_add((unsigned*)(p0.ws + WS_XCNT) + x * 32, 1u, __ATOMIC_RELAXED, __HIP_MEMORY_SCOPE_AGENT);
        }
        __syncthreads();
        my_xcc = __builtin_amdgcn_readfirstlane(sh[0]); my_rank = __builtin_amdgcn_readfirstlane(sh[1]);
        __syncthreads();
    }
    int gc = blockIdx.x;
    int ph_start = p0.ph_lo;
    if (ph_start == 0) {
        { OPQ phase_prep(TIDX, BIDX, (float*)shm, p); }
#if COOP
        GRID_SYNC();
        {
            bool ok = gridDim.x == 256;
            for (int x = 0; x < 8; ++x) ok = ok && (__hip_atomic_load((unsigned*)(p0.ws + WS_XCNT) + x * 32, __ATOMIC_RELAXED, __HIP_MEMORY_SCOPE_AGENT) == 32u);
            if (ok) gc = my_rank * 8 + my_xcc;
        }
#endif
        ph_start = 1;
    }
    for (int ph = ph_start; ph < p0.ph_hi; ++ph) {
        int la = -1, lb = -1, K = 1024, lda = 1024, ldb = 1024;
        switch (ph) {
        case 1: la = L_IN0; lb = L_IN0S; break;
        case 2: la = L_GA; K = 256; lda = 384; ldb = 256; break;
        case 4: la = L_GB; K = 384; lda = 384; ldb = 384; break;
        case 5: la = L_GLU; lb = L_GLUS; break;
        case 6: la = L_OUT0; lb = L_OUT0S; K = 2048; lda = 2048; ldb = 2048; break;
        case 7: la = L_IN1; lb = L_IN1S; break;
        case 11: la = L_OUT1; lb = L_OUT1S; break;
        default: break;
        }
        for (int jj = 0; jj < 2; ++jj) {
            const int l = jj ? lb : la;
            if (l < 0) continue;
            OPQ
            Sched S; S.list = l; S.G = G; S.c = jj ? G - 1 - gc : gc + oz; S.wsp = p.ws; S.outp = p.out;
            gemm_phase(TIDX, lds, K, lda, ldb, l == L_GLU, S, p);
        }
        __syncthreads();
        switch (ph) {
        case 2: { { OPQ phase_R1(TIDX, BIDX, (bf16_t*)shm, p); } __syncthreads(); { OPQ phase_sret(TIDX, BIDX, (float*)shm, p); } { OPQ phase_ss5(TIDX, BIDX, p); } } break;
        case 3: { { OPQ phase_s5scan(TIDX, BIDX, p); } { OPQ phase_R2(TIDX, BIDX, p); } } break;
        case 4: { OPQ phase_R3(TIDX, BIDX, (bf16_t*)shm, p); } break;
        case 8: { { OPQ phase_H1(TIDX, BIDX, (bf16_t*)shm, p); } __syncthreads(); { OPQ phase_shg(TIDX, BIDX, (float*)shm, p); } } break;
        case 9: { OPQ phase_H2(TIDX, BIDX, p); } break;
        case 10: { OPQ phase_H3(TIDX, BIDX, (bf16_t*)shm, p); } break;
        case 12: { OPQ phase_final(TIDX, BIDX, p); } break;
        default: break;
        }
#if COOP
        if (ph + 1 < p0.ph_hi) GRID_SYNC();
#endif
    }
}

extern "C" void kernel_launch(void* const* d_in, const int* in_sizes, int n_in, void* d_out, int out_size, void* d_ws, size_t ws_size, hipStream_t stream) {
    constexpr size_t kDynLds = 131072;
    static int grid_blocks = 0;
    if (!grid_blocks) {
        hipFuncSetAttribute((const void*)mega, hipFuncAttributeMaxDynamicSharedMemorySize, (int)kDynLds);
        int dev = 0, cus = 0, per_cu = 0;
        hipGetDevice(&dev);
        hipDeviceGetAttribute(&cus, hipDeviceAttributeMultiprocessorCount, dev);
        hipOccupancyMaxActiveBlocksPerMultiprocessor(&per_cu, mega, 512, kDynLds);
        if (per_cu < 1) per_cu = 1;
        grid_blocks = cus;
        if (grid_blocks > 256) grid_blocks = 256;
    }
    Params p{};
    const float** f = (const float**)&p;
    for (int i = 0; i < 25; ++i) f[i] = (const float*)d_in[i];
    p.out = (float*)d_out; p.ws = (char*)d_ws;
#if COOP
    p.ph_lo = 0; p.ph_hi = PH_MAX;
    hipMemsetAsync((char*)d_ws + WS_XCNT, 0, 1024, stream);
    void* args[] = {&p};
    hipError_t e = hipLaunchCooperativeKernel((const void*)mega, dim3(grid_blocks), dim3(512), args, kDynLds, stream);
    if (e != hipSuccess) fprintf(stderr, "cooperative launch failed: %s (grid %d)\n", hipGetErrorString(e), grid_blocks);
#else
    for (int ph = 0; ph < NPHASE; ++ph) {
        p.ph_lo = ph; p.ph_hi = ph + 1;
        hipLaunchKernelGGL(mega, dim3(grid_blocks), dim3(512), kDynLds, stream, p);
    }
#endif
}
```

```cpp
#include <hip/hip_runtime.h>
#include <hip/hip_cooperative_groups.h>
#include <cstdio>
namespace cg = cooperative_groups;

#ifndef PH_MAX
#define PH_MAX 13
#endif
#ifndef COOP
#define COOP 1
#endif

typedef unsigned short bf16_t;
typedef short bf16x8 __attribute__((ext_vector_type(8)));
typedef float f32x4 __attribute__((ext_vector_type(4)));
typedef unsigned u32x4 __attribute__((ext_vector_type(4)));
typedef unsigned u32x2 __attribute__((ext_vector_type(2)));
#define LAS __attribute__((address_space(3)))
#define DEVI __device__ __forceinline__

constexpr int TT = 2048, NBP = 8, MP = 16384, MS = 128, DM = 1024;
constexpr size_t MiB = (size_t)1 << 20;
constexpr size_t O_YP = 0, O_YS = 16777216, O_RETP = 16908288, O_RETS = 17956864, O_S5RP = 34734080, O_S5IP = 34766848,
                 O_S5RS = 34799616, O_S5IS = 35323904, O_HGP = 35848192, O_HGS = 36896768;
constexpr size_t WS_WIN0T = 0, WS_BT1 = 10 * MiB, WS_KT = 18 * MiB, WS_WGLUT = 34 * MiB, WS_WOUT0T = 36 * MiB, WS_WIN1T = 40 * MiB,
                 WS_BT2 = 48 * MiB, WS_Q = 60 * MiB, WS_KN = 76 * MiB, WS_VT = 92 * MiB, WS_SGA = 124 * MiB, WS_SGB = 156 * MiB,
                 WS_A2 = 188 * MiB, WS_Y5 = 0, WS_X1B = 60 * MiB, WS_SG1 = 0, WS_Q1 = 96 * MiB, WS_CUM = 128 * MiB, WS_IT = 192 * MiB,
                 WS_HKV = 32 * MiB;
constexpr size_t WS_MISC = 240 * MiB;
constexpr size_t WS_WOUT1T = WS_MISC;
constexpr size_t WS_ROPE = WS_MISC + 2 * MiB;
constexpr size_t WS_SSQ1 = WS_ROPE + 1280 * 1024;
constexpr size_t WS_SSQ2 = WS_SSQ1 + MiB;
constexpr size_t WS_H0S = WS_SSQ2 + MiB;
constexpr size_t WS_ZS = WS_H0S + 512 * 1024;
constexpr size_t WS_Y5S = WS_ZS + 2560 * 1024;
constexpr size_t WS_MIX0S = WS_Y5S + 512 * 1024;
constexpr size_t WS_X1S = WS_MIX0S + MiB;
constexpr size_t WS_X1SB = WS_X1S + 512 * 1024;
constexpr size_t WS_Z1S = WS_X1SB + 512 * 1024;
constexpr size_t WS_O1S = WS_Z1S + 2 * MiB;
constexpr size_t WS_BBG = WS_O1S + 512 * 1024;
constexpr size_t WS_LAM1 = WS_BBG + 512 * 1024;
constexpr size_t WS_LAM16 = WS_LAM1 + 32 * 1024;
constexpr size_t WS_LB = WS_LAM16 + 32 * 1024;
constexpr size_t WS_SSQ1S = WS_LB + 4096;
constexpr size_t WS_SSQ2S = WS_SSQ1S + MiB;
constexpr size_t WS_END = WS_SSQ2S + MiB;
constexpr size_t WS_XCNT = WS_END;
static_assert(WS_XCNT + 1024 <= 256 * MiB, "workspace overflow");

struct Params {
    const float *xp, *xs, *sret, *s5r, *s5i, *shg, *normw, *fnormw, *win0, *gnw, *lamre, *lamim, *logdt, *bre, *bim, *cre, *cim, *s5d,
        *gluw, *glub, *wout0, *win1, *hglb, *hgnw, *wout1;
    float* out;
    char* ws;
    int ph_lo, ph_hi;
};

DEVI bf16_t f2bf(float f) { unsigned u = __float_as_uint(f); u += 0x7FFFu + ((u >> 16) & 1u); return (bf16_t)(u >> 16); }
DEVI float bf2f(bf16_t b) { return __uint_as_float(((unsigned)b) << 16); }
DEVI unsigned pack2(float lo, float hi) { unsigned r; asm("v_cvt_pk_bf16_f32 %0, %1, %2" : "=v"(r) : "v"(lo), "v"(hi)); return r; }
DEVI float bflo(unsigned w) { return __uint_as_float(w << 16); }
DEVI float bfhi(unsigned w) { return __uint_as_float(w & 0xffff0000u); }
DEVI float sigm(float x) { return __builtin_amdgcn_rcpf(1.f + __builtin_amdgcn_exp2f(-1.4426950408889634f * x)); }
DEVI float silu_(float x) { return x * sigm(x); }
DEVI float gelu_(float x) { const float u = 1.5957691216f * (x + 0.044715f * x * x * x); return x * __builtin_amdgcn_rcpf(1.f + __builtin_amdgcn_exp2f(-1.4426950408889634f * u)); }
DEVI u32x2 pack4(f32x4 v) { u32x2 r; r.x = pack2(v[0], v[1]); r.y = pack2(v[2], v[3]); return r; }
DEVI float wave_sum(float v) {
#pragma unroll
    for (int o = 32; o > 0; o >>= 1) v += __shfl_xor(v, o);
    return v;
}
DEVI float grp16_sum(float v) { v += __shfl_xor(v, 1); v += __shfl_xor(v, 2); v += __shfl_xor(v, 4); v += __shfl_xor(v, 8); return v; }
DEVI f32x4 mfma16(bf16x8 a, bf16x8 b, f32x4 c) { return __builtin_amdgcn_mfma_f32_16x16x32_bf16(a, b, c, 0, 0, 0); }
DEVI float row_rstd16(const float* ssq, size_t row) {
    const f32x4 a = *(const f32x4*)(ssq + row * 4), b = *(const f32x4*)(ssq + (MP + row) * 4), c = *(const f32x4*)(ssq + (2 * (size_t)MP + row) * 4), d = *(const f32x4*)(ssq + (3 * (size_t)MP + row) * 4);
    float s = (a[0] + a[1] + a[2] + a[3]) + (b[0] + b[1] + b[2] + b[3]) + (c[0] + c[1] + c[2] + c[3]) + (d[0] + d[1] + d[2] + d[3]);
    return rsqrtf(s * (1.0f / 1024.0f) + 1e-6f);
}

constexpr int BM = 256, BK = 64, HALF = 128, HTB = HALF * BK * 2, NXCD = 8, WGM = 8;
DEVI int lds_byte(int r, int c) { const int st = (r >> 4) * 2 + (c >> 5), rr = r & 15, cc = c & 31, ob = rr * 64 + cc * 2; return st * 1024 + (ob ^ (((ob >> 9) & 1) << 5)); }
DEVI void stage_rc(int b, int& R, int& C) { const int st = b / 1024, sb = b % 1024, swz = sb ^ (((sb >> 9) & 1) << 5); R = (st >> 1) * 16 + swz / 64; C = (st & 1) * 32 + (swz % 64) / 2; }

enum { K_Q = 0, K_K, K_VT, K_GA, K_U, K_GB, K_SIN0, K_E5, K_Y5, K_GLU, K_SGLU, K_OUT0, K_SOUT0, K_Q1, K_F, K_IT, K_G1, K_SIN1, K_OUT1, K_SOUT1 };
enum { L_IN0 = 0, L_IN0S, L_GA, L_GB, L_GLU, L_GLUS, L_OUT0, L_OUT0S, L_IN1, L_IN1S, L_OUT1, L_OUT1S };

struct Unit { const char* a; const char* b; int kind, pm, pn; };

DEVI void static_order(int L, int nM, int nN, int& pm, int& pn) {
    const int nwg = nM * nN; int wgid = L;
    { const int q = nwg / NXCD, r = nwg % NXCD, xcd = wgid % NXCD, off = wgid / NXCD; wgid = (xcd < r ? xcd * (q + 1) : r * (q + 1) + (xcd - r) * q) + off; }
    const int nig = WGM * nN, gid = wgid / nig, fm = gid * WGM, gsz = (nM - fm) < WGM ? (nM - fm) : WGM;
    pm = fm + ((wgid % nig) % gsz); pn = (wgid % nig) / gsz;
}

struct Sched {
    int list, G, c; char* wsp; float* outp;
    DEVI bool next(int i, Unit& u) const {
        const int L = i * G + c; const char* ws = wsp;
        switch (list) {
        case L_IN0: {
            if (L >= 1280) return false; int pm, pn; static_order(L, 64, 20, pm, pn); u.pm = pm; u.pn = pn;
            const char* h0 = (const char*)(outp + O_RETS);
            if (pn >= 4 && pn < 8) { u.kind = K_VT; u.a = ws + WS_WIN0T + (size_t)(1024 + 256 * (pn - 4)) * 2048; u.b = h0 + (size_t)pm * 256 * 2048; }
            else { u.kind = pn < 2 ? K_Q : pn < 4 ? K_K : pn < 12 ? K_GA : pn < 16 ? K_U : K_GB; u.a = h0 + (size_t)pm * 256 * 2048; u.b = ws + WS_WIN0T + (size_t)pn * 256 * 2048; }
            return true; }
        case L_IN0S: if (L >= 20) return false; u.pm = 0; u.pn = L; u.kind = K_SIN0; u.a = ws + WS_H0S; u.b = ws + WS_WIN0T + (size_t)L * 256 * 2048; return true;
        case L_GA: if (L >= 256) return false; u.pm = L & 3; u.pn = L >> 2; u.kind = K_E5; u.a = ws + WS_A2 + ((size_t)(L >> 2) * 1024 + (L & 3) * 256) * 768; u.b = ws + WS_BT1 + (size_t)(L >> 2) * 256 * 512; return true;
        case L_GB: if (L >= 256) return false; u.pm = L & 3; u.pn = L >> 2; u.kind = K_Y5; u.a = ws + WS_A2 + ((size_t)(L >> 2) * 1024 + (L & 3) * 256) * 768; u.b = ws + WS_BT2 + (size_t)(L >> 2) * 256 * 768; return true;
        case L_GLU: { if (L >= 256) return false; int pm, pn; static_order(L, 64, 4, pm, pn); u.pm = pm; u.pn = pn; u.kind = K_GLU; u.a = ws + WS_Y5 + (size_t)pm * 256 * 32; u.b = ws + WS_WGLUT + (size_t)pn * 256 * 2048; return true; }
        case L_GLUS: if (L >= 4) return false; u.pm = 0; u.pn = L; u.kind = K_SGLU; u.a = ws + WS_Y5S; u.b = ws + WS_WGLUT + (size_t)L * 256 * 2048; return true;
        case L_OUT0: { if (L >= 256) return false; int pm, pn; static_order(L, 64, 4, pm, pn); u.pm = pm; u.pn = pn; u.kind = K_OUT0; u.a = (const char*)(outp + O_HGS) + (size_t)pm * 256 * 4096; u.b = ws + WS_WOUT0T + (size_t)pn * 256 * 4096; return true; }
        case L_OUT0S: if (L >= 4) return false; u.pm = 0; u.pn = L; u.kind = K_SOUT0; u.a = ws + WS_MIX0S; u.b = ws + WS_WOUT0T + (size_t)L * 256 * 4096; return true;
        case L_IN1: {
            if (L >= 1024) return false; int pm, pn; static_order(L, 64, 16, pm, pn); u.pm = pm; u.pn = pn;
            if (pn >= 8 && pn < 12) { u.kind = K_IT; u.a = ws + WS_WIN1T + (size_t)(256 * pn) * 2048; u.b = ws + WS_X1B + (size_t)pm * 256 * 2048; }
            else { u.kind = pn < 4 ? K_Q1 : pn < 8 ? K_F : K_G1; u.a = ws + WS_X1B + (size_t)pm * 256 * 2048; u.b = ws + WS_WIN1T + (size_t)pn * 256 * 2048; }
            return true; }
        case L_IN1S: if (L >= 16) return false; u.pm = 0; u.pn = L; u.kind = K_SIN1; u.a = ws + WS_X1SB; u.b = ws + WS_WIN1T + (size_t)L * 256 * 2048; return true;
        case L_OUT1: { if (L >= 256) return false; int pm, pn; static_order(L, 64, 4, pm, pn); u.pm = pm; u.pn = pn; u.kind = K_OUT1; u.a = ws + WS_Q1 + (size_t)pm * 256 * 2048; u.b = ws + WS_WOUT1T + (size_t)pn * 256 * 2048; return true; }
        case L_OUT1S: if (L >= 4) return false; u.pm = 0; u.pn = L; u.kind = K_SOUT1; u.a = ws + WS_O1S; u.b = ws + WS_WOUT1T + (size_t)L * 256 * 2048; return true;
        }
        return false;
    }
};

DEVI void epilogue(const Params& p, const f32x4 (&acc)[2][2][4][2], const Unit& u, int wr, int wc, int fr, int fq) {
    char* ws = p.ws;
    const int kind = u.kind;
    if (kind == K_Q || kind == K_K) {
        const float* rope = (const float*)(ws + WS_ROPE);
        bf16_t* dst = (bf16_t*)(ws + (kind == K_Q ? WS_Q : WS_KN));
        bf16_t* kt = (bf16_t*)(ws + WS_KT);
        const int tq = kind == K_Q ? u.pn : u.pn - 2;
        const float sc = kind == K_Q ? 1.0f : 0.08838834764831845f;
#pragma unroll
        for (int ai = 0; ai < 2; ++ai) {
#pragma unroll
          for (int mh = 0; mh < 2; ++mh) {
            f32x4 cs[4][2], sn[4][2];
#pragma unroll
            for (int m = mh * 2; m < mh * 2 + 2; ++m)
#pragma unroll
                for (int n = 0; n < 2; ++n) {
                    const int token = u.pm * 256 + ai * 128 + wr * 64 + m * 16 + fr, pos = token & 2047, j = (wc * 32 + n * 16 + fq * 4) & 63;
                    cs[m][n] = *(const f32x4*)(rope + pos * 128 + j); sn[m][n] = *(const f32x4*)(rope + pos * 128 + 64 + j);
                }
#pragma unroll
            for (int m = mh * 2; m < mh * 2 + 2; ++m) {
                const int token = u.pm * 256 + ai * 128 + wr * 64 + m * 16 + fr;
#pragma unroll
                for (int n = 0; n < 2; ++n) {
                    const int w = wc * 32 + n * 16 + fq * 4, hl = w >> 6, j = w & 63, head = 2 * tq + hl;
                    const f32x4 x1 = acc[ai][0][m][n], x2 = acc[ai][1][m][n];
                    const f32x4 y1 = (x1 * cs[m][n] - x2 * sn[m][n]) * sc, y2 = (x1 * sn[m][n] + x2 * cs[m][n]) * sc;
                    bf16_t* d = dst + (size_t)token * 512 + head * 128 + j;
                    *(u32x2*)d = pack4(y1); *(u32x2*)(d + 64) = pack4(y2);
                    if (kind == K_K) {
                        const int b = token >> 11, t = token & 2047;
                        bf16_t* kk = kt + ((size_t)(b * 4 + head) * 128 + j) * 2048 + t;
#pragma unroll
                        for (int i = 0; i < 4; ++i) { kk[(size_t)i * 2048] = f2bf(y1[i]); kk[(size_t)(64 + i) * 2048] = f2bf(y2[i]); }
                    }
                }
            }
          }
        }
    } else if (kind == K_VT || kind == K_IT) {
        const bool isv = kind == K_VT;
        const float* ssq = (const float*)(ws + WS_SSQ1);
        bf16_t* dst = (bf16_t*)(ws + (isv ? WS_VT : WS_IT));
        f32x4 rsa[2][2];
#pragma unroll
        for (int bj = 0; bj < 2; ++bj)
#pragma unroll
            for (int n = 0; n < 2; ++n) {
                const int token = u.pm * 256 + bj * 128 + wc * 32 + n * 16 + fq * 4;
                f32x4 rs = {1.f, 1.f, 1.f, 1.f};
                if (!isv) { rs[0] = row_rstd16(ssq, token); rs[1] = row_rstd16(ssq, token + 1); rs[2] = row_rstd16(ssq, token + 2); rs[3] = row_rstd16(ssq, token + 3); }
                rsa[bj][n] = rs;
            }
#pragma unroll
        for (int bj = 0; bj < 2; ++bj)
#pragma unroll
            for (int n = 0; n < 2; ++n) {
                const int token = u.pm * 256 + bj * 128 + wc * 32 + n * 16 + fq * 4, b = token >> 11, t = token & 2047;
                const f32x4 rs = rsa[bj][n];
#pragma unroll
                for (int ai = 0; ai < 2; ++ai)
#pragma unroll
                    for (int m = 0; m < 4; ++m) {
                        const int row = ai * 128 + wr * 64 + m * 16 + fr;
                        size_t off;
                        if (isv) off = ((size_t)(b * 4 + (u.pn - 4)) * 256 + row) * 2048 + t;
                        else { const int eg = (u.pn - 8) * 256 + row; off = ((size_t)(b * 8 + (eg >> 7)) * 128 + (eg & 127)) * 2048 + t; }
                        *(u32x2*)(dst + off) = pack4(acc[ai][bj][m][n] * rs);
                    }
            }
    } else if (kind == K_GA || kind == K_GB || kind == K_U) {
#pragma unroll
        for (int ai = 0; ai < 2; ++ai)
#pragma unroll
            for (int m = 0; m < 4; ++m) {
                const int token = u.pm * 256 + ai * 128 + wr * 64 + m * 16 + fr;
#pragma unroll
                for (int bj = 0; bj < 2; ++bj)
#pragma unroll
                    for (int n = 0; n < 2; ++n) {
                        const int cl = bj * 128 + wc * 32 + n * 16 + fq * 4;
                        f32x4 v = acc[ai][bj][m][n];
                        if (kind == K_U) {
                            const int cu = (u.pn - 12) * 256 + cl, g = cu >> 4, c = cu & 15;
                            bf16_t* d = (bf16_t*)(ws + WS_A2) + ((size_t)g * 1024 + (token >> 4)) * 384 + (token & 15) * 16 + c;
                            *(u32x2*)d = pack4(v);
                        } else {
                            v[0] = silu_(v[0]); v[1] = silu_(v[1]); v[2] = silu_(v[2]); v[3] = silu_(v[3]);
                            bf16_t* d = (bf16_t*)(ws + (kind == K_GA ? WS_SGA : WS_SGB)) + (size_t)token * 1024 + (u.pn - (kind == K_GA ? 8 : 16)) * 256 + cl;
                            *(u32x2*)d = pack4(v);
                        }
                    }
            }
    } else if (kind == K_SIN0) {
        const float* rope = (const float*)(ws + WS_ROPE) + 2048 * 128;
        float* zs = (float*)(ws + WS_ZS);
#pragma unroll
        for (int m = 0; m < 4; ++m) {
            const int row = wr * 64 + m * 16 + fr;
            if (u.pn < 4) {
                const float sc = u.pn < 2 ? 1.0f : 0.08838834764831845f;
#pragma unroll
                for (int n = 0; n < 2; ++n) {
                    const int w = wc * 32 + n * 16 + fq * 4, hl = w >> 6, j = w & 63;
                    const f32x4 cs = *(const f32x4*)(rope + j), sn = *(const f32x4*)(rope + 64 + j);
                    const f32x4 x1 = acc[0][0][m][n], x2 = acc[0][1][m][n];
                    float* d = zs + (size_t)row * 5120 + u.pn * 256 + hl * 128 + j;
                    *(f32x4*)d = (x1 * cs - x2 * sn) * sc; *(f32x4*)(d + 64) = (x1 * sn + x2 * cs) * sc;
                }
            } else {
                const bool gate = (u.pn >= 8 && u.pn < 12) || u.pn >= 16;
#pragma unroll
                for (int bj = 0; bj < 2; ++bj)
#pragma unroll
                    for (int n = 0; n < 2; ++n) {
                        f32x4 v = acc[0][bj][m][n];
                        if (gate) { v[0] = silu_(v[0]); v[1] = silu_(v[1]); v[2] = silu_(v[2]); v[3] = silu_(v[3]); }
                        *(f32x4*)(zs + (size_t)row * 5120 + u.pn * 256 + bj * 128 + wc * 32 + n * 16 + fq * 4) = v;
                    }
            }
        }
    } else if (kind == K_E5) {
        float* e5 = (float*)(p.out + O_HGS);
#pragma unroll
        for (int ai = 0; ai < 2; ++ai)
#pragma unroll
            for (int m = 0; m < 4; ++m) {
                const int row = u.pm * 256 + ai * 128 + wr * 64 + m * 16 + fr;
#pragma unroll
                for (int n = 0; n < 2; ++n) *(f32x4*)(e5 + ((size_t)u.pn * 1024 + row) * 128 + wc * 32 + n * 16 + fq * 4) = acc[ai][0][m][n];
            }
    } else if (kind == K_Y5) {
        const bf16_t* a2 = (const bf16_t*)(ws + WS_A2);
        bf16_t* y5 = (bf16_t*)(ws + WS_Y5);
        const int g = u.pn;
        f32x4 ddv[2][2];
#pragma unroll
        for (int bj = 0; bj < 2; ++bj)
#pragma unroll
            for (int n = 0; n < 2; ++n) ddv[bj][n] = *(const f32x4*)(p.s5d + g * 16 + ((bj * 128 + wc * 32 + n * 16 + fq * 4) & 15));
#pragma unroll
        for (int ai = 0; ai < 2; ++ai) {
#pragma unroll
          for (int mh = 0; mh < 2; ++mh) {
            u32x2 uv[4][2][2];
#pragma unroll
            for (int m = mh * 2; m < mh * 2 + 2; ++m)
#pragma unroll
                for (int bj = 0; bj < 2; ++bj)
#pragma unroll
                    for (int n = 0; n < 2; ++n) uv[m][bj][n] = *(const u32x2*)(a2 + ((size_t)g * 1024 + u.pm * 256 + ai * 128 + wr * 64 + m * 16 + fr) * 384 + bj * 128 + wc * 32 + n * 16 + fq * 4);
#pragma unroll
            for (int m = mh * 2; m < mh * 2 + 2; ++m) {
                const int row = u.pm * 256 + ai * 128 + wr * 64 + m * 16 + fr;
#pragma unroll
                for (int bj = 0; bj < 2; ++bj)
#pragma unroll
                    for (int n = 0; n < 2; ++n) {
                        const int col = bj * 128 + wc * 32 + n * 16 + fq * 4;
                        const u32x2 uu = uv[m][bj][n]; const f32x4 dd = ddv[bj][n];
                        f32x4 v = acc[ai][bj][m][n];
                        v[0] = gelu_(v[0] + dd[0] * bflo(uu.x)); v[1] = gelu_(v[1] + dd[1] * bfhi(uu.x));
                        v[2] = gelu_(v[2] + dd[2] * bflo(uu.y)); v[3] = gelu_(v[3] + dd[3] * bfhi(uu.y));
                        *(u32x2*)(y5 + ((size_t)g * 1024 + row) * 256 + col) = pack4(v);
                    }
            }
          }
        }
    } else if (kind == K_SGLU) {
        const bf16_t* y5 = (const bf16_t*)(ws + WS_Y5S);
        const float* zs = (const float*)(ws + WS_ZS);
        bf16_t* mix = (bf16_t*)(ws + WS_MIX0S);
#pragma unroll
        for (int m = 0; m < 4; ++m) {
            const size_t token = (size_t)wr * 64 + m * 16 + fr;
#pragma unroll
            for (int bj = 0; bj < 2; ++bj)
#pragma unroll
                for (int n = 0; n < 2; ++n) {
                    const int col = u.pn * 256 + bj * 128 + wc * 32 + n * 16 + fq * 4;
                    const f32x4 bb = *(const f32x4*)(p.glub + col);
                    const u32x2 yy = *(const u32x2*)(y5 + token * 1024 + col);
                    const f32x4 gg = *(const f32x4*)(zs + token * 5120 + 4096 + col);
                    f32x4 v = acc[0][bj][m][n] + bb;
                    v[0] = bflo(yy.x) * sigm(v[0]) * gg[0]; v[1] = bfhi(yy.x) * sigm(v[1]) * gg[1];
                    v[2] = bflo(yy.y) * sigm(v[2]) * gg[2]; v[3] = bfhi(yy.y) * sigm(v[3]) * gg[3];
                    *(u32x2*)(mix + token * 2048 + 1024 + col) = pack4(v);
                }
        }
    } else if (kind == K_GLU) {
        const bf16_t* y5 = (const bf16_t*)(ws + WS_Y5);
        const bf16_t* sgb = (const bf16_t*)(ws + WS_SGB);
        bf16_t* mix = (bf16_t*)(p.out + O_HGS);
        f32x4 bbv[2][2];
#pragma unroll
        for (int bj = 0; bj < 2; ++bj)
#pragma unroll
            for (int n = 0; n < 2; ++n) bbv[bj][n] = *(const f32x4*)(p.glub + u.pn * 256 + bj * 128 + wc * 32 + n * 16 + fq * 4);
#pragma unroll
        for (int ai = 0; ai < 2; ++ai)
#pragma unroll
          for (int mh = 0; mh < 2; ++mh) {
            u32x2 yv[4][2][2], gp[4][2][2];
#pragma unroll
            for (int m = mh * 2; m < mh * 2 + 2; ++m)
#pragma unroll
                for (int bj = 0; bj < 2; ++bj)
#pragma unroll
                    for (int n = 0; n < 2; ++n) {
                        const size_t token = (size_t)u.pm * 256 + ai * 128 + wr * 64 + m * 16 + fr; const int col = u.pn * 256 + bj * 128 + wc * 32 + n * 16 + fq * 4;
                        yv[m][bj][n] = *(const u32x2*)(y5 + ((size_t)(col >> 4) * MP + token) * 16 + (col & 15));
                        gp[m][bj][n] = *(const u32x2*)(sgb + token * 1024 + col);
                    }
#pragma unroll
            for (int m = mh * 2; m < mh * 2 + 2; ++m) {
                const size_t token = (size_t)u.pm * 256 + ai * 128 + wr * 64 + m * 16 + fr;
#pragma unroll
                for (int bj = 0; bj < 2; ++bj)
#pragma unroll
                    for (int n = 0; n < 2; ++n) {
                        const int col = u.pn * 256 + bj * 128 + wc * 32 + n * 16 + fq * 4;
                        const u32x2 yy = yv[m][bj][n], t = gp[m][bj][n];
                        f32x4 v = acc[ai][bj][m][n] + bbv[bj][n];
                        v[0] = bflo(yy.x) * sigm(v[0]) * bflo(t.x); v[1] = bfhi(yy.x) * sigm(v[1]) * bfhi(t.x);
                        v[2] = bflo(yy.y) * sigm(v[2]) * bflo(t.y); v[3] = bfhi(yy.y) * sigm(v[3]) * bfhi(t.y);
                        *(u32x2*)(mix + token * 2048 + 1024 + col) = pack4(v);
                    }
            }
          }
    } else if (kind == K_OUT0 || kind == K_SOUT0 || kind == K_OUT1 || kind == K_SOUT1) {
        const bool smp = kind == K_SOUT0 || kind == K_SOUT1, l0 = kind == K_OUT0 || kind == K_SOUT0;
        const float* res = l0 ? (smp ? p.xs : p.xp) : (smp ? (const float*)(ws + WS_X1S) : p.out + O_YP);
        float* dst = l0 ? (smp ? (float*)(ws + WS_X1S) : p.out + O_YP) : (smp ? p.out + O_YS : p.out + O_YP);
        bf16_t* dstb = (bf16_t*)(ws + (smp ? WS_X1SB : WS_X1B));
        float* ssq = (float*)(ws + (l0 ? (smp ? WS_SSQ1S : WS_SSQ1) : (smp ? WS_SSQ2S : WS_SSQ2)));
#pragma unroll
        for (int ai = 0; ai < 2; ++ai) {
            if (smp && ai) break;
#pragma unroll
          for (int mh = 0; mh < 2; ++mh) {
            f32x4 rv[4][2][2];
#pragma unroll
            for (int m = mh * 2; m < mh * 2 + 2; ++m)
#pragma unroll
                for (int bj = 0; bj < 2; ++bj)
#pragma unroll
                    for (int n = 0; n < 2; ++n) rv[m][bj][n] = *(const f32x4*)(res + ((size_t)u.pm * 256 + ai * 128 + wr * 64 + m * 16 + fr) * 1024 + u.pn * 256 + bj * 128 + wc * 32 + n * 16 + fq * 4);
#pragma unroll
            for (int m = mh * 2; m < mh * 2 + 2; ++m) {
                const size_t token = (size_t)u.pm * 256 + ai * 128 + wr * 64 + m * 16 + fr;
                float s = 0.f;
#pragma unroll
                for (int bj = 0; bj < 2; ++bj)
#pragma unroll
                    for (int n = 0; n < 2; ++n) {
                        const int col = u.pn * 256 + bj * 128 + wc * 32 + n * 16 + fq * 4;
                        const f32x4 v = acc[ai][bj][m][n] + rv[m][bj][n];
                        *(f32x4*)(dst + token * 1024 + col) = v;
                        if (l0) *(u32x2*)(dstb + token * 1024 + col) = pack4(v);
                        s += v[0] * v[0] + v[1] * v[1] + v[2] * v[2] + v[3] * v[3];
                    }
                s += __shfl_xor(s, 16); s += __shfl_xor(s, 32);
                if (fq == 0) ssq[((size_t)u.pn * MP + token) * 4 + wc] = s;
            }
          }
        }
    } else if (kind == K_Q1 || kind == K_F || kind == K_G1) {
        const float* ssq = (const float*)(ws + WS_SSQ1);
        const float* lb = (const float*)(ws + WS_LB);
#pragma unroll
        for (int ai = 0; ai < 2; ++ai) {
            float rr[4];
#pragma unroll
            for (int m = 0; m < 4; ++m) rr[m] = row_rstd16(ssq, (size_t)u.pm * 256 + ai * 128 + wr * 64 + m * 16 + fr);
            __builtin_amdgcn_sched_barrier(0);
#pragma unroll
            for (int m = 0; m < 4; ++m) {
                const size_t token = (size_t)u.pm * 256 + ai * 128 + wr * 64 + m * 16 + fr;
                const float r = rr[m];
#pragma unroll
                for (int bj = 0; bj < 2; ++bj)
#pragma unroll
                    for (int n = 0; n < 2; ++n) {
                        const int cl = (u.pn & 3) * 256 + bj * 128 + wc * 32 + n * 16 + fq * 4;
                        f32x4 v = acc[ai][bj][m][n] * r;
                        if (kind == K_F) {
                            const f32x4 l = *(const f32x4*)(lb + cl);
#pragma unroll
                            for (int i = 0; i < 4; ++i) v[i] = __logf(l[i] + (1.f - l[i]) * sigm(v[i]));
                            *(f32x4*)((float*)(ws + WS_CUM) + token * 1024 + cl) = v;
                        } else {
                            v[0] = silu_(v[0]); v[1] = silu_(v[1]); v[2] = silu_(v[2]); v[3] = silu_(v[3]);
                            *(u32x2*)((bf16_t*)(ws + (kind == K_Q1 ? WS_Q1 : WS_SG1)) + token * 1024 + cl) = pack4(v);
                        }
                    }
            }
        }
    } else if (kind == K_SIN1) {
        const float* ssq = (const float*)(ws + WS_SSQ1S);
        const float* lb = (const float*)(ws + WS_LB);
        float* z1 = (float*)(ws + WS_Z1S);
#pragma unroll
        for (int m = 0; m < 4; ++m) {
            const size_t row = wr * 64 + m * 16 + fr;
            const float r = row_rstd16(ssq, row);
            const int ty = u.pn >> 2;
#pragma unroll
            for (int bj = 0; bj < 2; ++bj)
#pragma unroll
                for (int n = 0; n < 2; ++n) {
                    const int cl = (u.pn & 3) * 256 + bj * 128 + wc * 32 + n * 16 + fq * 4;
                    f32x4 v = acc[0][bj][m][n] * r;
                    if (ty == 1) { const f32x4 l = *(const f32x4*)(lb + cl);
#pragma unroll
                        for (int i = 0; i < 4; ++i) v[i] = l[i] + (1.f - l[i]) * sigm(v[i]); }
                    else if (ty != 2) { v[0] = silu_(v[0]); v[1] = silu_(v[1]); v[2] = silu_(v[2]); v[3] = silu_(v[3]); }
                    *(f32x4*)(z1 + row * 4096 + ty * 1024 + cl) = v;
                }
        }
    }
}

DEVI void gemm_phase(const int TIDX, LAS unsigned char* lds, const int K, const int lda, const int ldb, const bool ga, const Sched S, const Params& P) {
    const int tid = TIDX, wid = __builtin_amdgcn_readfirstlane(tid >> 6), lane = tid & 63, wr = wid >> 2, wc = wid & 3, fr = lane & 15, fq = lane >> 4;
    const int nt = K / BK;
    unsigned voffA[2], voffB[2];
#pragma unroll
    for (int i = 0; i < 2; ++i) { int R, C; stage_rc(tid * 16 + i * 8192, R, C); voffA[i] = ga ? (unsigned)(R * 32 + (C >> 4) * (MP * 32) + (C & 15) * 2) : (unsigned)(R * lda + C) * 2u; voffB[i] = (unsigned)(R * ldb + C) * 2u; }
    const size_t kstep = (size_t)(BK * 2), kstepA = ga ? (size_t)4 * MP * 32 : kstep;
    const size_t hstepA = ga ? (size_t)HALF * 32 : (size_t)HALF * lda * 2, hstepB = (size_t)HALF * ldb * 2;
    const unsigned ldsw = (unsigned)wid * 1024u;
    const int aoff = lds_byte(wr * 64 + fr, fq * 8), boff = lds_byte(wc * 32 + fr, fq * 8);
#define PG8_SA(b, h) (((b) * 2 + (h)) * HTB)
#define PG8_SB(b, h) ((4 + (b) * 2 + (h)) * HTB)
#define PG8_STAGE(bufoff, gbase, voff) do { _Pragma("unroll") for (int _i = 0; _i < 2; ++_i) \
        __builtin_amdgcn_global_load_lds((const unsigned*)((const char*)(gbase) + (voff)[_i]), (LAS unsigned*)(lds + (bufoff) + ldsw + _i * 8192), 16, 0, 0); } while (0)
#define PG8_LDA(dst, b, h) do { _Pragma("unroll") for (int m = 0; m < 4; ++m) _Pragma("unroll") for (int k = 0; k < 2; ++k) dst[m][k] = *(const LAS bf16x8*)(lds + PG8_SA(b, h) + aoff + m * 2048 + k * 1024); } while (0)
#define PG8_LDB(dst, b, h) do { _Pragma("unroll") for (int n = 0; n < 2; ++n) _Pragma("unroll") for (int k = 0; k < 2; ++k) dst[n][k] = *(const LAS bf16x8*)(lds + PG8_SB(b, h) + boff + n * 2048 + k * 1024); } while (0)
#define PG8_MMA(ai, bj, At, Bt) do { __builtin_amdgcn_s_setprio(1); _Pragma("unroll") for (int m = 0; m < 4; ++m) _Pragma("unroll") for (int n = 0; n < 2; ++n) _Pragma("unroll") for (int k = 0; k < 2; ++k) \
        acc[ai][bj][m][n] = __builtin_amdgcn_mfma_f32_16x16x32_bf16(Bt[n][k], At[m][k], acc[ai][bj][m][n], 0, 0, 0); __builtin_amdgcn_s_setprio(0); } while (0)
#define PG8_WAIT_V(n) asm volatile("s_waitcnt vmcnt(" #n ")" ::: "memory")
#define PG8_WAIT_L(n) asm volatile("s_waitcnt lgkmcnt(" #n ")" ::: "memory")
#define PG8_BAR __builtin_amdgcn_s_barrier()
#define PG8_SCHED __builtin_amdgcn_sched_barrier(0)
    Unit cur, nxt; int ui = 0;
    if (!S.next(0, cur)) return;
    f32x4 acc[2][2][4][2];
#pragma unroll
    for (int a = 0; a < 2; ++a)
#pragma unroll
        for (int b = 0; b < 2; ++b)
#pragma unroll
            for (int m = 0; m < 4; ++m)
#pragma unroll
                for (int n = 0; n < 2; ++n) acc[a][b][m][n] = (f32x4){0.f, 0.f, 0.f, 0.f};
    bf16x8 At[4][2], B0[2][2], B1[2][2];
    const char* cA = cur.a; const char* cB = cur.b;
    PG8_STAGE(PG8_SB(0, 0), cB, voffB); PG8_STAGE(PG8_SA(0, 0), cA, voffA); PG8_STAGE(PG8_SB(0, 1), cB + hstepB, voffB); PG8_STAGE(PG8_SA(0, 1), cA + hstepA, voffA);
    if (wr == 1) PG8_BAR;
    PG8_WAIT_V(4); PG8_BAR;
    PG8_STAGE(PG8_SB(1, 0), cB + kstep, voffB); PG8_STAGE(PG8_SA(1, 0), cA + kstepA, voffA); PG8_STAGE(PG8_SB(1, 1), cB + hstepB + kstep, voffB);
    PG8_WAIT_V(6); PG8_BAR;
    for (;;) {
        const bool has_next = S.next(ui + 1, nxt);
        const char* nA = has_next ? nxt.a : cA; const char* nB = has_next ? nxt.b : cB;
        for (int t = 0; t < nt; t += 2) {
            const bool last = (t == nt - 2);
            const char* a1 = cA + (size_t)(t + 1) * kstepA;
            const char* a2 = last ? nA : cA + (size_t)(t + 2) * kstepA; const char* b2 = last ? nB : cB + (size_t)(t + 2) * kstep;
            const char* a3 = a2 + kstepA; const char* b3 = b2 + kstep;
            PG8_LDB(B0, 0, 0); PG8_SCHED; PG8_LDA(At, 0, 0); PG8_STAGE(PG8_SA(1, 1), a1 + hstepA, voffA);
            PG8_WAIT_L(8); PG8_BAR; PG8_WAIT_L(0); PG8_MMA(0, 0, At, B0); PG8_BAR; PG8_SCHED;
            PG8_LDB(B1, 0, 1); PG8_STAGE(PG8_SB(0, 0), b2, voffB);
            PG8_BAR; PG8_WAIT_L(0); PG8_MMA(0, 1, At, B1); PG8_BAR;
            PG8_LDA(At, 0, 1); PG8_STAGE(PG8_SA(0, 0), a2, voffA);
            PG8_BAR; PG8_WAIT_L(0); PG8_MMA(1, 0, At, B0); PG8_BAR; PG8_SCHED;
            PG8_STAGE(PG8_SB(0, 1), b2 + hstepB, voffB);
            PG8_WAIT_V(6); PG8_BAR; PG8_MMA(1, 1, At, B1); PG8_BAR;
            PG8_LDB(B0, 1, 0); PG8_SCHED; PG8_LDA(At, 1, 0); PG8_STAGE(PG8_SA(0, 1), a2 + hstepA, voffA);
            PG8_WAIT_L(8); PG8_BAR; PG8_WAIT_L(0); PG8_MMA(0, 0, At, B0); PG8_BAR; PG8_SCHED;
            PG8_LDB(B1, 1, 1); PG8_STAGE(PG8_SB(1, 0), b3, voffB);
            PG8_BAR; PG8_WAIT_L(0); PG8_MMA(0, 1, At, B1); PG8_BAR;
            PG8_LDA(At, 1, 1); PG8_STAGE(PG8_SA(1, 0), a3, voffA);
            PG8_BAR; PG8_WAIT_L(0); PG8_MMA(1, 0, At, B0); PG8_BAR; PG8_SCHED;
            PG8_STAGE(PG8_SB(1, 1), b3 + hstepB, voffB);
            PG8_WAIT_V(6); PG8_BAR; PG8_MMA(1, 1, At, B1); PG8_BAR;
        }
        { int ozv; asm volatile("v_mov_b32 %0, 0" : "=v"(ozv)); epilogue(P, acc, cur, wr, wc, fr + ozv, fq + ozv); }
        if (!has_next) break;
#pragma unroll
        for (int a = 0; a < 2; ++a)
#pragma unroll
            for (int b = 0; b < 2; ++b)
#pragma unroll
                for (int m = 0; m < 4; ++m)
#pragma unroll
                    for (int n = 0; n < 2; ++n) acc[a][b][m][n] = (f32x4){0.f, 0.f, 0.f, 0.f};
        cur = nxt; cA = nA; cB = nB; ++ui;
    }
    PG8_WAIT_V(0);
    if (wr == 0) PG8_BAR;
    PG8_BAR;
}

DEVI void prep_transpose(const int TIDX, const int BIDX, float* tile, const float* src, int K, int N, bf16_t* dst, const float* kscale, bool permqk, int job0, int& jobbase, int gsz) {
    (void)tile;
    const int nk8 = K / 8, ntn = N / 64, njobs = ntn * (nk8 / 8), lane = TIDX & 63, wid = TIDX >> 6;
    for (int jb = job0 - jobbase; jb < njobs; jb += gsz) {
        if (jb < 0) continue;
        const int tn = jb / (nk8 / 8), tk = jb % (nk8 / 8), n0 = tn * 64, k0 = tk * 64 + wid * 8;
        int c0 = n0;
        if (permqk && n0 < 1024) { const int tile_ = n0 >> 8, cp = n0 & 255, bj = cp >> 7, w = cp & 127; c0 = tile_ * 256 + (w >> 6) * 128 + bj * 64; }
        float v[8];
#pragma unroll
        for (int j = 0; j < 8; ++j) v[j] = src[(size_t)(k0 + j) * N + c0 + lane] * (kscale ? kscale[k0 + j] : 1.f);
        u32x4 o; o.x = pack2(v[0], v[1]); o.y = pack2(v[2], v[3]); o.z = pack2(v[4], v[5]); o.w = pack2(v[6], v[7]);
        *(u32x4*)(dst + (size_t)(n0 + lane) * K + k0) = o;
    }
    jobbase += njobs;
}

DEVI void prep_s5_tables(const int TIDX, const int BIDX, float* L, const Params& p, int g) {
    float* pwr = L;
    float* pwi = pwr + 17 * 64;
    float* bbr = pwi + 17 * 64;
    float* bbi = bbr + 1024;
    float* cr = bbi + 1024;
    float* ci = cr + 1024;
    float* kg = ci + 1024;
    const int tid = TIDX;
    char* ws = p.ws;
    __syncthreads();
    {
        const double dt = exp((double)p.logdt[g]);
        for (int i = tid; i < 17 * 64; i += 512) {
            const int t = i >> 6, pp = i & 63;
            const double lr = p.lamre[g * 64 + pp], li = p.lamim[g * 64 + pp];
            const double mag = exp(lr * dt * t), ang = li * dt * t;
            pwr[t * 64 + pp] = (float)(mag * cos(ang)); pwi[t * 64 + pp] = (float)(mag * sin(ang));
        }
        for (int i = tid; i < 1024; i += 512) {
            const int pp = i >> 4, c = i & 15;
            const double lr = p.lamre[g * 64 + pp], li = p.lamim[g * 64 + pp];
            const double mag = exp(lr * dt), ang = li * dt, lbr = mag * cos(ang), lbi = mag * sin(ang);
            const double nr = lbr - 1.0, den = lr * lr + li * li, fr = (nr * lr + lbi * li) / den, fi = (lbi * lr - nr * li) / den;
            const double br = p.bre[(g * 64 + pp) * 16 + c], bi = p.bim[(g * 64 + pp) * 16 + c];
            const float xr = (float)(fr * br - fi * bi), xi = (float)(fr * bi + fi * br);
            bbr[i] = xr; bbi[i] = xi;
            float* bbg = (float*)(ws + WS_BBG); bbg[(g * 1024 + i) * 2] = xr; bbg[(g * 1024 + i) * 2 + 1] = xi;
            if (c == 0) { float* lam1 = (float*)(ws + WS_LAM1); lam1[(g * 64 + pp) * 2] = (float)lbr; lam1[(g * 64 + pp) * 2 + 1] = (float)lbi; }
        }
    }
    __syncthreads();
    if (tid < 64) { float* lam16 = (float*)(ws + WS_LAM16); lam16[(g * 64 + tid) * 2] = pwr[16 * 64 + tid]; lam16[(g * 64 + tid) * 2 + 1] = pwi[16 * 64 + tid]; }
    for (int i = tid; i < 1024; i += 512) { cr[i] = p.cre[g * 1024 + i]; ci[i] = p.cim[g * 1024 + i]; }
    __syncthreads();
    for (int i = tid; i < 4096; i += 512) {
        const int tau = i >> 8, c = (i >> 4) & 15, cp = i & 15;
        float s = 0.f;
        for (int pp = 0; pp < 64; ++pp) {
            const float a = pwr[tau * 64 + pp], b = pwi[tau * 64 + pp], xr = bbr[pp * 16 + cp], xi = bbi[pp * 16 + cp];
            s += cr[c * 64 + pp] * (a * xr - b * xi) - ci[c * 64 + pp] * (a * xi + b * xr);
        }
        kg[i] = s;
    }
    __syncthreads();
    bf16_t* bt2 = (bf16_t*)(ws + WS_BT2) + (size_t)g * 256 * 384;
    for (int i = tid; i < 256 * 48; i += 512) {
        const int n = i / 48, k8 = (i % 48) * 8, t = n >> 4, c = n & 15;
        float v[8];
#pragma unroll
        for (int j = 0; j < 8; ++j) {
            const int k = k8 + j;
            if (k < 256) { const int s = k >> 4, cp = k & 15; v[j] = t >= s ? kg[(t - s) * 256 + c * 16 + cp] : 0.f; }
            else { const int q = k - 256, pp = q & 63; const float a = pwr[(t + 1) * 64 + pp], b = pwi[(t + 1) * 64 + pp];
                v[j] = q < 64 ? (cr[c * 64 + pp] * a - ci[c * 64 + pp] * b) : -(cr[c * 64 + pp] * b + ci[c * 64 + pp] * a); }
        }
        u32x4 o; o.x = pack2(v[0], v[1]); o.y = pack2(v[2], v[3]); o.z = pack2(v[4], v[5]); o.w = pack2(v[6], v[7]);
        *(u32x4*)(bt2 + (size_t)n * 384 + k8) = o;
    }
    bf16_t* bt1 = (bf16_t*)(ws + WS_BT1) + (size_t)g * 256 * 256;
    for (int i = tid; i < 256 * 32; i += 512) {
        const int n = i >> 5, k8 = (i & 31) * 8;
        float v[8];
#pragma unroll
        for (int j = 0; j < 8; ++j) {
            const int k = k8 + j, s = k >> 4, cp = k & 15;
            if (n >= 128) v[j] = 0.f;
            else { const int pp = n & 63; const float a = pwr[(15 - s) * 64 + pp], b = pwi[(15 - s) * 64 + pp], xr = bbr[pp * 16 + cp], xi = bbi[pp * 16 + cp];
                v[j] = n < 64 ? (a * xr - b * xi) : (a * xi + b * xr); }
        }
        u32x4 o; o.x = pack2(v[0], v[1]); o.y = pack2(v[2], v[3]); o.z = pack2(v[4], v[5]); o.w = pack2(v[6], v[7]);
        *(u32x4*)(bt1 + (size_t)n * 256 + k8) = o;
    }
}

DEVI void phase_prep(const int TIDX, const int BIDX, float* L, const Params& p) {
    const int tid = TIDX, bid = BIDX, G = gridDim.x, lane = tid & 63, wid = tid >> 6;
    char* ws = p.ws;
    for (int g = G - 1 - bid; g < 64; g += G) if (g >= 0) prep_s5_tables(TIDX, BIDX, L, p, g);
    __syncthreads();
    const int GT = G > 64 ? G - 64 : G;
    const int tb = (G > 64 && bid >= GT) ? (1 << 28) : bid;
    int jobbase = 0;
    prep_transpose(TIDX, BIDX, L, p.win0, 1024, 5120, (bf16_t*)(ws + WS_WIN0T), nullptr, true, tb, jobbase, GT);
    prep_transpose(TIDX, BIDX, L, p.gluw, 1024, 1024, (bf16_t*)(ws + WS_WGLUT), nullptr, false, tb, jobbase, GT);
    prep_transpose(TIDX, BIDX, L, p.wout0, 2048, 1024, (bf16_t*)(ws + WS_WOUT0T), nullptr, false, tb, jobbase, GT);
    prep_transpose(TIDX, BIDX, L, p.win1, 1024, 4096, (bf16_t*)(ws + WS_WIN1T), p.normw + 1024, false, tb, jobbase, GT);
    prep_transpose(TIDX, BIDX, L, p.wout1, 1024, 1024, (bf16_t*)(ws + WS_WOUT1T), nullptr, false, tb, jobbase, GT);
    bf16_t* h0 = (bf16_t*)(p.out + O_RETS); bf16_t* h0s = (bf16_t*)(ws + WS_H0S);
    for (int row = bid * 8 + wid; row < MP + 256; row += G * 8) {
        bf16_t* d = row < MP ? h0 + (size_t)row * 1024 : h0s + (size_t)(row - MP) * 1024;
        if (row >= MP + MS) { for (int i = 0; i < 4; ++i) *(u32x2*)(d + i * 256 + lane * 4) = (u32x2){0u, 0u}; continue; }
        const float* x = row < MP ? p.xp + (size_t)row * 1024 : p.xs + (size_t)(row - MP) * 1024;
        f32x4 v[4]; float s = 0.f;
#pragma unroll
        for (int i = 0; i < 4; ++i) { v[i] = *(const f32x4*)(x + i * 256 + lane * 4); s += v[i][0] * v[i][0] + v[i][1] * v[i][1] + v[i][2] * v[i][2] + v[i][3] * v[i][3]; }
        s = wave_sum(s);
        const float r = rsqrtf(s * (1.0f / 1024.0f) + 1e-6f);
#pragma unroll
        for (int i = 0; i < 4; ++i) { const f32x4 w = *(const f32x4*)(p.normw + i * 256 + lane * 4); *(u32x2*)(d + i * 256 + lane * 4) = pack4(v[i] * r * w); }
    }
    for (int i = bid * 512 + tid; i < 128 * 1024 / 8; i += G * 512) {
        const u32x4 z = {0u, 0u, 0u, 0u};
        *(u32x4*)((bf16_t*)(ws + WS_Y5S) + 128 * 1024 + (size_t)i * 8) = z;
        *(u32x4*)((bf16_t*)(ws + WS_X1SB) + 128 * 1024 + (size_t)i * 8) = z;
        *(u32x4*)((bf16_t*)(ws + WS_O1S) + 128 * 1024 + (size_t)i * 8) = z;
        *(u32x4*)((bf16_t*)(ws + WS_MIX0S) + 128 * 2048 + (size_t)i * 16) = z;
        *(u32x4*)((bf16_t*)(ws + WS_MIX0S) + 128 * 2048 + (size_t)i * 16 + 8) = z;
    }
    float* rope = (float*)(ws + WS_ROPE);
    for (int i = bid * 512 + tid; i < 2049 * 64; i += G * 512) {
        const int pr = i >> 6, j = i & 63; const double pos = pr == 2048 ? 16384.0 : (double)pr;
        const double inv = exp2(-(double)j * (13.287712379549449 / 64.0));
        const double rev = pos * inv * 0.15915494309189535; const double fr = rev - floor(rev); const double a = fr * 6.283185307179586;
        rope[pr * 128 + j] = (float)cos(a); rope[pr * 128 + 64 + j] = (float)sin(a);
    }
    float* lb = (float*)(ws + WS_LB);
    for (int i = bid * 512 + tid; i < 1024; i += G * 512) lb[i] = 1.f / (1.f + expf(p.hglb[i] - p.hglb[1024 + i]));
}

DEVI float ret_lg(int h) { return log1pf(-exp2f(-5.0f - (float)h)); }

DEVI void phase_R1(const int TIDX, const int BIDX, bf16_t* L, const Params& p) {
    const int tid = TIDX, wid = tid >> 6, lane = tid & 63, r16 = lane & 15, g = lane >> 4;
    const bf16_t* kt = (const bf16_t*)(p.ws + WS_KT); const bf16_t* vt = (const bf16_t*)(p.ws + WS_VT);
    float* kvt = p.out + O_YP;
    for (int it = BIDX; it < 512; it += gridDim.x) {
        const int bh = it >> 4, c = it & 15, h = bh & 3, t0 = c * 128; const float lg = ret_lg(h);
        __syncthreads();
        { const int d = tid >> 2, seg = tid & 3;
#pragma unroll
          for (int q = 0; q < 4; ++q) {
              const int l0 = seg * 32 + q * 8;
              const u32x4 v = *(const u32x4*)(kt + ((size_t)bh * 128 + d) * 2048 + t0 + l0);
              u32x4 o; const unsigned* vv = (const unsigned*)&v; unsigned* oo = (unsigned*)&o;
#pragma unroll
              for (int j = 0; j < 4; ++j) oo[j] = pack2(bflo(vv[j]) * __expf(lg * (float)(127 - l0 - 2 * j)), bfhi(vv[j]) * __expf(lg * (float)(126 - l0 - 2 * j)));
              *(u32x4*)(L + d * 136 + l0) = o; } }
        __syncthreads();
        bf16x8 bfr[2][4];
#pragma unroll
        for (int ct = 0; ct < 2; ++ct)
#pragma unroll
            for (int kk = 0; kk < 4; ++kk) bfr[ct][kk] = *(const bf16x8*)(vt + ((size_t)bh * 256 + wid * 32 + ct * 16 + r16) * 2048 + t0 + kk * 32 + g * 8);
#pragma unroll
        for (int rt = 0; rt < 8; ++rt) {
            f32x4 a0 = {0.f, 0.f, 0.f, 0.f}, a1 = a0;
#pragma unroll
            for (int kk = 0; kk < 4; ++kk) { const bf16x8 a = *(const bf16x8*)(L + (rt * 16 + r16) * 136 + kk * 32 + g * 8); a0 = mfma16(a, bfr[0][kk], a0); a1 = mfma16(a, bfr[1][kk], a1); }
            float* d0 = kvt + (((size_t)bh * 16 + c) * 256 + wid * 32 + r16) * 128 + rt * 16 + g * 4;
            *(f32x4*)d0 = a0; *(f32x4*)(d0 + 16 * 128) = a1;
        }
    }
}

DEVI void phase_R2(const int TIDX, const int BIDX, const Params& p) {
    float* kvt = p.out + O_YP;
    for (int i = BIDX * 512 + TIDX; i < 32 * 256 * 16; i += gridDim.x * 512) {
        const int q = i & 15, e = (i >> 4) & 255, bh = i >> 12, h = bh & 3; const float dec = __expf(ret_lg(h) * 128.f);
        f32x4 s0 = {0.f, 0.f, 0.f, 0.f}, s1 = s0;
#pragma unroll 4
        for (int c = 0; c < 16; ++c) {
            float* ptr = kvt + (((size_t)bh * 16 + c) * 256 + e) * 128 + q * 8;
            const f32x4 v0 = *(const f32x4*)ptr, v1 = *(const f32x4*)(ptr + 4);
            u32x4 o; o.x = pack2(s0[0], s0[1]); o.y = pack2(s0[2], s0[3]); o.z = pack2(s1[0], s1[1]); o.w = pack2(s1[2], s1[3]);
            *(u32x4*)ptr = o;
            s0 = s0 * dec + v0; s1 = s1 * dec + v1;
        }
        float* o = p.out + O_RETP + ((size_t)bh * 128 + q * 8) * 256 + e;
#pragma unroll
        for (int j = 0; j < 4; ++j) { o[(size_t)j * 256] = s0[j]; o[(size_t)(j + 4) * 256] = s1[j]; }
    }
}

DEVI void phase_R3(const int TIDX, const int BIDX, bf16_t* L, const Params& p) {
    const int tid = TIDX, wid = tid >> 6, lane = tid & 63, r16 = lane & 15, g = lane >> 4;
    const bf16_t* Q = (const bf16_t*)(p.ws + WS_Q); const bf16_t* KN = (const bf16_t*)(p.ws + WS_KN); const bf16_t* vt = (const bf16_t*)(p.ws + WS_VT);
    const bf16_t* sga = (const bf16_t*)(p.ws + WS_SGA); bf16_t* mix = (bf16_t*)(p.out + O_HGS);
    const float* kvt = p.out + O_YP;
    bf16_t* S = L;
    float* st = (float*)(L + 128 * 136);
    float* mr = st + 128 * 16;
    for (int it = BIDX; it < 512; it += gridDim.x) {
        const int bh = it >> 4, c = it & 15, h = bh & 3, b = bh >> 2, l0 = wid * 16; const size_t tok0 = (size_t)b * 2048 + c * 128; const float lg = ret_lg(h);
        bf16x8 qa[4];
#pragma unroll
        for (int kk = 0; kk < 4; ++kk) qa[kk] = *(const bf16x8*)(Q + (tok0 + l0 + r16) * 512 + h * 128 + kk * 32 + g * 8);
        __syncthreads();
        for (int j = 0; j < 8; ++j) {
            f32x4 sc = {0.f, 0.f, 0.f, 0.f};
            if (j <= wid) {
#pragma unroll
                for (int kk = 0; kk < 4; ++kk) sc = mfma16(qa[kk], *(const bf16x8*)(KN + (tok0 + j * 16 + r16) * 512 + h * 128 + kk * 32 + g * 8), sc);
            }
#pragma unroll
            for (int r = 0; r < 4; ++r) {
                const int li = l0 + g * 4 + r, mi = j * 16 + r16; const float v = (j <= wid && li >= mi) ? sc[r] * __expf(lg * (float)(li - mi)) : 0.f;
                S[li * 136 + mi] = f2bf(v);
            }
        }
        f32x4 acc[8][2];
#pragma unroll
        for (int rt = 0; rt < 8; ++rt) { acc[rt][0] = (f32x4){0.f, 0.f, 0.f, 0.f}; acc[rt][1] = (f32x4){0.f, 0.f, 0.f, 0.f}; }
        if (c > 0) {
            bf16x8 bs[2][4];
#pragma unroll
            for (int ct = 0; ct < 2; ++ct)
#pragma unroll
                for (int kk = 0; kk < 4; ++kk) bs[ct][kk] = *(const bf16x8*)(kvt + (((size_t)bh * 16 + c) * 256 + wid * 32 + ct * 16 + r16) * 128 + kk * 32 + g * 8);
#pragma unroll
            for (int rt = 0; rt < 8; ++rt) {
                f32x4 a0 = {0.f, 0.f, 0.f, 0.f}, a1 = a0;
#pragma unroll
                for (int kk = 0; kk < 4; ++kk) {
                    const bf16x8 q = *(const bf16x8*)(Q + (tok0 + rt * 16 + r16) * 512 + h * 128 + kk * 32 + g * 8);
                    a0 = mfma16(q, bs[0][kk], a0); a1 = mfma16(q, bs[1][kk], a1);
                }
#pragma unroll
                for (int r = 0; r < 4; ++r) { const float qd = __expf(lg * (float)(rt * 16 + g * 4 + r + 1)); a0[r] *= qd; a1[r] *= qd; }
                acc[rt][0] = a0; acc[rt][1] = a1;
                __builtin_amdgcn_sched_barrier(0);
            }
        }
        bf16x8 bv[2][4];
#pragma unroll
        for (int ct = 0; ct < 2; ++ct)
#pragma unroll
            for (int kk = 0; kk < 4; ++kk) bv[ct][kk] = *(const bf16x8*)(vt + ((size_t)bh * 256 + wid * 32 + ct * 16 + r16) * 2048 + c * 128 + kk * 32 + g * 8);
        __syncthreads();
#pragma unroll
        for (int rt = 0; rt < 8; ++rt) {
            f32x4 a0 = acc[rt][0], a1 = acc[rt][1];
#pragma unroll
            for (int kk = 0; kk < 4; ++kk) {
                if (kk <= (rt >> 1)) {
                    const bf16x8 a = *(const bf16x8*)(S + (rt * 16 + r16) * 136 + kk * 32 + g * 8);
                    a0 = mfma16(a, bv[0][kk], a0); a1 = mfma16(a, bv[1][kk], a1);
                }
            }
            acc[rt][0] = a0; acc[rt][1] = a1;
#pragma unroll
            for (int r = 0; r < 4; ++r) {
                float s1 = a0[r] + a1[r], s2 = a0[r] * a0[r] + a1[r] * a1[r];
                s1 = grp16_sum(s1); s2 = grp16_sum(s2);
                if (r16 == 0) { st[((rt * 16 + g * 4 + r) * 8 + wid) * 2] = s1; st[((rt * 16 + g * 4 + r) * 8 + wid) * 2 + 1] = s2; }
            }
            __builtin_amdgcn_sched_barrier(0);
        }
        __syncthreads();
        if (tid < 128) {
            float s1 = 0.f, s2 = 0.f;
#pragma unroll
            for (int w = 0; w < 8; ++w) { s1 += st[(tid * 8 + w) * 2]; s2 += st[(tid * 8 + w) * 2 + 1]; }
            const float mu = s1 * (1.f / 256.f), var = fmaxf(s2 * (1.f / 256.f) - mu * mu, 0.f);
            mr[tid * 2] = mu; mr[tid * 2 + 1] = rsqrtf(var + 1e-5f);
        }
        __syncthreads();
        const float gw0 = p.gnw[h * 256 + wid * 32 + r16], gw1 = p.gnw[h * 256 + wid * 32 + 16 + r16];
#pragma unroll
        for (int rt = 0; rt < 8; ++rt)
#pragma unroll
            for (int r = 0; r < 4; ++r) {
                const int row = rt * 16 + g * 4 + r; const size_t token = tok0 + row; const float mu = mr[row * 2], rs = mr[row * 2 + 1];
                const size_t o = token * 1024 + h * 256 + wid * 32 + r16;
                const float v0 = (acc[rt][0][r] - mu) * rs * gw0 * bf2f(sga[o]), v1 = (acc[rt][1][r] - mu) * rs * gw1 * bf2f(sga[o + 16]);
                mix[token * 2048 + h * 256 + wid * 32 + r16] = f2bf(v0); mix[token * 2048 + h * 256 + wid * 32 + 16 + r16] = f2bf(v1);
            }
    }
}

DEVI void phase_s5scan(const int TIDX, const int BIDX, const Params& p) {
    const int wid = TIDX >> 6, lane = TIDX & 63;
    const float* e5 = p.out + O_HGS; bf16_t* a2 = (bf16_t*)(p.ws + WS_A2); const float* lam16 = (const float*)(p.ws + WS_LAM16);
    for (int it = BIDX * 8 + wid; it < 512; it += gridDim.x * 8) {
        const int b = it >> 6, g = it & 63;
        const float ar = lam16[(g * 64 + lane) * 2], ai = lam16[(g * 64 + lane) * 2 + 1];
        float hr = 0.f, hi = 0.f;
        for (int jb = 0; jb < 128; jb += 16) {
            float er[16], ei[16];
#pragma unroll
            for (int j = 0; j < 16; ++j) { const float* ep = e5 + ((size_t)g * 1024 + b * 128 + jb + j) * 128; er[j] = ep[lane]; ei[j] = ep[64 + lane]; }
#pragma unroll
            for (int j = 0; j < 16; ++j) {
                bf16_t* hp = a2 + ((size_t)g * 1024 + b * 128 + jb + j) * 384 + 256;
                hp[lane] = f2bf(hr); hp[64 + lane] = f2bf(hi);
                const float nr = ar * hr - ai * hi + er[j], ni = ar * hi + ai * hr + ei[j];
                hr = nr; hi = ni;
            }
        }
        p.out[O_S5RP + (size_t)(b * 64 + g) * 64 + lane] = hr; p.out[O_S5IP + (size_t)(b * 64 + g) * 64 + lane] = hi;
    }
}

DEVI void phase_H1(const int TIDX, const int BIDX, bf16_t* L, const Params& p) {
    const int tid = TIDX, wid = tid >> 6, lane = tid & 63, r16 = lane & 15, g = lane >> 4;
    float* cum = (float*)(p.ws + WS_CUM); const bf16_t* itp = (const bf16_t*)(p.ws + WS_IT); float* hkv = (float*)(p.ws + WS_HKV);
    float* tot = (float*)(L + 128 * 136);
    for (int it = BIDX; it < 1024; it += gridDim.x) {
        const int bh = it >> 4, c = it & 15, h = bh & 7, b = bh >> 3; const size_t tok0 = (size_t)b * 2048 + c * 128;
        const int d = tid & 127, part = tid >> 7;
        float* col = cum + (tok0 + part * 32) * 1024 + h * 128 + d;
        float lf[32]; float s = 0.f;
#pragma unroll
        for (int l = 0; l < 32; ++l) { lf[l] = col[(size_t)l * 1024]; s += lf[l]; }
        __syncthreads();
        tot[part * 128 + d] = s;
        __syncthreads();
        float off = 0.f, last = 0.f;
#pragma unroll
        for (int pp = 0; pp < 4; ++pp) { const float t = tot[pp * 128 + d]; if (pp < part) off += t; last += t; }
        float cc = off;
#pragma unroll
        for (int l = 0; l < 32; ++l) {
            cc += lf[l]; col[(size_t)l * 1024] = cc;
            L[d * 136 + part * 32 + l] = f2bf((1.f - __expf(lf[l])) * __expf(last - cc));
        }
        __syncthreads();
        bf16x8 bfr[4];
#pragma unroll
        for (int kk = 0; kk < 4; ++kk) bfr[kk] = *(const bf16x8*)(itp + ((size_t)bh * 128 + wid * 16 + r16) * 2048 + c * 128 + kk * 32 + g * 8);
#pragma unroll
        for (int rt = 0; rt < 8; ++rt) {
            f32x4 a0 = {0.f, 0.f, 0.f, 0.f};
#pragma unroll
            for (int kk = 0; kk < 4; ++kk) a0 = mfma16(*(const bf16x8*)(L + (rt * 16 + r16) * 136 + kk * 32 + g * 8), bfr[kk], a0);
            *(f32x4*)(hkv + (((size_t)bh * 16 + c) * 128 + wid * 16 + r16) * 128 + rt * 16 + g * 4) = a0;
        }
    }
}

DEVI void phase_H2(const int TIDX, const int BIDX, const Params& p) {
    float* hkv = (float*)(p.ws + WS_HKV); const float* cum = (const float*)(p.ws + WS_CUM);
    for (int i = BIDX * 512 + TIDX; i < 64 * 128 * 16; i += gridDim.x * 512) {
        const int q = i & 15, e = (i >> 4) & 127, bh = i >> 11, h = bh & 7, b = bh >> 3;
        f32x4 s0 = {0.f, 0.f, 0.f, 0.f}, s1 = s0;
#pragma unroll 4
        for (int c = 0; c < 16; ++c) {
            float* ptr = hkv + (((size_t)bh * 16 + c) * 128 + e) * 128 + q * 8;
            const float* lp = cum + ((size_t)b * 2048 + c * 128 + 127) * 1024 + h * 128 + q * 8;
            const f32x4 v0 = *(const f32x4*)ptr, v1 = *(const f32x4*)(ptr + 4), d0 = *(const f32x4*)lp, d1 = *(const f32x4*)(lp + 4);
            u32x4 o; o.x = pack2(s0[0], s0[1]); o.y = pack2(s0[2], s0[3]); o.z = pack2(s1[0], s1[1]); o.w = pack2(s1[2], s1[3]);
            *(u32x4*)ptr = o;
#pragma unroll
            for (int j = 0; j < 4; ++j) { s0[j] = s0[j] * __expf(d0[j]) + v0[j]; s1[j] = s1[j] * __expf(d1[j]) + v1[j]; }
        }
        float* o = p.out + O_HGP + ((size_t)bh * 128 + q * 8) * 128 + e;
#pragma unroll
        for (int j = 0; j < 4; ++j) { o[(size_t)j * 128] = s0[j]; o[(size_t)(j + 4) * 128] = s1[j]; }
    }
}

DEVI void phase_H3(const int TIDX, const int BIDX, bf16_t* L, const Params& p) {
    const int tid = TIDX, wid = tid >> 6, lane = tid & 63, r16 = lane & 15, g = lane >> 4;
    const float* cum = (const float*)(p.ws + WS_CUM); const bf16_t* itp = (const bf16_t*)(p.ws + WS_IT); const float* hkv = (const float*)(p.ws + WS_HKV);
    bf16_t* q1 = (bf16_t*)(p.ws + WS_Q1); const bf16_t* sg1 = (const bf16_t*)(p.ws + WS_SG1);
    bf16_t* kt = L; bf16_t* S = L + 128 * 136; bf16_t* QA = L + 2 * 128 * 136;
    float* st = (float*)(L + 3 * 128 * 136);
    float* rsn = st + 128 * 8;
    for (int it = BIDX; it < 1024; it += gridDim.x) {
        const int bh = it >> 4, c = it & 15, h = bh & 7, b = bh >> 3, l0 = wid * 16; const size_t tok0 = (size_t)b * 2048 + c * 128;
        const float* refp = cum + (tok0 + 63) * 1024 + h * 128;
        __syncthreads();
        { const int m = tid >> 2, seg = tid & 3; const float* cp = cum + (tok0 + m) * 1024 + h * 128 + seg * 32;
#pragma unroll
          for (int q = 0; q < 8; ++q) {
              const f32x4 cv = *(const f32x4*)(cp + q * 4), rv = *(const f32x4*)(refp + seg * 32 + q * 4);
              f32x4 pv = {0.f, 0.f, 0.f, 0.f}; if (m > 0) pv = *(const f32x4*)(cp - 1024 + q * 4);
              f32x4 o;
#pragma unroll
              for (int j = 0; j < 4; ++j) o[j] = (1.f - __expf(cv[j] - pv[j])) * __expf(rv[j] - cv[j]);
              *(u32x2*)(kt + m * 136 + seg * 32 + q * 4) = pack4(o); } }
        bf16x8 qr[4];
#pragma unroll
        for (int kk = 0; kk < 4; ++kk) {
            const size_t o = (tok0 + l0 + r16) * 1024 + h * 128 + kk * 32 + g * 8;
            const u32x4 qq = *(const u32x4*)(q1 + o);
            const f32x4 c0 = *(const f32x4*)(cum + o), c1 = *(const f32x4*)(cum + o + 4), r0 = *(const f32x4*)(refp + kk * 32 + g * 8), r1 = *(const f32x4*)(refp + kk * 32 + g * 8 + 4);
            const unsigned* qv = (const unsigned*)&qq; u32x4 a, bb; unsigned* av = (unsigned*)&a; unsigned* bv = (unsigned*)&bb;
#pragma unroll
            for (int j = 0; j < 4; ++j) {
                const float cl = j < 2 ? c0[2 * j] : c1[2 * j - 4], ch = j < 2 ? c0[2 * j + 1] : c1[2 * j - 3];
                const float rl = j < 2 ? r0[2 * j] : r1[2 * j - 4], rh = j < 2 ? r0[2 * j + 1] : r1[2 * j - 3];
                const float ql = bflo(qv[j]), qh = bfhi(qv[j]);
                av[j] = pack2(ql * __expf(cl - rl), qh * __expf(ch - rh)); bv[j] = pack2(ql * __expf(cl), qh * __expf(ch));
            }
            qr[kk] = *(bf16x8*)&a;
            *(u32x4*)(QA + (l0 + r16) * 136 + kk * 32 + g * 8) = bb;
        }
        bf16x8 bi[4], bs[4];
#pragma unroll
        for (int kk = 0; kk < 4; ++kk) {
            bi[kk] = *(const bf16x8*)(itp + ((size_t)bh * 128 + wid * 16 + r16) * 2048 + c * 128 + kk * 32 + g * 8);
            bs[kk] = *(const bf16x8*)(hkv + (((size_t)bh * 16 + c) * 128 + wid * 16 + r16) * 128 + kk * 32 + g * 8);
        }
        __syncthreads();
        for (int j = 0; j < 8; ++j) {
            f32x4 sc = {0.f, 0.f, 0.f, 0.f};
            if (j <= wid) {
#pragma unroll
                for (int kk = 0; kk < 4; ++kk) sc = mfma16(qr[kk], *(const bf16x8*)(kt + (j * 16 + r16) * 136 + kk * 32 + g * 8), sc);
            }
#pragma unroll
            for (int r = 0; r < 4; ++r) {
                const int li = l0 + g * 4 + r, mi = j * 16 + r16; const float v = (j <= wid && li >= mi) ? sc[r] : 0.f;
                S[li * 136 + mi] = f2bf(v);
            }
        }
        __syncthreads();
        f32x4 acc[8];
#pragma unroll
        for (int rt = 0; rt < 8; ++rt) {
            f32x4 a0 = {0.f, 0.f, 0.f, 0.f};
            if (c > 0) {
#pragma unroll
                for (int kk = 0; kk < 4; ++kk) a0 = mfma16(*(const bf16x8*)(QA + (rt * 16 + r16) * 136 + kk * 32 + g * 8), bs[kk], a0);
            }
#pragma unroll
            for (int kk = 0; kk < 4; ++kk) {
                if (kk <= (rt >> 1)) a0 = mfma16(*(const bf16x8*)(S + (rt * 16 + r16) * 136 + kk * 32 + g * 8), bi[kk], a0);
            }
            acc[rt] = a0;
#pragma unroll
            for (int r = 0; r < 4; ++r) {
                const float s2 = grp16_sum(a0[r] * a0[r]);
                if (r16 == 0) st[(rt * 16 + g * 4 + r) * 8 + wid] = s2;
            }
        }
        __syncthreads();
        if (tid < 128) {
            float s2 = 0.f;
#pragma unroll
            for (int w = 0; w < 8; ++w) s2 += st[tid * 8 + w];
            rsn[tid] = rsqrtf(s2 * (1.f / 128.f) + 1e-6f);
        }
        __syncthreads();
        const float gw = p.hgnw[h * 128 + wid * 16 + r16];
#pragma unroll
        for (int rt = 0; rt < 8; ++rt)
#pragma unroll
            for (int r = 0; r < 4; ++r) {
                const int row = rt * 16 + g * 4 + r; const unsigned o = ((unsigned)tok0 + row) * 1024u + h * 128 + wid * 16 + r16;
                q1[o] = f2bf(acc[rt][r] * rsn[row] * gw * bf2f(sg1[o]));
            }
    }
}

DEVI void phase_ss5(const int TIDX, const int BIDX, const Params& p) {
    const int wid = TIDX >> 6, lane = TIDX & 63;
    const float* zs = (const float*)(p.ws + WS_ZS); const float* bbg = (const float*)(p.ws + WS_BBG); const float* lam1 = (const float*)(p.ws + WS_LAM1);
    bf16_t* y5s = (bf16_t*)(p.ws + WS_Y5S);
    for (int it = BIDX * 8 + wid; it < 128 * 64; it += gridDim.x * 8) {
        const int b = it >> 6, g = it & 63;
        float u[16];
#pragma unroll
        for (int c = 0; c < 16; ++c) u[c] = zs[(size_t)b * 5120 + 3072 + g * 16 + c];
        float xr = 0.f, xi = 0.f;
#pragma unroll
        for (int c = 0; c < 16; ++c) { xr += bbg[((g * 64 + lane) * 16 + c) * 2] * u[c]; xi += bbg[((g * 64 + lane) * 16 + c) * 2 + 1] * u[c]; }
        const float ar = lam1[(g * 64 + lane) * 2], ai = lam1[(g * 64 + lane) * 2 + 1];
        const float sr = p.s5r[(size_t)(b * 64 + g) * 64 + lane], si = p.s5i[(size_t)(b * 64 + g) * 64 + lane];
        const float hr = ar * sr - ai * si + xr, hi = ar * si + ai * sr + xi;
        p.out[O_S5RS + (size_t)(b * 64 + g) * 64 + lane] = hr; p.out[O_S5IS + (size_t)(b * 64 + g) * 64 + lane] = hi;
        float mine = 0.f;
#pragma unroll
        for (int c = 0; c < 16; ++c) {
            float v = p.cre[(g * 16 + c) * 64 + lane] * hr - p.cim[(g * 16 + c) * 64 + lane] * hi;
            v = wave_sum(v);
            if (lane == c) mine = v + p.s5d[g * 16 + c] * u[c];
        }
        if (lane < 16) y5s[(size_t)b * 1024 + g * 16 + lane] = f2bf(gelu_(mine));
    }
}

DEVI void phase_sret(const int TIDX, const int BIDX, float* L, const Params& p) {
    const int tid = TIDX, lane = tid & 63, wid = tid >> 6;
    const float* zs = (const float*)(p.ws + WS_ZS); bf16_t* mix = (bf16_t*)(p.ws + WS_MIX0S);
    float* qs = L; float* ks = L + 128; float* red = L + 256; float* st = L + 256 + 2048;
    for (int it = BIDX; it < 512; it += gridDim.x) {
        const int b = it >> 2, h = it & 3, e4 = (tid & 63) * 4, dg = tid >> 6, d0 = dg * 16; const float gam = 1.0f - exp2f(-5.0f - (float)h);
        __syncthreads();
        if (tid < 128) qs[tid] = zs[(size_t)b * 5120 + h * 128 + tid]; else if (tid < 256) ks[tid - 128] = zs[(size_t)b * 5120 + 512 + h * 128 + tid - 128];
        const f32x4 v = *(const f32x4*)(zs + (size_t)b * 5120 + 1024 + h * 256 + e4);
        __syncthreads();
        const float* s0 = p.sret + ((size_t)it * 128 + d0) * 256 + e4; float* so = p.out + O_RETS + ((size_t)it * 128 + d0) * 256 + e4;
        f32x4 sv[16];
#pragma unroll
        for (int j = 0; j < 16; ++j) sv[j] = *(const f32x4*)(s0 + (size_t)j * 256);
        f32x4 o = {0.f, 0.f, 0.f, 0.f};
#pragma unroll
        for (int j = 0; j < 16; ++j) { const f32x4 s = sv[j] * gam + v * ks[d0 + j]; *(f32x4*)(so + (size_t)j * 256) = s; o += s * qs[d0 + j]; }
        *(f32x4*)(red + dg * 256 + e4) = o;
        __syncthreads();
        float tot = 0.f;
        if (tid < 256) {
#pragma unroll
            for (int k = 0; k < 8; ++k) tot += red[k * 256 + tid];
            const float s = wave_sum(tot); if (lane == 0) st[wid] = s; }
        __syncthreads();
        const float mu = (st[0] + st[1] + st[2] + st[3]) * (1.f / 256.f);
        __syncthreads();
        if (tid < 256) { const float dd = tot - mu; const float s = wave_sum(dd * dd); if (lane == 0) st[wid] = s; }
        __syncthreads();
        const float rs = rsqrtf((st[0] + st[1] + st[2] + st[3]) * (1.f / 256.f) + 1e-5f);
        if (tid < 256) mix[(size_t)b * 2048 + h * 256 + tid] = f2bf((tot - mu) * rs * p.gnw[h * 256 + tid] * zs[(size_t)b * 5120 + 2048 + h * 256 + tid]);
    }
}

DEVI void phase_shg(const int TIDX, const int BIDX, float* L, const Params& p) {
    const int tid = TIDX, lane = tid & 63, wid = tid >> 6;
    const float* z1 = (const float*)(p.ws + WS_Z1S); bf16_t* o1s = (bf16_t*)(p.ws + WS_O1S);
    float* qs = L; float* fs = L + 128; float* red = L + 256; float* st = L + 256 + 2048;
    for (int it = BIDX; it < 1024; it += gridDim.x) {
        const int b = it >> 3, h = it & 7, e4 = (tid & 31) * 4, dg = tid >> 5, d0 = dg * 8;
        __syncthreads();
        if (tid < 128) qs[tid] = z1[(size_t)b * 4096 + h * 128 + tid]; else if (tid < 256) fs[tid - 128] = z1[(size_t)b * 4096 + 1024 + h * 128 + tid - 128];
        const f32x4 iv = *(const f32x4*)(z1 + (size_t)b * 4096 + 2048 + h * 128 + e4);
        __syncthreads();
        const float* s0 = p.shg + ((size_t)it * 128 + d0) * 128 + e4; float* so = p.out + O_HGS + ((size_t)it * 128 + d0) * 128 + e4;
        f32x4 sv[8];
#pragma unroll
        for (int j = 0; j < 8; ++j) sv[j] = *(const f32x4*)(s0 + (size_t)j * 128);
        f32x4 o = {0.f, 0.f, 0.f, 0.f};
#pragma unroll
        for (int j = 0; j < 8; ++j) { const float f = fs[d0 + j]; const f32x4 s = sv[j] * f + iv * (1.f - f); *(f32x4*)(so + (size_t)j * 128) = s; o += s * qs[d0 + j]; }
        *(f32x4*)(red + dg * 128 + e4) = o;
        __syncthreads();
        float tot = 0.f;
        if (tid < 128) {
#pragma unroll
            for (int k = 0; k < 16; ++k) tot += red[k * 128 + tid];
            const float s = wave_sum(tot * tot); if (lane == 0) st[wid] = s; }
        __syncthreads();
        const float rs = rsqrtf((st[0] + st[1]) * (1.f / 128.f) + 1e-6f);
        if (tid < 128) o1s[(size_t)b * 1024 + h * 128 + tid] = f2bf(tot * rs * p.hgnw[h * 128 + tid] * z1[(size_t)b * 4096 + 3072 + h * 128 + tid]);
    }
}

DEVI void phase_final(const int TIDX, const int BIDX, const Params& p) {
    const int wid = TIDX >> 6, lane = TIDX & 63;
    for (int row = (BIDX * 8 + wid) * 2; row < MP + MS; row += gridDim.x * 16) {
        const bool smp = row >= MP; const size_t r = smp ? row - MP : row;
        float* x = p.out + (smp ? O_YS : O_YP) + r * 1024;
        f32x4 v[2][4]; float s0 = 0.f, s1 = 0.f;
#pragma unroll
        for (int i = 0; i < 4; ++i) { v[0][i] = *(const f32x4*)(x + i * 256 + lane * 4); v[1][i] = *(const f32x4*)(x + 1024 + i * 256 + lane * 4); }
#pragma unroll
        for (int i = 0; i < 4; ++i) {
            s0 += v[0][i][0] * v[0][i][0] + v[0][i][1] * v[0][i][1] + v[0][i][2] * v[0][i][2] + v[0][i][3] * v[0][i][3];
            s1 += v[1][i][0] * v[1][i][0] + v[1][i][1] * v[1][i][1] + v[1][i][2] * v[1][i][2] + v[1][i][3] * v[1][i][3];
        }
        s0 = wave_sum(s0); s1 = wave_sum(s1);
        const float r0 = rsqrtf(s0 * (1.0f / 1024.0f) + 1e-6f), r1 = rsqrtf(s1 * (1.0f / 1024.0f) + 1e-6f);
#pragma unroll
        for (int i = 0; i < 4; ++i) {
            const f32x4 w = *(const f32x4*)(p.fnormw + i * 256 + lane * 4);
            *(f32x4*)(x + i * 256 + lane * 4) = v[0][i] * r0 * w; *(f32x4*)(x + 1024 + i * 256 + lane * 4) = v[1][i] * r1 * w;
        }
    }
}

#define GRID_SYNC() do { asm volatile("s_waitcnt vmcnt(0) lgkmcnt(0)" ::: "memory"); cg::this_grid().sync(); } while (0)
constexpr int NPHASE = 13;
__global__ void __launch_bounds__(512, 2) mega(Params p0) {
    extern __shared__ __attribute__((aligned(16))) unsigned char shm[];
    LAS unsigned char* lds = (LAS unsigned char*)shm;
    const int G = gridDim.x;
#define OPQ int oz; asm volatile("s_mov_b32 %0, 0" : "=s"(oz)); int ozv; asm volatile("v_mov_b32 %0, 0" : "=v"(ozv)); \
    Params p = p0; p.ws = p0.ws + oz; p.out = p0.out + oz; const int TIDX = threadIdx.x + ozv, BIDX = blockIdx.x + oz; (void)TIDX; (void)BIDX;
    int my_xcc, my_rank;
    {
        int* sh = (int*)shm;
        if (threadIdx.x == 0) {
            const unsigned x = (unsigned)__builtin_amdgcn_s_getreg((3 << 11) | 20) & 7u;
            sh[0] = (int)x; sh[1] = (int)__hip_atomic_fetch_add((unsigned*)(p0.ws + WS_XCNT) + x * 32, 1u, __ATOMIC_RELAXED, __HIP_MEMORY_SCOPE_AGENT);
        }
        __syncthreads();
        my_xcc = __builtin_amdgcn_readfirstlane(sh[0]); my_rank = __builtin_amdgcn_readfirstlane(sh[1]);
        __syncthreads();
    }
    int gc = blockIdx.x;
    int ph_start = p0.ph_lo;
    if (ph_start == 0) {
        { OPQ phase_prep(TIDX, BIDX, (float*)shm, p); }
#if COOP
        GRID_SYNC();
        {
            bool ok = gridDim.x == 256;
            for (int x = 0; x < 8; ++x) ok = ok && (__hip_atomic_load((unsigned*)(p0.ws + WS_XCNT) + x * 32, __ATOMIC_RELAXED, __HIP_MEMORY_SCOPE_AGENT) == 32u);
            if (ok) gc = my_rank * 8 + my_xcc;
        }
#endif
        ph_start = 1;
    }
    for (int ph = ph_start; ph < p0.ph_hi; ++ph) {
        int la = -1, lb = -1, K = 1024, lda = 1024, ldb = 1024;
        switch (ph) {
        case 1: la = L_IN0; lb = L_IN0S; break;
        case 2: la = L_GA; K = 256; lda = 384; ldb = 256; break;
        case 4: la = L_GB; K = 384; lda = 384; ldb = 384; break;
        case 5: la = L_GLU; lb = L_GLUS; break;
        case 6: la = L_OUT0; lb = L_OUT0S; K = 2048; lda = 2048; ldb = 2048; break;
        case 7: la = L_IN1; lb = L_IN1S; break;
        case 11: la = L_OUT1; lb = L_OUT1S; break;
        default: break;
        }
        for (int jj = 0; jj < 2; ++jj) {
            const int l = jj ? lb : la;
            if (l < 0) continue;
            OPQ
            Sched S; S.list = l; S.G = G; S.c = jj ? G - 1 - gc : gc + oz; S.wsp = p.ws; S.outp = p.out;
            gemm_phase(TIDX, lds, K, lda, ldb, l == L_GLU, S, p);
        }
        __syncthreads();
        switch (ph) {
        case 2: { { OPQ phase_R1(TIDX, BIDX, (bf16_t*)shm, p); } __syncthreads(); { OPQ phase_sret(TIDX, BIDX, (float*)shm, p); } { OPQ phase_ss5(TIDX, BIDX, p); } } break;
        case 3: { { OPQ phase_s5scan(TIDX, BIDX, p); } { OPQ phase_R2(TIDX, BIDX, p); } } break;
        case 4: { OPQ phase_R3(TIDX, BIDX, (bf16_t*)shm, p); } break;
        case 8: { { OPQ phase_H1(TIDX, BIDX, (bf16_t*)shm, p); } __syncthreads(); { OPQ phase_shg(TIDX, BIDX, (float*)shm, p); } } break;
        case 9: { OPQ phase_H2(TIDX, BIDX, p); } break;
        case 10: { OPQ phase_H3(TIDX, BIDX, (bf16_t*)shm, p); } break;
        case 12: { OPQ phase_final(TIDX, BIDX, p); } break;
        default: break;
        }
#if COOP
        if (ph + 1 < p0.ph_hi) GRID_SYNC();
#endif
    }
}

extern "C" void kernel_launch(void* const* d_in, const int* in_sizes, int n_in, void* d_out, int out_size, void* d_ws, size_t ws_size, hipStream_t stream) {
    constexpr size_t kDynLds = 131072;
    static int grid_blocks = 0;
    if (!grid_blocks) {
        hipFuncSetAttribute((const void*)mega, hipFuncAttributeMaxDynamicSharedMemorySize, (int)kDynLds);
        int dev = 0, cus = 0, per_cu = 0;
        hipGetDevice(&dev);
        hipDeviceGetAttribute(&cus, hipDeviceAttributeMultiprocessorCount, dev);
        hipOccupancyMaxActiveBlocksPerMultiprocessor(&per_cu, mega, 512, kDynLds);
        if (per_cu < 1) per_cu = 1;
        grid_blocks = cus;
        if (grid_blocks > 256) grid_blocks = 256;
    }
    Params p{};
    const float** f = (const float**)&p;
    for (int i = 0; i < 25; ++i) f[i] = (const float*)d_in[i];
    p.out = (float*)d_out; p.ws = (char*)d_ws;
#if COOP
    p.ph_lo = 0; p.ph_hi = PH_MAX;
    hipMemsetAsync((char*)d_ws + WS_XCNT, 0, 1024, stream);
    void* args[] = {&p};
    hipError_t e = hipLaunchCooperativeKernel((const void*)mega, dim3(grid_blocks), dim3(512), args, kDynLds, stream);
    if (e != hipSuccess) fprintf(stderr, "cooperative launch failed: %s (grid %d)\n", hipGetErrorString(e), grid_blocks);
#else
    for (int ph = 0; ph < NPHASE; ++ph) {
        p.ph_lo = ph; p.ph_hi = ph + 1;
        hipLaunchKernelGGL(mega, dim3(grid_blocks), dim3(512), kDynLds, stream, p);
    }
#endif
}
```

```cpp
#include <hip/hip_runtime.h>
#include <hip/hip_cooperative_groups.h>
#include <cstdio>
namespace cg = cooperative_groups;

#ifndef PH_MAX
#define PH_MAX 13
#endif
#ifndef COOP
#define COOP 1
#endif

typedef unsigned short bf16_t;
typedef short bf16x8 __attribute__((ext_vector_type(8)));
typedef float f32x4 __attribute__((ext_vector_type(4)));
typedef unsigned u32x4 __attribute__((ext_vector_type(4)));
typedef unsigned u32x2 __attribute__((ext_vector_type(2)));
#define LAS __attribute__((address_space(3)))
#define DEVI __device__ __forceinline__

constexpr int TT = 2048, NBP = 8, MP = 16384, MS = 128, DM = 1024;
constexpr size_t MiB = (size_t)1 << 20;
constexpr size_t O_YP = 0, O_YS = 16777216, O_RETP = 16908288, O_RETS = 17956864, O_S5RP = 34734080, O_S5IP = 34766848,
                 O_S5RS = 34799616, O_S5IS = 35323904, O_HGP = 35848192, O_HGS = 36896768;
constexpr size_t WS_WIN0T = 0, WS_BT1 = 10 * MiB, WS_KT = 18 * MiB, WS_WGLUT = 34 * MiB, WS_WOUT0T = 36 * MiB, WS_WIN1T = 40 * MiB,
                 WS_BT2 = 48 * MiB, WS_Q = 60 * MiB, WS_KN = 76 * MiB, WS_VT = 92 * MiB, WS_SGA = 124 * MiB, WS_SGB = 156 * MiB,
                 WS_A2 = 188 * MiB, WS_Y5 = 0, WS_X1B = 60 * MiB, WS_SG1 = 0, WS_Q1 = 96 * MiB, WS_CUM = 128 * MiB, WS_IT = 192 * MiB,
                 WS_HKV = 32 * MiB;
constexpr size_t WS_MISC = 240 * MiB;
constexpr size_t WS_WOUT1T = WS_MISC;
constexpr size_t WS_ROPE = WS_MISC + 2 * MiB;
constexpr size_t WS_SSQ1 = WS_ROPE + 1280 * 1024;
constexpr size_t WS_SSQ2 = WS_SSQ1 + MiB;
constexpr size_t WS_H0S = WS_SSQ2 + MiB;
constexpr size_t WS_ZS = WS_H0S + 512 * 1024;
constexpr size_t WS_Y5S = WS_ZS + 2560 * 1024;
constexpr size_t WS_MIX0S = WS_Y5S + 512 * 1024;
constexpr size_t WS_X1S = WS_MIX0S + MiB;
constexpr size_t WS_X1SB = WS_X1S + 512 * 1024;
constexpr size_t WS_Z1S = WS_X1SB + 512 * 1024;
constexpr size_t WS_O1S = WS_Z1S + 2 * MiB;
constexpr size_t WS_BBG = WS_O1S + 512 * 1024;
constexpr size_t WS_LAM1 = WS_BBG + 512 * 1024;
constexpr size_t WS_LAM16 = WS_LAM1 + 32 * 1024;
constexpr size_t WS_LB = WS_LAM16 + 32 * 1024;
constexpr size_t WS_SSQ1S = WS_LB + 4096;
constexpr size_t WS_SSQ2S = WS_SSQ1S + MiB;
constexpr size_t WS_END = WS_SSQ2S + MiB;
constexpr size_t WS_XCNT = WS_END;
static_assert(WS_XCNT + 1024 <= 256 * MiB, "workspace overflow");

struct Params {
    const float *xp, *xs, *sret, *s5r, *s5i, *shg, *normw, *fnormw, *win0, *gnw, *lamre, *lamim, *logdt, *bre, *bim, *cre, *cim, *s5d,
        *gluw, *glub, *wout0, *win1, *hglb, *hgnw, *wout1;
    float* out;
    char* ws;
    int ph_lo, ph_hi;
};

DEVI bf16_t f2bf(float f) { unsigned u = __float_as_uint(f); u += 0x7FFFu + ((u >> 16) & 1u); return (bf16_t)(u >> 16); }
DEVI float bf2f(bf16_t b) { return __uint_as_float(((unsigned)b) << 16); }
DEVI unsigned pack2(float lo, float hi) { unsigned r; asm("v_cvt_pk_bf16_f32 %0, %1, %2" : "=v"(r) : "v"(lo), "v"(hi)); return r; }
DEVI float bflo(unsigned w) { return __uint_as_float(w << 16); }
DEVI float bfhi(unsigned w) { return __uint_as_float(w & 0xffff0000u); }
DEVI float sigm(float x) { return __builtin_amdgcn_rcpf(1.f + __builtin_amdgcn_exp2f(-1.4426950408889634f * x)); }
DEVI float silu_(float x) { return x * sigm(x); }
DEVI float gelu_(float x) { const float u = 1.5957691216f * (x + 0.044715f * x * x * x); return x * __builtin_amdgcn_rcpf(1.f + __builtin_amdgcn_exp2f(-1.4426950408889634f * u)); }
DEVI u32x2 pack4(f32x4 v) { u32x2 r; r.x = pack2(v[0], v[1]); r.y = pack2(v[2], v[3]); return r; }
DEVI float wave_sum(float v) {
#pragma unroll
    for (int o = 32; o > 0; o >>= 1) v += __shfl_xor(v, o);
    return v;
}
DEVI float grp16_sum(float v) { v += __shfl_xor(v, 1); v += __shfl_xor(v, 2); v += __shfl_xor(v, 4); v += __shfl_xor(v, 8); return v; }
DEVI f32x4 mfma16(bf16x8 a, bf16x8 b, f32x4 c) { return __builtin_amdgcn_mfma_f32_16x16x32_bf16(a, b, c, 0, 0, 0); }
DEVI float row_rstd16(const float* ssq, size_t row) {
    const f32x4 a = *(const f32x4*)(ssq + row * 4), b = *(const f32x4*)(ssq + (MP + row) * 4), c = *(const f32x4*)(ssq + (2 * (size_t)MP + row) * 4), d = *(const f32x4*)(ssq + (3 * (size_t)MP + row) * 4);
    float s = (a[0] + a[1] + a[2] + a[3]) + (b[0] + b[1] + b[2] + b[3]) + (c[0] + c[1] + c[2] + c[3]) + (d[0] + d[1] + d[2] + d[3]);
    return rsqrtf(s * (1.0f / 1024.0f) + 1e-6f);
}

constexpr int BM = 256, BK = 64, HALF = 128, HTB = HALF * BK * 2, NXCD = 8, WGM = 8;
DEVI int lds_byte(int r, int c) { const int st = (r >> 4) * 2 + (c >> 5), rr = r & 15, cc = c & 31, ob = rr * 64 + cc * 2; return st * 1024 + (ob ^ (((ob >> 9) & 1) << 5)); }
DEVI void stage_rc(int b, int& R, int& C) { const int st = b / 1024, sb = b % 1024, swz = sb ^ (((sb >> 9) & 1) << 5); R = (st >> 1) * 16 + swz / 64; C = (st & 1) * 32 + (swz % 64) / 2; }

enum { K_Q = 0, K_K, K_VT, K_GA, K_U, K_GB, K_SIN0, K_E5, K_Y5, K_GLU, K_SGLU, K_OUT0, K_SOUT0, K_Q1, K_F, K_IT, K_G1, K_SIN1, K_OUT1, K_SOUT1 };
enum { L_IN0 = 0, L_IN0S, L_GA, L_GB, L_GLU, L_GLUS, L_OUT0, L_OUT0S, L_IN1, L_IN1S, L_OUT1, L_OUT1S };

struct Unit { const char* a; const char* b; int kind, pm, pn; };

DEVI void static_order(int L, int nM, int nN, int& pm, int& pn) {
    const int nwg = nM * nN; int wgid = L;
    { const int q = nwg / NXCD, r = nwg % NXCD, xcd = wgid % NXCD, off = wgid / NXCD; wgid = (xcd < r ? xcd * (q + 1) : r * (q + 1) + (xcd - r) * q) + off; }
    const int nig = WGM * nN, gid = wgid / nig, fm = gid * WGM, gsz = (nM - fm) < WGM ? (nM - fm) : WGM;
    pm = fm + ((wgid % nig) % gsz); pn = (wgid % nig) / gsz;
}

struct Sched {
    int list, G, c; char* wsp; float* outp;
    DEVI bool next(int i, Unit& u) const {
        const int L = i * G + c; const char* ws = wsp;
        switch (list) {
        case L_IN0: {
            if (L >= 1280) return false; int pm, pn; static_order(L, 64, 20, pm, pn); u.pm = pm; u.pn = pn;
            const char* h0 = (const char*)(outp + O_RETS);
            if (pn >= 4 && pn < 8) { u.kind = K_VT; u.a = ws + WS_WIN0T + (size_t)(1024 + 256 * (pn - 4)) * 2048; u.b = h0 + (size_t)pm * 256 * 2048; }
            else { u.kind = pn < 2 ? K_Q : pn < 4 ? K_K : pn < 12 ? K_GA : pn < 16 ? K_U : K_GB; u.a = h0 + (size_t)pm * 256 * 2048; u.b = ws + WS_WIN0T + (size_t)pn * 256 * 2048; }
            return true; }
        case L_IN0S: if (L >= 20) return false; u.pm = 0; u.pn = L; u.kind = K_SIN0; u.a = ws + WS_H0S; u.b = ws + WS_WIN0T + (size_t)L * 256 * 2048; return true;
        case L_GA: if (L >= 256) return false; u.pm = L & 3; u.pn = L >> 2; u.kind = K_E5; u.a = ws + WS_A2 + ((size_t)(L >> 2) * 1024 + (L & 3) * 256) * 768; u.b = ws + WS_BT1 + (size_t)(L >> 2) * 256 * 512; return true;
        case L_GB: if (L >= 256) return false; u.pm = L & 3; u.pn = L >> 2; u.kind = K_Y5; u.a = ws + WS_A2 + ((size_t)(L >> 2) * 1024 + (L & 3) * 256) * 768; u.b = ws + WS_BT2 + (size_t)(L >> 2) * 256 * 768; return true;
        case L_GLU: { if (L >= 256) return false; int pm, pn; static_order(L, 64, 4, pm, pn); u.pm = pm; u.pn = pn; u.kind = K_GLU; u.a = ws + WS_Y5 + (size_t)pm * 256 * 32; u.b = ws + WS_WGLUT + (size_t)pn * 256 * 2048; return true; }
        case L_GLUS: if (L >= 4) return false; u.pm = 0; u.pn = L; u.kind = K_SGLU; u.a = ws + WS_Y5S; u.b = ws + WS_WGLUT + (size_t)L * 256 * 2048; return true;
        case L_OUT0: { if (L >= 256) return false; int pm, pn; static_order(L, 64, 4, pm, pn); u.pm = pm; u.pn = pn; u.kind = K_OUT0; u.a = (const char*)(outp + O_HGS) + (size_t)pm * 256 * 4096; u.b = ws + WS_WOUT0T + (size_t)pn * 256 * 4096; return true; }
        case L_OUT0S: if (L >= 4) return false; u.pm = 0; u.pn = L; u.kind = K_SOUT0; u.a = ws + WS_MIX0S; u.b = ws + WS_WOUT0T + (size_t)L * 256 * 4096; return true;
        case L_IN1: {
            if (L >= 1024) return false; int pm, pn; static_order(L, 64, 16, pm, pn); u.pm = pm; u.pn = pn;
            if (pn >= 8 && pn < 12) { u.kind = K_IT; u.a = ws + WS_WIN1T + (size_t)(256 * pn) * 2048; u.b = ws + WS_X1B + (size_t)pm * 256 * 2048; }
            else { u.kind = pn < 4 ? K_Q1 : pn < 8 ? K_F : K_G1; u.a = ws + WS_X1B + (size_t)pm * 256 * 2048; u.b = ws + WS_WIN1T + (size_t)pn * 256 * 2048; }
            return true; }
        case L_IN1S: if (L >= 16) return false; u.pm = 0; u.pn = L; u.kind = K_SIN1; u.a = ws + WS_X1SB; u.b = ws + WS_WIN1T + (size_t)L * 256 * 2048; return true;
        case L_OUT1: { if (L >= 256) return false; int pm, pn; static_order(L, 64, 4, pm, pn); u.pm = pm; u.pn = pn; u.kind = K_OUT1; u.a = ws + WS_Q1 + (size_t)pm * 256 * 2048; u.b = ws + WS_WOUT1T + (size_t)pn * 256 * 2048; return true; }
        case L_OUT1S: if (L >= 4) return false; u.pm = 0; u.pn = L; u.kind = K_SOUT1; u.a = ws + WS_O1S; u.b = ws + WS_WOUT1T + (size_t)L * 256 * 2048; return true;
        }
        return false;
    }
};

DEVI void epilogue(const Params& p, const f32x4 (&acc)[2][2][4][2], const Unit& u, int wr, int wc, int fr, int fq) {
    char* ws = p.ws;
    const int kind = u.kind;
    if (kind == K_Q || kind == K_K) {
        const float* rope = (const float*)(ws + WS_ROPE);
        bf16_t* dst = (bf16_t*)(ws + (kind == K_Q ? WS_Q : WS_KN));
        bf16_t* kt = (bf16_t*)(ws + WS_KT);
        const int tq = kind == K_Q ? u.pn : u.pn - 2;
        const float sc = kind == K_Q ? 1.0f : 0.08838834764831845f;
#pragma unroll
        for (int ai = 0; ai < 2; ++ai) {
#pragma unroll
          for (int mh = 0; mh < 2; ++mh) {
            f32x4 cs[4][2], sn[4][2];
#pragma unroll
            for (int m = mh * 2; m < mh * 2 + 2; ++m)
#pragma unroll
                for (int n = 0; n < 2; ++n) {
                    const int token = u.pm * 256 + ai * 128 + wr * 64 + m * 16 + fr, pos = token & 2047, j = (wc * 32 + n * 16 + fq * 4) & 63;
                    cs[m][n] = *(const f32x4*)(rope + pos * 128 + j); sn[m][n] = *(const f32x4*)(rope + pos * 128 + 64 + j);
                }
#pragma unroll
            for (int m = mh * 2; m < mh * 2 + 2; ++m) {
                const int token = u.pm * 256 + ai * 128 + wr * 64 + m * 16 + fr;
#pragma unroll
                for (int n = 0; n < 2; ++n) {
                    const int w = wc * 32 + n * 16 + fq * 4, hl = w >> 6, j = w & 63, head = 2 * tq + hl;
                    const f32x4 x1 = acc[ai][0][m][n], x2 = acc[ai][1][m][n];
                    const f32x4 y1 = (x1 * cs[m][n] - x2 * sn[m][n]) * sc, y2 = (x1 * sn[m][n] + x2 * cs[m][n]) * sc;
                    bf16_t* d = dst + (size_t)token * 512 + head * 128 + j;
                    *(u32x2*)d = pack4(y1); *(u32x2*)(d + 64) = pack4(y2);
                    if (kind == K_K) {
                        const int b = token >> 11, t = token & 2047;
                        bf16_t* kk = kt + ((size_t)(b * 4 + head) * 128 + j) * 2048 + t;
#pragma unroll
                        for (int i = 0; i < 4; ++i) { kk[(size_t)i * 2048] = f2bf(y1[i]); kk[(size_t)(64 + i) * 2048] = f2bf(y2[i]); }
                    }
                }
            }
          }
        }
    } else if (kind == K_VT || kind == K_IT) {
        const bool isv = kind == K_VT;
        const float* ssq = (const float*)(ws + WS_SSQ1);
        bf16_t* dst = (bf16_t*)(ws + (isv ? WS_VT : WS_IT));
        f32x4 rsa[2][2];
#pragma unroll
        for (int bj = 0; bj < 2; ++bj)
#pragma unroll
            for (int n = 0; n < 2; ++n) {
                const int token = u.pm * 256 + bj * 128 + wc * 32 + n * 16 + fq * 4;
                f32x4 rs = {1.f, 1.f, 1.f, 1.f};
                if (!isv) { rs[0] = row_rstd16(ssq, token); rs[1] = row_rstd16(ssq, token + 1); rs[2] = row_rstd16(ssq, token + 2); rs[3] = row_rstd16(ssq, token + 3); }
                rsa[bj][n] = rs;
            }
#pragma unroll
        for (int bj = 0; bj < 2; ++bj)
#pragma unroll
            for (int n = 0; n < 2; ++n) {
                const int token = u.pm * 256 + bj * 128 + wc * 32 + n * 16 + fq * 4, b = token >> 11, t = token & 2047;
                const f32x4 rs = rsa[bj][n];
#pragma unroll
                for (int ai = 0; ai < 2; ++ai)
#pragma unroll
                    for (int m = 0; m < 4; ++m) {
                        const int row = ai * 128 + wr * 64 + m * 16 + fr;
                        size_t off;
                        if (isv) off = ((size_t)(b * 4 + (u.pn - 4)) * 256 + row) * 2048 + t;
                        else { const int eg = (u.pn - 8) * 256 + row; off = ((size_t)(b * 8 + (eg >> 7)) * 128 + (eg & 127)) * 2048 + t; }
                        *(u32x2*)(dst + off) = pack4(acc[ai][bj][m][n] * rs);
                    }
            }
    } else if (kind == K_GA || kind == K_GB || kind == K_U) {
#pragma unroll
        for (int ai = 0; ai < 2; ++ai)
#pragma unroll
            for (int m = 0; m < 4; ++m) {
                const int token = u.pm * 256 + ai * 128 + wr * 64 + m * 16 + fr;
#pragma unroll
                for (int bj = 0; bj < 2; ++bj)
#pragma unroll
                    for (int n = 0; n < 2; ++n) {
                        const int cl = bj * 128 + wc * 32 + n * 16 + fq * 4;
                        f32x4 v = acc[ai][bj][m][n];
                        if (kind == K_U) {
                            const int cu = (u.pn - 12) * 256 + cl, g = cu >> 4, c = cu & 15;
                            bf16_t* d = (bf16_t*)(ws + WS_A2) + ((size_t)g * 1024 + (token >> 4)) * 384 + (token & 15) * 16 + c;
                            *(u32x2*)d = pack4(v);
                        } else {
                            v[0] = silu_(v[0]); v[1] = silu_(v[1]); v[2] = silu_(v[2]); v[3] = silu_(v[3]);
                            bf16_t* d = (bf16_t*)(ws + (kind == K_GA ? WS_SGA : WS_SGB)) + (size_t)token * 1024 + (u.pn - (kind == K_GA ? 8 : 16)) * 256 + cl;
                            *(u32x2*)d = pack4(v);
                        }
                    }
            }
    } else if (kind == K_SIN0) {
        const float* rope = (const float*)(ws + WS_ROPE) + 2048 * 128;
        float* zs = (float*)(ws + WS_ZS);
#pragma unroll
        for (int m = 0; m < 4; ++m) {
            const int row = wr * 64 + m * 16 + fr;
            if (u.pn < 4) {
                const float sc = u.pn < 2 ? 1.0f : 0.08838834764831845f;
#pragma unroll
                for (int n = 0; n < 2; ++n) {
                    const int w = wc * 32 + n * 16 + fq * 4, hl = w >> 6, j = w & 63;
                    const f32x4 cs = *(const f32x4*)(rope + j), sn = *(const f32x4*)(rope + 64 + j);
                    const f32x4 x1 = acc[0][0][m][n], x2 = acc[0][1][m][n];
                    float* d = zs + (size_t)row * 5120 + u.pn * 256 + hl * 128 + j;
                    *(f32x4*)d = (x1 * cs - x2 * sn) * sc; *(f32x4*)(d + 64) = (x1 * sn + x2 * cs) * sc;
                }
            } else {
                const bool gate = (u.pn >= 8 && u.pn < 12) || u.pn >= 16;
#pragma unroll
                for (int bj = 0; bj < 2; ++bj)
#pragma unroll
                    for (int n = 0; n < 2; ++n) {
                        f32x4 v = acc[0][bj][m][n];
                        if (gate) { v[0] = silu_(v[0]); v[1] = silu_(v[1]); v[2] = silu_(v[2]); v[3] = silu_(v[3]); }
                        *(f32x4*)(zs + (size_t)row * 5120 + u.pn * 256 + bj * 128 + wc * 32 + n * 16 + fq * 4) = v;
                    }
            }
        }
    } else if (kind == K_E5) {
        float* e5 = (float*)(p.out + O_HGS);
#pragma unroll
        for (int ai = 0; ai < 2; ++ai)
#pragma unroll
            for (int m = 0; m < 4; ++m) {
                const int row = u.pm * 256 + ai * 128 + wr * 64 + m * 16 + fr;
#pragma unroll
                for (int n = 0; n < 2; ++n) *(f32x4*)(e5 + ((size_t)u.pn * 1024 + row) * 128 + wc * 32 + n * 16 + fq * 4) = acc[ai][0][m][n];
            }
    } else if (kind == K_Y5) {
        const bf16_t* a2 = (const bf16_t*)(ws + WS_A2);
        bf16_t* y5 = (bf16_t*)(ws + WS_Y5);
        const int g = u.pn;
        f32x4 ddv[2][2];
#pragma unroll
        for (int bj = 0; bj < 2; ++bj)
#pragma unroll
            for (int n = 0; n < 2; ++n) ddv[bj][n] = *(const f32x4*)(p.s5d + g * 16 + ((bj * 128 + wc * 32 + n * 16 + fq * 4) & 15));
#pragma unroll
        for (int ai = 0; ai < 2; ++ai) {
#pragma unroll
          for (int mh = 0; mh < 2; ++mh) {
            u32x2 uv[4][2][2];
#pragma unroll
            for (int m = mh * 2; m < mh * 2 + 2; ++m)
#pragma unroll
                for (int bj = 0; bj < 2; ++bj)
#pragma unroll
                    for (int n = 0; n < 2; ++n) uv[m][bj][n] = *(const u32x2*)(a2 + ((size_t)g * 1024 + u.pm * 256 + ai * 128 + wr * 64 + m * 16 + fr) * 384 + bj * 128 + wc * 32 + n * 16 + fq * 4);
#pragma unroll
            for (int m = mh * 2; m < mh * 2 + 2; ++m) {
                const int row = u.pm * 256 + ai * 128 + wr * 64 + m * 16 + fr;
#pragma unroll
                for (int bj = 0; bj < 2; ++bj)
#pragma unroll
                    for (int n = 0; n < 2; ++n) {
                        const int col = bj * 128 + wc * 32 + n * 16 + fq * 4;
                        const u32x2 uu = uv[m][bj][n]; const f32x4 dd = ddv[bj][n];
                        f32x4 v = acc[ai][bj][m][n];
                        v[0] = gelu_(v[0] + dd[0] * bflo(uu.x)); v[1] = gelu_(v[1] + dd[1] * bfhi(uu.x));
                        v[2] = gelu_(v[2] + dd[2] * bflo(uu.y)); v[3] = gelu_(v[3] + dd[3] * bfhi(uu.y));
                        *(u32x2*)(y5 + ((size_t)g * 1024 + row) * 256 + col) = pack4(v);
                    }
            }
          }
        }
    } else if (kind == K_SGLU) {
        const bf16_t* y5 = (const bf16_t*)(ws + WS_Y5S);
        const float* zs = (const float*)(ws + WS_ZS);
        bf16_t* mix = (bf16_t*)(ws + WS_MIX0S);
#pragma unroll
        for (int m = 0; m < 4; ++m) {
            const size_t token = (size_t)wr * 64 + m * 16 + fr;
#pragma unroll
            for (int bj = 0; bj < 2; ++bj)
#pragma unroll
                for (int n = 0; n < 2; ++n) {
                    const int col = u.pn * 256 + bj * 128 + wc * 32 + n * 16 + fq * 4;
                    const f32x4 bb = *(const f32x4*)(p.glub + col);
                    const u32x2 yy = *(const u32x2*)(y5 + token * 1024 + col);
                    const f32x4 gg = *(const f32x4*)(zs + token * 5120 + 4096 + col);
                    f32x4 v = acc[0][bj][m][n] + bb;
                    v[0] = bflo(yy.x) * sigm(v[0]) * gg[0]; v[1] = bfhi(yy.x) * sigm(v[1]) * gg[1];
                    v[2] = bflo(yy.y) * sigm(v[2]) * gg[2]; v[3] = bfhi(yy.y) * sigm(v[3]) * gg[3];
                    *(u32x2*)(mix + token * 2048 + 1024 + col) = pack4(v);
                }
        }
    } else if (kind == K_GLU) {
        const bf16_t* y5 = (const bf16_t*)(ws + WS_Y5);
        const bf16_t* sgb = (const bf16_t*)(ws + WS_SGB);
        bf16_t* mix = (bf16_t*)(p.out + O_HGS);
        f32x4 bbv[2][2];
#pragma unroll
        for (int bj = 0; bj < 2; ++bj)
#pragma unroll
            for (int n = 0; n < 2; ++n) bbv[bj][n] = *(const f32x4*)(p.glub + u.pn * 256 + bj * 128 + wc * 32 + n * 16 + fq * 4);
#pragma unroll
        for (int ai = 0; ai < 2; ++ai)
#pragma unroll
          for (int mh = 0; mh < 2; ++mh) {
            u32x2 yv[4][2][2], gp[4][2][2];
#pragma unroll
            for (int m = mh * 2; m < mh * 2 + 2; ++m)
#pragma unroll
                for (int bj = 0; bj < 2; ++bj)
#pragma unroll
                    for (int n = 0; n < 2; ++n) {
                        const size_t token = (size_t)u.pm * 256 + ai * 128 + wr * 64 + m * 16 + fr; const int col = u.pn * 256 + bj * 128 + wc * 32 + n * 16 + fq * 4;
                        yv[m][bj][n] = *(const u32x2*)(y5 + ((size_t)(col >> 4) * MP + token) * 16 + (col & 15));
                        gp[m][bj][n] = *(const u32x2*)(sgb + token * 1024 + col);
                    }
#pragma unroll
            for (int m = mh * 2; m < mh * 2 + 2; ++m) {
                const size_t token = (size_t)u.pm * 256 + ai * 128 + wr * 64 + m * 16 + fr;
#pragma unroll
                for (int bj = 0; bj < 2; ++bj)
#pragma unroll
                    for (int n = 0; n < 2; ++n) {
                        const int col = u.pn * 256 + bj * 128 + wc * 32 + n * 16 + fq * 4;
                        const u32x2 yy = yv[m][bj][n], t = gp[m][bj][n];
                        f32x4 v = acc[ai][bj][m][n] + bbv[bj][n];
                        v[0] = bflo(yy.x) * sigm(v[0]) * bflo(t.x); v[1] = bfhi(yy.x) * sigm(v[1]) * bfhi(t.x);
                        v[2] = bflo(yy.y) * sigm(v[2]) * bflo(t.y); v[3] = bfhi(yy.y) * sigm(v[3]) * bfhi(t.y);
                        *(u32x2*)(mix + token * 2048 + 1024 + col) = pack4(v);
                    }
            }
          }
    } else if (kind == K_OUT0 || kind == K_SOUT0 || kind == K_OUT1 || kind == K_SOUT1) {
        const bool smp = kind == K_SOUT0 || kind == K_SOUT1, l0 = kind == K_OUT0 || kind == K_SOUT0;
        const float* res = l0 ? (smp ? p.xs : p.xp) : (smp ? (const float*)(ws + WS_X1S) : p.out + O_YP);
        float* dst = l0 ? (smp ? (float*)(ws + WS_X1S) : p.out + O_YP) : (smp ? p.out + O_YS : p.out + O_YP);
        bf16_t* dstb = (bf16_t*)(ws + (smp ? WS_X1SB : WS_X1B));
        float* ssq = (float*)(ws + (l0 ? (smp ? WS_SSQ1S : WS_SSQ1) : (smp ? WS_SSQ2S : WS_SSQ2)));
#pragma unroll
        for (int ai = 0; ai < 2; ++ai) {
            if (smp && ai) break;
#pragma unroll
          for (int mh = 0; mh < 2; ++mh) {
            f32x4 rv[4][2][2];
#pragma unroll
            for (int m = mh * 2; m < mh * 2 + 2; ++m)
#pragma unroll
                for (int bj = 0; bj < 2; ++bj)
#pragma unroll
                    for (int n = 0; n < 2; ++n) rv[m][bj][n] = *(const f32x4*)(res + ((size_t)u.pm * 256 + ai * 128 + wr * 64 + m * 16 + fr) * 1024 + u.pn * 256 + bj * 128 + wc * 32 + n * 16 + fq * 4);
#pragma unroll
            for (int m = mh * 2; m < mh * 2 + 2; ++m) {
                const size_t token = (size_t)u.pm * 256 + ai * 128 + wr * 64 + m * 16 + fr;
                float s = 0.f;
#pragma unroll
                for (int bj = 0; bj < 2; ++bj)
#pragma unroll
                    for (int n = 0; n < 2; ++n) {
                        const int col = u.pn * 256 + bj * 128 + wc * 32 + n * 16 + fq * 4;
                        const f32x4 v = acc[ai][bj][m][n] + rv[m][bj][n];
                        *(f32x4*)(dst + token * 1024 + col) = v;
                        if (l0) *(u32x2*)(dstb + token * 1024 + col) = pack4(v);
                        s += v[0] * v[0] + v[1] * v[1] + v[2] * v[2] + v[3] * v[3];
                    }
                s += __shfl_xor(s, 16); s += __shfl_xor(s, 32);
                if (fq == 0) ssq[((size_t)u.pn * MP + token) * 4 + wc] = s;
            }
          }
        }
    } else if (kind == K_Q1 || kind == K_F || kind == K_G1) {
        const float* ssq = (const float*)(ws + WS_SSQ1);
        const float* lb = (const float*)(ws + WS_LB);
#pragma unroll
        for (int ai = 0; ai < 2; ++ai) {
            float rr[4];
#pragma unroll
            for (int m = 0; m < 4; ++m) rr[m] = row_rstd16(ssq, (size_t)u.pm * 256 + ai * 128 + wr * 64 + m * 16 + fr);
            __builtin_amdgcn_sched_barrier(0);
#pragma unroll
            for (int m = 0; m < 4; ++m) {
                const size_t token = (size_t)u.pm * 256 + ai * 128 + wr * 64 + m * 16 + fr;
                const float r = rr[m];
#pragma unroll
                for (int bj = 0; bj < 2; ++bj)
#pragma unroll
                    for (int n = 0; n < 2; ++n) {
                        const int cl = (u.pn & 3) * 256 + bj * 128 + wc * 32 + n * 16 + fq * 4;
                        f32x4 v = acc[ai][bj][m][n] * r;
                        if (kind == K_F) {
                            const f32x4 l = *(const f32x4*)(lb + cl);
#pragma unroll
                            for (int i = 0; i < 4; ++i) v[i] = __logf(l[i] + (1.f - l[i]) * sigm(v[i]));
                            *(f32x4*)((float*)(ws + WS_CUM) + token * 1024 + cl) = v;
                        } else {
                            v[0] = silu_(v[0]); v[1] = silu_(v[1]); v[2] = silu_(v[2]); v[3] = silu_(v[3]);
                            *(u32x2*)((bf16_t*)(ws + (kind == K_Q1 ? WS_Q1 : WS_SG1)) + token * 1024 + cl) = pack4(v);
                        }
                    }
            }
        }
    } else if (kind == K_SIN1) {
        const float* ssq = (const float*)(ws + WS_SSQ1S);
        const float* lb = (const float*)(ws + WS_LB);
        float* z1 = (float*)(ws + WS_Z1S);
#pragma unroll
        for (int m = 0; m < 4; ++m) {
            const size_t row = wr * 64 + m * 16 + fr;
            const float r = row_rstd16(ssq, row);
            const int ty = u.pn >> 2;
#pragma unroll
            for (int bj = 0; bj < 2; ++bj)
#pragma unroll
                for (int n = 0; n < 2; ++n) {
                    const int cl = (u.pn & 3) * 256 + bj * 128 + wc * 32 + n * 16 + fq * 4;
                    f32x4 v = acc[0][bj][m][n] * r;
                    if (ty == 1) { const f32x4 l = *(const f32x4*)(lb + cl);
#pragma unroll
                        for (int i = 0; i < 4; ++i) v[i] = l[i] + (1.f - l[i]) * sigm(v[i]); }
                    else if (ty != 2) { v[0] = silu_(v[0]); v[1] = silu_(v[1]); v[2] = silu_(v[2]); v[3] = silu_(v[3]); }
                    *(f32x4*)(z1 + row * 4096 + ty * 1024 + cl) = v;
                }
        }
    }
}

DEVI void gemm_phase(const int TIDX, LAS unsigned char* lds, const int K, const int lda, const int ldb, const bool ga, const Sched S, const Params& P) {
    const int tid = TIDX, wid = __builtin_amdgcn_readfirstlane(tid >> 6), lane = tid & 63, wr = wid >> 2, wc = wid & 3, fr = lane & 15, fq = lane >> 4;
    const int nt = K / BK;
    unsigned voffA[2], voffB[2];
#pragma unroll
    for (int i = 0; i < 2; ++i) { int R, C; stage_rc(tid * 16 + i * 8192, R, C); voffA[i] = ga ? (unsigned)(R * 32 + (C >> 4) * (MP * 32) + (C & 15) * 2) : (unsigned)(R * lda + C) * 2u; voffB[i] = (unsigned)(R * ldb + C) * 2u; }
    const size_t kstep = (size_t)(BK * 2), kstepA = ga ? (size_t)4 * MP * 32 : kstep;
    const size_t hstepA = ga ? (size_t)HALF * 32 : (size_t)HALF * lda * 2, hstepB = (size_t)HALF * ldb * 2;
    const unsigned ldsw = (unsigned)wid * 1024u;
    const int aoff = lds_byte(wr * 64 + fr, fq * 8), boff = lds_byte(wc * 32 + fr, fq * 8);
#define PG8_SA(b, h) (((b) * 2 + (h)) * HTB)
#define PG8_SB(b, h) ((4 + (b) * 2 + (h)) * HTB)
#define PG8_STAGE(bufoff, gbase, voff) do { _Pragma("unroll") for (int _i = 0; _i < 2; ++_i) \
        __builtin_amdgcn_global_load_lds((const unsigned*)((const char*)(gbase) + (voff)[_i]), (LAS unsigned*)(lds + (bufoff) + ldsw + _i * 8192), 16, 0, 0); } while (0)
#define PG8_LDA(dst, b, h) do { _Pragma("unroll") for (int m = 0; m < 4; ++m) _Pragma("unroll") for (int k = 0; k < 2; ++k) dst[m][k] = *(const LAS bf16x8*)(lds + PG8_SA(b, h) + aoff + m * 2048 + k * 1024); } while (0)
#define PG8_LDB(dst, b, h) do { _Pragma("unroll") for (int n = 0; n < 2; ++n) _Pragma("unroll") for (int k = 0; k < 2; ++k) dst[n][k] = *(const LAS bf16x8*)(lds + PG8_SB(b, h) + boff + n * 2048 + k * 1024); } while (0)
#define PG8_MMA(ai, bj, At, Bt) do { __builtin_amdgcn_s_setprio(1); _Pragma("unroll") for (int m = 0; m < 4; ++m) _Pragma("unroll") for (int n = 0; n < 2; ++n) _Pragma("unroll") for (int k = 0; k < 2; ++k) \
        acc[ai][bj][m][n] = __builtin_amdgcn_mfma_f32_16x16x32_bf16(Bt[n][k], At[m][k], acc[ai][bj][m][n], 0, 0, 0); __builtin_amdgcn_s_setprio(0); } while (0)
#define PG8_WAIT_V(n) asm volatile("s_waitcnt vmcnt(" #n ")" ::: "memory")
#define PG8_WAIT_L(n) asm volatile("s_waitcnt lgkmcnt(" #n ")" ::: "memory")
#define PG8_BAR __builtin_amdgcn_s_barrier()
#define PG8_SCHED __builtin_amdgcn_sched_barrier(0)
    Unit cur, nxt; int ui = 0;
    if (!S.next(0, cur)) return;
    f32x4 acc[2][2][4][2];
#pragma unroll
    for (int a = 0; a < 2; ++a)
#pragma unroll
        for (int b = 0; b < 2; ++b)
#pragma unroll
            for (int m = 0; m < 4; ++m)
#pragma unroll
                for (int n = 0; n < 2; ++n) acc[a][b][m][n] = (f32x4){0.f, 0.f, 0.f, 0.f};
    bf16x8 At[4][2], B0[2][2], B1[2][2];
    const char* cA = cur.a; const char* cB = cur.b;
    PG8_STAGE(PG8_SB(0, 0), cB, voffB); PG8_STAGE(PG8_SA(0, 0), cA, voffA); PG8_STAGE(PG8_SB(0, 1), cB + hstepB, voffB); PG8_STAGE(PG8_SA(0, 1), cA + hstepA, voffA);
    if (wr == 1) PG8_BAR;
    PG8_WAIT_V(4); PG8_BAR;
    PG8_STAGE(PG8_SB(1, 0), cB + kstep, voffB); PG8_STAGE(PG8_SA(1, 0), cA + kstepA, voffA); PG8_STAGE(PG8_SB(1, 1), cB + hstepB + kstep, voffB);
    PG8_WAIT_V(6); PG8_BAR;
    for (;;) {
        const bool has_next = S.next(ui + 1, nxt);
        const char* nA = has_next ? nxt.a : cA; const char* nB = has_next ? nxt.b : cB;
        for (int t = 0; t < nt; t += 2) {
            const bool last = (t == nt - 2);
            const char* a1 = cA + (size_t)(t + 1) * kstepA;
            const char* a2 = last ? nA : cA + (size_t)(t + 2) * kstepA; const char* b2 = last ? nB : cB + (size_t)(t + 2) * kstep;
            const char* a3 = a2 + kstepA; const char* b3 = b2 + kstep;
            PG8_LDB(B0, 0, 0); PG8_SCHED; PG8_LDA(At, 0, 0); PG8_STAGE(PG8_SA(1, 1), a1 + hstepA, voffA);
            PG8_WAIT_L(8); PG8_BAR; PG8_WAIT_L(0); PG8_MMA(0, 0, At, B0); PG8_BAR; PG8_SCHED;
            PG8_LDB(B1, 0, 1); PG8_STAGE(PG8_SB(0, 0), b2, voffB);
            PG8_BAR; PG8_WAIT_L(0); PG8_MMA(0, 1, At, B1); PG8_BAR;
            PG8_LDA(At, 0, 1); PG8_STAGE(PG8_SA(0, 0), a2, voffA);
            PG8_BAR; PG8_WAIT_L(0); PG8_MMA(1, 0, At, B0); PG8_BAR; PG8_SCHED;
            PG8_STAGE(PG8_SB(0, 1), b2 + hstepB, voffB);
            PG8_WAIT_V(6); PG8_BAR; PG8_MMA(1, 1, At, B1); PG8_BAR;
            PG8_LDB(B0, 1, 0); PG8_SCHED; PG8_LDA(At, 1, 0); PG8_STAGE(PG8_SA(0, 1), a2 + hstepA, voffA);
            PG8_WAIT_L(8); PG8_BAR; PG8_WAIT_L(0); PG8_MMA(0, 0, At, B0); PG8_BAR; PG8_SCHED;
            PG8_LDB(B1, 1, 1); PG8_STAGE(PG8_SB(1, 0), b3, voffB);
            PG8_BAR; PG8_WAIT_L(0); PG8_MMA(0, 1, At, B1); PG8_BAR;
            PG8_LDA(At, 1, 1); PG8_STAGE(PG8_SA(1, 0), a3, voffA);
            PG8_BAR; PG8_WAIT_L(0); PG8_MMA(1, 0, At, B0); PG8_BAR; PG8_SCHED;
            PG8_STAGE(PG8_SB(1, 1), b3 + hstepB, voffB);
            PG8_WAIT_V(6); PG8_BAR; PG8_MMA(1, 1, At, B1); PG8_BAR;
        }
        { int ozv; asm volatile("v_mov_b32 %0, 0" : "=v"(ozv)); epilogue(P, acc, cur, wr, wc, fr + ozv, fq + ozv); }
        if (!has_next) break;
#pragma unroll
        for (int a = 0; a < 2; ++a)
#pragma unroll
            for (int b = 0; b < 2; ++b)
#pragma unroll
                for (int m = 0; m < 4; ++m)
#pragma unroll
                    for (int n = 0; n < 2; ++n) acc[a][b][m][n] = (f32x4){0.f, 0.f, 0.f, 0.f};
        cur = nxt; cA = nA; cB = nB; ++ui;
    }
    PG8_WAIT_V(0);
    if (wr == 0) PG8_BAR;
    PG8_BAR;
}

DEVI void prep_transpose(const int TIDX, const int BIDX, float* tile, const float* src, int K, int N, bf16_t* dst, const float* kscale, bool permqk, int job0, int& jobbase, int gsz) {
    (void)tile;
    const int nk8 = K / 8, ntn = N / 64, njobs = ntn * (nk8 / 8), lane = TIDX & 63, wid = TIDX >> 6;
    for (int jb = job0 - jobbase; jb < njobs; jb += gsz) {
        if (jb < 0) continue;
        const int tn = jb / (nk8 / 8), tk = jb % (nk8 / 8), n0 = tn * 64, k0 = tk * 64 + wid * 8;
        int c0 = n0;
        if (permqk && n0 < 1024) { const int tile_ = n0 >> 8, cp = n0 & 255, bj = cp >> 7, w = cp & 127; c0 = tile_ * 256 + (w >> 6) * 128 + bj * 64; }
        float v[8];
#pragma unroll
        for (int j = 0; j < 8; ++j) v[j] = src[(size_t)(k0 + j) * N + c0 + lane] * (kscale ? kscale[k0 + j] : 1.f);
        u32x4 o; o.x = pack2(v[0], v[1]); o.y = pack2(v[2], v[3]); o.z = pack2(v[4], v[5]); o.w = pack2(v[6], v[7]);
        *(u32x4*)(dst + (size_t)(n0 + lane) * K + k0) = o;
    }
    jobbase += njobs;
}

DEVI void prep_s5_tables(const int TIDX, const int BIDX, float* L, const Params& p, int g) {
    float* pwr = L;
    float* pwi = pwr + 17 * 64;
    float* bbr = pwi + 17 * 64;
    float* bbi = bbr + 1024;
    float* cr = bbi + 1024;
    float* ci = cr + 1024;
    float* kg = ci + 1024;
    const int tid = TIDX;
    char* ws = p.ws;
    __syncthreads();
    {
        const double dt = exp((double)p.logdt[g]);
        for (int i = tid; i < 17 * 64; i += 512) {
            const int t = i >> 6, pp = i & 63;
            const double lr = p.lamre[g * 64 + pp], li = p.lamim[g * 64 + pp];
            const double mag = exp(lr * dt * t), ang = li * dt * t;
            pwr[t * 64 + pp] = (float)(mag * cos(ang)); pwi[t * 64 + pp] = (float)(mag * sin(ang));
        }
        for (int i = tid; i < 1024; i += 512) {
            const int pp = i >> 4, c = i & 15;
            const double lr = p.lamre[g * 64 + pp], li = p.lamim[g * 64 + pp];
            const double mag = exp(lr * dt), ang = li * dt, lbr = mag * cos(ang), lbi = mag * sin(ang);
            const double nr = lbr - 1.0, den = lr * lr + li * li, fr = (nr * lr + lbi * li) / den, fi = (lbi * lr - nr * li) / den;
            const double br = p.bre[(g * 64 + pp) * 16 + c], bi = p.bim[(g * 64 + pp) * 16 + c];
            const float xr = (float)(fr * br - fi * bi), xi = (float)(fr * bi + fi * br);
            bbr[i] = xr; bbi[i] = xi;
            float* bbg = (float*)(ws + WS_BBG); bbg[(g * 1024 + i) * 2] = xr; bbg[(g * 1024 + i) * 2 + 1] = xi;
            if (c == 0) { float* lam1 = (float*)(ws + WS_LAM1); lam1[(g * 64 + pp) * 2] = (float)lbr; lam1[(g * 64 + pp) * 2 + 1] = (float)lbi; }
        }
    }
    __syncthreads();
    if (tid < 64) { float* lam16 = (float*)(ws + WS_LAM16); lam16[(g * 64 + tid) * 2] = pwr[16 * 64 + tid]; lam16[(g * 64 + tid) * 2 + 1] = pwi[16 * 64 + tid]; }
    for (int i = tid; i < 1024; i += 512) { cr[i] = p.cre[g * 1024 + i]; ci[i] = p.cim[g * 1024 + i]; }
    __syncthreads();
    for (int i = tid; i < 4096; i += 512) {
        const int tau = i >> 8, c = (i >> 4) & 15, cp = i & 15;
        float s = 0.f;
        for (int pp = 0; pp < 64; ++pp) {
            const float a = pwr[tau * 64 + pp], b = pwi[tau * 64 + pp], xr = bbr[pp * 16 + cp], xi = bbi[pp * 16 + cp];
            s += cr[c * 64 + pp] * (a * xr - b * xi) - ci[c * 64 + pp] * (a * xi + b * xr);
        }
        kg[i] = s;
    }
    __syncthreads();
    bf16_t* bt2 = (bf16_t*)(ws + WS_BT2) + (size_t)g * 256 * 384;
    for (int i = tid; i < 256 * 48; i += 512) {
        const int n = i / 48, k8 = (i % 48) * 8, t = n >> 4, c = n & 15;
        float v[8];
#pragma unroll
        for (int j = 0; j < 8; ++j) {
            const int k = k8 + j;
            if (k < 256) { const int s = k >> 4, cp = k & 15; v[j] = t >= s ? kg[(t - s) * 256 + c * 16 + cp] : 0.f; }
            else { const int q = k - 256, pp = q & 63; const float a = pwr[(t + 1) * 64 + pp], b = pwi[(t + 1) * 64 + pp];
                v[j] = q < 64 ? (cr[c * 64 + pp] * a - ci[c * 64 + pp] * b) : -(cr[c * 64 + pp] * b + ci[c * 64 + pp] * a); }
        }
        u32x4 o; o.x = pack2(v[0], v[1]); o.y = pack2(v[2], v[3]); o.z = pack2(v[4], v[5]); o.w = pack2(v[6], v[7]);
        *(u32x4*)(bt2 + (size_t)n * 384 + k8) = o;
    }
    bf16_t* bt1 = (bf16_t*)(ws + WS_BT1) + (size_t)g * 256 * 256;
    for (int i = tid; i < 256 * 32; i += 512) {
        const int n = i >> 5, k8 = (i & 31) * 8;
        float v[8];
#pragma unroll
        for (int j = 0; j < 8; ++j) {
            const int k = k8 + j, s = k >> 4, cp = k & 15;
            if (n >= 128) v[j] = 0.f;
            else { const int pp = n & 63; const float a = pwr[(15 - s) * 64 + pp], b = pwi[(15 - s) * 64 + pp], xr = bbr[pp * 16 + cp], xi = bbi[pp * 16 + cp];
                v[j] = n < 64 ? (a * xr - b * xi) : (a * xi + b * xr); }
        }
        u32x4 o; o.x = pack2(v[0], v[1]); o.y = pack2(v[2], v[3]); o.z = pack2(v[4], v[5]); o.w = pack2(v[6], v[7]);
        *(u32x4*)(bt1 + (size_t)n * 256 + k8) = o;
    }
}

DEVI void phase_prep(const int TIDX, const int BIDX, float* L, const Params& p) {
    const int tid = TIDX, bid = BIDX, G = gridDim.x, lane = tid & 63, wid = tid >> 6;
    char* ws = p.ws;
    for (int g = G - 1 - bid; g < 64; g += G) if (g >= 0) prep_s5_tables(TIDX, BIDX, L, p, g);
    __syncthreads();
    const int GT = G > 64 ? G - 64 : G;
    const int tb = (G > 64 && bid >= GT) ? (1 << 28) : bid;
    int jobbase = 0;
    prep_transpose(TIDX, BIDX, L, p.win0, 1024, 5120, (bf16_t*)(ws + WS_WIN0T), nullptr, true, tb, jobbase, GT);
    prep_transpose(TIDX, BIDX, L, p.gluw, 1024, 1024, (bf16_t*)(ws + WS_WGLUT), nullptr, false, tb, jobbase, GT);
    prep_transpose(TIDX, BIDX, L, p.wout0, 2048, 1024, (bf16_t*)(ws + WS_WOUT0T), nullptr, false, tb, jobbase, GT);
    prep_transpose(TIDX, BIDX, L, p.win1, 1024, 4096, (bf16_t*)(ws + WS_WIN1T), p.normw + 1024, false, tb, jobbase, GT);
    prep_transpose(TIDX, BIDX, L, p.wout1, 1024, 1024, (bf16_t*)(ws + WS_WOUT1T), nullptr, false, tb, jobbase, GT);
    bf16_t* h0 = (bf16_t*)(p.out + O_RETS); bf16_t* h0s = (bf16_t*)(ws + WS_H0S);
    for (int row = bid * 8 + wid; row < MP + 256; row += G * 8) {
        bf16_t* d = row < MP ? h0 + (size_t)row * 1024 : h0s + (size_t)(row - MP) * 1024;
        if (row >= MP + MS) { for (int i = 0; i < 4; ++i) *(u32x2*)(d + i * 256 + lane * 4) = (u32x2){0u, 0u}; continue; }
        const float* x = row < MP ? p.xp + (size_t)row * 1024 : p.xs + (size_t)(row - MP) * 1024;
        f32x4 v[4]; float s = 0.f;
#pragma unroll
        for (int i = 0; i < 4; ++i) { v[i] = *(const f32x4*)(x + i * 256 + lane * 4); s += v[i][0] * v[i][0] + v[i][1] * v[i][1] + v[i][2] * v[i][2] + v[i][3] * v[i][3]; }
        s = wave_sum(s);
        const float r = rsqrtf(s * (1.0f / 1024.0f) + 1e-6f);
#pragma unroll
        for (int i = 0; i < 4; ++i) { const f32x4 w = *(const f32x4*)(p.normw + i * 256 + lane * 4); *(u32x2*)(d + i * 256 + lane * 4) = pack4(v[i] * r * w); }
    }
    for (int i = bid * 512 + tid; i < 128 * 1024 / 8; i += G * 512) {
        const u32x4 z = {0u, 0u, 0u, 0u};
        *(u32x4*)((bf16_t*)(ws + WS_Y5S) + 128 * 1024 + (size_t)i * 8) = z;
        *(u32x4*)((bf16_t*)(ws + WS_X1SB) + 128 * 1024 + (size_t)i * 8) = z;
        *(u32x4*)((bf16_t*)(ws + WS_O1S) + 128 * 1024 + (size_t)i * 8) = z;
        *(u32x4*)((bf16_t*)(ws + WS_MIX0S) + 128 * 2048 + (size_t)i * 16) = z;
        *(u32x4*)((bf16_t*)(ws + WS_MIX0S) + 128 * 2048 + (size_t)i * 16 + 8) = z;
    }
    float* rope = (float*)(ws + WS_ROPE);
    for (int i = bid * 512 + tid; i < 2049 * 64; i += G * 512) {
        const int pr = i >> 6, j = i & 63; const double pos = pr == 2048 ? 16384.0 : (double)pr;
        const double inv = exp2(-(double)j * (13.287712379549449 / 64.0));
        const double rev = pos * inv * 0.15915494309189535; const double fr = rev - floor(rev); const double a = fr * 6.283185307179586;
        rope[pr * 128 + j] = (float)cos(a); rope[pr * 128 + 64 + j] = (float)sin(a);
    }
    float* lb = (float*)(ws + WS_LB);
    for (int i = bid * 512 + tid; i < 1024; i += G * 512) lb[i] = 1.f / (1.f + expf(p.hglb[i] - p.hglb[1024 + i]));
}

DEVI float ret_lg(int h) { return log1pf(-exp2f(-5.0f - (float)h)); }

DEVI void phase_R1(const int TIDX, const int BIDX, bf16_t* L, const Params& p) {
    const int tid = TIDX, wid = tid >> 6, lane = tid & 63, r16 = lane & 15, g = lane >> 4;
    const bf16_t* kt = (const bf16_t*)(p.ws + WS_KT); const bf16_t* vt = (const bf16_t*)(p.ws + WS_VT);
    float* kvt = p.out + O_YP;
    for (int it = BIDX; it < 512; it += gridDim.x) {
        const int bh = it >> 4, c = it & 15, h = bh & 3, t0 = c * 128; const float lg = ret_lg(h);
        __syncthreads();
        { const int d = tid >> 2, seg = tid & 3;
#pragma unroll
          for (int q = 0; q < 4; ++q) {
              const int l0 = seg * 32 + q * 8;
              const u32x4 v = *(const u32x4*)(kt + ((size_t)bh * 128 + d) * 2048 + t0 + l0);
              u32x4 o; const unsigned* vv = (const unsigned*)&v; unsigned* oo = (unsigned*)&o;
#pragma unroll
              for (int j = 0; j < 4; ++j) oo[j] = pack2(bflo(vv[j]) * __expf(lg * (float)(127 - l0 - 2 * j)), bfhi(vv[j]) * __expf(lg * (float)(126 - l0 - 2 * j)));
              *(u32x4*)(L + d * 136 + l0) = o; } }
        __syncthreads();
        bf16x8 bfr[2][4];
#pragma unroll
        for (int ct = 0; ct < 2; ++ct)
#pragma unroll
            for (int kk = 0; kk < 4; ++kk) bfr[ct][kk] = *(const bf16x8*)(vt + ((size_t)bh * 256 + wid * 32 + ct * 16 + r16) * 2048 + t0 + kk * 32 + g * 8);
#pragma unroll
        for (int rt = 0; rt < 8; ++rt) {
            f32x4 a0 = {0.f, 0.f, 0.f, 0.f}, a1 = a0;
#pragma unroll
            for (int kk = 0; kk < 4; ++kk) { const bf16x8 a = *(const bf16x8*)(L + (rt * 16 + r16) * 136 + kk * 32 + g * 8); a0 = mfma16(a, bfr[0][kk], a0); a1 = mfma16(a, bfr[1][kk], a1); }
            float* d0 = kvt + (((size_t)bh * 16 + c) * 256 + wid * 32 + r16) * 128 + rt * 16 + g * 4;
            *(f32x4*)d0 = a0; *(f32x4*)(d0 + 16 * 128) = a1;
        }
    }
}

DEVI void phase_R2(const int TIDX, const int BIDX, const Params& p) {
    float* kvt = p.out + O_YP;
    for (int i = BIDX * 512 + TIDX; i < 32 * 256 * 16; i += gridDim.x * 512) {
        const int q = i & 15, e = (i >> 4) & 255, bh = i >> 12, h = bh & 3; const float dec = __expf(ret_lg(h) * 128.f);
        f32x4 s0 = {0.f, 0.f, 0.f, 0.f}, s1 = s0;
#pragma unroll 4
        for (int c = 0; c < 16; ++c) {
            float* ptr = kvt + (((size_t)bh * 16 + c) * 256 + e) * 128 + q * 8;
            const f32x4 v0 = *(const f32x4*)ptr, v1 = *(const f32x4*)(ptr + 4);
            u32x4 o; o.x = pack2(s0[0], s0[1]); o.y = pack2(s0[2], s0[3]); o.z = pack2(s1[0], s1[1]); o.w = pack2(s1[2], s1[3]);
            *(u32x4*)ptr = o;
            s0 = s0 * dec + v0; s1 = s1 * dec + v1;
        }
        float* o = p.out + O_RETP + ((size_t)bh * 128 + q * 8) * 256 + e;
#pragma unroll
        for (int j = 0; j < 4; ++j) { o[(size_t)j * 256] = s0[j]; o[(size_t)(j + 4) * 256] = s1[j]; }
    }
}

DEVI void phase_R3(const int TIDX, const int BIDX, bf16_t* L, const Params& p) {
    const int tid = TIDX, wid = tid >> 6, lane = tid & 63, r16 = lane & 15, g = lane >> 4;
    const bf16_t* Q = (const bf16_t*)(p.ws + WS_Q); const bf16_t* KN = (const bf16_t*)(p.ws + WS_KN); const bf16_t* vt = (const bf16_t*)(p.ws + WS_VT);
    const bf16_t* sga = (const bf16_t*)(p.ws + WS_SGA); bf16_t* mix = (bf16_t*)(p.out + O_HGS);
    const float* kvt = p.out + O_YP;
    bf16_t* S = L;
    float* st = (float*)(L + 128 * 136);
    float* mr = st + 128 * 16;
    for (int it = BIDX; it < 512; it += gridDim.x) {
        const int bh = it >> 4, c = it & 15, h = bh & 3, b = bh >> 2, l0 = wid * 16; const size_t tok0 = (size_t)b * 2048 + c * 128; const float lg = ret_lg(h);
        bf16x8 qa[4];
#pragma unroll
        for (int kk = 0; kk < 4; ++kk) qa[kk] = *(const bf16x8*)(Q + (tok0 + l0 + r16) * 512 + h * 128 + kk * 32 + g * 8);
        __syncthreads();
        for (int j = 0; j < 8; ++j) {
            f32x4 sc = {0.f, 0.f, 0.f, 0.f};
            if (j <= wid) {
#pragma unroll
                for (int kk = 0; kk < 4; ++kk) sc = mfma16(qa[kk], *(const bf16x8*)(KN + (tok0 + j * 16 + r16) * 512 + h * 128 + kk * 32 + g * 8), sc);
            }
#pragma unroll
            for (int r = 0; r < 4; ++r) {
                const int li = l0 + g * 4 + r, mi = j * 16 + r16; const float v = (j <= wid && li >= mi) ? sc[r] * __expf(lg * (float)(li - mi)) : 0.f;
                S[li * 136 + mi] = f2bf(v);
            }
        }
        f32x4 acc[8][2];
#pragma unroll
        for (int rt = 0; rt < 8; ++rt) { acc[rt][0] = (f32x4){0.f, 0.f, 0.f, 0.f}; acc[rt][1] = (f32x4){0.f, 0.f, 0.f, 0.f}; }
        if (c > 0) {
            bf16x8 bs[2][4];
#pragma unroll
            for (int ct = 0; ct < 2; ++ct)
#pragma unroll
                for (int kk = 0; kk < 4; ++kk) bs[ct][kk] = *(const bf16x8*)(kvt + (((size_t)bh * 16 + c) * 256 + wid * 32 + ct * 16 + r16) * 128 + kk * 32 + g * 8);
#pragma unroll
            for (int rt = 0; rt < 8; ++rt) {
                f32x4 a0 = {0.f, 0.f, 0.f, 0.f}, a1 = a0;
#pragma unroll
                for (int kk = 0; kk < 4; ++kk) {
                    const bf16x8 q = *(const bf16x8*)(Q + (tok0 + rt * 16 + r16) * 512 + h * 128 + kk * 32 + g * 8);
                    a0 = mfma16(q, bs[0][kk], a0); a1 = mfma16(q, bs[1][kk], a1);
                }
#pragma unroll
                for (int r = 0; r < 4; ++r) { const float qd = __expf(lg * (float)(rt * 16 + g * 4 + r + 1)); a0[r] *= qd; a1[r] *= qd; }
                acc[rt][0] = a0; acc[rt][1] = a1;
                __builtin_amdgcn_sched_barrier(0);
            }
        }
        bf16x8 bv[2][4];
#pragma unroll
        for (int ct = 0; ct < 2; ++ct)
#pragma unroll
            for (int kk = 0; kk < 4; ++kk) bv[ct][kk] = *(const bf16x8*)(vt + ((size_t)bh * 256 + wid * 32 + ct * 16 + r16) * 2048 + c * 128 + kk * 32 + g * 8);
        __syncthreads();
#pragma unroll
        for (int rt = 0; rt < 8; ++rt) {
            f32x4 a0 = acc[rt][0], a1 = acc[rt][1];
#pragma unroll
            for (int kk = 0; kk < 4; ++kk) {
                if (kk <= (rt >> 1)) {
                    const bf16x8 a = *(const bf16x8*)(S + (rt * 16 + r16) * 136 + kk * 32 + g * 8);
                    a0 = mfma16(a, bv[0][kk], a0); a1 = mfma16(a, bv[1][kk], a1);
                }
            }
            acc[rt][0] = a0; acc[rt][1] = a1;
#pragma unroll
            for (int r = 0; r < 4; ++r) {
                float s1 = a0[r] + a1[r], s2 = a0[r] * a0[r] + a1[r] * a1[r];
                s1 = grp16_sum(s1); s2 = grp16_sum(s2);
                if (r16 == 0) { st[((rt * 16 + g * 4 + r) * 8 + wid) * 2] = s1; st[((rt * 16 + g * 4 + r) * 8 + wid) * 2 + 1] = s2; }
            }
            __builtin_amdgcn_sched_barrier(0);
        }
        __syncthreads();
        if (tid < 128) {
            float s1 = 0.f, s2 = 0.f;
#pragma unroll
            for (int w = 0; w < 8; ++w) { s1 += st[(tid * 8 + w) * 2]; s2 += st[(tid * 8 + w) * 2 + 1]; }
            const float mu = s1 * (1.f / 256.f), var = fmaxf(s2 * (1.f / 256.f) - mu * mu, 0.f);
            mr[tid * 2] = mu; mr[tid * 2 + 1] = rsqrtf(var + 1e-5f);
        }
        __syncthreads();
        const float gw0 = p.gnw[h * 256 + wid * 32 + r16], gw1 = p.gnw[h * 256 + wid * 32 + 16 + r16];
#pragma unroll
        for (int rt = 0; rt < 8; ++rt)
#pragma unroll
            for (int r = 0; r < 4; ++r) {
                const int row = rt * 16 + g * 4 + r; const size_t token = tok0 + row; const float mu = mr[row * 2], rs = mr[row * 2 + 1];
                const size_t o = token * 1024 + h * 256 + wid * 32 + r16;
                const float v0 = (acc[rt][0][r] - mu) * rs * gw0 * bf2f(sga[o]), v1 = (acc[rt][1][r] - mu) * rs * gw1 * bf2f(sga[o + 16]);
                mix[token * 2048 + h * 256 + wid * 32 + r16] = f2bf(v0); mix[token * 2048 + h * 256 + wid * 32 + 16 + r16] = f2bf(v1);
            }
    }
}

DEVI void phase_s5scan(const int TIDX, const int BIDX, const Params& p) {
    const int wid = TIDX >> 6, lane = TIDX & 63;
    const float* e5 = p.out + O_HGS; bf16_t* a2 = (bf16_t*)(p.ws + WS_A2); const float* lam16 = (const float*)(p.ws + WS_LAM16);
    for (int it = BIDX * 8 + wid; it < 512; it += gridDim.x * 8) {
        const int b = it >> 6, g = it & 63;
        const float ar = lam16[(g * 64 + lane) * 2], ai = lam16[(g * 64 + lane) * 2 + 1];
        float hr = 0.f, hi = 0.f;
        for (int jb = 0; jb < 128; jb += 16) {
            float er[16], ei[16];
#pragma unroll
            for (int j = 0; j < 16; ++j) { const float* ep = e5 + ((size_t)g * 1024 + b * 128 + jb + j) * 128; er[j] = ep[lane]; ei[j] = ep[64 + lane]; }
#pragma unroll
            for (int j = 0; j < 16; ++j) {
                bf16_t* hp = a2 + ((size_t)g * 1024 + b * 128 + jb + j) * 384 + 256;
                hp[lane] = f2bf(hr); hp[64 + lane] = f2bf(hi);
                const float nr = ar * hr - ai * hi + er[j], ni = ar * hi + ai * hr + ei[j];
                hr = nr; hi = ni;
            }
        }
        p.out[O_S5RP + (size_t)(b * 64 + g) * 64 + lane] = hr; p.out[O_S5IP + (size_t)(b * 64 + g) * 64 + lane] = hi;
    }
}

DEVI void phase_H1(const int TIDX, const int BIDX, bf16_t* L, const Params& p) {
    const int tid = TIDX, wid = tid >> 6, lane = tid & 63, r16 = lane & 15, g = lane >> 4;
    float* cum = (float*)(p.ws + WS_CUM); const bf16_t* itp = (const bf16_t*)(p.ws + WS_IT); float* hkv = (float*)(p.ws + WS_HKV);
    float* tot = (float*)(L + 128 * 136);
    for (int it = BIDX; it < 1024; it += gridDim.x) {
        const int bh = it >> 4, c = it & 15, h = bh & 7, b = bh >> 3; const size_t tok0 = (size_t)b * 2048 + c * 128;
        const int d = tid & 127, part = tid >> 7;
        float* col = cum + (tok0 + part * 32) * 1024 + h * 128 + d;
        float lf[32]; float s = 0.f;
#pragma unroll
        for (int l = 0; l < 32; ++l) { lf[l] = col[(size_t)l * 1024]; s += lf[l]; }
        __syncthreads();
        tot[part * 128 + d] = s;
        __syncthreads();
        float off = 0.f, last = 0.f;
#pragma unroll
        for (int pp = 0; pp < 4; ++pp) { const float t = tot[pp * 128 + d]; if (pp < part) off += t; last += t; }
        float cc = off;
#pragma unroll
        for (int l = 0; l < 32; ++l) {
            cc += lf[l]; col[(size_t)l * 1024] = cc;
            L[d * 136 + part * 32 + l] = f2bf((1.f - __expf(lf[l])) * __expf(last - cc));
        }
        __syncthreads();
        bf16x8 bfr[4];
#pragma unroll
        for (int kk = 0; kk < 4; ++kk) bfr[kk] = *(const bf16x8*)(itp + ((size_t)bh * 128 + wid * 16 + r16) * 2048 + c * 128 + kk * 32 + g * 8);
#pragma unroll
        for (int rt = 0; rt < 8; ++rt) {
            f32x4 a0 = {0.f, 0.f, 0.f, 0.f};
#pragma unroll
            for (int kk = 0; kk < 4; ++kk) a0 = mfma16(*(const bf16x8*)(L + (rt * 16 + r16) * 136 + kk * 32 + g * 8), bfr[kk], a0);
            *(f32x4*)(hkv + (((size_t)bh * 16 + c) * 128 + wid * 16 + r16) * 128 + rt * 16 + g * 4) = a0;
        }
    }
}

DEVI void phase_H2(const int TIDX, const int BIDX, const Params& p) {
    float* hkv = (float*)(p.ws + WS_HKV); const float* cum = (const float*)(p.ws + WS_CUM);
    for (int i = BIDX * 512 + TIDX; i < 64 * 128 * 16; i += gridDim.x * 512) {
        const int q = i & 15, e = (i >> 4) & 127, bh = i >> 11, h = bh & 7, b = bh >> 3;
        f32x4 s0 = {0.f, 0.f, 0.f, 0.f}, s1 = s0;
#pragma unroll 4
        for (int c = 0; c < 16; ++c) {
            float* ptr = hkv + (((size_t)bh * 16 + c) * 128 + e) * 128 + q * 8;
            const float* lp = cum + ((size_t)b * 2048 + c * 128 + 127) * 1024 + h * 128 + q * 8;
            const f32x4 v0 = *(const f32x4*)ptr, v1 = *(const f32x4*)(ptr + 4), d0 = *(const f32x4*)lp, d1 = *(const f32x4*)(lp + 4);
            u32x4 o; o.x = pack2(s0[0], s0[1]); o.y = pack2(s0[2], s0[3]); o.z = pack2(s1[0], s1[1]); o.w = pack2(s1[2], s1[3]);
            *(u32x4*)ptr = o;
#pragma unroll
            for (int j = 0; j < 4; ++j) { s0[j] = s0[j] * __expf(d0[j]) + v0[j]; s1[j] = s1[j] * __expf(d1[j]) + v1[j]; }
        }
        float* o = p.out + O_HGP + ((size_t)bh * 128 + q * 8) * 128 + e;
#pragma unroll
        for (int j = 0; j < 4; ++j) { o[(size_t)j * 128] = s0[j]; o[(size_t)(j + 4) * 128] = s1[j]; }
    }
}

DEVI void phase_H3(const int TIDX, const int BIDX, bf16_t* L, const Params& p) {
    const int tid = TIDX, wid = tid >> 6, lane = tid & 63, r16 = lane & 15, g = lane >> 4;
    const float* cum = (const float*)(p.ws + WS_CUM); const bf16_t* itp = (const bf16_t*)(p.ws + WS_IT); const float* hkv = (const float*)(p.ws + WS_HKV);
    bf16_t* q1 = (bf16_t*)(p.ws + WS_Q1); const bf16_t* sg1 = (const bf16_t*)(p.ws + WS_SG1);
    bf16_t* kt = L; bf16_t* S = L + 128 * 136; bf16_t* QA = L + 2 * 128 * 136;
    float* st = (float*)(L + 3 * 128 * 136);
    float* rsn = st + 128 * 8;
    for (int it = BIDX; it < 1024; it += gridDim.x) {
        const int bh = it >> 4, c = it & 15, h = bh & 7, b = bh >> 3, l0 = wid * 16; const size_t tok0 = (size_t)b * 2048 + c * 128;
        const float* refp = cum + (tok0 + 63) * 1024 + h * 128;
        __syncthreads();
        { const int m = tid >> 2, seg = tid & 3; const float* cp = cum + (tok0 + m) * 1024 + h * 128 + seg * 32;
#pragma unroll
          for (int q = 0; q < 8; ++q) {
              const f32x4 cv = *(const f32x4*)(cp + q * 4), rv = *(const f32x4*)(refp + seg * 32 + q * 4);
              f32x4 pv = {0.f, 0.f, 0.f, 0.f}; if (m > 0) pv = *(const f32x4*)(cp - 1024 + q * 4);
              f32x4 o;
#pragma unroll
              for (int j = 0; j < 4; ++j) o[j] = (1.f - __expf(cv[j] - pv[j])) * __expf(rv[j] - cv[j]);
              *(u32x2*)(kt + m * 136 + seg * 32 + q * 4) = pack4(o); } }
        bf16x8 qr[4];
#pragma unroll
        for (int kk = 0; kk < 4; ++kk) {
            const size_t o = (tok0 + l0 + r16) * 1024 + h * 128 + kk * 32 + g * 8;
            const u32x4 qq = *(const u32x4*)(q1 + o);
            const f32x4 c0 = *(const f32x4*)(cum + o), c1 = *(const f32x4*)(cum + o + 4), r0 = *(const f32x4*)(refp + kk * 32 + g * 8), r1 = *(const f32x4*)(refp + kk * 32 + g * 8 + 4);
            const unsigned* qv = (const unsigned*)&qq; u32x4 a, bb; unsigned* av = (unsigned*)&a; unsigned* bv = (unsigned*)&bb;
#pragma unroll
            for (int j = 0; j < 4; ++j) {
                const float cl = j < 2 ? c0[2 * j] : c1[2 * j - 4], ch = j < 2 ? c0[2 * j + 1] : c1[2 * j - 3];
                const float rl = j < 2 ? r0[2 * j] : r1[2 * j - 4], rh = j < 2 ? r0[2 * j + 1] : r1[2 * j - 3];
                const float ql = bflo(qv[j]), qh = bfhi(qv[j]);
                av[j] = pack2(ql * __expf(cl - rl), qh * __expf(ch - rh)); bv[j] = pack2(ql * __expf(cl), qh * __expf(ch));
            }
            qr[kk] = *(bf16x8*)&a;
            *(u32x4*)(QA + (l0 + r16) * 136 + kk * 32 + g * 8) = bb;
        }
        bf16x8 bi[4], bs[4];
#pragma unroll
        for (int kk = 0; kk < 4; ++kk) {
            bi[kk] = *(const bf16x8*)(itp + ((size_t)bh * 128 + wid * 16 + r16) * 2048 + c * 128 + kk * 32 + g * 8);
            bs[kk] = *(const bf16x8*)(hkv + (((size_t)bh * 16 + c) * 128 + wid * 16 + r16) * 128 + kk * 32 + g * 8);
        }
        __syncthreads();
        for (int j = 0; j < 8; ++j) {
            f32x4 sc = {0.f, 0.f, 0.f, 0.f};
            if (j <= wid) {
#pragma unroll
                for (int kk = 0; kk < 4; ++kk) sc = mfma16(qr[kk], *(const bf16x8*)(kt + (j * 16 + r16) * 136 + kk * 32 + g * 8), sc);
            }
#pragma unroll
            for (int r = 0; r < 4; ++r) {
                const int li = l0 + g * 4 + r, mi = j * 16 + r16; const float v = (j <= wid && li >= mi) ? sc[r] : 0.f;
                S[li * 136 + mi] = f2bf(v);
            }
        }
        __syncthreads();
        f32x4 acc[8];
#pragma unroll
        for (int rt = 0; rt < 8; ++rt) {
            f32x4 a0 = {0.f, 0.f, 0.f, 0.f};
            if (c > 0) {
#pragma unroll
                for (int kk = 0; kk < 4; ++kk) a0 = mfma16(*(const bf16x8*)(QA + (rt * 16 + r16) * 136 + kk * 32 + g * 8), bs[kk], a0);
            }
#pragma unroll
            for (int kk = 0; kk < 4; ++kk) {
                if (kk <= (rt >> 1)) a0 = mfma16(*(const bf16x8*)(S + (rt * 16 + r16) * 136 + kk * 32 + g * 8), bi[kk], a0);
            }
            acc[rt] = a0;
#pragma unroll
            for (int r = 0; r < 4; ++r) {
                const float s2 = grp16_sum(a0[r] * a0[r]);
                if (r16 == 0) st[(rt * 16 + g * 4 + r) * 8 + wid] = s2;
            }
        }
        __syncthreads();
        if (tid < 128) {
            float s2 = 0.f;
#pragma unroll
            for (int w = 0; w < 8; ++w) s2 += st[tid * 8 + w];
            rsn[tid] = rsqrtf(s2 * (1.f / 128.f) + 1e-6f);
        }
        __syncthreads();
        const float gw = p.hgnw[h * 128 + wid * 16 + r16];
#pragma unroll
        for (int rt = 0; rt < 8; ++rt)
#pragma unroll
            for (int r = 0; r < 4; ++r) {
                const int row = rt * 16 + g * 4 + r; const unsigned o = ((unsigned)tok0 + row) * 1024u + h * 128 + wid * 16 + r16;
                q1[o] = f2bf(acc[rt][r] * rsn[row] * gw * bf2f(sg1[o]));
            }
    }
}

DEVI void phase_ss5(const int TIDX, const int BIDX, const Params& p) {
    const int wid = TIDX >> 6, lane = TIDX & 63;
    const float* zs = (const float*)(p.ws + WS_ZS); const float* bbg = (const float*)(p.ws + WS_BBG); const float* lam1 = (const float*)(p.ws + WS_LAM1);
    bf16_t* y5s = (bf16_t*)(p.ws + WS_Y5S);
    for (int it = BIDX * 8 + wid; it < 128 * 64; it += gridDim.x * 8) {
        const int b = it >> 6, g = it & 63;
        float u[16];
#pragma unroll
        for (int c = 0; c < 16; ++c) u[c] = zs[(size_t)b * 5120 + 3072 + g * 16 + c];
        float xr = 0.f, xi = 0.f;
#pragma unroll
        for (int c = 0; c < 16; ++c) { xr += bbg[((g * 64 + lane) * 16 + c) * 2] * u[c]; xi += bbg[((g * 64 + lane) * 16 + c) * 2 + 1] * u[c]; }
        const float ar = lam1[(g * 64 + lane) * 2], ai = lam1[(g * 64 + lane) * 2 + 1];
        const float sr = p.s5r[(size_t)(b * 64 + g) * 64 + lane], si = p.s5i[(size_t)(b * 64 + g) * 64 + lane];
        const float hr = ar * sr - ai * si + xr, hi = ar * si + ai * sr + xi;
        p.out[O_S5RS + (size_t)(b * 64 + g) * 64 + lane] = hr; p.out[O_S5IS + (size_t)(b * 64 + g) * 64 + lane] = hi;
        float mine = 0.f;
#pragma unroll
        for (int c = 0; c < 16; ++c) {
            float v = p.cre[(g * 16 + c) * 64 + lane] * hr - p.cim[(g * 16 + c) * 64 + lane] * hi;
            v = wave_sum(v);
            if (lane == c) mine = v + p.s5d[g * 16 + c] * u[c];
        }
        if (lane < 16) y5s[(size_t)b * 1024 + g * 16 + lane] = f2bf(gelu_(mine));
    }
}

DEVI void phase_sret(const int TIDX, const int BIDX, float* L, const Params& p) {
    const int tid = TIDX, lane = tid & 63, wid = tid >> 6;
    const float* zs = (const float*)(p.ws + WS_ZS); bf16_t* mix = (bf16_t*)(p.ws + WS_MIX0S);
    float* qs = L; float* ks = L + 128; float* red = L + 256; float* st = L + 256 + 2048;
    for (int it = BIDX; it < 512; it += gridDim.x) {
        const int b = it >> 2, h = it & 3, e4 = (tid & 63) * 4, dg = tid >> 6, d0 = dg * 16; const float gam = 1.0f - exp2f(-5.0f - (float)h);
        __syncthreads();
        if (tid < 128) qs[tid] = zs[(size_t)b * 5120 + h * 128 + tid]; else if (tid < 256) ks[tid - 128] = zs[(size_t)b * 5120 + 512 + h * 128 + tid - 128];
        const f32x4 v = *(const f32x4*)(zs + (size_t)b * 5120 + 1024 + h * 256 + e4);
        __syncthreads();
        const float* s0 = p.sret + ((size_t)it * 128 + d0) * 256 + e4; float* so = p.out + O_RETS + ((size_t)it * 128 + d0) * 256 + e4;
        f32x4 sv[16];
#pragma unroll
        for (int j = 0; j < 16; ++j) sv[j] = *(const f32x4*)(s0 + (size_t)j * 256);
        f32x4 o = {0.f, 0.f, 0.f, 0.f};
#pragma unroll
        for (int j = 0; j < 16; ++j) { const f32x4 s = sv[j] * gam + v * ks[d0 + j]; *(f32x4*)(so + (size_t)j * 256) = s; o += s * qs[d0 + j]; }
        *(f32x4*)(red + dg * 256 + e4) = o;
        __syncthreads();
        float tot = 0.f;
        if (tid < 256) {
#pragma unroll
            for (int k = 0; k < 8; ++k) tot += red[k * 256 + tid];
            const float s = wave_sum(tot); if (lane == 0) st[wid] = s; }
        __syncthreads();
        const float mu = (st[0] + st[1] + st[2] + st[3]) * (1.f / 256.f);
        __syncthreads();
        if (tid < 256) { const float dd = tot - mu; const float s = wave_sum(dd * dd); if (lane == 0) st[wid] = s; }
        __syncthreads();
        const float rs = rsqrtf((st[0] + st[1] + st[2] + st[3]) * (1.f / 256.f) + 1e-5f);
        if (tid < 256) mix[(size_t)b * 2048 + h * 256 + tid] = f2bf((tot - mu) * rs * p.gnw[h * 256 + tid] * zs[(size_t)b * 5120 + 2048 + h * 256 + tid]);
    }
}

DEVI void phase_shg(const int TIDX, const int BIDX, float* L, const Params& p) {
    const int tid = TIDX, lane = tid & 63, wid = tid >> 6;
    const float* z1 = (const float*)(p.ws + WS_Z1S); bf16_t* o1s = (bf16_t*)(p.ws + WS_O1S);
    float* qs = L; float* fs = L + 128; float* red = L + 256; float* st = L + 256 + 2048;
    for (int it = BIDX; it < 1024; it += gridDim.x) {
        const int b = it >> 3, h = it & 7, e4 = (tid & 31) * 4, dg = tid >> 5, d0 = dg * 8;
        __syncthreads();
        if (tid < 128) qs[tid] = z1[(size_t)b * 4096 + h * 128 + tid]; else if (tid < 256) fs[tid - 128] = z1[(size_t)b * 4096 + 1024 + h * 128 + tid - 128];
        const f32x4 iv = *(const f32x4*)(z1 + (size_t)b * 4096 + 2048 + h * 128 + e4);
        __syncthreads();
        const float* s0 = p.shg + ((size_t)it * 128 + d0) * 128 + e4; float* so = p.out + O_HGS + ((size_t)it * 128 + d0) * 128 + e4;
        f32x4 sv[8];
#pragma unroll
        for (int j = 0; j < 8; ++j) sv[j] = *(const f32x4*)(s0 + (size_t)j * 128);
        f32x4 o = {0.f, 0.f, 0.f, 0.f};
#pragma unroll
        for (int j = 0; j < 8; ++j) { const float f = fs[d0 + j]; const f32x4 s = sv[j] * f + iv * (1.f - f); *(f32x4*)(so + (size_t)j * 128) = s; o += s * qs[d0 + j]; }
        *(f32x4*)(red + dg * 128 + e4) = o;
        __syncthreads();
        float tot = 0.f;
        if (tid < 128) {
#pragma unroll
            for (int k = 0; k < 16; ++k) tot += red[k * 128 + tid];
            const float s = wave_sum(tot * tot); if (lane == 0) st[wid] = s; }
        __syncthreads();
        const float rs = rsqrtf((st[0] + st[1]) * (1.f / 128.f) + 1e-6f);
        if (tid < 128) o1s[(size_t)b * 1024 + h * 128 + tid] = f2bf(tot * rs * p.hgnw[h * 128 + tid] * z1[(size_t)b * 4096 + 3072 + h * 128 + tid]);
    }
}

DEVI void phase_final(const int TIDX, const int BIDX, const Params& p) {
    const int wid = TIDX >> 6, lane = TIDX & 63;
    for (int row = (BIDX * 8 + wid) * 2; row < MP + MS; row += gridDim.x * 16) {
        const bool smp = row >= MP; const size_t r = smp ? row - MP : row;
        float* x = p.out + (smp ? O_YS : O_YP) + r * 1024;
        f32x4 v[2][4]; float s0 = 0.f, s1 = 0.f;
#pragma unroll
        for (int i = 0; i < 4; ++i) { v[0][i] = *(const f32x4*)(x + i * 256 + lane * 4); v[1][i] = *(const f32x4*)(x + 1024 + i * 256 + lane * 4); }
#pragma unroll
        for (int i = 0; i < 4; ++i) {
            s0 += v[0][i][0] * v[0][i][0] + v[0][i][1] * v[0][i][1] + v[0][i][2] * v[0][i][2] + v[0][i][3] * v[0][i][3];
            s1 += v[1][i][0] * v[1][i][0] + v[1][i][1] * v[1][i][1] + v[1][i][2] * v[1][i][2] + v[1][i][3] * v[1][i][3];
        }
        s0 = wave_sum(s0); s1 = wave_sum(s1);
        const float r0 = rsqrtf(s0 * (1.0f / 1024.0f) + 1e-6f), r1 = rsqrtf(s1 * (1.0f / 1024.0f) + 1e-6f);
#pragma unroll
        for (int i = 0; i < 4; ++i) {
            const f32x4 w = *(const f32x4*)(p.fnormw + i * 256 + lane * 4);
            *(f32x4*)(x + i * 256 + lane * 4) = v[0][i] * r0 * w; *(f32x4*)(x + 1024 + i * 256 + lane * 4) = v[1][i] * r1 * w;
        }
    }
}

#define GRID_SYNC() do { asm volatile("s_waitcnt vmcnt(0) lgkmcnt(0)" ::: "memory"); cg::this_grid().sync(); } while (0)
constexpr int NPHASE = 13;
__global__ void __launch_bounds__(512, 2) mega(Params p0) {
    extern __shared__ __attribute__((aligned(16))) unsigned char shm[];
    LAS unsigned char* lds = (LAS unsigned char*)shm;
    const int G = gridDim.x;
#define OPQ int oz; asm volatile("s_mov_b32 %0, 0" : "=s"(oz)); int ozv; asm volatile("v_mov_b32 %0, 0" : "=v"(ozv)); \
    Params p = p0; p.ws = p0.ws + oz; p.out = p0.out + oz; const int TIDX = threadIdx.x + ozv, BIDX = blockIdx.x + oz; (void)TIDX; (void)BIDX;
    int my_xcc, my_rank;
    {
        int* sh = (int*)shm;
        if (threadIdx.x == 0) {
            const unsigned x = (unsigned)__builtin_amdgcn_s_getreg((3 << 11) | 20) & 7u;
            sh[0] = (int)x; sh[1] = (int)__hip_atomic_fetch_add((unsigned*)(p0.ws + WS_XCNT) + x * 32, 1u, __ATOMIC_RELAXED, __HIP_MEMORY_SCOPE_AGENT);
        }
        __syncthreads();
        my_xcc = __builtin_amdgcn_readfirstlane(sh[0]); my_rank = __builtin_amdgcn_readfirstlane(sh[1]);
        __syncthreads();
    }
    int gc = blockIdx.x;
    int ph_start = p0.ph_lo;
    if (ph_start == 0) {
        { OPQ phase_prep(TIDX, BIDX, (float*)shm, p); }
#if COOP
        GRID_SYNC();
        {
            bool ok = gridDim.x == 256;
            for (int x = 0; x < 8; ++x) ok = ok && (__hip_atomic_load((unsigned*)(p0.ws + WS_XCNT) + x * 32, __ATOMIC_RELAXED, __HIP_MEMORY_SCOPE_AGENT) == 32u);
            if (ok) gc = my_rank * 8 + my_xcc;
        }
#endif
        ph_start = 1;
    }
    for (int ph = ph_start; ph < p0.ph_hi; ++ph) {
        int la = -1, lb = -1, K = 1024, lda = 1024, ldb = 1024;
        switch (ph) {
        case 1: la = L_IN0; lb = L_IN0S; break;
        case 2: la = L_GA; K = 256; lda = 384; ldb = 256; break;
        case 4: la = L_GB; K = 384; lda = 384; ldb = 384; break;
        case 3: lb = L_GLUS; break;
        case 5: la = L_GLU; break;
        case 6: la = L_OUT0; lb = L_OUT0S; K = 2048; lda = 2048; ldb = 2048; break;
        case 7: la = L_IN1; lb = L_IN1S; break;
        case 9: lb = L_OUT1S; break;
        case 11: la = L_OUT1; break;
        default: break;
        }
        for (int jj = 0; jj < 2; ++jj) {
            const int l = jj ? lb : la;
            if (l < 0) continue;
            OPQ
            Sched S; S.list = l; S.G = G; S.c = jj ? G - 1 - gc : gc + oz; S.wsp = p.ws; S.outp = p.out;
            gemm_phase(TIDX, lds, K, lda, ldb, l == L_GLU, S, p);
        }
        __syncthreads();
        switch (ph) {
        case 2: { { OPQ phase_R1(TIDX, BIDX, (bf16_t*)shm, p); } __syncthreads(); { OPQ phase_sret(TIDX, BIDX, (float*)shm, p); } { OPQ phase_ss5(TIDX, BIDX, p); } } break;
        case 3: { { OPQ phase_s5scan(TIDX, BIDX, p); } { OPQ phase_R2(TIDX, BIDX, p); } } break;
        case 4: { OPQ phase_R3(TIDX, BIDX, (bf16_t*)shm, p); } break;
        case 8: { { OPQ phase_H1(TIDX, BIDX, (bf16_t*)shm, p); } __syncthreads(); { OPQ phase_shg(TIDX, BIDX, (float*)shm, p); } } break;
        case 9: { OPQ phase_H2(TIDX, BIDX, p); } break;
        case 10: { OPQ phase_H3(TIDX, BIDX, (bf16_t*)shm, p); } break;
        case 12: { OPQ phase_final(TIDX, BIDX, p); } break;
        default: break;
        }
#if COOP
        if (ph + 1 < p0.ph_hi) GRID_SYNC();
#endif
    }
}

extern "C" void kernel_launch(void* const* d_in, const int* in_sizes, int n_in, void* d_out, int out_size, void* d_ws, size_t ws_size, hipStream_t stream) {
    constexpr size_t kDynLds = 131072;
    static int grid_blocks = 0;
    if (!grid_blocks) {
        hipFuncSetAttribute((const void*)mega, hipFuncAttributeMaxDynamicSharedMemorySize, (int)kDynLds);
        int dev = 0, cus = 0, per_cu = 0;
        hipGetDevice(&dev);
        hipDeviceGetAttribute(&cus, hipDeviceAttributeMultiprocessorCount, dev);
        hipOccupancyMaxActiveBlocksPerMultiprocessor(&per_cu, mega, 512, kDynLds);
        if (per_cu < 1) per_cu = 1;
        grid_blocks = cus;
        if (grid_blocks > 256) grid_blocks = 256;
    }
    Params p{};
    const float** f = (const float**)&p;
    for (int i = 0; i < 25; ++i) f[i] = (const float*)d_in[i];
    p.out = (float*)d_out; p.ws = (char*)d_ws;
#if COOP
    p.ph_lo = 0; p.ph_hi = PH_MAX;
    hipMemsetAsync((char*)d_ws + WS_XCNT, 0, 1024, stream);
    void* args[] = {&p};
    hipError_t e = hipLaunchCooperativeKernel((const void*)mega, dim3(grid_blocks), dim3(512), args, kDynLds, stream);
    if (e != hipSuccess) fprintf(stderr, "cooperative launch failed: %s (grid %d)\n", hipGetErrorString(e), grid_blocks);
#else
    for (int ph = 0; ph < NPHASE; ++ph) {
        p.ph_lo = ph; p.ph_hi = ph + 1;
        hipLaunchKernelGGL(mega, dim3(grid_blocks), dim3(512), kDynLds, stream, p);
    }
#endif
}
```

```cpp
#include <hip/hip_runtime.h>
#include <hip/hip_cooperative_groups.h>
#include <cstdio>
namespace cg = cooperative_groups;

#ifndef PH_MAX
#define PH_MAX 13
#endif
#ifndef COOP
#define COOP 1
#endif

typedef unsigned short bf16_t;
typedef short bf16x8 __attribute__((ext_vector_type(8)));
typedef float f32x4 __attribute__((ext_vector_type(4)));
typedef unsigned u32x4 __attribute__((ext_vector_type(4)));
typedef unsigned u32x2 __attribute__((ext_vector_type(2)));
#define LAS __attribute__((address_space(3)))
#define DEVI __device__ __forceinline__

constexpr int TT = 2048, NBP = 8, MP = 16384, MS = 128, DM = 1024;
constexpr size_t MiB = (size_t)1 << 20;
constexpr size_t O_YP = 0, O_YS = 16777216, O_RETP = 16908288, O_RETS = 17956864, O_S5RP = 34734080, O_S5IP = 34766848,
                 O_S5RS = 34799616, O_S5IS = 35323904, O_HGP = 35848192, O_HGS = 36896768;
constexpr size_t WS_WIN0T = 0, WS_BT1 = 10 * MiB, WS_KT = 18 * MiB, WS_WGLUT = 34 * MiB, WS_WOUT0T = 36 * MiB, WS_WIN1T = 40 * MiB,
                 WS_BT2 = 48 * MiB, WS_Q = 60 * MiB, WS_KN = 76 * MiB, WS_VT = 92 * MiB, WS_SGA = 124 * MiB, WS_SGB = 156 * MiB,
                 WS_A2 = 188 * MiB, WS_Y5 = 0, WS_X1B = 60 * MiB, WS_SG1 = 0, WS_Q1 = 96 * MiB, WS_CUM = 128 * MiB, WS_IT = 192 * MiB,
                 WS_HKV = 32 * MiB;
constexpr size_t WS_MISC = 240 * MiB;
constexpr size_t WS_WOUT1T = WS_MISC;
constexpr size_t WS_ROPE = WS_MISC + 2 * MiB;
constexpr size_t WS_SSQ1 = WS_ROPE + 1280 * 1024;
constexpr size_t WS_SSQ2 = WS_SSQ1 + MiB;
constexpr size_t WS_H0S = WS_SSQ2 + MiB;
constexpr size_t WS_ZS = WS_H0S + 512 * 1024;
constexpr size_t WS_Y5S = WS_ZS + 2560 * 1024;
constexpr size_t WS_MIX0S = WS_Y5S + 512 * 1024;
constexpr size_t WS_X1S = WS_MIX0S + MiB;
constexpr size_t WS_X1SB = WS_X1S + 512 * 1024;
constexpr size_t WS_Z1S = WS_X1SB + 512 * 1024;
constexpr size_t WS_O1S = WS_Z1S + 2 * MiB;
constexpr size_t WS_BBG = WS_O1S + 512 * 1024;
constexpr size_t WS_LAM1 = WS_BBG + 512 * 1024;
constexpr size_t WS_LAM16 = WS_LAM1 + 32 * 1024;
constexpr size_t WS_LB = WS_LAM16 + 32 * 1024;
constexpr size_t WS_SSQ1S = WS_LB + 4096;
constexpr size_t WS_SSQ2S = WS_SSQ1S + MiB;
constexpr size_t WS_END = WS_SSQ2S + MiB;
constexpr size_t WS_XCNT = WS_END;
static_assert(WS_XCNT + 1024 <= 256 * MiB, "workspace overflow");

struct Params {
    const float *xp, *xs, *sret, *s5r, *s5i, *shg, *normw, *fnormw, *win0, *gnw, *lamre, *lamim, *logdt, *bre, *bim, *cre, *cim, *s5d,
        *gluw, *glub, *wout0, *win1, *hglb, *hgnw, *wout1;
    float* out;
    char* ws;
    int ph_lo, ph_hi;
};

DEVI bf16_t f2bf(float f) { unsigned u = __float_as_uint(f); u += 0x7FFFu + ((u >> 16) & 1u); return (bf16_t)(u >> 16); }
DEVI float bf2f(bf16_t b) { return __uint_as_float(((unsigned)b) << 16); }
DEVI unsigned pack2(float lo, float hi) { unsigned r; asm("v_cvt_pk_bf16_f32 %0, %1, %2" : "=v"(r) : "v"(lo), "v"(hi)); return r; }
DEVI float bflo(unsigned w) { return __uint_as_float(w << 16); }
DEVI float bfhi(unsigned w) { return __uint_as_float(w & 0xffff0000u); }
DEVI float sigm(float x) { return __builtin_amdgcn_rcpf(1.f + __builtin_amdgcn_exp2f(-1.4426950408889634f * x)); }
DEVI float silu_(float x) { return x * sigm(x); }
DEVI float gelu_(float x) { const float u = 1.5957691216f * (x + 0.044715f * x * x * x); return x * __builtin_amdgcn_rcpf(1.f + __builtin_amdgcn_exp2f(-1.4426950408889634f * u)); }
DEVI u32x2 pack4(f32x4 v) { u32x2 r; r.x = pack2(v[0], v[1]); r.y = pack2(v[2], v[3]); return r; }
DEVI float wave_sum(float v) {
#pragma unroll
    for (int o = 32; o > 0; o >>= 1) v += __shfl_xor(v, o);
    return v;
}
DEVI float grp16_sum(float v) { v += __shfl_xor(v, 1); v += __shfl_xor(v, 2); v += __shfl_xor(v, 4); v += __shfl_xor(v, 8); return v; }
DEVI f32x4 mfma16(bf16x8 a, bf16x8 b, f32x4 c) { return __builtin_amdgcn_mfma_f32_16x16x32_bf16(a, b, c, 0, 0, 0); }
DEVI float row_rstd16(const float* ssq, size_t row) {
    const f32x4 a = *(const f32x4*)(ssq + row * 4), b = *(const f32x4*)(ssq + (MP + row) * 4), c = *(const f32x4*)(ssq + (2 * (size_t)MP + row) * 4), d = *(const f32x4*)(ssq + (3 * (size_t)MP + row) * 4);
    float s = (a[0] + a[1] + a[2] + a[3]) + (b[0] + b[1] + b[2] + b[3]) + (c[0] + c[1] + c[2] + c[3]) + (d[0] + d[1] + d[2] + d[3]);
    return rsqrtf(s * (1.0f / 1024.0f) + 1e-6f);
}

constexpr int BM = 256, BK = 64, HALF = 128, HTB = HALF * BK * 2, NXCD = 8, WGM = 8;
DEVI int lds_byte(int r, int c) { const int st = (r >> 4) * 2 + (c >> 5), rr = r & 15, cc = c & 31, ob = rr * 64 + cc * 2; return st * 1024 + (ob ^ (((ob >> 9) & 1) << 5)); }
DEVI void stage_rc(int b, int& R, int& C) { const int st = b / 1024, sb = b % 1024, swz = sb ^ (((sb >> 9) & 1) << 5); R = (st >> 1) * 16 + swz / 64; C = (st & 1) * 32 + (swz % 64) / 2; }

enum { K_Q = 0, K_K, K_VT, K_GA, K_U, K_GB, K_SIN0, K_E5, K_Y5, K_GLU, K_SGLU, K_OUT0, K_SOUT0, K_Q1, K_F, K_IT, K_G1, K_SIN1, K_OUT1, K_SOUT1 };
enum { L_IN0 = 0, L_IN0S, L_GA, L_GB, L_GLU, L_GLUS, L_OUT0, L_OUT0S, L_IN1, L_IN1S, L_OUT1, L_OUT1S };

struct Unit { const char* a; const char* b; int kind, pm, pn; };

DEVI void static_order(int L, int nM, int nN, int& pm, int& pn) {
    const int nwg = nM * nN; int wgid = L;
    { const int q = nwg / NXCD, r = nwg % NXCD, xcd = wgid % NXCD, off = wgid / NXCD; wgid = (xcd < r ? xcd * (q + 1) : r * (q + 1) + (xcd - r) * q) + off; }
    const int nig = WGM * nN, gid = wgid / nig, fm = gid * WGM, gsz = (nM - fm) < WGM ? (nM - fm) : WGM;
    pm = fm + ((wgid % nig) % gsz); pn = (wgid % nig) / gsz;
}

struct Sched {
    int list, G, c; char* wsp; float* outp;
    DEVI bool next(int i, Unit& u) const {
        const int L = i * G + c; const char* ws = wsp;
        switch (list) {
        case L_IN0: {
            if (L >= 1280) return false; int pm, pn; static_order(L, 64, 20, pm, pn); u.pm = pm; u.pn = pn;
            const char* h0 = (const char*)(outp + O_RETS);
            if (pn >= 4 && pn < 8) { u.kind = K_VT; u.a = ws + WS_WIN0T + (size_t)(1024 + 256 * (pn - 4)) * 2048; u.b = h0 + (size_t)pm * 256 * 2048; }
            else { u.kind = pn < 2 ? K_Q : pn < 4 ? K_K : pn < 12 ? K_GA : pn < 16 ? K_U : K_GB; u.a = h0 + (size_t)pm * 256 * 2048; u.b = ws + WS_WIN0T + (size_t)pn * 256 * 2048; }
            return true; }
        case L_IN0S: if (L >= 20) return false; u.pm = 0; u.pn = L; u.kind = K_SIN0; u.a = ws + WS_H0S; u.b = ws + WS_WIN0T + (size_t)L * 256 * 2048; return true;
        case L_GA: if (L >= 256) return false; u.pm = L & 3; u.pn = L >> 2; u.kind = K_E5; u.a = ws + WS_A2 + ((size_t)(L >> 2) * 1024 + (L & 3) * 256) * 768; u.b = ws + WS_BT1 + (size_t)(L >> 2) * 256 * 512; return true;
        case L_GB: if (L >= 256) return false; u.pm = L & 3; u.pn = L >> 2; u.kind = K_Y5; u.a = ws + WS_A2 + ((size_t)(L >> 2) * 1024 + (L & 3) * 256) * 768; u.b = ws + WS_BT2 + (size_t)(L >> 2) * 256 * 768; return true;
        case L_GLU: { if (L >= 256) return false; int pm, pn; static_order(L, 64, 4, pm, pn); u.pm = pm; u.pn = pn; u.kind = K_GLU; u.a = ws + WS_Y5 + (size_t)pm * 256 * 32; u.b = ws + WS_WGLUT + (size_t)pn * 256 * 2048; return true; }
        case L_GLUS: if (L >= 4) return false; u.pm = 0; u.pn = L; u.kind = K_SGLU; u.a = ws + WS_Y5S; u.b = ws + WS_WGLUT + (size_t)L * 256 * 2048; return true;
        case L_OUT0: { if (L >= 256) return false; int pm, pn; static_order(L, 64, 4, pm, pn); u.pm = pm; u.pn = pn; u.kind = K_OUT0; u.a = (const char*)(outp + O_HGS) + (size_t)pm * 256 * 4096; u.b = ws + WS_WOUT0T + (size_t)pn * 256 * 4096; return true; }
        case L_OUT0S: if (L >= 4) return false; u.pm = 0; u.pn = L; u.kind = K_SOUT0; u.a = ws + WS_MIX0S; u.b = ws + WS_WOUT0T + (size_t)L * 256 * 4096; return true;
        case L_IN1: {
            if (L >= 1024) return false; int pm, pn; static_order(L, 64, 16, pm, pn); u.pm = pm; u.pn = pn;
            if (pn >= 8 && pn < 12) { u.kind = K_IT; u.a = ws + WS_WIN1T + (size_t)(256 * pn) * 2048; u.b = ws + WS_X1B + (size_t)pm * 256 * 2048; }
            else { u.kind = pn < 4 ? K_Q1 : pn < 8 ? K_F : K_G1; u.a = ws + WS_X1B + (size_t)pm * 256 * 2048; u.b = ws + WS_WIN1T + (size_t)pn * 256 * 2048; }
            return true; }
        case L_IN1S: if (L >= 16) return false; u.pm = 0; u.pn = L; u.kind = K_SIN1; u.a = ws + WS_X1SB; u.b = ws + WS_WIN1T + (size_t)L * 256 * 2048; return true;
        case L_OUT1: { if (L >= 256) return false; int pm, pn; static_order(L, 64, 4, pm, pn); u.pm = pm; u.pn = pn; u.kind = K_OUT1; u.a = ws + WS_Q1 + (size_t)pm * 256 * 2048; u.b = ws + WS_WOUT1T + (size_t)pn * 256 * 2048; return true; }
        case L_OUT1S: if (L >= 4) return false; u.pm = 0; u.pn = L; u.kind = K_SOUT1; u.a = ws + WS_O1S; u.b = ws + WS_WOUT1T + (size_t)L * 256 * 2048; return true;
        }
        return false;
    }
};

DEVI void epilogue(const Params& p, const f32x4 (&acc)[2][2][4][2], const Unit& u, int wr, int wc, int fr, int fq) {
    char* ws = p.ws;
    const int kind = u.kind;
    if (kind == K_Q || kind == K_K) {
        const float* rope = (const float*)(ws + WS_ROPE);
        bf16_t* dst = (bf16_t*)(ws + (kind == K_Q ? WS_Q : WS_KN));
        bf16_t* kt = (bf16_t*)(ws + WS_KT);
        const int tq = kind == K_Q ? u.pn : u.pn - 2;
        const float sc = kind == K_Q ? 1.0f : 0.08838834764831845f;
#pragma unroll
        for (int ai = 0; ai < 2; ++ai) {
#pragma unroll
          for (int mh = 0; mh < 2; ++mh) {
            f32x4 cs[4][2], sn[4][2];
#pragma unroll
            for (int m = mh * 2; m < mh * 2 + 2; ++m)
#pragma unroll
                for (int n = 0; n < 2; ++n) {
                    const int token = u.pm * 256 + ai * 128 + wr * 64 + m * 16 + fr, pos = token & 2047, j = (wc * 32 + n * 16 + fq * 4) & 63;
                    cs[m][n] = *(const f32x4*)(rope + pos * 128 + j); sn[m][n] = *(const f32x4*)(rope + pos * 128 + 64 + j);
                }
#pragma unroll
            for (int m = mh * 2; m < mh * 2 + 2; ++m) {
                const int token = u.pm * 256 + ai * 128 + wr * 64 + m * 16 + fr;
#pragma unroll
                for (int n = 0; n < 2; ++n) {
                    const int w = wc * 32 + n * 16 + fq * 4, hl = w >> 6, j = w & 63, head = 2 * tq + hl;
                    const f32x4 x1 = acc[ai][0][m][n], x2 = acc[ai][1][m][n];
                    const f32x4 y1 = (x1 * cs[m][n] - x2 * sn[m][n]) * sc, y2 = (x1 * sn[m][n] + x2 * cs[m][n]) * sc;
                    bf16_t* d = dst + (size_t)token * 512 + head * 128 + j;
                    *(u32x2*)d = pack4(y1); *(u32x2*)(d + 64) = pack4(y2);
                    if (kind == K_K) {
                        const int b = token >> 11, t = token & 2047;
                        bf16_t* kk = kt + ((size_t)(b * 4 + head) * 128 + j) * 2048 + t;
#pragma unroll
                        for (int i = 0; i < 4; ++i) { kk[(size_t)i * 2048] = f2bf(y1[i]); kk[(size_t)(64 + i) * 2048] = f2bf(y2[i]); }
                    }
                }
            }
          }
        }
    } else if (kind == K_VT || kind == K_IT) {
        const bool isv = kind == K_VT;
        const float* ssq = (const float*)(ws + WS_SSQ1);
        bf16_t* dst = (bf16_t*)(ws + (isv ? WS_VT : WS_IT));
        f32x4 rsa[2][2];
#pragma unroll
        for (int bj = 0; bj < 2; ++bj)
#pragma unroll
            for (int n = 0; n < 2; ++n) {
                const int token = u.pm * 256 + bj * 128 + wc * 32 + n * 16 + fq * 4;
                f32x4 rs = {1.f, 1.f, 1.f, 1.f};
                if (!isv) { rs[0] = row_rstd16(ssq, token); rs[1] = row_rstd16(ssq, token + 1); rs[2] = row_rstd16(ssq, token + 2); rs[3] = row_rstd16(ssq, token + 3); }
                rsa[bj][n] = rs;
            }
#pragma unroll
        for (int bj = 0; bj < 2; ++bj)
#pragma unroll
            for (int n = 0; n < 2; ++n) {
                const int token = u.pm * 256 + bj * 128 + wc * 32 + n * 16 + fq * 4, b = token >> 11, t = token & 2047;
                const f32x4 rs = rsa[bj][n];
#pragma unroll
                for (int ai = 0; ai < 2; ++ai)
#pragma unroll
                    for (int m = 0; m < 4; ++m) {
                        const int row = ai * 128 + wr * 64 + m * 16 + fr;
                        size_t off;
                        if (isv) off = ((size_t)(b * 4 + (u.pn - 4)) * 256 + row) * 2048 + t;
                        else { const int eg = (u.pn - 8) * 256 + row; off = ((size_t)(b * 8 + (eg >> 7)) * 128 + (eg & 127)) * 2048 + t; }
                        *(u32x2*)(dst + off) = pack4(acc[ai][bj][m][n] * rs);
                    }
            }
    } else if (kind == K_GA || kind == K_GB || kind == K_U) {
#pragma unroll
        for (int ai = 0; ai < 2; ++ai)
#pragma unroll
            for (int m = 0; m < 4; ++m) {
                const int token = u.pm * 256 + ai * 128 + wr * 64 + m * 16 + fr;
#pragma unroll
                for (int bj = 0; bj < 2; ++bj)
#pragma unroll
                    for (int n = 0; n < 2; ++n) {
                        const int cl = bj * 128 + wc * 32 + n * 16 + fq * 4;
                        f32x4 v = acc[ai][bj][m][n];
                        if (kind == K_U) {
                            const int cu = (u.pn - 12) * 256 + cl, g = cu >> 4, c = cu & 15;
                            bf16_t* d = (bf16_t*)(ws + WS_A2) + ((size_t)g * 1024 + (token >> 4)) * 384 + (token & 15) * 16 + c;
                            *(u32x2*)d = pack4(v);
                        } else {
                            v[0] = silu_(v[0]); v[1] = silu_(v[1]); v[2] = silu_(v[2]); v[3] = silu_(v[3]);
                            bf16_t* d = (bf16_t*)(ws + (kind == K_GA ? WS_SGA : WS_SGB)) + (size_t)token * 1024 + (u.pn - (kind == K_GA ? 8 : 16)) * 256 + cl;
                            *(u32x2*)d = pack4(v);
                        }
                    }
            }
    } else if (kind == K_SIN0) {
        const float* rope = (const float*)(ws + WS_ROPE) + 2048 * 128;
        float* zs = (float*)(ws + WS_ZS);
#pragma unroll
        for (int m = 0; m < 4; ++m) {
            const int row = wr * 64 + m * 16 + fr;
            if (u.pn < 4) {
                const float sc = u.pn < 2 ? 1.0f : 0.08838834764831845f;
#pragma unroll
                for (int n = 0; n < 2; ++n) {
                    const int w = wc * 32 + n * 16 + fq * 4, hl = w >> 6, j = w & 63;
                    const f32x4 cs = *(const f32x4*)(rope + j), sn = *(const f32x4*)(rope + 64 + j);
                    const f32x4 x1 = acc[0][0][m][n], x2 = acc[0][1][m][n];
                    float* d = zs + (size_t)row * 5120 + u.pn * 256 + hl * 128 + j;
                    *(f32x4*)d = (x1 * cs - x2 * sn) * sc; *(f32x4*)(d + 64) = (x1 * sn + x2 * cs) * sc;
                }
            } else {
                const bool gate = (u.pn >= 8 && u.pn < 12) || u.pn >= 16;
#pragma unroll
                for (int bj = 0; bj < 2; ++bj)
#pragma unroll
                    for (int n = 0; n < 2; ++n) {
                        f32x4 v = acc[0][bj][m][n];
                        if (gate) { v[0] = silu_(v[0]); v[1] = silu_(v[1]); v[2] = silu_(v[2]); v[3] = silu_(v[3]); }
                        *(f32x4*)(zs + (size_t)row * 5120 + u.pn * 256 + bj * 128 + wc * 32 + n * 16 + fq * 4) = v;
                    }
            }
        }
    } else if (kind == K_E5) {
        float* e5 = (float*)(p.out + O_HGS);
#pragma unroll
        for (int ai = 0; ai < 2; ++ai)
#pragma unroll
            for (int m = 0; m < 4; ++m) {
                const int row = u.pm * 256 + ai * 128 + wr * 64 + m * 16 + fr;
#pragma unroll
                for (int n = 0; n < 2; ++n) *(f32x4*)(e5 + ((size_t)u.pn * 1024 + row) * 128 + wc * 32 + n * 16 + fq * 4) = acc[ai][0][m][n];
            }
    } else if (kind == K_Y5) {
        const bf16_t* a2 = (const bf16_t*)(ws + WS_A2);
        bf16_t* y5 = (bf16_t*)(ws + WS_Y5);
        const int g = u.pn;
        f32x4 ddv[2][2];
#pragma unroll
        for (int bj = 0; bj < 2; ++bj)
#pragma unroll
            for (int n = 0; n < 2; ++n) ddv[bj][n] = *(const f32x4*)(p.s5d + g * 16 + ((bj * 128 + wc * 32 + n * 16 + fq * 4) & 15));
#pragma unroll
        for (int ai = 0; ai < 2; ++ai) {
#pragma unroll
          for (int mh = 0; mh < 2; ++mh) {
            u32x2 uv[4][2][2];
#pragma unroll
            for (int m = mh * 2; m < mh * 2 + 2; ++m)
#pragma unroll
                for (int bj = 0; bj < 2; ++bj)
#pragma unroll
                    for (int n = 0; n < 2; ++n) uv[m][bj][n] = *(const u32x2*)(a2 + ((size_t)g * 1024 + u.pm * 256 + ai * 128 + wr * 64 + m * 16 + fr) * 384 + bj * 128 + wc * 32 + n * 16 + fq * 4);
#pragma unroll
            for (int m = mh * 2; m < mh * 2 + 2; ++m) {
                const int row = u.pm * 256 + ai * 128 + wr * 64 + m * 16 + fr;
#pragma unroll
                for (int bj = 0; bj < 2; ++bj)
#pragma unroll
                    for (int n = 0; n < 2; ++n) {
                        const int col = bj * 128 + wc * 32 + n * 16 + fq * 4;
                        const u32x2 uu = uv[m][bj][n]; const f32x4 dd = ddv[bj][n];
                        f32x4 v = acc[ai][bj][m][n];
                        v[0] = gelu_(v[0] + dd[0] * bflo(uu.x)); v[1] = gelu_(v[1] + dd[1] * bfhi(uu.x));
                        v[2] = gelu_(v[2] + dd[2] * bflo(uu.y)); v[3] = gelu_(v[3] + dd[3] * bfhi(uu.y));
                        *(u32x2*)(y5 + ((size_t)g * 1024 + row) * 256 + col) = pack4(v);
                    }
            }
          }
        }
    } else if (kind == K_SGLU) {
        const bf16_t* y5 = (const bf16_t*)(ws + WS_Y5S);
        const float* zs = (const float*)(ws + WS_ZS);
        bf16_t* mix = (bf16_t*)(ws + WS_MIX0S);
#pragma unroll
        for (int m = 0; m < 4; ++m) {
            const size_t token = (size_t)wr * 64 + m * 16 + fr;
#pragma unroll
            for (int bj = 0; bj < 2; ++bj)
#pragma unroll
                for (int n = 0; n < 2; ++n) {
                    const int col = u.pn * 256 + bj * 128 + wc * 32 + n * 16 + fq * 4;
                    const f32x4 bb = *(const f32x4*)(p.glub + col);
                    const u32x2 yy = *(const u32x2*)(y5 + token * 1024 + col);
                    const f32x4 gg = *(const f32x4*)(zs + token * 5120 + 4096 + col);
                    f32x4 v = acc[0][bj][m][n] + bb;
                    v[0] = bflo(yy.x) * sigm(v[0]) * gg[0]; v[1] = bfhi(yy.x) * sigm(v[1]) * gg[1];
                    v[2] = bflo(yy.y) * sigm(v[2]) * gg[2]; v[3] = bfhi(yy.y) * sigm(v[3]) * gg[3];
                    *(u32x2*)(mix + token * 2048 + 1024 + col) = pack4(v);
                }
        }
    } else if (kind == K_GLU) {
        const bf16_t* y5 = (const bf16_t*)(ws + WS_Y5);
        const bf16_t* sgb = (const bf16_t*)(ws + WS_SGB);
        bf16_t* mix = (bf16_t*)(p.out + O_HGS);
        f32x4 bbv[2][2];
#pragma unroll
        for (int bj = 0; bj < 2; ++bj)
#pragma unroll
            for (int n = 0; n < 2; ++n) bbv[bj][n] = *(const f32x4*)(p.glub + u.pn * 256 + bj * 128 + wc * 32 + n * 16 + fq * 4);
#pragma unroll
        for (int ai = 0; ai < 2; ++ai)
#pragma unroll
          for (int mh = 0; mh < 2; ++mh) {
            u32x2 yv[4][2][2], gp[4][2][2];
#pragma unroll
            for (int m = mh * 2; m < mh * 2 + 2; ++m)
#pragma unroll
                for (int bj = 0; bj < 2; ++bj)
#pragma unroll
                    for (int n = 0; n < 2; ++n) {
                        const size_t token = (size_t)u.pm * 256 + ai * 128 + wr * 64 + m * 16 + fr; const int col = u.pn * 256 + bj * 128 + wc * 32 + n * 16 + fq * 4;
                        yv[m][bj][n] = *(const u32x2*)(y5 + ((size_t)(col >> 4) * MP + token) * 16 + (col & 15));
                        gp[m][bj][n] = *(const u32x2*)(sgb + token * 1024 + col);
                    }
#pragma unroll
            for (int m = mh * 2; m < mh * 2 + 2; ++m) {
                const size_t token = (size_t)u.pm * 256 + ai * 128 + wr * 64 + m * 16 + fr;
#pragma unroll
                for (int bj = 0; bj < 2; ++bj)
#pragma unroll
                    for (int n = 0; n < 2; ++n) {
                        const int col = u.pn * 256 + bj * 128 + wc * 32 + n * 16 + fq * 4;
                        const u32x2 yy = yv[m][bj][n], t = gp[m][bj][n];
                        f32x4 v = acc[ai][bj][m][n] + bbv[bj][n];
                        v[0] = bflo(yy.x) * sigm(v[0]) * bflo(t.x); v[1] = bfhi(yy.x) * sigm(v[1]) * bfhi(t.x);
                        v[2] = bflo(yy.y) * sigm(v[2]) * bflo(t.y); v[3] = bfhi(yy.y) * sigm(v[3]) * bfhi(t.y);
                        *(u32x2*)(mix + token * 2048 + 1024 + col) = pack4(v);
                    }
            }
          }
    } else if (kind == K_OUT0 || kind == K_SOUT0 || kind == K_OUT1 || kind == K_SOUT1) {
        const bool smp = kind == K_SOUT0 || kind == K_SOUT1, l0 = kind == K_OUT0 || kind == K_SOUT0;
        const float* res = l0 ? (smp ? p.xs : p.xp) : (smp ? (const float*)(ws + WS_X1S) : p.out + O_YP);
        float* dst = l0 ? (smp ? (float*)(ws + WS_X1S) : p.out + O_YP) : (smp ? p.out + O_YS : p.out + O_YP);
        bf16_t* dstb = (bf16_t*)(ws + (smp ? WS_X1SB : WS_X1B));
        float* ssq = (float*)(ws + (l0 ? (smp ? WS_SSQ1S : WS_SSQ1) : (smp ? WS_SSQ2S : WS_SSQ2)));
#pragma unroll
        for (int ai = 0; ai < 2; ++ai) {
            if (smp && ai) break;
#pragma unroll
          for (int mh = 0; mh < 2; ++mh) {
            f32x4 rv[4][2][2];
#pragma unroll
            for (int m = mh * 2; m < mh * 2 + 2; ++m)
#pragma unroll
                for (int bj = 0; bj < 2; ++bj)
#pragma unroll
                    for (int n = 0; n < 2; ++n) rv[m][bj][n] = *(const f32x4*)(res + ((size_t)u.pm * 256 + ai * 128 + wr * 64 + m * 16 + fr) * 1024 + u.pn * 256 + bj * 128 + wc * 32 + n * 16 + fq * 4);
#pragma unroll
            for (int m = mh * 2; m < mh * 2 + 2; ++m) {
                const size_t token = (size_t)u.pm * 256 + ai * 128 + wr * 64 + m * 16 + fr;
                float s = 0.f;
#pragma unroll
                for (int bj = 0; bj < 2; ++bj)
#pragma unroll
                    for (int n = 0; n < 2; ++n) {
                        const int col = u.pn * 256 + bj * 128 + wc * 32 + n * 16 + fq * 4;
                        const f32x4 v = acc[ai][bj][m][n] + rv[m][bj][n];
                        *(f32x4*)(dst + token * 1024 + col) = v;
                        if (l0) *(u32x2*)(dstb + token * 1024 + col) = pack4(v);
                        s += v[0] * v[0] + v[1] * v[1] + v[2] * v[2] + v[3] * v[3];
                    }
                s += __shfl_xor(s, 16); s += __shfl_xor(s, 32);
                if (fq == 0) ssq[((size_t)u.pn * MP + token) * 4 + wc] = s;
            }
          }
        }
    } else if (kind == K_Q1 || kind == K_F || kind == K_G1) {
        const float* ssq = (const float*)(ws + WS_SSQ1);
        const float* lb = (const float*)(ws + WS_LB);
#pragma unroll
        for (int ai = 0; ai < 2; ++ai) {
            float rr[4];
#pragma unroll
            for (int m = 0; m < 4; ++m) rr[m] = row_rstd16(ssq, (size_t)u.pm * 256 + ai * 128 + wr * 64 + m * 16 + fr);
            __builtin_amdgcn_sched_barrier(0);
#pragma unroll
            for (int m = 0; m < 4; ++m) {
                const size_t token = (size_t)u.pm * 256 + ai * 128 + wr * 64 + m * 16 + fr;
                const float r = rr[m];
#pragma unroll
                for (int bj = 0; bj < 2; ++bj)
#pragma unroll
                    for (int n = 0; n < 2; ++n) {
                        const int cl = (u.pn & 3) * 256 + bj * 128 + wc * 32 + n * 16 + fq * 4;
                        f32x4 v = acc[ai][bj][m][n] * r;
                        if (kind == K_F) {
                            const f32x4 l = *(const f32x4*)(lb + cl);
#pragma unroll
                            for (int i = 0; i < 4; ++i) v[i] = __logf(l[i] + (1.f - l[i]) * sigm(v[i]));
                            *(f32x4*)((float*)(ws + WS_CUM) + token * 1024 + cl) = v;
                        } else {
                            v[0] = silu_(v[0]); v[1] = silu_(v[1]); v[2] = silu_(v[2]); v[3] = silu_(v[3]);
                            *(u32x2*)((bf16_t*)(ws + (kind == K_Q1 ? WS_Q1 : WS_SG1)) + token * 1024 + cl) = pack4(v);
                        }
                    }
            }
        }
    } else if (kind == K_SIN1) {
        const float* ssq = (const float*)(ws + WS_SSQ1S);
        const float* lb = (const float*)(ws + WS_LB);
        float* z1 = (float*)(ws + WS_Z1S);
#pragma unroll
        for (int m = 0; m < 4; ++m) {
            const size_t row = wr * 64 + m * 16 + fr;
            const float r = row_rstd16(ssq, row);
            const int ty = u.pn >> 2;
#pragma unroll
            for (int bj = 0; bj < 2; ++bj)
#pragma unroll
                for (int n = 0; n < 2; ++n) {
                    const int cl = (u.pn & 3) * 256 + bj * 128 + wc * 32 + n * 16 + fq * 4;
                    f32x4 v = acc[0][bj][m][n] * r;
                    if (ty == 1) { const f32x4 l = *(const f32x4*)(lb + cl);
#pragma unroll
                        for (int i = 0; i < 4; ++i) v[i] = l[i] + (1.f - l[i]) * sigm(v[i]); }
                    else if (ty != 2) { v[0] = silu_(v[0]); v[1] = silu_(v[1]); v[2] = silu_(v[2]); v[3] = silu_(v[3]); }
                    *(f32x4*)(z1 + row * 4096 + ty * 1024 + cl) = v;
                }
        }
    }
}

DEVI void gemm_phase(const int TIDX, LAS unsigned char* lds, const int K, const int lda, const int ldb, const bool ga, const Sched S, const Params& P) {
    const int tid = TIDX, wid = __builtin_amdgcn_readfirstlane(tid >> 6), lane = tid & 63, wr = wid >> 2, wc = wid & 3, fr = lane & 15, fq = lane >> 4;
    const int nt = K / BK;
    unsigned voffA[2], voffB[2];
#pragma unroll
    for (int i = 0; i < 2; ++i) { int R, C; stage_rc(tid * 16 + i * 8192, R, C); voffA[i] = ga ? (unsigned)(R * 32 + (C >> 4) * (MP * 32) + (C & 15) * 2) : (unsigned)(R * lda + C) * 2u; voffB[i] = (unsigned)(R * ldb + C) * 2u; }
    const size_t kstep = (size_t)(BK * 2), kstepA = ga ? (size_t)4 * MP * 32 : kstep;
    const size_t hstepA = ga ? (size_t)HALF * 32 : (size_t)HALF * lda * 2, hstepB = (size_t)HALF * ldb * 2;
    const unsigned ldsw = (unsigned)wid * 1024u;
    const int aoff = lds_byte(wr * 64 + fr, fq * 8), boff = lds_byte(wc * 32 + fr, fq * 8);
#define PG8_SA(b, h) (((b) * 2 + (h)) * HTB)
#define PG8_SB(b, h) ((4 + (b) * 2 + (h)) * HTB)
#define PG8_STAGE(bufoff, gbase, voff) do { _Pragma("unroll") for (int _i = 0; _i < 2; ++_i) \
        __builtin_amdgcn_global_load_lds((const unsigned*)((const char*)(gbase) + (voff)[_i]), (LAS unsigned*)(lds + (bufoff) + ldsw + _i * 8192), 16, 0, 0); } while (0)
#define PG8_LDA(dst, b, h) do { _Pragma("unroll") for (int m = 0; m < 4; ++m) _Pragma("unroll") for (int k = 0; k < 2; ++k) dst[m][k] = *(const LAS bf16x8*)(lds + PG8_SA(b, h) + aoff + m * 2048 + k * 1024); } while (0)
#define PG8_LDB(dst, b, h) do { _Pragma("unroll") for (int n = 0; n < 2; ++n) _Pragma("unroll") for (int k = 0; k < 2; ++k) dst[n][k] = *(const LAS bf16x8*)(lds + PG8_SB(b, h) + boff + n * 2048 + k * 1024); } while (0)
#define PG8_MMA(ai, bj, At, Bt) do { __builtin_amdgcn_s_setprio(1); _Pragma("unroll") for (int m = 0; m < 4; ++m) _Pragma("unroll") for (int n = 0; n < 2; ++n) _Pragma("unroll") for (int k = 0; k < 2; ++k) \
        acc[ai][bj][m][n] = __builtin_amdgcn_mfma_f32_16x16x32_bf16(Bt[n][k], At[m][k], acc[ai][bj][m][n], 0, 0, 0); __builtin_amdgcn_s_setprio(0); } while (0)
#define PG8_WAIT_V(n) asm volatile("s_waitcnt vmcnt(" #n ")" ::: "memory")
#define PG8_WAIT_L(n) asm volatile("s_waitcnt lgkmcnt(" #n ")" ::: "memory")
#define PG8_BAR __builtin_amdgcn_s_barrier()
#define PG8_SCHED __builtin_amdgcn_sched_barrier(0)
    Unit cur, nxt; int ui = 0;
    if (!S.next(0, cur)) return;
    f32x4 acc[2][2][4][2];
#pragma unroll
    for (int a = 0; a < 2; ++a)
#pragma unroll
        for (int b = 0; b < 2; ++b)
#pragma unroll
            for (int m = 0; m < 4; ++m)
#pragma unroll
                for (int n = 0; n < 2; ++n) acc[a][b][m][n] = (f32x4){0.f, 0.f, 0.f, 0.f};
    bf16x8 At[4][2], B0[2][2], B1[2][2];
    const char* cA = cur.a; const char* cB = cur.b;
    PG8_STAGE(PG8_SB(0, 0), cB, voffB); PG8_STAGE(PG8_SA(0, 0), cA, voffA); PG8_STAGE(PG8_SB(0, 1), cB + hstepB, voffB); PG8_STAGE(PG8_SA(0, 1), cA + hstepA, voffA);
    if (wr == 1) PG8_BAR;
    PG8_WAIT_V(4); PG8_BAR;
    PG8_STAGE(PG8_SB(1, 0), cB + kstep, voffB); PG8_STAGE(PG8_SA(1, 0), cA + kstepA, voffA); PG8_STAGE(PG8_SB(1, 1), cB + hstepB + kstep, voffB);
    PG8_WAIT_V(6); PG8_BAR;
    for (;;) {
        const bool has_next = S.next(ui + 1, nxt);
        const char* nA = has_next ? nxt.a : cA; const char* nB = has_next ? nxt.b : cB;
        for (int t = 0; t < nt; t += 2) {
            const bool last = (t == nt - 2);
            const char* a1 = cA + (size_t)(t + 1) * kstepA;
            const char* a2 = last ? nA : cA + (size_t)(t + 2) * kstepA; const char* b2 = last ? nB : cB + (size_t)(t + 2) * kstep;
            const char* a3 = a2 + kstepA; const char* b3 = b2 + kstep;
            PG8_LDB(B0, 0, 0); PG8_SCHED; PG8_LDA(At, 0, 0); PG8_STAGE(PG8_SA(1, 1), a1 + hstepA, voffA);
            PG8_WAIT_L(8); PG8_BAR; PG8_WAIT_L(0); PG8_MMA(0, 0, At, B0); PG8_BAR; PG8_SCHED;
            PG8_LDB(B1, 0, 1); PG8_STAGE(PG8_SB(0, 0), b2, voffB);
            PG8_BAR; PG8_WAIT_L(0); PG8_MMA(0, 1, At, B1); PG8_BAR;
            PG8_LDA(At, 0, 1); PG8_STAGE(PG8_SA(0, 0), a2, voffA);
            PG8_BAR; PG8_WAIT_L(0); PG8_MMA(1, 0, At, B0); PG8_BAR; PG8_SCHED;
            PG8_STAGE(PG8_SB(0, 1), b2 + hstepB, voffB);
            PG8_WAIT_V(6); PG8_BAR; PG8_MMA(1, 1, At, B1); PG8_BAR;
            PG8_LDB(B0, 1, 0); PG8_SCHED; PG8_LDA(At, 1, 0); PG8_STAGE(PG8_SA(0, 1), a2 + hstepA, voffA);
            PG8_WAIT_L(8); PG8_BAR; PG8_WAIT_L(0); PG8_MMA(0, 0, At, B0); PG8_BAR; PG8_SCHED;
            PG8_LDB(B1, 1, 1); PG8_STAGE(PG8_SB(1, 0), b3, voffB);
            PG8_BAR; PG8_WAIT_L(0); PG8_MMA(0, 1, At, B1); PG8_BAR;
            PG8_LDA(At, 1, 1); PG8_STAGE(PG8_SA(1, 0), a3, voffA);
            PG8_BAR; PG8_WAIT_L(0); PG8_MMA(1, 0, At, B0); PG8_BAR; PG8_SCHED;
            PG8_STAGE(PG8_SB(1, 1), b3 + hstepB, voffB);
            PG8_WAIT_V(6); PG8_BAR; PG8_MMA(1, 1, At, B1); PG8_BAR;
        }
        { int ozv; asm volatile("v_mov_b32 %0, 0" : "=v"(ozv)); epilogue(P, acc, cur, wr, wc, fr + ozv, fq + ozv); }
        if (!has_next) break;
#pragma unroll
        for (int a = 0; a < 2; ++a)
#pragma unroll
            for (int b = 0; b < 2; ++b)
#pragma unroll
                for (int m = 0; m < 4; ++m)
#pragma unroll
                    for (int n = 0; n < 2; ++n) acc[a][b][m][n] = (f32x4){0.f, 0.f, 0.f, 0.f};
        cur = nxt; cA = nA; cB = nB; ++ui;
    }
    PG8_WAIT_V(0);
    if (wr == 0) PG8_BAR;
    PG8_BAR;
}

DEVI void prep_transpose(const int TIDX, const int BIDX, float* tile, const float* src, int K, int N, bf16_t* dst, const float* kscale, bool permqk, int job0, int& jobbase, int gsz) {
    (void)tile;
    const int nk8 = K / 8, ntn = N / 64, njobs = ntn * (nk8 / 8), lane = TIDX & 63, wid = TIDX >> 6;
    for (int jb = job0 - jobbase; jb < njobs; jb += gsz) {
        if (jb < 0) continue;
        const int tn = jb / (nk8 / 8), tk = jb % (nk8 / 8), n0 = tn * 64, k0 = tk * 64 + wid * 8;
        int c0 = n0;
        if (permqk && n0 < 1024) { const int tile_ = n0 >> 8, cp = n0 & 255, bj = cp >> 7, w = cp & 127; c0 = tile_ * 256 + (w >> 6) * 128 + bj * 64; }
        float v[8];
#pragma unroll
        for (int j = 0; j < 8; ++j) v[j] = src[(size_t)(k0 + j) * N + c0 + lane] * (kscale ? kscale[k0 + j] : 1.f);
        u32x4 o; o.x = pack2(v[0], v[1]); o.y = pack2(v[2], v[3]); o.z = pack2(v[4], v[5]); o.w = pack2(v[6], v[7]);
        *(u32x4*)(dst + (size_t)(n0 + lane) * K + k0) = o;
    }
    jobbase += njobs;
}

DEVI void prep_s5_tables(const int TIDX, const int BIDX, float* L, const Params& p, int g) {
    float* pwr = L;
    float* pwi = pwr + 17 * 64;
    float* bbr = pwi + 17 * 64;
    float* bbi = bbr + 1024;
    float* cr = bbi + 1024;
    float* ci = cr + 1024;
    float* kg = ci + 1024;
    const int tid = TIDX;
    char* ws = p.ws;
    __syncthreads();
    {
        const double dt = exp((double)p.logdt[g]);
        for (int i = tid; i < 17 * 64; i += 512) {
            const int t = i >> 6, pp = i & 63;
            const double lr = p.lamre[g * 64 + pp], li = p.lamim[g * 64 + pp];
            const double mag = exp(lr * dt * t), ang = li * dt * t;
            pwr[t * 64 + pp] = (float)(mag * cos(ang)); pwi[t * 64 + pp] = (float)(mag * sin(ang));
        }
        for (int i = tid; i < 1024; i += 512) {
            const int pp = i >> 4, c = i & 15;
            const double lr = p.lamre[g * 64 + pp], li = p.lamim[g * 64 + pp];
            const double mag = exp(lr * dt), ang = li * dt, lbr = mag * cos(ang), lbi = mag * sin(ang);
            const double nr = lbr - 1.0, den = lr * lr + li * li, fr = (nr * lr + lbi * li) / den, fi = (lbi * lr - nr * li) / den;
            const double br = p.bre[(g * 64 + pp) * 16 + c], bi = p.bim[(g * 64 + pp) * 16 + c];
            const float xr = (float)(fr * br - fi * bi), xi = (float)(fr * bi + fi * br);
            bbr[i] = xr; bbi[i] = xi;
            float* bbg = (float*)(ws + WS_BBG); bbg[(g * 1024 + i) * 2] = xr; bbg[(g * 1024 + i) * 2 + 1] = xi;
            if (c == 0) { float* lam1 = (float*)(ws + WS_LAM1); lam1[(g * 64 + pp) * 2] = (float)lbr; lam1[(g * 64 + pp) * 2 + 1] = (float)lbi; }
        }
    }
    __syncthreads();
    if (tid < 64) { float* lam16 = (float*)(ws + WS_LAM16); lam16[(g * 64 + tid) * 2] = pwr[16 * 64 + tid]; lam16[(g * 64 + tid) * 2 + 1] = pwi[16 * 64 + tid]; }
    for (int i = tid; i < 1024; i += 512) { cr[i] = p.cre[g * 1024 + i]; ci[i] = p.cim[g * 1024 + i]; }
    __syncthreads();
    for (int i = tid; i < 4096; i += 512) {
        const int tau = i >> 8, c = (i >> 4) & 15, cp = i & 15;
        float s = 0.f;
        for (int pp = 0; pp < 64; ++pp) {
            const float a = pwr[tau * 64 + pp], b = pwi[tau * 64 + pp], xr = bbr[pp * 16 + cp], xi = bbi[pp * 16 + cp];
            s += cr[c * 64 + pp] * (a * xr - b * xi) - ci[c * 64 + pp] * (a * xi + b * xr);
        }
        kg[i] = s;
    }
    __syncthreads();
    bf16_t* bt2 = (bf16_t*)(ws + WS_BT2) + (size_t)g * 256 * 384;
    for (int i = tid; i < 256 * 48; i += 512) {
        const int n = i / 48, k8 = (i % 48) * 8, t = n >> 4, c = n & 15;
        float v[8];
#pragma unroll
        for (int j = 0; j < 8; ++j) {
            const int k = k8 + j;
            if (k < 256) { const int s = k >> 4, cp = k & 15; v[j] = t >= s ? kg[(t - s) * 256 + c * 16 + cp] : 0.f; }
            else { const int q = k - 256, pp = q & 63; const float a = pwr[(t + 1) * 64 + pp], b = pwi[(t + 1) * 64 + pp];
                v[j] = q < 64 ? (cr[c * 64 + pp] * a - ci[c * 64 + pp] * b) : -(cr[c * 64 + pp] * b + ci[c * 64 + pp] * a); }
        }
        u32x4 o; o.x = pack2(v[0], v[1]); o.y = pack2(v[2], v[3]); o.z = pack2(v[4], v[5]); o.w = pack2(v[6], v[7]);
        *(u32x4*)(bt2 + (size_t)n * 384 + k8) = o;
    }
    bf16_t* bt1 = (bf16_t*)(ws + WS_BT1) + (size_t)g * 256 * 256;
    for (int i = tid; i < 256 * 32; i += 512) {
        const int n = i >> 5, k8 = (i & 31) * 8;
        float v[8];
#pragma unroll
        for (int j = 0; j < 8; ++j) {
            const int k = k8 + j, s = k >> 4, cp = k & 15;
            if (n >= 128) v[j] = 0.f;
            else { const int pp = n & 63; const float a = pwr[(15 - s) * 64 + pp], b = pwi[(15 - s) * 64 + pp], xr = bbr[pp * 16 + cp], xi = bbi[pp * 16 + cp];
                v[j] = n < 64 ? (a * xr - b * xi) : (a * xi + b * xr); }
        }
        u32x4 o; o.x = pack2(v[0], v[1]); o.y = pack2(v[2], v[3]); o.z = pack2(v[4], v[5]); o.w = pack2(v[6], v[7]);
        *(u32x4*)(bt1 + (size_t)n * 256 + k8) = o;
    }
}

DEVI void phase_prep(const int TIDX, const int BIDX, float* L, const Params& p) {
    const int tid = TIDX, bid = BIDX, G = gridDim.x, lane = tid & 63, wid = tid >> 6;
    char* ws = p.ws;
    for (int g = G - 1 - bid; g < 64; g += G) if (g >= 0) prep_s5_tables(TIDX, BIDX, L, p, g);
    __syncthreads();
    const int GT = G > 64 ? G - 64 : G;
    const int tb = (G > 64 && bid >= GT) ? (1 << 28) : bid;
    int jobbase = 0;
    prep_transpose(TIDX, BIDX, L, p.win0, 1024, 5120, (bf16_t*)(ws + WS_WIN0T), nullptr, true, tb, jobbase, GT);
    prep_transpose(TIDX, BIDX, L, p.gluw, 1024, 1024, (bf16_t*)(ws + WS_WGLUT), nullptr, false, tb, jobbase, GT);
    prep_transpose(TIDX, BIDX, L, p.wout0, 2048, 1024, (bf16_t*)(ws + WS_WOUT0T), nullptr, false, tb, jobbase, GT);
    prep_transpose(TIDX, BIDX, L, p.win1, 1024, 4096, (bf16_t*)(ws + WS_WIN1T), p.normw + 1024, false, tb, jobbase, GT);
    prep_transpose(TIDX, BIDX, L, p.wout1, 1024, 1024, (bf16_t*)(ws + WS_WOUT1T), nullptr, false, tb, jobbase, GT);
    bf16_t* h0 = (bf16_t*)(p.out + O_RETS); bf16_t* h0s = (bf16_t*)(ws + WS_H0S);
    for (int row = bid * 8 + wid; row < MP + 256; row += G * 8) {
        bf16_t* d = row < MP ? h0 + (size_t)row * 1024 : h0s + (size_t)(row - MP) * 1024;
        if (row >= MP + MS) { for (int i = 0; i < 4; ++i) *(u32x2*)(d + i * 256 + lane * 4) = (u32x2){0u, 0u}; continue; }
        const float* x = row < MP ? p.xp + (size_t)row * 1024 : p.xs + (size_t)(row - MP) * 1024;
        f32x4 v[4]; float s = 0.f;
#pragma unroll
        for (int i = 0; i < 4; ++i) { v[i] = *(const f32x4*)(x + i * 256 + lane * 4); s += v[i][0] * v[i][0] + v[i][1] * v[i][1] + v[i][2] * v[i][2] + v[i][3] * v[i][3]; }
        s = wave_sum(s);
        const float r = rsqrtf(s * (1.0f / 1024.0f) + 1e-6f);
#pragma unroll
        for (int i = 0; i < 4; ++i) { const f32x4 w = *(const f32x4*)(p.normw + i * 256 + lane * 4); *(u32x2*)(d + i * 256 + lane * 4) = pack4(v[i] * r * w); }
    }
    for (int i = bid * 512 + tid; i < 128 * 1024 / 8; i += G * 512) {
        const u32x4 z = {0u, 0u, 0u, 0u};
        *(u32x4*)((bf16_t*)(ws + WS_Y5S) + 128 * 1024 + (size_t)i * 8) = z;
        *(u32x4*)((bf16_t*)(ws + WS_X1SB) + 128 * 1024 + (size_t)i * 8) = z;
        *(u32x4*)((bf16_t*)(ws + WS_O1S) + 128 * 1024 + (size_t)i * 8) = z;
        *(u32x4*)((bf16_t*)(ws + WS_MIX0S) + 128 * 2048 + (size_t)i * 16) = z;
        *(u32x4*)((bf16_t*)(ws + WS_MIX0S) + 128 * 2048 + (size_t)i * 16 + 8) = z;
    }
    float* rope = (float*)(ws + WS_ROPE);
    for (int i = bid * 512 + tid; i < 2049 * 64; i += G * 512) {
        const int pr = i >> 6, j = i & 63; const double pos = pr == 2048 ? 16384.0 : (double)pr;
        const double inv = exp2(-(double)j * (13.287712379549449 / 64.0));
        const double rev = pos * inv * 0.15915494309189535; const double fr = rev - floor(rev); const double a = fr * 6.283185307179586;
        rope[pr * 128 + j] = (float)cos(a); rope[pr * 128 + 64 + j] = (float)sin(a);
    }
    float* lb = (float*)(ws + WS_LB);
    for (int i = bid * 512 + tid; i < 1024; i += G * 512) lb[i] = 1.f / (1.f + expf(p.hglb[i] - p.hglb[1024 + i]));
}

DEVI float ret_lg(int h) { return log1pf(-exp2f(-5.0f - (float)h)); }

DEVI void phase_R1(const int TIDX, const int BIDX, bf16_t* L, const Params& p) {
    const int tid = TIDX, wid = tid >> 6, lane = tid & 63, r16 = lane & 15, g = lane >> 4;
    const bf16_t* kt = (const bf16_t*)(p.ws + WS_KT); const bf16_t* vt = (const bf16_t*)(p.ws + WS_VT);
    float* kvt = p.out + O_YP;
    for (int it = BIDX; it < 512; it += gridDim.x) {
        const int bh = it >> 4, c = it & 15, h = bh & 3, t0 = c * 128; const float lg = ret_lg(h);
        __syncthreads();
        { const int d = tid >> 2, seg = tid & 3;
#pragma unroll
          for (int q = 0; q < 4; ++q) {
              const int l0 = seg * 32 + q * 8;
              const u32x4 v = *(const u32x4*)(kt + ((size_t)bh * 128 + d) * 2048 + t0 + l0);
              u32x4 o; const unsigned* vv = (const unsigned*)&v; unsigned* oo = (unsigned*)&o;
#pragma unroll
              for (int j = 0; j < 4; ++j) oo[j] = pack2(bflo(vv[j]) * __expf(lg * (float)(127 - l0 - 2 * j)), bfhi(vv[j]) * __expf(lg * (float)(126 - l0 - 2 * j)));
              *(u32x4*)(L + d * 136 + l0) = o; } }
        __syncthreads();
        bf16x8 bfr[2][4];
#pragma unroll
        for (int ct = 0; ct < 2; ++ct)
#pragma unroll
            for (int kk = 0; kk < 4; ++kk) bfr[ct][kk] = *(const bf16x8*)(vt + ((size_t)bh * 256 + wid * 32 + ct * 16 + r16) * 2048 + t0 + kk * 32 + g * 8);
#pragma unroll
        for (int rt = 0; rt < 8; ++rt) {
            f32x4 a0 = {0.f, 0.f, 0.f, 0.f}, a1 = a0;
#pragma unroll
            for (int kk = 0; kk < 4; ++kk) { const bf16x8 a = *(const bf16x8*)(L + (rt * 16 + r16) * 136 + kk * 32 + g * 8); a0 = mfma16(a, bfr[0][kk], a0); a1 = mfma16(a, bfr[1][kk], a1); }
            float* d0 = kvt + (((size_t)bh * 16 + c) * 256 + wid * 32 + r16) * 128 + rt * 16 + g * 4;
            *(f32x4*)d0 = a0; *(f32x4*)(d0 + 16 * 128) = a1;
        }
    }
}

DEVI void phase_R2(const int TIDX, const int BIDX, const Params& p) {
    float* kvt = p.out + O_YP;
    for (int i = BIDX * 512 + TIDX; i < 32 * 256 * 16; i += gridDim.x * 512) {
        const int q = i & 15, e = (i >> 4) & 255, bh = i >> 12, h = bh & 3; const float dec = __expf(ret_lg(h) * 128.f);
        f32x4 s0 = {0.f, 0.f, 0.f, 0.f}, s1 = s0;
#pragma unroll 4
        for (int c = 0; c < 16; ++c) {
            float* ptr = kvt + (((size_t)bh * 16 + c) * 256 + e) * 128 + q * 8;
            const f32x4 v0 = *(const f32x4*)ptr, v1 = *(const f32x4*)(ptr + 4);
            u32x4 o; o.x = pack2(s0[0], s0[1]); o.y = pack2(s0[2], s0[3]); o.z = pack2(s1[0], s1[1]); o.w = pack2(s1[2], s1[3]);
            *(u32x4*)ptr = o;
            s0 = s0 * dec + v0; s1 = s1 * dec + v1;
        }
        float* o = p.out + O_RETP + ((size_t)bh * 128 + q * 8) * 256 + e;
#pragma unroll
        for (int j = 0; j < 4; ++j) { o[(size_t)j * 256] = s0[j]; o[(size_t)(j + 4) * 256] = s1[j]; }
    }
}

DEVI void phase_R3(const int TIDX, const int BIDX, bf16_t* L, const Params& p) {
    const int tid = TIDX, wid = tid >> 6, lane = tid & 63, r16 = lane & 15, g = lane >> 4;
    const bf16_t* Q = (const bf16_t*)(p.ws + WS_Q); const bf16_t* KN = (const bf16_t*)(p.ws + WS_KN); const bf16_t* vt = (const bf16_t*)(p.ws + WS_VT);
    const bf16_t* sga = (const bf16_t*)(p.ws + WS_SGA); bf16_t* mix = (bf16_t*)(p.out + O_HGS);
    const float* kvt = p.out + O_YP;
    bf16_t* S = L;
    float* st = (float*)(L + 128 * 136);
    float* mr = st + 128 * 16;
    const int nwk = gridDim.x == 256 ? 252 : (int)gridDim.x;
    for (int it = BIDX < nwk ? BIDX : 512; it < 512; it += nwk) {
        const int bh = it >> 4, c = it & 15, h = bh & 3, b = bh >> 2, l0 = wid * 16; const size_t tok0 = (size_t)b * 2048 + c * 128; const float lg = ret_lg(h);
        bf16x8 qa[4];
#pragma unroll
        for (int kk = 0; kk < 4; ++kk) qa[kk] = *(const bf16x8*)(Q + (tok0 + l0 + r16) * 512 + h * 128 + kk * 32 + g * 8);
        __syncthreads();
        for (int j = 0; j < 8; ++j) {
            f32x4 sc = {0.f, 0.f, 0.f, 0.f};
            if (j <= wid) {
#pragma unroll
                for (int kk = 0; kk < 4; ++kk) sc = mfma16(qa[kk], *(const bf16x8*)(KN + (tok0 + j * 16 + r16) * 512 + h * 128 + kk * 32 + g * 8), sc);
            }
#pragma unroll
            for (int r = 0; r < 4; ++r) {
                const int li = l0 + g * 4 + r, mi = j * 16 + r16; const float v = (j <= wid && li >= mi) ? sc[r] * __expf(lg * (float)(li - mi)) : 0.f;
                S[li * 136 + mi] = f2bf(v);
            }
        }
        f32x4 acc[8][2];
#pragma unroll
        for (int rt = 0; rt < 8; ++rt) { acc[rt][0] = (f32x4){0.f, 0.f, 0.f, 0.f}; acc[rt][1] = (f32x4){0.f, 0.f, 0.f, 0.f}; }
        if (c > 0) {
            bf16x8 bs[2][4];
#pragma unroll
            for (int ct = 0; ct < 2; ++ct)
#pragma unroll
                for (int kk = 0; kk < 4; ++kk) bs[ct][kk] = *(const bf16x8*)(kvt + (((size_t)bh * 16 + c) * 256 + wid * 32 + ct * 16 + r16) * 128 + kk * 32 + g * 8);
#pragma unroll
            for (int rt = 0; rt < 8; ++rt) {
                f32x4 a0 = {0.f, 0.f, 0.f, 0.f}, a1 = a0;
#pragma unroll
                for (int kk = 0; kk < 4; ++kk) {
                    const bf16x8 q = *(const bf16x8*)(Q + (tok0 + rt * 16 + r16) * 512 + h * 128 + kk * 32 + g * 8);
                    a0 = mfma16(q, bs[0][kk], a0); a1 = mfma16(q, bs[1][kk], a1);
                }
#pragma unroll
                for (int r = 0; r < 4; ++r) { const float qd = __expf(lg * (float)(rt * 16 + g * 4 + r + 1)); a0[r] *= qd; a1[r] *= qd; }
                acc[rt][0] = a0; acc[rt][1] = a1;
                __builtin_amdgcn_sched_barrier(0);
            }
        }
        bf16x8 bv[2][4];
#pragma unroll
        for (int ct = 0; ct < 2; ++ct)
#pragma unroll
            for (int kk = 0; kk < 4; ++kk) bv[ct][kk] = *(const bf16x8*)(vt + ((size_t)bh * 256 + wid * 32 + ct * 16 + r16) * 2048 + c * 128 + kk * 32 + g * 8);
        __syncthreads();
#pragma unroll
        for (int rt = 0; rt < 8; ++rt) {
            f32x4 a0 = acc[rt][0], a1 = acc[rt][1];
#pragma unroll
            for (int kk = 0; kk < 4; ++kk) {
                if (kk <= (rt >> 1)) {
                    const bf16x8 a = *(const bf16x8*)(S + (rt * 16 + r16) * 136 + kk * 32 + g * 8);
                    a0 = mfma16(a, bv[0][kk], a0); a1 = mfma16(a, bv[1][kk], a1);
                }
            }
            acc[rt][0] = a0; acc[rt][1] = a1;
#pragma unroll
            for (int r = 0; r < 4; ++r) {
                float s1 = a0[r] + a1[r], s2 = a0[r] * a0[r] + a1[r] * a1[r];
                s1 = grp16_sum(s1); s2 = grp16_sum(s2);
                if (r16 == 0) { st[((rt * 16 + g * 4 + r) * 8 + wid) * 2] = s1; st[((rt * 16 + g * 4 + r) * 8 + wid) * 2 + 1] = s2; }
            }
            __builtin_amdgcn_sched_barrier(0);
        }
        __syncthreads();
        if (tid < 128) {
            float s1 = 0.f, s2 = 0.f;
#pragma unroll
            for (int w = 0; w < 8; ++w) { s1 += st[(tid * 8 + w) * 2]; s2 += st[(tid * 8 + w) * 2 + 1]; }
            const float mu = s1 * (1.f / 256.f), var = fmaxf(s2 * (1.f / 256.f) - mu * mu, 0.f);
            mr[tid * 2] = mu; mr[tid * 2 + 1] = rsqrtf(var + 1e-5f);
        }
        __syncthreads();
        const float gw0 = p.gnw[h * 256 + wid * 32 + r16], gw1 = p.gnw[h * 256 + wid * 32 + 16 + r16];
#pragma unroll
        for (int rt = 0; rt < 8; ++rt)
#pragma unroll
            for (int r = 0; r < 4; ++r) {
                const int row = rt * 16 + g * 4 + r; const size_t token = tok0 + row; const float mu = mr[row * 2], rs = mr[row * 2 + 1];
                const size_t o = token * 1024 + h * 256 + wid * 32 + r16;
                const float v0 = (acc[rt][0][r] - mu) * rs * gw0 * bf2f(sga[o]), v1 = (acc[rt][1][r] - mu) * rs * gw1 * bf2f(sga[o + 16]);
                mix[token * 2048 + h * 256 + wid * 32 + r16] = f2bf(v0); mix[token * 2048 + h * 256 + wid * 32 + 16 + r16] = f2bf(v1);
            }
    }
}

DEVI void phase_s5scan(const int TIDX, const int BIDX, const Params& p) {
    const int wid = TIDX >> 6, lane = TIDX & 63;
    const float* e5 = p.out + O_HGS; bf16_t* a2 = (bf16_t*)(p.ws + WS_A2); const float* lam16 = (const float*)(p.ws + WS_LAM16);
    for (int it = BIDX * 8 + wid; it < 512; it += gridDim.x * 8) {
        const int b = it >> 6, g = it & 63;
        const float ar = lam16[(g * 64 + lane) * 2], ai = lam16[(g * 64 + lane) * 2 + 1];
        float hr = 0.f, hi = 0.f;
        for (int jb = 0; jb < 128; jb += 16) {
            float er[16], ei[16];
#pragma unroll
            for (int j = 0; j < 16; ++j) { const float* ep = e5 + ((size_t)g * 1024 + b * 128 + jb + j) * 128; er[j] = ep[lane]; ei[j] = ep[64 + lane]; }
#pragma unroll
            for (int j = 0; j < 16; ++j) {
                bf16_t* hp = a2 + ((size_t)g * 1024 + b * 128 + jb + j) * 384 + 256;
                hp[lane] = f2bf(hr); hp[64 + lane] = f2bf(hi);
                const float nr = ar * hr - ai * hi + er[j], ni = ar * hi + ai * hr + ei[j];
                hr = nr; hi = ni;
            }
        }
        p.out[O_S5RP + (size_t)(b * 64 + g) * 64 + lane] = hr; p.out[O_S5IP + (size_t)(b * 64 + g) * 64 + lane] = hi;
    }
}

DEVI void phase_H1(const int TIDX, const int BIDX, bf16_t* L, const Params& p) {
    const int tid = TIDX, wid = tid >> 6, lane = tid & 63, r16 = lane & 15, g = lane >> 4;
    float* cum = (float*)(p.ws + WS_CUM); const bf16_t* itp = (const bf16_t*)(p.ws + WS_IT); float* hkv = (float*)(p.ws + WS_HKV);
    float* tot = (float*)(L + 128 * 136);
    for (int it = BIDX; it < 1024; it += gridDim.x) {
        const int bh = it >> 4, c = it & 15, h = bh & 7, b = bh >> 3; const size_t tok0 = (size_t)b * 2048 + c * 128;
        const int d = tid & 127, part = tid >> 7;
        float* col = cum + (tok0 + part * 32) * 1024 + h * 128 + d;
        float lf[32]; float s = 0.f;
#pragma unroll
        for (int l = 0; l < 32; ++l) { lf[l] = col[(size_t)l * 1024]; s += lf[l]; }
        __syncthreads();
        tot[part * 128 + d] = s;
        __syncthreads();
        float off = 0.f, last = 0.f;
#pragma unroll
        for (int pp = 0; pp < 4; ++pp) { const float t = tot[pp * 128 + d]; if (pp < part) off += t; last += t; }
        float cc = off;
#pragma unroll
        for (int l = 0; l < 32; ++l) {
            cc += lf[l]; col[(size_t)l * 1024] = cc;
            L[d * 136 + part * 32 + l] = f2bf((1.f - __expf(lf[l])) * __expf(last - cc));
        }
        __syncthreads();
        bf16x8 bfr[4];
#pragma unroll
        for (int kk = 0; kk < 4; ++kk) bfr[kk] = *(const bf16x8*)(itp + ((size_t)bh * 128 + wid * 16 + r16) * 2048 + c * 128 + kk * 32 + g * 8);
#pragma unroll
        for (int rt = 0; rt < 8; ++rt) {
            f32x4 a0 = {0.f, 0.f, 0.f, 0.f};
#pragma unroll
            for (int kk = 0; kk < 4; ++kk) a0 = mfma16(*(const bf16x8*)(L + (rt * 16 + r16) * 136 + kk * 32 + g * 8), bfr[kk], a0);
            *(f32x4*)(hkv + (((size_t)bh * 16 + c) * 128 + wid * 16 + r16) * 128 + rt * 16 + g * 4) = a0;
        }
    }
}

DEVI void phase_H2(const int TIDX, const int BIDX, const Params& p) {
    float* hkv = (float*)(p.ws + WS_HKV); const float* cum = (const float*)(p.ws + WS_CUM);
    for (int i = BIDX * 512 + TIDX; i < 64 * 128 * 16; i += gridDim.x * 512) {
        const int q = i & 15, e = (i >> 4) & 127, bh = i >> 11, h = bh & 7, b = bh >> 3;
        f32x4 s0 = {0.f, 0.f, 0.f, 0.f}, s1 = s0;
#pragma unroll 4
        for (int c = 0; c < 16; ++c) {
            float* ptr = hkv + (((size_t)bh * 16 + c) * 128 + e) * 128 + q * 8;
            const float* lp = cum + ((size_t)b * 2048 + c * 128 + 127) * 1024 + h * 128 + q * 8;
            const f32x4 v0 = *(const f32x4*)ptr, v1 = *(const f32x4*)(ptr + 4), d0 = *(const f32x4*)lp, d1 = *(const f32x4*)(lp + 4);
            u32x4 o; o.x = pack2(s0[0], s0[1]); o.y = pack2(s0[2], s0[3]); o.z = pack2(s1[0], s1[1]); o.w = pack2(s1[2], s1[3]);
            *(u32x4*)ptr = o;
#pragma unroll
            for (int j = 0; j < 4; ++j) { s0[j] = s0[j] * __expf(d0[j]) + v0[j]; s1[j] = s1[j] * __expf(d1[j]) + v1[j]; }
        }
        float* o = p.out + O_HGP + ((size_t)bh * 128 + q * 8) * 128 + e;
#pragma unroll
        for (int j = 0; j < 4; ++j) { o[(size_t)j * 128] = s0[j]; o[(size_t)(j + 4) * 128] = s1[j]; }
    }
}

DEVI void phase_H3(const int TIDX, const int BIDX, bf16_t* L, const Params& p) {
    const int tid = TIDX, wid = tid >> 6, lane = tid & 63, r16 = lane & 15, g = lane >> 4;
    const float* cum = (const float*)(p.ws + WS_CUM); const bf16_t* itp = (const bf16_t*)(p.ws + WS_IT); const float* hkv = (const float*)(p.ws + WS_HKV);
    bf16_t* q1 = (bf16_t*)(p.ws + WS_Q1); const bf16_t* sg1 = (const bf16_t*)(p.ws + WS_SG1);
    bf16_t* kt = L; bf16_t* S = L + 128 * 136; bf16_t* QA = L + 2 * 128 * 136;
    float* st = (float*)(L + 3 * 128 * 136);
    float* rsn = st + 128 * 8;
    for (int it = BIDX; it < 1024; it += gridDim.x) {
        const int bh = it >> 4, c = it & 15, h = bh & 7, b = bh >> 3, l0 = wid * 16; const size_t tok0 = (size_t)b * 2048 + c * 128;
        const float* refp = cum + (tok0 + 63) * 1024 + h * 128;
        __syncthreads();
        { const int m = tid >> 2, seg = tid & 3; const float* cp = cum + (tok0 + m) * 1024 + h * 128 + seg * 32;
#pragma unroll
          for (int q = 0; q < 8; ++q) {
              const f32x4 cv = *(const f32x4*)(cp + q * 4), rv = *(const f32x4*)(refp + seg * 32 + q * 4);
              f32x4 pv = {0.f, 0.f, 0.f, 0.f}; if (m > 0) pv = *(const f32x4*)(cp - 1024 + q * 4);
              f32x4 o;
#pragma unroll
              for (int j = 0; j < 4; ++j) o[j] = (1.f - __expf(cv[j] - pv[j])) * __expf(rv[j] - cv[j]);
              *(u32x2*)(kt + m * 136 + seg * 32 + q * 4) = pack4(o); } }
        bf16x8 qr[4];
#pragma unroll
        for (int kk = 0; kk < 4; ++kk) {
            const size_t o = (tok0 + l0 + r16) * 1024 + h * 128 + kk * 32 + g * 8;
            const u32x4 qq = *(const u32x4*)(q1 + o);
            const f32x4 c0 = *(const f32x4*)(cum + o), c1 = *(const f32x4*)(cum + o + 4), r0 = *(const f32x4*)(refp + kk * 32 + g * 8), r1 = *(const f32x4*)(refp + kk * 32 + g * 8 + 4);
            const unsigned* qv = (const unsigned*)&qq; u32x4 a, bb; unsigned* av = (unsigned*)&a; unsigned* bv = (unsigned*)&bb;
#pragma unroll
            for (int j = 0; j < 4; ++j) {
                const float cl = j < 2 ? c0[2 * j] : c1[2 * j - 4], ch = j < 2 ? c0[2 * j + 1] : c1[2 * j - 3];
                const float rl = j < 2 ? r0[2 * j] : r1[2 * j - 4], rh = j < 2 ? r0[2 * j + 1] : r1[2 * j - 3];
                const float ql = bflo(qv[j]), qh = bfhi(qv[j]);
                av[j] = pack2(ql * __expf(cl - rl), qh * __expf(ch - rh)); bv[j] = pack2(ql * __expf(cl), qh * __expf(ch));
            }
            qr[kk] = *(bf16x8*)&a;
            *(u32x4*)(QA + (l0 + r16) * 136 + kk * 32 + g * 8) = bb;
        }
        bf16x8 bi[4], bs[4];
#pragma unroll
        for (int kk = 0; kk < 4; ++kk) {
            bi[kk] = *(const bf16x8*)(itp + ((size_t)bh * 128 + wid * 16 + r16) * 2048 + c * 128 + kk * 32 + g * 8);
            bs[kk] = *(const bf16x8*)(hkv + (((size_t)bh * 16 + c) * 128 + wid * 16 + r16) * 128 + kk * 32 + g * 8);
        }
        __syncthreads();
        for (int j = 0; j < 8; ++j) {
            f32x4 sc = {0.f, 0.f, 0.f, 0.f};
            if (j <= wid) {
#pragma unroll
                for (int kk = 0; kk < 4; ++kk) sc = mfma16(qr[kk], *(const bf16x8*)(kt + (j * 16 + r16) * 136 + kk * 32 + g * 8), sc);
            }
#pragma unroll
            for (int r = 0; r < 4; ++r) {
                const int li = l0 + g * 4 + r, mi = j * 16 + r16; const float v = (j <= wid && li >= mi) ? sc[r] : 0.f;
                S[li * 136 + mi] = f2bf(v);
            }
        }
        __syncthreads();
        f32x4 acc[8];
#pragma unroll
        for (int rt = 0; rt < 8; ++rt) {
            f32x4 a0 = {0.f, 0.f, 0.f, 0.f};
            if (c > 0) {
#pragma unroll
                for (int kk = 0; kk < 4; ++kk) a0 = mfma16(*(const bf16x8*)(QA + (rt * 16 + r16) * 136 + kk * 32 + g * 8), bs[kk], a0);
            }
#pragma unroll
            for (int kk = 0; kk < 4; ++kk) {
                if (kk <= (rt >> 1)) a0 = mfma16(*(const bf16x8*)(S + (rt * 16 + r16) * 136 + kk * 32 + g * 8), bi[kk], a0);
            }
            acc[rt] = a0;
#pragma unroll
            for (int r = 0; r < 4; ++r) {
                const float s2 = grp16_sum(a0[r] * a0[r]);
                if (r16 == 0) st[(rt * 16 + g * 4 + r) * 8 + wid] = s2;
            }
        }
        __syncthreads();
        if (tid < 128) {
            float s2 = 0.f;
#pragma unroll
            for (int w = 0; w < 8; ++w) s2 += st[tid * 8 + w];
            rsn[tid] = rsqrtf(s2 * (1.f / 128.f) + 1e-6f);
        }
        __syncthreads();
        const float gw = p.hgnw[h * 128 + wid * 16 + r16];
#pragma unroll
        for (int rt = 0; rt < 8; ++rt)
#pragma unroll
            for (int r = 0; r < 4; ++r) {
                const int row = rt * 16 + g * 4 + r; const unsigned o = ((unsigned)tok0 + row) * 1024u + h * 128 + wid * 16 + r16;
                q1[o] = f2bf(acc[rt][r] * rsn[row] * gw * bf2f(sg1[o]));
            }
    }
}

DEVI void phase_ss5(const int TIDX, const int BIDX, const Params& p) {
    const int wid = TIDX >> 6, lane = TIDX & 63;
    const float* zs = (const float*)(p.ws + WS_ZS); const float* bbg = (const float*)(p.ws + WS_BBG); const float* lam1 = (const float*)(p.ws + WS_LAM1);
    bf16_t* y5s = (bf16_t*)(p.ws + WS_Y5S);
    for (int it = BIDX * 8 + wid; it < 128 * 64; it += gridDim.x * 8) {
        const int b = it >> 6, g = it & 63;
        float u[16];
#pragma unroll
        for (int c = 0; c < 16; ++c) u[c] = zs[(size_t)b * 5120 + 3072 + g * 16 + c];
        float xr = 0.f, xi = 0.f;
#pragma unroll
        for (int c = 0; c < 16; ++c) { xr += bbg[((g * 64 + lane) * 16 + c) * 2] * u[c]; xi += bbg[((g * 64 + lane) * 16 + c) * 2 + 1] * u[c]; }
        const float ar = lam1[(g * 64 + lane) * 2], ai = lam1[(g * 64 + lane) * 2 + 1];
        const float sr = p.s5r[(size_t)(b * 64 + g) * 64 + lane], si = p.s5i[(size_t)(b * 64 + g) * 64 + lane];
        const float hr = ar * sr - ai * si + xr, hi = ar * si + ai * sr + xi;
        p.out[O_S5RS + (size_t)(b * 64 + g) * 64 + lane] = hr; p.out[O_S5IS + (size_t)(b * 64 + g) * 64 + lane] = hi;
        float mine = 0.f;
#pragma unroll
        for (int c = 0; c < 16; ++c) {
            float v = p.cre[(g * 16 + c) * 64 + lane] * hr - p.cim[(g * 16 + c) * 64 + lane] * hi;
            v = wave_sum(v);
            if (lane == c) mine = v + p.s5d[g * 16 + c] * u[c];
        }
        if (lane < 16) y5s[(size_t)b * 1024 + g * 16 + lane] = f2bf(gelu_(mine));
    }
}

DEVI void phase_sret(const int TIDX, const int BIDX, float* L, const Params& p) {
    const int tid = TIDX, lane = tid & 63, wid = tid >> 6;
    const float* zs = (const float*)(p.ws + WS_ZS); bf16_t* mix = (bf16_t*)(p.ws + WS_MIX0S);
    float* qs = L; float* ks = L + 128; float* red = L + 256; float* st = L + 256 + 2048;
    for (int it = BIDX; it < 512; it += gridDim.x) {
        const int b = it >> 2, h = it & 3, e4 = (tid & 63) * 4, dg = tid >> 6, d0 = dg * 16; const float gam = 1.0f - exp2f(-5.0f - (float)h);
        __syncthreads();
        if (tid < 128) qs[tid] = zs[(size_t)b * 5120 + h * 128 + tid]; else if (tid < 256) ks[tid - 128] = zs[(size_t)b * 5120 + 512 + h * 128 + tid - 128];
        const f32x4 v = *(const f32x4*)(zs + (size_t)b * 5120 + 1024 + h * 256 + e4);
        __syncthreads();
        const float* s0 = p.sret + ((size_t)it * 128 + d0) * 256 + e4; float* so = p.out + O_RETS + ((size_t)it * 128 + d0) * 256 + e4;
        f32x4 sv[16];
#pragma unroll
        for (int j = 0; j < 16; ++j) sv[j] = *(const f32x4*)(s0 + (size_t)j * 256);
        f32x4 o = {0.f, 0.f, 0.f, 0.f};
#pragma unroll
        for (int j = 0; j < 16; ++j) { const f32x4 s = sv[j] * gam + v * ks[d0 + j]; *(f32x4*)(so + (size_t)j * 256) = s; o += s * qs[d0 + j]; }
        *(f32x4*)(red + dg * 256 + e4) = o;
        __syncthreads();
        float tot = 0.f;
        if (tid < 256) {
#pragma unroll
            for (int k = 0; k < 8; ++k) tot += red[k * 256 + tid];
            const float s = wave_sum(tot); if (lane == 0) st[wid] = s; }
        __syncthreads();
        const float mu = (st[0] + st[1] + st[2] + st[3]) * (1.f / 256.f);
        __syncthreads();
        if (tid < 256) { const float dd = tot - mu; const float s = wave_sum(dd * dd); if (lane == 0) st[wid] = s; }
        __syncthreads();
        const float rs = rsqrtf((st[0] + st[1] + st[2] + st[3]) * (1.f / 256.f) + 1e-5f);
        if (tid < 256) mix[(size_t)b * 2048 + h * 256 + tid] = f2bf((tot - mu) * rs * p.gnw[h * 256 + tid] * zs[(size_t)b * 5120 + 2048 + h * 256 + tid]);
    }
}

DEVI void phase_shg(const int TIDX, const int BIDX, float* L, const Params& p) {
    const int tid = TIDX, lane = tid & 63, wid = tid >> 6;
    const float* z1 = (const float*)(p.ws + WS_Z1S); bf16_t* o1s = (bf16_t*)(p.ws + WS_O1S);
    float* qs = L; float* fs = L + 128; float* red = L + 256; float* st = L + 256 + 2048;
    for (int it = BIDX; it < 1024; it += gridDim.x) {
        const int b = it >> 3, h = it & 7, e4 = (tid & 31) * 4, dg = tid >> 5, d0 = dg * 8;
        __syncthreads();
        if (tid < 128) qs[tid] = z1[(size_t)b * 4096 + h * 128 + tid]; else if (tid < 256) fs[tid - 128] = z1[(size_t)b * 4096 + 1024 + h * 128 + tid - 128];
        const f32x4 iv = *(const f32x4*)(z1 + (size_t)b * 4096 + 2048 + h * 128 + e4);
        __syncthreads();
        const float* s0 = p.shg + ((size_t)it * 128 + d0) * 128 + e4; float* so = p.out + O_HGS + ((size_t)it * 128 + d0) * 128 + e4;
        f32x4 sv[8];
#pragma unroll
        for (int j = 0; j < 8; ++j) sv[j] = *(const f32x4*)(s0 + (size_t)j * 128);
        f32x4 o = {0.f, 0.f, 0.f, 0.f};
#pragma unroll
        for (int j = 0; j < 8; ++j) { const float f = fs[d0 + j]; const f32x4 s = sv[j] * f + iv * (1.f - f); *(f32x4*)(so + (size_t)j * 128) = s; o += s * qs[d0 + j]; }
        *(f32x4*)(red + dg * 128 + e4) = o;
        __syncthreads();
        float tot = 0.f;
        if (tid < 128) {
#pragma unroll
            for (int k = 0; k < 16; ++k) tot += red[k * 128 + tid];
            const float s = wave_sum(tot * tot); if (lane == 0) st[wid] = s; }
        __syncthreads();
        const float rs = rsqrtf((st[0] + st[1]) * (1.f / 128.f) + 1e-6f);
        if (tid < 128) o1s[(size_t)b * 1024 + h * 128 + tid] = f2bf(tot * rs * p.hgnw[h * 128 + tid] * z1[(size_t)b * 4096 + 3072 + h * 128 + tid]);
    }
}

DEVI void phase_final(const int TIDX, const int BIDX, const Params& p) {
    const int wid = TIDX >> 6, lane = TIDX & 63;
    for (int row = (BIDX * 8 + wid) * 2; row < MP + MS; row += gridDim.x * 16) {
        const bool smp = row >= MP; const size_t r = smp ? row - MP : row;
        float* x = p.out + (smp ? O_YS : O_YP) + r * 1024;
        f32x4 v[2][4]; float s0 = 0.f, s1 = 0.f;
#pragma unroll
        for (int i = 0; i < 4; ++i) { v[0][i] = *(const f32x4*)(x + i * 256 + lane * 4); v[1][i] = *(const f32x4*)(x + 1024 + i * 256 + lane * 4); }
#pragma unroll
        for (int i = 0; i < 4; ++i) {
            s0 += v[0][i][0] * v[0][i][0] + v[0][i][1] * v[0][i][1] + v[0][i][2] * v[0][i][2] + v[0][i][3] * v[0][i][3];
            s1 += v[1][i][0] * v[1][i][0] + v[1][i][1] * v[1][i][1] + v[1][i][2] * v[1][i][2] + v[1][i][3] * v[1][i][3];
        }
        s0 = wave_sum(s0); s1 = wave_sum(s1);
        const float r0 = rsqrtf(s0 * (1.0f / 1024.0f) + 1e-6f), r1 = rsqrtf(s1 * (1.0f / 1024.0f) + 1e-6f);
#pragma unroll
        for (int i = 0; i < 4; ++i) {
            const f32x4 w = *(const f32x4*)(p.fnormw + i * 256 + lane * 4);
            *(f32x4*)(x + i * 256 + lane * 4) = v[0][i] * r0 * w; *(f32x4*)(x + 1024 + i * 256 + lane * 4) = v[1][i] * r1 * w;
        }
    }
}

#define GRID_SYNC() do { asm volatile("s_waitcnt vmcnt(0) lgkmcnt(0)" ::: "memory"); cg::this_grid().sync(); } while (0)
constexpr int NPHASE = 13;
__global__ void __launch_bounds__(512, 2) mega(Params p0) {
    extern __shared__ __attribute__((aligned(16))) unsigned char shm[];
    LAS unsigned char* lds = (LAS unsigned char*)shm;
    const int G = gridDim.x;
#define OPQ int oz; asm volatile("s_mov_b32 %0, 0" : "=s"(oz)); int ozv; asm volatile("v_mov_b32 %0, 0" : "=v"(ozv)); \
    Params p = p0; p.ws = p0.ws + oz; p.out = p0.out + oz; const int TIDX = threadIdx.x + ozv, BIDX = blockIdx.x + oz; (void)TIDX; (void)BIDX;
    int my_xcc, my_rank;
    {
        int* sh = (int*)shm;
        if (threadIdx.x == 0) {
            const unsigned x = (unsigned)__builtin_amdgcn_s_getreg((3 << 11) | 20) & 7u;
            sh[0] = (int)x; sh[1] = (int)__hip_atomic_fetch_add((unsigned*)(p0.ws + WS_XCNT) + x * 32, 1u, __ATOMIC_RELAXED, __HIP_MEMORY_SCOPE_AGENT);
        }
        __syncthreads();
        my_xcc = __builtin_amdgcn_readfirstlane(sh[0]); my_rank = __builtin_amdgcn_readfirstlane(sh[1]);
        __syncthreads();
    }
    int gc = blockIdx.x;
    int ph_start = p0.ph_lo;
    if (ph_start == 0) {
        { OPQ phase_prep(TIDX, BIDX, (float*)shm, p); }
#if COOP
        GRID_SYNC();
        {
            bool ok = gridDim.x == 256;
            for (int x = 0; x < 8; ++x) ok = ok && (__hip_atomic_load((unsigned*)(p0.ws + WS_XCNT) + x * 32, __ATOMIC_RELAXED, __HIP_MEMORY_SCOPE_AGENT) == 32u);
            if (ok) gc = my_rank * 8 + my_xcc;
        }
#endif
        ph_start = 1;
    }
    for (int ph = ph_start; ph < p0.ph_hi; ++ph) {
        int la = -1, lb = -1, K = 1024, lda = 1024, ldb = 1024, Kb = 0;
        switch (ph) {
        case 1: la = L_IN0; lb = L_IN0S; break;
        case 2: la = L_GA; K = 256; lda = 384; ldb = 256; break;
        case 4: la = L_GB; K = 384; lda = 384; ldb = 384; lb = L_OUT0S; Kb = 2048; break;
        case 3: lb = L_GLUS; break;
        case 5: la = L_GLU; break;
        case 6: la = L_OUT0; K = 2048; lda = 2048; ldb = 2048; break;
        case 7: la = L_IN1; lb = L_IN1S; break;
        case 9: lb = L_OUT1S; break;
        case 11: la = L_OUT1; break;
        default: break;
        }
        for (int jj = 0; jj < 2; ++jj) {
            const int l = jj ? lb : la;
            if (l < 0) continue;
            OPQ
            Sched S; S.list = l; S.G = G; S.c = jj ? G - 1 - gc : gc + oz; S.wsp = p.ws; S.outp = p.out;
            if (jj && Kb) gemm_phase(TIDX, lds, Kb, Kb, Kb, false, S, p); else gemm_phase(TIDX, lds, K, lda, ldb, l == L_GLU, S, p);
        }
        __syncthreads();
        switch (ph) {
        case 2: { { OPQ phase_R1(TIDX, BIDX, (bf16_t*)shm, p); } __syncthreads(); { OPQ phase_sret(TIDX, BIDX, (float*)shm, p); } { OPQ phase_ss5(TIDX, BIDX, p); } } break;
        case 3: { { OPQ phase_s5scan(TIDX, BIDX, p); } { OPQ phase_R2(TIDX, BIDX, p); } } break;
        case 4: { OPQ phase_R3(TIDX, gc + oz, (bf16_t*)shm, p); } break;
        case 8: { { OPQ phase_H1(TIDX, BIDX, (bf16_t*)shm, p); } __syncthreads(); { OPQ phase_shg(TIDX, BIDX, (float*)shm, p); } } break;
        case 9: { OPQ phase_H2(TIDX, BIDX, p); } break;
        case 10: { OPQ phase_H3(TIDX, BIDX, (bf16_t*)shm, p); } break;
        case 12: { OPQ phase_final(TIDX, BIDX, p); } break;
        default: break;
        }
#if COOP
        if (ph + 1 < p0.ph_hi) GRID_SYNC();
#endif
    }
}

extern "C" void kernel_launch(void* const* d_in, const int* in_sizes, int n_in, void* d_out, int out_size, void* d_ws, size_t ws_size, hipStream_t stream) {
    constexpr size_t kDynLds = 131072;
    static int grid_blocks = 0;
    if (!grid_blocks) {
        hipFuncSetAttribute((const void*)mega, hipFuncAttributeMaxDynamicSharedMemorySize, (int)kDynLds);
        int dev = 0, cus = 0, per_cu = 0;
        hipGetDevice(&dev);
        hipDeviceGetAttribute(&cus, hipDeviceAttributeMultiprocessorCount, dev);
        hipOccupancyMaxActiveBlocksPerMultiprocessor(&per_cu, mega, 512, kDynLds);
        if (per_cu < 1) per_cu = 1;
        grid_blocks = cus;
        if (grid_blocks > 256) grid_blocks = 256;
    }
    Params p{};
    const float** f = (const float**)&p;
    for (int i = 0; i < 25; ++i) f[i] = (const float*)d_in[i];
    p.out = (float*)d_out; p.ws = (char*)d_ws;
#if COOP
    p.ph_lo = 0; p.ph_hi = PH_MAX;
    hipMemsetAsync((char*)d_ws + WS_XCNT, 0, 1024, stream);
    void* args[] = {&p};
    hipError_t e = hipLaunchCooperativeKernel((const void*)mega, dim3(grid_blocks), dim3(512), args, kDynLds, stream);
    if (e != hipSuccess) fprintf(stderr, "cooperative launch failed: %s (grid %d)\n", hipGetErrorString(e), grid_blocks);
#else
    for (int ph = 0; ph < NPHASE; ++ph) {
        p.ph_lo = ph; p.ph_hi = ph + 1;
        hipLaunchKernelGGL(mega, dim3(grid_blocks), dim3(512), kDynLds, stream, p);
    }
#endif
}
```

```cpp
#include <hip/hip_runtime.h>
#include <hip/hip_cooperative_groups.h>
#include <cstdio>
namespace cg = cooperative_groups;

#ifndef PH_MAX
#define PH_MAX 13
#endif
#ifndef COOP
#define COOP 1
#endif

typedef unsigned short bf16_t;
typedef short bf16x8 __attribute__((ext_vector_type(8)));
typedef float f32x4 __attribute__((ext_vector_type(4)));
typedef unsigned u32x4 __attribute__((ext_vector_type(4)));
typedef unsigned u32x2 __attribute__((ext_vector_type(2)));
#define LAS __attribute__((address_space(3)))
#define DEVI __device__ __forceinline__

constexpr int TT = 2048, NBP = 8, MP = 16384, MS = 128, DM = 1024;
constexpr size_t MiB = (size_t)1 << 20;
constexpr size_t O_YP = 0, O_YS = 16777216, O_RETP = 16908288, O_RETS = 17956864, O_S5RP = 34734080, O_S5IP = 34766848,
                 O_S5RS = 34799616, O_S5IS = 35323904, O_HGP = 35848192, O_HGS = 36896768;
constexpr size_t WS_WIN0T = 0, WS_BT1 = 10 * MiB, WS_KT = 18 * MiB, WS_WGLUT = 34 * MiB, WS_WOUT0T = 36 * MiB, WS_WIN1T = 40 * MiB,
                 WS_BT2 = 48 * MiB, WS_Q = 60 * MiB, WS_KN = 76 * MiB, WS_VT = 92 * MiB, WS_SGA = 124 * MiB, WS_SGB = 156 * MiB,
                 WS_A2 = 188 * MiB, WS_Y5 = 0, WS_X1B = 60 * MiB, WS_SG1 = 0, WS_Q1 = 96 * MiB, WS_CUM = 128 * MiB, WS_IT = 192 * MiB,
                 WS_HKV = 32 * MiB;
constexpr size_t WS_MISC = 240 * MiB;
constexpr size_t WS_WOUT1T = WS_MISC;
constexpr size_t WS_ROPE = WS_MISC + 2 * MiB;
constexpr size_t WS_SSQ1 = WS_ROPE + 1280 * 1024;
constexpr size_t WS_SSQ2 = WS_SSQ1 + MiB;
constexpr size_t WS_H0S = WS_SSQ2 + MiB;
constexpr size_t WS_ZS = WS_H0S + 512 * 1024;
constexpr size_t WS_Y5S = WS_ZS + 2560 * 1024;
constexpr size_t WS_MIX0S = WS_Y5S + 512 * 1024;
constexpr size_t WS_X1S = WS_MIX0S + MiB;
constexpr size_t WS_X1SB = WS_X1S + 512 * 1024;
constexpr size_t WS_Z1S = WS_X1SB + 512 * 1024;
constexpr size_t WS_O1S = WS_Z1S + 2 * MiB;
constexpr size_t WS_BBG = WS_O1S + 512 * 1024;
constexpr size_t WS_LAM1 = WS_BBG + 512 * 1024;
constexpr size_t WS_LAM16 = WS_LAM1 + 32 * 1024;
constexpr size_t WS_LB = WS_LAM16 + 32 * 1024;
constexpr size_t WS_SSQ1S = WS_LB + 4096;
constexpr size_t WS_SSQ2S = WS_SSQ1S + MiB;
constexpr size_t WS_END = WS_SSQ2S + MiB;
constexpr size_t WS_XCNT = WS_END;
static_assert(WS_XCNT + 1024 <= 256 * MiB, "workspace overflow");

struct Params {
    const float *xp, *xs, *sret, *s5r, *s5i, *shg, *normw, *fnormw, *win0, *gnw, *lamre, *lamim, *logdt, *bre, *bim, *cre, *cim, *s5d,
        *gluw, *glub, *wout0, *win1, *hglb, *hgnw, *wout1;
    float* out;
    char* ws;
    int ph_lo, ph_hi;
};

DEVI bf16_t f2bf(float f) { unsigned u = __float_as_uint(f); u += 0x7FFFu + ((u >> 16) & 1u); return (bf16_t)(u >> 16); }
DEVI float bf2f(bf16_t b) { return __uint_as_float(((unsigned)b) << 16); }
DEVI unsigned pack2(float lo, float hi) { unsigned r; asm("v_cvt_pk_bf16_f32 %0, %1, %2" : "=v"(r) : "v"(lo), "v"(hi)); return r; }
DEVI float bflo(unsigned w) { return __uint_as_float(w << 16); }
DEVI float bfhi(unsigned w) { return __uint_as_float(w & 0xffff0000u); }
DEVI float sigm(float x) { return __builtin_amdgcn_rcpf(1.f + __builtin_amdgcn_exp2f(-1.4426950408889634f * x)); }
DEVI float silu_(float x) { return x * sigm(x); }
DEVI float gelu_(float x) { const float u = 1.5957691216f * (x + 0.044715f * x * x * x); return x * __builtin_amdgcn_rcpf(1.f + __builtin_amdgcn_exp2f(-1.4426950408889634f * u)); }
DEVI u32x2 pack4(f32x4 v) { u32x2 r; r.x = pack2(v[0], v[1]); r.y = pack2(v[2], v[3]); return r; }
DEVI float wave_sum(float v) {
#pragma unroll
    for (int o = 32; o > 0; o >>= 1) v += __shfl_xor(v, o);
    return v;
}
DEVI float grp16_sum(float v) { v += __shfl_xor(v, 1); v += __shfl_xor(v, 2); v += __shfl_xor(v, 4); v += __shfl_xor(v, 8); return v; }
DEVI f32x4 mfma16(bf16x8 a, bf16x8 b, f32x4 c) { return __builtin_amdgcn_mfma_f32_16x16x32_bf16(a, b, c, 0, 0, 0); }
DEVI float row_rstd16(const float* ssq, size_t row) {
    const f32x4 a = *(const f32x4*)(ssq + row * 4), b = *(const f32x4*)(ssq + (MP + row) * 4), c = *(const f32x4*)(ssq + (2 * (size_t)MP + row) * 4), d = *(const f32x4*)(ssq + (3 * (size_t)MP + row) * 4);
    float s = (a[0] + a[1] + a[2] + a[3]) + (b[0] + b[1] + b[2] + b[3]) + (c[0] + c[1] + c[2] + c[3]) + (d[0] + d[1] + d[2] + d[3]);
    return rsqrtf(s * (1.0f / 1024.0f) + 1e-6f);
}

constexpr int BM = 256, BK = 64, HALF = 128, HTB = HALF * BK * 2, NXCD = 8, WGM = 8;
DEVI int lds_byte(int r, int c) { const int st = (r >> 4) * 2 + (c >> 5), rr = r & 15, cc = c & 31, ob = rr * 64 + cc * 2; return st * 1024 + (ob ^ (((ob >> 9) & 1) << 5)); }
DEVI void stage_rc(int b, int& R, int& C) { const int st = b / 1024, sb = b % 1024, swz = sb ^ (((sb >> 9) & 1) << 5); R = (st >> 1) * 16 + swz / 64; C = (st & 1) * 32 + (swz % 64) / 2; }

enum { K_Q = 0, K_K, K_VT, K_GA, K_U, K_GB, K_SIN0, K_E5, K_Y5, K_GLU, K_SGLU, K_OUT0, K_SOUT0, K_Q1, K_F, K_IT, K_G1, K_SIN1, K_OUT1, K_SOUT1 };
enum { L_IN0 = 0, L_IN0S, L_GA, L_GB, L_GLU, L_GLUS, L_OUT0, L_OUT0S, L_IN1, L_IN1S, L_OUT1, L_OUT1S };

struct Unit { const char* a; const char* b; int kind, pm, pn; };

DEVI void static_order(int L, int nM, int nN, int& pm, int& pn) {
    const int nwg = nM * nN; int wgid = L;
    { const int q = nwg / NXCD, r = nwg % NXCD, xcd = wgid % NXCD, off = wgid / NXCD; wgid = (xcd < r ? xcd * (q + 1) : r * (q + 1) + (xcd - r) * q) + off; }
    const int nig = WGM * nN, gid = wgid / nig, fm = gid * WGM, gsz = (nM - fm) < WGM ? (nM - fm) : WGM;
    pm = fm + ((wgid % nig) % gsz); pn = (wgid % nig) / gsz;
}

struct Sched {
    int list, G, c; char* wsp; float* outp;
    DEVI bool next(int i, Unit& u) const {
        const int L = i * G + c; const char* ws = wsp;
        switch (list) {
        case L_IN0: {
            if (L >= 1280) return false; int pm, pn; static_order(L, 64, 20, pm, pn); u.pm = pm; u.pn = pn;
            const char* h0 = (const char*)(outp + O_RETS);
            if (pn >= 4 && pn < 8) { u.kind = K_VT; u.a = ws + WS_WIN0T + (size_t)(1024 + 256 * (pn - 4)) * 2048; u.b = h0 + (size_t)pm * 256 * 2048; }
            else { u.kind = pn < 2 ? K_Q : pn < 4 ? K_K : pn < 12 ? K_GA : pn < 16 ? K_U : K_GB; u.a = h0 + (size_t)pm * 256 * 2048; u.b = ws + WS_WIN0T + (size_t)pn * 256 * 2048; }
            return true; }
        case L_IN0S: if (L >= 20) return false; u.pm = 0; u.pn = L; u.kind = K_SIN0; u.a = ws + WS_H0S; u.b = ws + WS_WIN0T + (size_t)L * 256 * 2048; return true;
        case L_GA: if (L >= 256) return false; u.pm = L & 3; u.pn = L >> 2; u.kind = K_E5; u.a = ws + WS_A2 + ((size_t)(L >> 2) * 1024 + (L & 3) * 256) * 768; u.b = ws + WS_BT1 + (size_t)(L >> 2) * 256 * 512; return true;
        case L_GB: if (L >= 256) return false; u.pm = L & 3; u.pn = L >> 2; u.kind = K_Y5; u.a = ws + WS_A2 + ((size_t)(L >> 2) * 1024 + (L & 3) * 256) * 768; u.b = ws + WS_BT2 + (size_t)(L >> 2) * 256 * 768; return true;
        case L_GLU: { if (L >= 256) return false; int pm, pn; static_order(L, 64, 4, pm, pn); u.pm = pm; u.pn = pn; u.kind = K_GLU; u.a = ws + WS_Y5 + (size_t)pm * 256 * 32; u.b = ws + WS_WGLUT + (size_t)pn * 256 * 2048; return true; }
        case L_GLUS: if (L >= 4) return false; u.pm = 0; u.pn = L; u.kind = K_SGLU; u.a = ws + WS_Y5S; u.b = ws + WS_WGLUT + (size_t)L * 256 * 2048; return true;
        case L_OUT0: { if (L >= 256) return false; int pm, pn; static_order(L, 64, 4, pm, pn); u.pm = pm; u.pn = pn; u.kind = K_OUT0; u.a = (const char*)(outp + O_HGS) + (size_t)pm * 256 * 4096; u.b = ws + WS_WOUT0T + (size_t)pn * 256 * 4096; return true; }
        case L_OUT0S: if (L >= 4) return false; u.pm = 0; u.pn = L; u.kind = K_SOUT0; u.a = ws + WS_MIX0S; u.b = ws + WS_WOUT0T + (size_t)L * 256 * 4096; return true;
        case L_IN1: {
            if (L >= 1024) return false; int pm, pn; static_order(L, 64, 16, pm, pn); u.pm = pm; u.pn = pn;
            if (pn >= 8 && pn < 12) { u.kind = K_IT; u.a = ws + WS_WIN1T + (size_t)(256 * pn) * 2048; u.b = ws + WS_X1B + (size_t)pm * 256 * 2048; }
            else { u.kind = pn < 4 ? K_Q1 : pn < 8 ? K_F : K_G1; u.a = ws + WS_X1B + (size_t)pm * 256 * 2048; u.b = ws + WS_WIN1T + (size_t)pn * 256 * 2048; }
            return true; }
        case L_IN1S: if (L >= 16) return false; u.pm = 0; u.pn = L; u.kind = K_SIN1; u.a = ws + WS_X1SB; u.b = ws + WS_WIN1T + (size_t)L * 256 * 2048; return true;
        case L_OUT1: { if (L >= 256) return false; int pm, pn; static_order(L, 64, 4, pm, pn); u.pm = pm; u.pn = pn; u.kind = K_OUT1; u.a = ws + WS_Q1 + (size_t)pm * 256 * 2048; u.b = ws + WS_WOUT1T + (size_t)pn * 256 * 2048; return true; }
        case L_OUT1S: if (L >= 4) return false; u.pm = 0; u.pn = L; u.kind = K_SOUT1; u.a = ws + WS_O1S; u.b = ws + WS_WOUT1T + (size_t)L * 256 * 2048; return true;
        }
        return false;
    }
};

DEVI void epilogue(const Params& p, const f32x4 (&acc)[2][2][4][2], const Unit& u, int wr, int wc, int fr, int fq) {
    char* ws = p.ws;
    const int kind = u.kind;
    if (kind == K_Q || kind == K_K) {
        const float* rope = (const float*)(ws + WS_ROPE);
        bf16_t* dst = (bf16_t*)(ws + (kind == K_Q ? WS_Q : WS_KN));
        bf16_t* kt = (bf16_t*)(ws + WS_KT);
        const int tq = kind == K_Q ? u.pn : u.pn - 2;
        const float sc = kind == K_Q ? 1.0f : 0.08838834764831845f;
#pragma unroll
        for (int ai = 0; ai < 2; ++ai) {
#pragma unroll
          for (int mh = 0; mh < 2; ++mh) {
            f32x4 cs[4][2], sn[4][2];
#pragma unroll
            for (int m = mh * 2; m < mh * 2 + 2; ++m)
#pragma unroll
                for (int n = 0; n < 2; ++n) {
                    const int token = u.pm * 256 + ai * 128 + wr * 64 + m * 16 + fr, pos = token & 2047, j = (wc * 32 + n * 16 + fq * 4) & 63;
                    cs[m][n] = *(const f32x4*)(rope + pos * 128 + j); sn[m][n] = *(const f32x4*)(rope + pos * 128 + 64 + j);
                }
#pragma unroll
            for (int m = mh * 2; m < mh * 2 + 2; ++m) {
                const int token = u.pm * 256 + ai * 128 + wr * 64 + m * 16 + fr;
#pragma unroll
                for (int n = 0; n < 2; ++n) {
                    const int w = wc * 32 + n * 16 + fq * 4, hl = w >> 6, j = w & 63, head = 2 * tq + hl;
                    const f32x4 x1 = acc[ai][0][m][n], x2 = acc[ai][1][m][n];
                    const f32x4 y1 = (x1 * cs[m][n] - x2 * sn[m][n]) * sc, y2 = (x1 * sn[m][n] + x2 * cs[m][n]) * sc;
                    bf16_t* d = dst + (size_t)token * 512 + head * 128 + j;
                    *(u32x2*)d = pack4(y1); *(u32x2*)(d + 64) = pack4(y2);
                    if (kind == K_K) {
                        const int b = token >> 11, t = token & 2047;
                        bf16_t* kk = kt + ((size_t)(b * 4 + head) * 128 + j) * 2048 + t;
#pragma unroll
                        for (int i = 0; i < 4; ++i) { kk[(size_t)i * 2048] = f2bf(y1[i]); kk[(size_t)(64 + i) * 2048] = f2bf(y2[i]); }
                    }
                }
            }
          }
        }
    } else if (kind == K_VT || kind == K_IT) {
        const bool isv = kind == K_VT;
        const float* ssq = (const float*)(ws + WS_SSQ1);
        bf16_t* dst = (bf16_t*)(ws + (isv ? WS_VT : WS_IT));
        f32x4 rsa[2][2];
#pragma unroll
        for (int bj = 0; bj < 2; ++bj)
#pragma unroll
            for (int n = 0; n < 2; ++n) {
                const int token = u.pm * 256 + bj * 128 + wc * 32 + n * 16 + fq * 4;
                f32x4 rs = {1.f, 1.f, 1.f, 1.f};
                if (!isv) { rs[0] = row_rstd16(ssq, token); rs[1] = row_rstd16(ssq, token + 1); rs[2] = row_rstd16(ssq, token + 2); rs[3] = row_rstd16(ssq, token + 3); }
                rsa[bj][n] = rs;
            }
#pragma unroll
        for (int bj = 0; bj < 2; ++bj)
#pragma unroll
            for (int n = 0; n < 2; ++n) {
                const int token = u.pm * 256 + bj * 128 + wc * 32 + n * 16 + fq * 4, b = token >> 11, t = token & 2047;
                const f32x4 rs = rsa[bj][n];
#pragma unroll
                for (int ai = 0; ai < 2; ++ai)
#pragma unroll
                    for (int m = 0; m < 4; ++m) {
                        const int row = ai * 128 + wr * 64 + m * 16 + fr;
                        size_t off;
                        if (isv) off = ((size_t)(b * 4 + (u.pn - 4)) * 256 + row) * 2048 + t;
                        else { const int eg = (u.pn - 8) * 256 + row; off = ((size_t)(b * 8 + (eg >> 7)) * 128 + (eg & 127)) * 2048 + t; }
                        *(u32x2*)(dst + off) = pack4(acc[ai][bj][m][n] * rs);
                    }
            }
    } else if (kind == K_GA || kind == K_GB || kind == K_U) {
#pragma unroll
        for (int ai = 0; ai < 2; ++ai)
#pragma unroll
            for (int m = 0; m < 4; ++m) {
                const int token = u.pm * 256 + ai * 128 + wr * 64 + m * 16 + fr;
#pragma unroll
                for (int bj = 0; bj < 2; ++bj)
#pragma unroll
                    for (int n = 0; n < 2; ++n) {
                        const int cl = bj * 128 + wc * 32 + n * 16 + fq * 4;
                        f32x4 v = acc[ai][bj][m][n];
                        if (kind == K_U) {
                            const int cu = (u.pn - 12) * 256 + cl, g = cu >> 4, c = cu & 15;
                            bf16_t* d = (bf16_t*)(ws + WS_A2) + ((size_t)g * 1024 + (token >> 4)) * 384 + (token & 15) * 16 + c;
                            *(u32x2*)d = pack4(v);
                        } else {
                            v[0] = silu_(v[0]); v[1] = silu_(v[1]); v[2] = silu_(v[2]); v[3] = silu_(v[3]);
                            bf16_t* d = (bf16_t*)(ws + (kind == K_GA ? WS_SGA : WS_SGB)) + (size_t)token * 1024 + (u.pn - (kind == K_GA ? 8 : 16)) * 256 + cl;
                            *(u32x2*)d = pack4(v);
                        }
                    }
            }
    } else if (kind == K_SIN0) {
        const float* rope = (const float*)(ws + WS_ROPE) + 2048 * 128;
        float* zs = (float*)(ws + WS_ZS);
#pragma unroll
        for (int m = 0; m < 4; ++m) {
            const int row = wr * 64 + m * 16 + fr;
            if (u.pn < 4) {
                const float sc = u.pn < 2 ? 1.0f : 0.08838834764831845f;
#pragma unroll
                for (int n = 0; n < 2; ++n) {
                    const int w = wc * 32 + n * 16 + fq * 4, hl = w >> 6, j = w & 63;
                    const f32x4 cs = *(const f32x4*)(rope + j), sn = *(const f32x4*)(rope + 64 + j);
                    const f32x4 x1 = acc[0][0][m][n], x2 = acc[0][1][m][n];
                    float* d = zs + (size_t)row * 5120 + u.pn * 256 + hl * 128 + j;
                    *(f32x4*)d = (x1 * cs - x2 * sn) * sc; *(f32x4*)(d + 64) = (x1 * sn + x2 * cs) * sc;
                }
            } else {
                const bool gate = (u.pn >= 8 && u.pn < 12) || u.pn >= 16;
#pragma unroll
                for (int bj = 0; bj < 2; ++bj)
#pragma unroll
                    for (int n = 0; n < 2; ++n) {
                        f32x4 v = acc[0][bj][m][n];
                        if (gate) { v[0] = silu_(v[0]); v[1] = silu_(v[1]); v[2] = silu_(v[2]); v[3] = silu_(v[3]); }
                        *(f32x4*)(zs + (size_t)row * 5120 + u.pn * 256 + bj * 128 + wc * 32 + n * 16 + fq * 4) = v;
                    }
            }
        }
    } else if (kind == K_E5) {
        float* e5 = (float*)(p.out + O_HGS);
#pragma unroll
        for (int ai = 0; ai < 2; ++ai)
#pragma unroll
            for (int m = 0; m < 4; ++m) {
                const int row = u.pm * 256 + ai * 128 + wr * 64 + m * 16 + fr;
#pragma unroll
                for (int n = 0; n < 2; ++n) *(f32x4*)(e5 + ((size_t)u.pn * 1024 + row) * 128 + wc * 32 + n * 16 + fq * 4) = acc[ai][0][m][n];
            }
    } else if (kind == K_Y5) {
        const bf16_t* a2 = (const bf16_t*)(ws + WS_A2);
        bf16_t* y5 = (bf16_t*)(ws + WS_Y5);
        const int g = u.pn;
        f32x4 ddv[2][2];
#pragma unroll
        for (int bj = 0; bj < 2; ++bj)
#pragma unroll
            for (int n = 0; n < 2; ++n) ddv[bj][n] = *(const f32x4*)(p.s5d + g * 16 + ((bj * 128 + wc * 32 + n * 16 + fq * 4) & 15));
#pragma unroll
        for (int ai = 0; ai < 2; ++ai) {
#pragma unroll
          for (int mh = 0; mh < 2; ++mh) {
            u32x2 uv[4][2][2];
#pragma unroll
            for (int m = mh * 2; m < mh * 2 + 2; ++m)
#pragma unroll
                for (int bj = 0; bj < 2; ++bj)
#pragma unroll
                    for (int n = 0; n < 2; ++n) uv[m][bj][n] = *(const u32x2*)(a2 + ((size_t)g * 1024 + u.pm * 256 + ai * 128 + wr * 64 + m * 16 + fr) * 384 + bj * 128 + wc * 32 + n * 16 + fq * 4);
#pragma unroll
            for (int m = mh * 2; m < mh * 2 + 2; ++m) {
                const int row = u.pm * 256 + ai * 128 + wr * 64 + m * 16 + fr;
#pragma unroll
                for (int bj = 0; bj < 2; ++bj)
#pragma unroll
                    for (int n = 0; n < 2; ++n) {
                        const int col = bj * 128 + wc * 32 + n * 16 + fq * 4;
                        const u32x2 uu = uv[m][bj][n]; const f32x4 dd = ddv[bj][n];
                        f32x4 v = acc[ai][bj][m][n];
                        v[0] = gelu_(v[0] + dd[0] * bflo(uu.x)); v[1] = gelu_(v[1] + dd[1] * bfhi(uu.x));
                        v[2] = gelu_(v[2] + dd[2] * bflo(uu.y)); v[3] = gelu_(v[3] + dd[3] * bfhi(uu.y));
                        *(u32x2*)(y5 + ((size_t)g * 1024 + row) * 256 + col) = pack4(v);
                    }
            }
          }
        }
    } else if (kind == K_SGLU) {
        const bf16_t* y5 = (const bf16_t*)(ws + WS_Y5S);
        const float* zs = (const float*)(ws + WS_ZS);
        bf16_t* mix = (bf16_t*)(ws + WS_MIX0S);
#pragma unroll
        for (int m = 0; m < 4; ++m) {
            const size_t token = (size_t)wr * 64 + m * 16 + fr;
#pragma unroll
            for (int bj = 0; bj < 2; ++bj)
#pragma unroll
                for (int n = 0; n < 2; ++n) {
                    const int col = u.pn * 256 + bj * 128 + wc * 32 + n * 16 + fq * 4;
                    const f32x4 bb = *(const f32x4*)(p.glub + col);
                    const u32x2 yy = *(const u32x2*)(y5 + token * 1024 + col);
                    const f32x4 gg = *(const f32x4*)(zs + token * 5120 + 4096 + col);
                    f32x4 v = acc[0][bj][m][n] + bb;
                    v[0] = bflo(yy.x) * sigm(v[0]) * gg[0]; v[1] = bfhi(yy.x) * sigm(v[1]) * gg[1];
                    v[2] = bflo(yy.y) * sigm(v[2]) * gg[2]; v[3] = bfhi(yy.y) * sigm(v[3]) * gg[3];
                    *(u32x2*)(mix + token * 2048 + 1024 + col) = pack4(v);
                }
        }
    } else if (kind == K_GLU) {
        const bf16_t* y5 = (const bf16_t*)(ws + WS_Y5);
        const bf16_t* sgb = (const bf16_t*)(ws + WS_SGB);
        bf16_t* mix = (bf16_t*)(p.out + O_HGS);
        f32x4 bbv[2][2];
#pragma unroll
        for (int bj = 0; bj < 2; ++bj)
#pragma unroll
            for (int n = 0; n < 2; ++n) bbv[bj][n] = *(const f32x4*)(p.glub + u.pn * 256 + bj * 128 + wc * 32 + n * 16 + fq * 4);
#pragma unroll
        for (int ai = 0; ai < 2; ++ai)
#pragma unroll
          for (int mh = 0; mh < 2; ++mh) {
            u32x2 yv[4][2][2], gp[4][2][2];
#pragma unroll
            for (int m = mh * 2; m < mh * 2 + 2; ++m)
#pragma unroll
                for (int bj = 0; bj < 2; ++bj)
#pragma unroll
                    for (int n = 0; n < 2; ++n) {
                        const size_t token = (size_t)u.pm * 256 + ai * 128 + wr * 64 + m * 16 + fr; const int col = u.pn * 256 + bj * 128 + wc * 32 + n * 16 + fq * 4;
                        yv[m][bj][n] = *(const u32x2*)(y5 + ((size_t)(col >> 4) * MP + token) * 16 + (col & 15));
                        gp[m][bj][n] = *(const u32x2*)(sgb + token * 1024 + col);
                    }
#pragma unroll
            for (int m = mh * 2; m < mh * 2 + 2; ++m) {
                const size_t token = (size_t)u.pm * 256 + ai * 128 + wr * 64 + m * 16 + fr;
#pragma unroll
                for (int bj = 0; bj < 2; ++bj)
#pragma unroll
                    for (int n = 0; n < 2; ++n) {
                        const int col = u.pn * 256 + bj * 128 + wc * 32 + n * 16 + fq * 4;
                        const u32x2 yy = yv[m][bj][n], t = gp[m][bj][n];
                        f32x4 v = acc[ai][bj][m][n] + bbv[bj][n];
                        v[0] = bflo(yy.x) * sigm(v[0]) * bflo(t.x); v[1] = bfhi(yy.x) * sigm(v[1]) * bfhi(t.x);
                        v[2] = bflo(yy.y) * sigm(v[2]) * bflo(t.y); v[3] = bfhi(yy.y) * sigm(v[3]) * bfhi(t.y);
                        *(u32x2*)(mix + token * 2048 + 1024 + col) = pack4(v);
                    }
            }
          }
    } else if (kind == K_OUT0 || kind == K_SOUT0 || kind == K_OUT1 || kind == K_SOUT1) {
        const bool smp = kind == K_SOUT0 || kind == K_SOUT1, l0 = kind == K_OUT0 || kind == K_SOUT0;
        const float* res = l0 ? (smp ? p.xs : p.xp) : (smp ? (const float*)(ws + WS_X1S) : p.out + O_YP);
        float* dst = l0 ? (smp ? (float*)(ws + WS_X1S) : p.out + O_YP) : (smp ? p.out + O_YS : p.out + O_YP);
        bf16_t* dstb = (bf16_t*)(ws + (smp ? WS_X1SB : WS_X1B));
        float* ssq = (float*)(ws + (l0 ? (smp ? WS_SSQ1S : WS_SSQ1) : (smp ? WS_SSQ2S : WS_SSQ2)));
#pragma unroll
        for (int ai = 0; ai < 2; ++ai) {
            if (smp && ai) break;
#pragma unroll
          for (int mh = 0; mh < 2; ++mh) {
            f32x4 rv[4][2][2];
#pragma unroll
            for (int m = mh * 2; m < mh * 2 + 2; ++m)
#pragma unroll
                for (int bj = 0; bj < 2; ++bj)
#pragma unroll
                    for (int n = 0; n < 2; ++n) rv[m][bj][n] = *(const f32x4*)(res + ((size_t)u.pm * 256 + ai * 128 + wr * 64 + m * 16 + fr) * 1024 + u.pn * 256 + bj * 128 + wc * 32 + n * 16 + fq * 4);
#pragma unroll
            for (int m = mh * 2; m < mh * 2 + 2; ++m) {
                const size_t token = (size_t)u.pm * 256 + ai * 128 + wr * 64 + m * 16 + fr;
                float s = 0.f;
#pragma unroll
                for (int bj = 0; bj < 2; ++bj)
#pragma unroll
                    for (int n = 0; n < 2; ++n) {
                        const int col = u.pn * 256 + bj * 128 + wc * 32 + n * 16 + fq * 4;
                        const f32x4 v = acc[ai][bj][m][n] + rv[m][bj][n];
                        *(f32x4*)(dst + token * 1024 + col) = v;
                        if (l0) *(u32x2*)(dstb + token * 1024 + col) = pack4(v);
                        s += v[0] * v[0] + v[1] * v[1] + v[2] * v[2] + v[3] * v[3];
                    }
                s += __shfl_xor(s, 16); s += __shfl_xor(s, 32);
                if (fq == 0) ssq[((size_t)u.pn * MP + token) * 4 + wc] = s;
            }
          }
        }
    } else if (kind == K_Q1 || kind == K_F || kind == K_G1) {
        const float* ssq = (const float*)(ws + WS_SSQ1);
        const float* lb = (const float*)(ws + WS_LB);
#pragma unroll
        for (int ai = 0; ai < 2; ++ai) {
            float rr[4];
#pragma unroll
            for (int m = 0; m < 4; ++m) rr[m] = row_rstd16(ssq, (size_t)u.pm * 256 + ai * 128 + wr * 64 + m * 16 + fr);
            __builtin_amdgcn_sched_barrier(0);
#pragma unroll
            for (int m = 0; m < 4; ++m) {
                const size_t token = (size_t)u.pm * 256 + ai * 128 + wr * 64 + m * 16 + fr;
                const float r = rr[m];
#pragma unroll
                for (int bj = 0; bj < 2; ++bj)
#pragma unroll
                    for (int n = 0; n < 2; ++n) {
                        const int cl = (u.pn & 3) * 256 + bj * 128 + wc * 32 + n * 16 + fq * 4;
                        f32x4 v = acc[ai][bj][m][n] * r;
                        if (kind == K_F) {
                            const f32x4 l = *(const f32x4*)(lb + cl);
#pragma unroll
                            for (int i = 0; i < 4; ++i) v[i] = __logf(l[i] + (1.f - l[i]) * sigm(v[i]));
                            *(f32x4*)((float*)(ws + WS_CUM) + token * 1024 + cl) = v;
                        } else {
                            v[0] = silu_(v[0]); v[1] = silu_(v[1]); v[2] = silu_(v[2]); v[3] = silu_(v[3]);
                            *(u32x2*)((bf16_t*)(ws + (kind == K_Q1 ? WS_Q1 : WS_SG1)) + token * 1024 + cl) = pack4(v);
                        }
                    }
            }
        }
    } else if (kind == K_SIN1) {
        const float* ssq = (const float*)(ws + WS_SSQ1S);
        const float* lb = (const float*)(ws + WS_LB);
        float* z1 = (float*)(ws + WS_Z1S);
#pragma unroll
        for (int m = 0; m < 4; ++m) {
            const size_t row = wr * 64 + m * 16 + fr;
            const float r = row_rstd16(ssq, row);
            const int ty = u.pn >> 2;
#pragma unroll
            for (int bj = 0; bj < 2; ++bj)
#pragma unroll
                for (int n = 0; n < 2; ++n) {
                    const int cl = (u.pn & 3) * 256 + bj * 128 + wc * 32 + n * 16 + fq * 4;
                    f32x4 v = acc[0][bj][m][n] * r;
                    if (ty == 1) { const f32x4 l = *(const f32x4*)(lb + cl);
#pragma unroll
                        for (int i = 0; i < 4; ++i) v[i] = l[i] + (1.f - l[i]) * sigm(v[i]); }
                    else if (ty != 2) { v[0] = silu_(v[0]); v[1] = silu_(v[1]); v[2] = silu_(v[2]); v[3] = silu_(v[3]); }
                    *(f32x4*)(z1 + row * 4096 + ty * 1024 + cl) = v;
                }
        }
    }
}

DEVI void gemm_phase(const int TIDX, LAS unsigned char* lds, const int K, const int lda, const int ldb, const bool ga, const Sched S, const Params& P) {
    const int tid = TIDX, wid = __builtin_amdgcn_readfirstlane(tid >> 6), lane = tid & 63, wr = wid >> 2, wc = wid & 3, fr = lane & 15, fq = lane >> 4;
    const int nt = K / BK;
    unsigned voffA[2], voffB[2];
#pragma unroll
    for (int i = 0; i < 2; ++i) { int R, C; stage_rc(tid * 16 + i * 8192, R, C); voffA[i] = ga ? (unsigned)(R * 32 + (C >> 4) * (MP * 32) + (C & 15) * 2) : (unsigned)(R * lda + C) * 2u; voffB[i] = (unsigned)(R * ldb + C) * 2u; }
    const size_t kstep = (size_t)(BK * 2), kstepA = ga ? (size_t)4 * MP * 32 : kstep;
    const size_t hstepA = ga ? (size_t)HALF * 32 : (size_t)HALF * lda * 2, hstepB = (size_t)HALF * ldb * 2;
    const unsigned ldsw = (unsigned)wid * 1024u;
    const int aoff = lds_byte(wr * 64 + fr, fq * 8), boff = lds_byte(wc * 32 + fr, fq * 8);
#define PG8_SA(b, h) (((b) * 2 + (h)) * HTB)
#define PG8_SB(b, h) ((4 + (b) * 2 + (h)) * HTB)
#define PG8_STAGE(bufoff, gbase, voff) do { _Pragma("unroll") for (int _i = 0; _i < 2; ++_i) \
        __builtin_amdgcn_global_load_lds((const unsigned*)((const char*)(gbase) + (voff)[_i]), (LAS unsigned*)(lds + (bufoff) + ldsw + _i * 8192), 16, 0, 0); } while (0)
#define PG8_LDA(dst, b, h) do { _Pragma("unroll") for (int m = 0; m < 4; ++m) _Pragma("unroll") for (int k = 0; k < 2; ++k) dst[m][k] = *(const LAS bf16x8*)(lds + PG8_SA(b, h) + aoff + m * 2048 + k * 1024); } while (0)
#define PG8_LDB(dst, b, h) do { _Pragma("unroll") for (int n = 0; n < 2; ++n) _Pragma("unroll") for (int k = 0; k < 2; ++k) dst[n][k] = *(const LAS bf16x8*)(lds + PG8_SB(b, h) + boff + n * 2048 + k * 1024); } while (0)
#define PG8_MMA(ai, bj, At, Bt) do { __builtin_amdgcn_s_setprio(1); _Pragma("unroll") for (int m = 0; m < 4; ++m) _Pragma("unroll") for (int n = 0; n < 2; ++n) _Pragma("unroll") for (int k = 0; k < 2; ++k) \
        acc[ai][bj][m][n] = __builtin_amdgcn_mfma_f32_16x16x32_bf16(Bt[n][k], At[m][k], acc[ai][bj][m][n], 0, 0, 0); __builtin_amdgcn_s_setprio(0); } while (0)
#define PG8_WAIT_V(n) asm volatile("s_waitcnt vmcnt(" #n ")" ::: "memory")
#define PG8_WAIT_L(n) asm volatile("s_waitcnt lgkmcnt(" #n ")" ::: "memory")
#define PG8_BAR __builtin_amdgcn_s_barrier()
#define PG8_SCHED __builtin_amdgcn_sched_barrier(0)
    Unit cur, nxt; int ui = 0;
    if (!S.next(0, cur)) return;
    f32x4 acc[2][2][4][2];
#pragma unroll
    for (int a = 0; a < 2; ++a)
#pragma unroll
        for (int b = 0; b < 2; ++b)
#pragma unroll
            for (int m = 0; m < 4; ++m)
#pragma unroll
                for (int n = 0; n < 2; ++n) acc[a][b][m][n] = (f32x4){0.f, 0.f, 0.f, 0.f};
    bf16x8 At[4][2], B0[2][2], B1[2][2];
    const char* cA = cur.a; const char* cB = cur.b;
    PG8_STAGE(PG8_SB(0, 0), cB, voffB); PG8_STAGE(PG8_SA(0, 0), cA, voffA); PG8_STAGE(PG8_SB(0, 1), cB + hstepB, voffB); PG8_STAGE(PG8_SA(0, 1), cA + hstepA, voffA);
    if (wr == 1) PG8_BAR;
    PG8_WAIT_V(4); PG8_BAR;
    PG8_STAGE(PG8_SB(1, 0), cB + kstep, voffB); PG8_STAGE(PG8_SA(1, 0), cA + kstepA, voffA); PG8_STAGE(PG8_SB(1, 1), cB + hstepB + kstep, voffB);
    PG8_WAIT_V(6); PG8_BAR;
    for (;;) {
        const bool has_next = S.next(ui + 1, nxt);
        const char* nA = has_next ? nxt.a : cA; const char* nB = has_next ? nxt.b : cB;
        for (int t = 0; t < nt; t += 2) {
            const bool last = (t == nt - 2);
            const char* a1 = cA + (size_t)(t + 1) * kstepA;
            const char* a2 = last ? nA : cA + (size_t)(t + 2) * kstepA; const char* b2 = last ? nB : cB + (size_t)(t + 2) * kstep;
            const char* a3 = a2 + kstepA; const char* b3 = b2 + kstep;
            PG8_LDB(B0, 0, 0); PG8_SCHED; PG8_LDA(At, 0, 0); PG8_STAGE(PG8_SA(1, 1), a1 + hstepA, voffA);
            PG8_WAIT_L(8); PG8_BAR; PG8_WAIT_L(0); PG8_MMA(0, 0, At, B0); PG8_BAR; PG8_SCHED;
            PG8_LDB(B1, 0, 1); PG8_STAGE(PG8_SB(0, 0), b2, voffB);
            PG8_BAR; PG8_WAIT_L(0); PG8_MMA(0, 1, At, B1); PG8_BAR;
            PG8_LDA(At, 0, 1); PG8_STAGE(PG8_SA(0, 0), a2, voffA);
            PG8_BAR; PG8_WAIT_L(0); PG8_MMA(1, 0, At, B0); PG8_BAR; PG8_SCHED;
            PG8_STAGE(PG8_SB(0, 1), b2 + hstepB, voffB);
            PG8_WAIT_V(6); PG8_BAR; PG8_MMA(1, 1, At, B1); PG8_BAR;
            PG8_LDB(B0, 1, 0); PG8_SCHED; PG8_LDA(At, 1, 0); PG8_STAGE(PG8_SA(0, 1), a2 + hstepA, voffA);
            PG8_WAIT_L(8); PG8_BAR; PG8_WAIT_L(0); PG8_MMA(0, 0, At, B0); PG8_BAR; PG8_SCHED;
            PG8_LDB(B1, 1, 1); PG8_STAGE(PG8_SB(1, 0), b3, voffB);
            PG8_BAR; PG8_WAIT_L(0); PG8_MMA(0, 1, At, B1); PG8_BAR;
            PG8_LDA(At, 1, 1); PG8_STAGE(PG8_SA(1, 0), a3, voffA);
            PG8_BAR; PG8_WAIT_L(0); PG8_MMA(1, 0, At, B0); PG8_BAR; PG8_SCHED;
            PG8_STAGE(PG8_SB(1, 1), b3 + hstepB, voffB);
            PG8_WAIT_V(6); PG8_BAR; PG8_MMA(1, 1, At, B1); PG8_BAR;
        }
        { int ozv; asm volatile("v_mov_b32 %0, 0" : "=v"(ozv)); epilogue(P, acc, cur, wr, wc, fr + ozv, fq + ozv); }
        if (!has_next) break;
#pragma unroll
        for (int a = 0; a < 2; ++a)
#pragma unroll
            for (int b = 0; b < 2; ++b)
#pragma unroll
                for (int m = 0; m < 4; ++m)
#pragma unroll
                    for (int n = 0; n < 2; ++n) acc[a][b][m][n] = (f32x4){0.f, 0.f, 0.f, 0.f};
        cur = nxt; cA = nA; cB = nB; ++ui;
    }
    PG8_WAIT_V(0);
    if (wr == 0) PG8_BAR;
    PG8_BAR;
}

DEVI void prep_transpose(const int TIDX, const int BIDX, float* tile, const float* src, int K, int N, bf16_t* dst, const float* kscale, bool permqk, int job0, int& jobbase, int gsz) {
    (void)tile;
    const int nk8 = K / 8, ntn = N / 64, njobs = ntn * (nk8 / 8), lane = TIDX & 63, wid = TIDX >> 6;
    for (int jb = job0 - jobbase; jb < njobs; jb += gsz) {
        if (jb < 0) continue;
        const int tn = jb / (nk8 / 8), tk = jb % (nk8 / 8), n0 = tn * 64, k0 = tk * 64 + wid * 8;
        int c0 = n0;
        if (permqk && n0 < 1024) { const int tile_ = n0 >> 8, cp = n0 & 255, bj = cp >> 7, w = cp & 127; c0 = tile_ * 256 + (w >> 6) * 128 + bj * 64; }
        float v[8];
#pragma unroll
        for (int j = 0; j < 8; ++j) v[j] = src[(size_t)(k0 + j) * N + c0 + lane] * (kscale ? kscale[k0 + j] : 1.f);
        u32x4 o; o.x = pack2(v[0], v[1]); o.y = pack2(v[2], v[3]); o.z = pack2(v[4], v[5]); o.w = pack2(v[6], v[7]);
        *(u32x4*)(dst + (size_t)(n0 + lane) * K + k0) = o;
    }
    jobbase += njobs;
}

DEVI void prep_s5_tables(const int TIDX, const int BIDX, float* L, const Params& p, int g) {
    float* pwr = L;
    float* pwi = pwr + 17 * 64;
    float* bbr = pwi + 17 * 64;
    float* bbi = bbr + 1024;
    float* cr = bbi + 1024;
    float* ci = cr + 1024;
    float* kg = ci + 1024;
    const int tid = TIDX;
    char* ws = p.ws;
    __syncthreads();
    {
        const double dt = exp((double)p.logdt[g]);
        for (int i = tid; i < 17 * 64; i += 512) {
            const int t = i >> 6, pp = i & 63;
            const double lr = p.lamre[g * 64 + pp], li = p.lamim[g * 64 + pp];
            const double mag = exp(lr * dt * t), ang = li * dt * t;
            pwr[t * 64 + pp] = (float)(mag * cos(ang)); pwi[t * 64 + pp] = (float)(mag * sin(ang));
        }
        for (int i = tid; i < 1024; i += 512) {
            const int pp = i >> 4, c = i & 15;
            const double lr = p.lamre[g * 64 + pp], li = p.lamim[g * 64 + pp];
            const double mag = exp(lr * dt), ang = li * dt, lbr = mag * cos(ang), lbi = mag * sin(ang);
            const double nr = lbr - 1.0, den = lr * lr + li * li, fr = (nr * lr + lbi * li) / den, fi = (lbi * lr - nr * li) / den;
            const double br = p.bre[(g * 64 + pp) * 16 + c], bi = p.bim[(g * 64 + pp) * 16 + c];
            const float xr = (float)(fr * br - fi * bi), xi = (float)(fr * bi + fi * br);
            bbr[i] = xr; bbi[i] = xi;
            float* bbg = (float*)(ws + WS_BBG); bbg[(g * 1024 + i) * 2] = xr; bbg[(g * 1024 + i) * 2 + 1] = xi;
            if (c == 0) { float* lam1 = (float*)(ws + WS_LAM1); lam1[(g * 64 + pp) * 2] = (float)lbr; lam1[(g * 64 + pp) * 2 + 1] = (float)lbi; }
        }
    }
    __syncthreads();
    if (tid < 64) { float* lam16 = (float*)(ws + WS_LAM16); lam16[(g * 64 + tid) * 2] = pwr[16 * 64 + tid]; lam16[(g * 64 + tid) * 2 + 1] = pwi[16 * 64 + tid]; }
    for (int i = tid; i < 1024; i += 512) { cr[i] = p.cre[g * 1024 + i]; ci[i] = p.cim[g * 1024 + i]; }
    __syncthreads();
    for (int i = tid; i < 4096; i += 512) {
        const int tau = i >> 8, c = (i >> 4) & 15, cp = i & 15;
        float s = 0.f;
        for (int pp = 0; pp < 64; ++pp) {
            const float a = pwr[tau * 64 + pp], b = pwi[tau * 64 + pp], xr = bbr[pp * 16 + cp], xi = bbi[pp * 16 + cp];
            s += cr[c * 64 + pp] * (a * xr - b * xi) - ci[c * 64 + pp] * (a * xi + b * xr);
        }
        kg[i] = s;
    }
    __syncthreads();
    bf16_t* bt2 = (bf16_t*)(ws + WS_BT2) + (size_t)g * 256 * 384;
    for (int i = tid; i < 256 * 48; i += 512) {
        const int n = i / 48, k8 = (i % 48) * 8, t = n >> 4, c = n & 15;
        float v[8];
#pragma unroll
        for (int j = 0; j < 8; ++j) {
            const int k = k8 + j;
            if (k < 256) { const int s = k >> 4, cp = k & 15; v[j] = t >= s ? kg[(t - s) * 256 + c * 16 + cp] : 0.f; }
            else { const int q = k - 256, pp = q & 63; const float a = pwr[(t + 1) * 64 + pp], b = pwi[(t + 1) * 64 + pp];
                v[j] = q < 64 ? (cr[c * 64 + pp] * a - ci[c * 64 + pp] * b) : -(cr[c * 64 + pp] * b + ci[c * 64 + pp] * a); }
        }
        u32x4 o; o.x = pack2(v[0], v[1]); o.y = pack2(v[2], v[3]); o.z = pack2(v[4], v[5]); o.w = pack2(v[6], v[7]);
        *(u32x4*)(bt2 + (size_t)n * 384 + k8) = o;
    }
    bf16_t* bt1 = (bf16_t*)(ws + WS_BT1) + (size_t)g * 256 * 256;
    for (int i = tid; i < 256 * 32; i += 512) {
        const int n = i >> 5, k8 = (i & 31) * 8;
        float v[8];
#pragma unroll
        for (int j = 0; j < 8; ++j) {
            const int k = k8 + j, s = k >> 4, cp = k & 15;
            if (n >= 128) v[j] = 0.f;
            else { const int pp = n & 63; const float a = pwr[(15 - s) * 64 + pp], b = pwi[(15 - s) * 64 + pp], xr = bbr[pp * 16 + cp], xi = bbi[pp * 16 + cp];
                v[j] = n < 64 ? (a * xr - b * xi) : (a * xi + b * xr); }
        }
        u32x4 o; o.x = pack2(v[0], v[1]); o.y = pack2(v[2], v[3]); o.z = pack2(v[4], v[5]); o.w = pack2(v[6], v[7]);
        *(u32x4*)(bt1 + (size_t)n * 256 + k8) = o;
    }
}

DEVI void phase_prep(const int TIDX, const int BIDX, float* L, const Params& p) {
    const int tid = TIDX, bid = BIDX, G = gridDim.x, lane = tid & 63, wid = tid >> 6;
    char* ws = p.ws;
    for (int g = G - 1 - bid; g < 64; g += G) if (g >= 0) prep_s5_tables(TIDX, BIDX, L, p, g);
    __syncthreads();
    const int GT = G > 64 ? G - 64 : G;
    const int tb = (G > 64 && bid >= GT) ? (1 << 28) : bid;
    int jobbase = 0;
    prep_transpose(TIDX, BIDX, L, p.win0, 1024, 5120, (bf16_t*)(ws + WS_WIN0T), nullptr, true, tb, jobbase, GT);
    prep_transpose(TIDX, BIDX, L, p.gluw, 1024, 1024, (bf16_t*)(ws + WS_WGLUT), nullptr, false, tb, jobbase, GT);
    prep_transpose(TIDX, BIDX, L, p.wout0, 2048, 1024, (bf16_t*)(ws + WS_WOUT0T), nullptr, false, tb, jobbase, GT);
    prep_transpose(TIDX, BIDX, L, p.win1, 1024, 4096, (bf16_t*)(ws + WS_WIN1T), p.normw + 1024, false, tb, jobbase, GT);
    prep_transpose(TIDX, BIDX, L, p.wout1, 1024, 1024, (bf16_t*)(ws + WS_WOUT1T), nullptr, false, tb, jobbase, GT);
    bf16_t* h0 = (bf16_t*)(p.out + O_RETS); bf16_t* h0s = (bf16_t*)(ws + WS_H0S);
    for (int row = bid * 8 + wid; row < MP + 256; row += G * 8) {
        bf16_t* d = row < MP ? h0 + (size_t)row * 1024 : h0s + (size_t)(row - MP) * 1024;
        if (row >= MP + MS) { for (int i = 0; i < 4; ++i) *(u32x2*)(d + i * 256 + lane * 4) = (u32x2){0u, 0u}; continue; }
        const float* x = row < MP ? p.xp + (size_t)row * 1024 : p.xs + (size_t)(row - MP) * 1024;
        f32x4 v[4]; float s = 0.f;
#pragma unroll
        for (int i = 0; i < 4; ++i) { v[i] = *(const f32x4*)(x + i * 256 + lane * 4); s += v[i][0] * v[i][0] + v[i][1] * v[i][1] + v[i][2] * v[i][2] + v[i][3] * v[i][3]; }
        s = wave_sum(s);
        const float r = rsqrtf(s * (1.0f / 1024.0f) + 1e-6f);
#pragma unroll
        for (int i = 0; i < 4; ++i) { const f32x4 w = *(const f32x4*)(p.normw + i * 256 + lane * 4); *(u32x2*)(d + i * 256 + lane * 4) = pack4(v[i] * r * w); }
    }
    for (int i = bid * 512 + tid; i < 128 * 1024 / 8; i += G * 512) {
        const u32x4 z = {0u, 0u, 0u, 0u};
        *(u32x4*)((bf16_t*)(ws + WS_Y5S) + 128 * 1024 + (size_t)i * 8) = z;
        *(u32x4*)((bf16_t*)(ws + WS_X1SB) + 128 * 1024 + (size_t)i * 8) = z;
        *(u32x4*)((bf16_t*)(ws + WS_O1S) + 128 * 1024 + (size_t)i * 8) = z;
        *(u32x4*)((bf16_t*)(ws + WS_MIX0S) + 128 * 2048 + (size_t)i * 16) = z;
        *(u32x4*)((bf16_t*)(ws + WS_MIX0S) + 128 * 2048 + (size_t)i * 16 + 8) = z;
    }
    float* rope = (float*)(ws + WS_ROPE);
    for (int i = bid * 512 + tid; i < 2049 * 64; i += G * 512) {
        const int pr = i >> 6, j = i & 63; const double pos = pr == 2048 ? 16384.0 : (double)pr;
        const double inv = exp2(-(double)j * (13.287712379549449 / 64.0));
        const double rev = pos * inv * 0.15915494309189535; const double fr = rev - floor(rev); const double a = fr * 6.283185307179586;
        rope[pr * 128 + j] = (float)cos(a); rope[pr * 128 + 64 + j] = (float)sin(a);
    }
    float* lb = (float*)(ws + WS_LB);
    for (int i = bid * 512 + tid; i < 1024; i += G * 512) lb[i] = 1.f / (1.f + expf(p.hglb[i] - p.hglb[1024 + i]));
}

DEVI float ret_lg(int h) { return log1pf(-exp2f(-5.0f - (float)h)); }

DEVI void phase_R1(const int TIDX, const int BIDX, bf16_t* L, const Params& p) {
    const int tid = TIDX, wid = tid >> 6, lane = tid & 63, r16 = lane & 15, g = lane >> 4;
    const bf16_t* kt = (const bf16_t*)(p.ws + WS_KT); const bf16_t* vt = (const bf16_t*)(p.ws + WS_VT);
    float* kvt = p.out + O_YP;
    for (int it = BIDX; it < 512; it += gridDim.x) {
        const int bh = it >> 4, c = it & 15, h = bh & 3, t0 = c * 128; const float lg = ret_lg(h);
        __syncthreads();
        { const int d = tid >> 2, seg = tid & 3;
#pragma unroll
          for (int q = 0; q < 4; ++q) {
              const int l0 = seg * 32 + q * 8;
              const u32x4 v = *(const u32x4*)(kt + ((size_t)bh * 128 + d) * 2048 + t0 + l0);
              u32x4 o; const unsigned* vv = (const unsigned*)&v; unsigned* oo = (unsigned*)&o;
#pragma unroll
              for (int j = 0; j < 4; ++j) oo[j] = pack2(bflo(vv[j]) * __expf(lg * (float)(127 - l0 - 2 * j)), bfhi(vv[j]) * __expf(lg * (float)(126 - l0 - 2 * j)));
              *(u32x4*)(L + d * 136 + l0) = o; } }
        __syncthreads();
        bf16x8 bfr[2][4];
#pragma unroll
        for (int ct = 0; ct < 2; ++ct)
#pragma unroll
            for (int kk = 0; kk < 4; ++kk) bfr[ct][kk] = *(const bf16x8*)(vt + ((size_t)bh * 256 + wid * 32 + ct * 16 + r16) * 2048 + t0 + kk * 32 + g * 8);
#pragma unroll
        for (int rt = 0; rt < 8; ++rt) {
            f32x4 a0 = {0.f, 0.f, 0.f, 0.f}, a1 = a0;
#pragma unroll
            for (int kk = 0; kk < 4; ++kk) { const bf16x8 a = *(const bf16x8*)(L + (rt * 16 + r16) * 136 + kk * 32 + g * 8); a0 = mfma16(a, bfr[0][kk], a0); a1 = mfma16(a, bfr[1][kk], a1); }
            float* d0 = kvt + (((size_t)bh * 16 + c) * 256 + wid * 32 + r16) * 128 + rt * 16 + g * 4;
            *(f32x4*)d0 = a0; *(f32x4*)(d0 + 16 * 128) = a1;
        }
    }
}

DEVI void phase_R2(const int TIDX, const int BIDX, const Params& p) {
    float* kvt = p.out + O_YP;
    const int nwk = gridDim.x == 256 ? 252 : (int)gridDim.x;
    for (int i = BIDX < nwk ? BIDX * 512 + TIDX : (1 << 30); i < 32 * 256 * 16; i += nwk * 512) {
        const int q = i & 15, e = (i >> 4) & 255, bh = i >> 12, h = bh & 3; const float dec = __expf(ret_lg(h) * 128.f);
        f32x4 s0 = {0.f, 0.f, 0.f, 0.f}, s1 = s0;
#pragma unroll 4
        for (int c = 0; c < 16; ++c) {
            float* ptr = kvt + (((size_t)bh * 16 + c) * 256 + e) * 128 + q * 8;
            const f32x4 v0 = *(const f32x4*)ptr, v1 = *(const f32x4*)(ptr + 4);
            u32x4 o; o.x = pack2(s0[0], s0[1]); o.y = pack2(s0[2], s0[3]); o.z = pack2(s1[0], s1[1]); o.w = pack2(s1[2], s1[3]);
            *(u32x4*)ptr = o;
            s0 = s0 * dec + v0; s1 = s1 * dec + v1;
        }
        float* o = p.out + O_RETP + ((size_t)bh * 128 + q * 8) * 256 + e;
#pragma unroll
        for (int j = 0; j < 4; ++j) { o[(size_t)j * 256] = s0[j]; o[(size_t)(j + 4) * 256] = s1[j]; }
    }
}

DEVI void phase_R3(const int TIDX, const int BIDX, bf16_t* L, const Params& p) {
    const int tid = TIDX, wid = tid >> 6, lane = tid & 63, r16 = lane & 15, g = lane >> 4;
    const bf16_t* Q = (const bf16_t*)(p.ws + WS_Q); const bf16_t* KN = (const bf16_t*)(p.ws + WS_KN); const bf16_t* vt = (const bf16_t*)(p.ws + WS_VT);
    const bf16_t* sga = (const bf16_t*)(p.ws + WS_SGA); bf16_t* mix = (bf16_t*)(p.out + O_HGS);
    const float* kvt = p.out + O_YP;
    bf16_t* S = L;
    float* st = (float*)(L + 128 * 136);
    float* mr = st + 128 * 16;
    const int nwk = gridDim.x == 256 ? 252 : (int)gridDim.x;
    for (int it = BIDX < nwk ? BIDX : 512; it < 512; it += nwk) {
        const int bh = it >> 4, c = it & 15, h = bh & 3, b = bh >> 2, l0 = wid * 16; const size_t tok0 = (size_t)b * 2048 + c * 128; const float lg = ret_lg(h);
        bf16x8 qa[4];
#pragma unroll
        for (int kk = 0; kk < 4; ++kk) qa[kk] = *(const bf16x8*)(Q + (tok0 + l0 + r16) * 512 + h * 128 + kk * 32 + g * 8);
        __syncthreads();
        for (int j = 0; j < 8; ++j) {
            f32x4 sc = {0.f, 0.f, 0.f, 0.f};
            if (j <= wid) {
#pragma unroll
                for (int kk = 0; kk < 4; ++kk) sc = mfma16(qa[kk], *(const bf16x8*)(KN + (tok0 + j * 16 + r16) * 512 + h * 128 + kk * 32 + g * 8), sc);
            }
#pragma unroll
            for (int r = 0; r < 4; ++r) {
                const int li = l0 + g * 4 + r, mi = j * 16 + r16; const float v = (j <= wid && li >= mi) ? sc[r] * __expf(lg * (float)(li - mi)) : 0.f;
                S[li * 136 + mi] = f2bf(v);
            }
        }
        f32x4 acc[8][2];
#pragma unroll
        for (int rt = 0; rt < 8; ++rt) { acc[rt][0] = (f32x4){0.f, 0.f, 0.f, 0.f}; acc[rt][1] = (f32x4){0.f, 0.f, 0.f, 0.f}; }
        if (c > 0) {
            bf16x8 bs[2][4];
#pragma unroll
            for (int ct = 0; ct < 2; ++ct)
#pragma unroll
                for (int kk = 0; kk < 4; ++kk) bs[ct][kk] = *(const bf16x8*)(kvt + (((size_t)bh * 16 + c) * 256 + wid * 32 + ct * 16 + r16) * 128 + kk * 32 + g * 8);
#pragma unroll
            for (int rt = 0; rt < 8; ++rt) {
                f32x4 a0 = {0.f, 0.f, 0.f, 0.f}, a1 = a0;
#pragma unroll
                for (int kk = 0; kk < 4; ++kk) {
                    const bf16x8 q = *(const bf16x8*)(Q + (tok0 + rt * 16 + r16) * 512 + h * 128 + kk * 32 + g * 8);
                    a0 = mfma16(q, bs[0][kk], a0); a1 = mfma16(q, bs[1][kk], a1);
                }
#pragma unroll
                for (int r = 0; r < 4; ++r) { const float qd = __expf(lg * (float)(rt * 16 + g * 4 + r + 1)); a0[r] *= qd; a1[r] *= qd; }
                acc[rt][0] = a0; acc[rt][1] = a1;
                __builtin_amdgcn_sched_barrier(0);
            }
        }
        bf16x8 bv[2][4];
#pragma unroll
        for (int ct = 0; ct < 2; ++ct)
#pragma unroll
            for (int kk = 0; kk < 4; ++kk) bv[ct][kk] = *(const bf16x8*)(vt + ((size_t)bh * 256 + wid * 32 + ct * 16 + r16) * 2048 + c * 128 + kk * 32 + g * 8);
        __syncthreads();
#pragma unroll
        for (int rt = 0; rt < 8; ++rt) {
            f32x4 a0 = acc[rt][0], a1 = acc[rt][1];
#pragma unroll
            for (int kk = 0; kk < 4; ++kk) {
                if (kk <= (rt >> 1)) {
                    const bf16x8 a = *(const bf16x8*)(S + (rt * 16 + r16) * 136 + kk * 32 + g * 8);
                    a0 = mfma16(a, bv[0][kk], a0); a1 = mfma16(a, bv[1][kk], a1);
                }
            }
            acc[rt][0] = a0; acc[rt][1] = a1;
#pragma unroll
            for (int r = 0; r < 4; ++r) {
                float s1 = a0[r] + a1[r], s2 = a0[r] * a0[r] + a1[r] * a1[r];
                s1 = grp16_sum(s1); s2 = grp16_sum(s2);
                if (r16 == 0) { st[((rt * 16 + g * 4 + r) * 8 + wid) * 2] = s1; st[((rt * 16 + g * 4 + r) * 8 + wid) * 2 + 1] = s2; }
            }
            __builtin_amdgcn_sched_barrier(0);
        }
        __syncthreads();
        if (tid < 128) {
            float s1 = 0.f, s2 = 0.f;
#pragma unroll
            for (int w = 0; w < 8; ++w) { s1 += st[(tid * 8 + w) * 2]; s2 += st[(tid * 8 + w) * 2 + 1]; }
            const float mu = s1 * (1.f / 256.f), var = fmaxf(s2 * (1.f / 256.f) - mu * mu, 0.f);
            mr[tid * 2] = mu; mr[tid * 2 + 1] = rsqrtf(var + 1e-5f);
        }
        __syncthreads();
        const float gw0 = p.gnw[h * 256 + wid * 32 + r16], gw1 = p.gnw[h * 256 + wid * 32 + 16 + r16];
#pragma unroll
        for (int rt = 0; rt < 8; ++rt)
#pragma unroll
            for (int r = 0; r < 4; ++r) {
                const int row = rt * 16 + g * 4 + r; const size_t token = tok0 + row; const float mu = mr[row * 2], rs = mr[row * 2 + 1];
                const size_t o = token * 1024 + h * 256 + wid * 32 + r16;
                const float v0 = (acc[rt][0][r] - mu) * rs * gw0 * bf2f(sga[o]), v1 = (acc[rt][1][r] - mu) * rs * gw1 * bf2f(sga[o + 16]);
                mix[token * 2048 + h * 256 + wid * 32 + r16] = f2bf(v0); mix[token * 2048 + h * 256 + wid * 32 + 16 + r16] = f2bf(v1);
            }
    }
}

DEVI void phase_s5scan(const int TIDX, const int BIDX, const Params& p) {
    const int wid = TIDX >> 6, lane = TIDX & 63;
    const float* e5 = p.out + O_HGS; bf16_t* a2 = (bf16_t*)(p.ws + WS_A2); const float* lam16 = (const float*)(p.ws + WS_LAM16);
    for (int it = BIDX * 8 + wid; it < 512; it += gridDim.x * 8) {
        const int b = it >> 6, g = it & 63;
        const float ar = lam16[(g * 64 + lane) * 2], ai = lam16[(g * 64 + lane) * 2 + 1];
        float hr = 0.f, hi = 0.f;
        for (int jb = 0; jb < 128; jb += 16) {
            float er[16], ei[16];
#pragma unroll
            for (int j = 0; j < 16; ++j) { const float* ep = e5 + ((size_t)g * 1024 + b * 128 + jb + j) * 128; er[j] = ep[lane]; ei[j] = ep[64 + lane]; }
#pragma unroll
            for (int j = 0; j < 16; ++j) {
                bf16_t* hp = a2 + ((size_t)g * 1024 + b * 128 + jb + j) * 384 + 256;
                hp[lane] = f2bf(hr); hp[64 + lane] = f2bf(hi);
                const float nr = ar * hr - ai * hi + er[j], ni = ar * hi + ai * hr + ei[j];
                hr = nr; hi = ni;
            }
        }
        p.out[O_S5RP + (size_t)(b * 64 + g) * 64 + lane] = hr; p.out[O_S5IP + (size_t)(b * 64 + g) * 64 + lane] = hi;
    }
}

DEVI void phase_H1(const int TIDX, const int BIDX, bf16_t* L, const Params& p) {
    const int tid = TIDX, wid = tid >> 6, lane = tid & 63, r16 = lane & 15, g = lane >> 4;
    float* cum = (float*)(p.ws + WS_CUM); const bf16_t* itp = (const bf16_t*)(p.ws + WS_IT); float* hkv = (float*)(p.ws + WS_HKV);
    float* tot = (float*)(L + 128 * 136);
    for (int it = BIDX; it < 1024; it += gridDim.x) {
        const int bh = it >> 4, c = it & 15, h = bh & 7, b = bh >> 3; const size_t tok0 = (size_t)b * 2048 + c * 128;
        const int d = tid & 127, part = tid >> 7;
        float* col = cum + (tok0 + part * 32) * 1024 + h * 128 + d;
        float lf[32]; float s = 0.f;
#pragma unroll
        for (int l = 0; l < 32; ++l) { lf[l] = col[(size_t)l * 1024]; s += lf[l]; }
        __syncthreads();
        tot[part * 128 + d] = s;
        __syncthreads();
        float off = 0.f, last = 0.f;
#pragma unroll
        for (int pp = 0; pp < 4; ++pp) { const float t = tot[pp * 128 + d]; if (pp < part) off += t; last += t; }
        float cc = off;
#pragma unroll
        for (int l = 0; l < 32; ++l) {
            cc += lf[l]; col[(size_t)l * 1024] = cc;
            L[d * 136 + part * 32 + l] = f2bf((1.f - __expf(lf[l])) * __expf(last - cc));
        }
        __syncthreads();
        bf16x8 bfr[4];
#pragma unroll
        for (int kk = 0; kk < 4; ++kk) bfr[kk] = *(const bf16x8*)(itp + ((size_t)bh * 128 + wid * 16 + r16) * 2048 + c * 128 + kk * 32 + g * 8);
#pragma unroll
        for (int rt = 0; rt < 8; ++rt) {
            f32x4 a0 = {0.f, 0.f, 0.f, 0.f};
#pragma unroll
            for (int kk = 0; kk < 4; ++kk) a0 = mfma16(*(const bf16x8*)(L + (rt * 16 + r16) * 136 + kk * 32 + g * 8), bfr[kk], a0);
            *(f32x4*)(hkv + (((size_t)bh * 16 + c) * 128 + wid * 16 + r16) * 128 + rt * 16 + g * 4) = a0;
        }
    }
}

DEVI void phase_H2(const int TIDX, const int BIDX, const Params& p) {
    float* hkv = (float*)(p.ws + WS_HKV); const float* cum = (const float*)(p.ws + WS_CUM);
    const int nwk = gridDim.x == 256 ? 252 : (int)gridDim.x;
    for (int i = BIDX < nwk ? BIDX * 512 + TIDX : (1 << 30); i < 64 * 128 * 16; i += nwk * 512) {
        const int q = i & 15, e = (i >> 4) & 127, bh = i >> 11, h = bh & 7, b = bh >> 3;
        f32x4 s0 = {0.f, 0.f, 0.f, 0.f}, s1 = s0;
#pragma unroll 4
        for (int c = 0; c < 16; ++c) {
            float* ptr = hkv + (((size_t)bh * 16 + c) * 128 + e) * 128 + q * 8;
            const float* lp = cum + ((size_t)b * 2048 + c * 128 + 127) * 1024 + h * 128 + q * 8;
            const f32x4 v0 = *(const f32x4*)ptr, v1 = *(const f32x4*)(ptr + 4), d0 = *(const f32x4*)lp, d1 = *(const f32x4*)(lp + 4);
            u32x4 o; o.x = pack2(s0[0], s0[1]); o.y = pack2(s0[2], s0[3]); o.z = pack2(s1[0], s1[1]); o.w = pack2(s1[2], s1[3]);
            *(u32x4*)ptr = o;
#pragma unroll
            for (int j = 0; j < 4; ++j) { s0[j] = s0[j] * __expf(d0[j]) + v0[j]; s1[j] = s1[j] * __expf(d1[j]) + v1[j]; }
        }
        float* o = p.out + O_HGP + ((size_t)bh * 128 + q * 8) * 128 + e;
#pragma unroll
        for (int j = 0; j < 4; ++j) { o[(size_t)j * 128] = s0[j]; o[(size_t)(j + 4) * 128] = s1[j]; }
    }
}

DEVI void phase_H3(const int TIDX, const int BIDX, bf16_t* L, const Params& p) {
    const int tid = TIDX, wid = tid >> 6, lane = tid & 63, r16 = lane & 15, g = lane >> 4;
    const float* cum = (const float*)(p.ws + WS_CUM); const bf16_t* itp = (const bf16_t*)(p.ws + WS_IT); const float* hkv = (const float*)(p.ws + WS_HKV);
    bf16_t* q1 = (bf16_t*)(p.ws + WS_Q1); const bf16_t* sg1 = (const bf16_t*)(p.ws + WS_SG1);
    bf16_t* kt = L; bf16_t* S = L + 128 * 136; bf16_t* QA = L + 2 * 128 * 136;
    float* st = (float*)(L + 3 * 128 * 136);
    float* rsn = st + 128 * 8;
    for (int it = BIDX; it < 1024; it += gridDim.x) {
        const int bh = it >> 4, c = it & 15, h = bh & 7, b = bh >> 3, l0 = wid * 16; const size_t tok0 = (size_t)b * 2048 + c * 128;
        const float* refp = cum + (tok0 + 63) * 1024 + h * 128;
        __syncthreads();
        { const int m = tid >> 2, seg = tid & 3; const float* cp = cum + (tok0 + m) * 1024 + h * 128 + seg * 32;
#pragma unroll
          for (int q = 0; q < 8; ++q) {
              const f32x4 cv = *(const f32x4*)(cp + q * 4), rv = *(const f32x4*)(refp + seg * 32 + q * 4);
              f32x4 pv = {0.f, 0.f, 0.f, 0.f}; if (m > 0) pv = *(const f32x4*)(cp - 1024 + q * 4);
              f32x4 o;
#pragma unroll
              for (int j = 0; j < 4; ++j) o[j] = (1.f - __expf(cv[j] - pv[j])) * __expf(rv[j] - cv[j]);
              *(u32x2*)(kt + m * 136 + seg * 32 + q * 4) = pack4(o); } }
        bf16x8 qr[4];
#pragma unroll
        for (int kk = 0; kk < 4; ++kk) {
            const size_t o = (tok0 + l0 + r16) * 1024 + h * 128 + kk * 32 + g * 8;
            const u32x4 qq = *(const u32x4*)(q1 + o);
            const f32x4 c0 = *(const f32x4*)(cum + o), c1 = *(const f32x4*)(cum + o + 4), r0 = *(const f32x4*)(refp + kk * 32 + g * 8), r1 = *(const f32x4*)(refp + kk * 32 + g * 8 + 4);
            const unsigned* qv = (const unsigned*)&qq; u32x4 a, bb; unsigned* av = (unsigned*)&a; unsigned* bv = (unsigned*)&bb;
#pragma unroll
            for (int j = 0; j < 4; ++j) {
                const float cl = j < 2 ? c0[2 * j] : c1[2 * j - 4], ch = j < 2 ? c0[2 * j + 1] : c1[2 * j - 3];
                const float rl = j < 2 ? r0[2 * j] : r1[2 * j - 4], rh = j < 2 ? r0[2 * j + 1] : r1[2 * j - 3];
                const float ql = bflo(qv[j]), qh = bfhi(qv[j]);
                av[j] = pack2(ql * __expf(cl - rl), qh * __expf(ch - rh)); bv[j] = pack2(ql * __expf(cl), qh * __expf(ch));
            }
            qr[kk] = *(bf16x8*)&a;
            *(u32x4*)(QA + (l0 + r16) * 136 + kk * 32 + g * 8) = bb;
        }
        bf16x8 bi[4], bs[4];
#pragma unroll
        for (int kk = 0; kk < 4; ++kk) {
            bi[kk] = *(const bf16x8*)(itp + ((size_t)bh * 128 + wid * 16 + r16) * 2048 + c * 128 + kk * 32 + g * 8);
            bs[kk] = *(const bf16x8*)(hkv + (((size_t)bh * 16 + c) * 128 + wid * 16 + r16) * 128 + kk * 32 + g * 8);
        }
        __syncthreads();
        for (int j = 0; j < 8; ++j) {
            f32x4 sc = {0.f, 0.f, 0.f, 0.f};
            if (j <= wid) {
#pragma unroll
                for (int kk = 0; kk < 4; ++kk) sc = mfma16(qr[kk], *(const bf16x8*)(kt + (j * 16 + r16) * 136 + kk * 32 + g * 8), sc);
            }
#pragma unroll
            for (int r = 0; r < 4; ++r) {
                const int li = l0 + g * 4 + r, mi = j * 16 + r16; const float v = (j <= wid && li >= mi) ? sc[r] : 0.f;
                S[li * 136 + mi] = f2bf(v);
            }
        }
        __syncthreads();
        f32x4 acc[8];
#pragma unroll
        for (int rt = 0; rt < 8; ++rt) {
            f32x4 a0 = {0.f, 0.f, 0.f, 0.f};
            if (c > 0) {
#pragma unroll
                for (int kk = 0; kk < 4; ++kk) a0 = mfma16(*(const bf16x8*)(QA + (rt * 16 + r16) * 136 + kk * 32 + g * 8), bs[kk], a0);
            }
#pragma unroll
            for (int kk = 0; kk < 4; ++kk) {
                if (kk <= (rt >> 1)) a0 = mfma16(*(const bf16x8*)(S + (rt * 16 + r16) * 136 + kk * 32 + g * 8), bi[kk], a0);
            }
            acc[rt] = a0;
#pragma unroll
            for (int r = 0; r < 4; ++r) {
                const float s2 = grp16_sum(a0[r] * a0[r]);
                if (r16 == 0) st[(rt * 16 + g * 4 + r) * 8 + wid] = s2;
            }
        }
        __syncthreads();
        if (tid < 128) {
            float s2 = 0.f;
#pragma unroll
            for (int w = 0; w < 8; ++w) s2 += st[tid * 8 + w];
            rsn[tid] = rsqrtf(s2 * (1.f / 128.f) + 1e-6f);
        }
        __syncthreads();
        const float gw = p.hgnw[h * 128 + wid * 16 + r16];
#pragma unroll
        for (int rt = 0; rt < 8; ++rt)
#pragma unroll
            for (int r = 0; r < 4; ++r) {
                const int row = rt * 16 + g * 4 + r; const unsigned o = ((unsigned)tok0 + row) * 1024u + h * 128 + wid * 16 + r16;
                q1[o] = f2bf(acc[rt][r] * rsn[row] * gw * bf2f(sg1[o]));
            }
    }
}

DEVI void phase_ss5(const int TIDX, const int BIDX, const Params& p) {
    const int wid = TIDX >> 6, lane = TIDX & 63;
    const float* zs = (const float*)(p.ws + WS_ZS); const float* bbg = (const float*)(p.ws + WS_BBG); const float* lam1 = (const float*)(p.ws + WS_LAM1);
    bf16_t* y5s = (bf16_t*)(p.ws + WS_Y5S);
    for (int it = BIDX * 8 + wid; it < 128 * 64; it += gridDim.x * 8) {
        const int b = it >> 6, g = it & 63;
        float u[16];
#pragma unroll
        for (int c = 0; c < 16; ++c) u[c] = zs[(size_t)b * 5120 + 3072 + g * 16 + c];
        float xr = 0.f, xi = 0.f;
#pragma unroll
        for (int c = 0; c < 16; ++c) { xr += bbg[((g * 64 + lane) * 16 + c) * 2] * u[c]; xi += bbg[((g * 64 + lane) * 16 + c) * 2 + 1] * u[c]; }
        const float ar = lam1[(g * 64 + lane) * 2], ai = lam1[(g * 64 + lane) * 2 + 1];
        const float sr = p.s5r[(size_t)(b * 64 + g) * 64 + lane], si = p.s5i[(size_t)(b * 64 + g) * 64 + lane];
        const float hr = ar * sr - ai * si + xr, hi = ar * si + ai * sr + xi;
        p.out[O_S5RS + (size_t)(b * 64 + g) * 64 + lane] = hr; p.out[O_S5IS + (size_t)(b * 64 + g) * 64 + lane] = hi;
        float mine = 0.f;
#pragma unroll
        for (int c = 0; c < 16; ++c) {
            float v = p.cre[(g * 16 + c) * 64 + lane] * hr - p.cim[(g * 16 + c) * 64 + lane] * hi;
            v = wave_sum(v);
            if (lane == c) mine = v + p.s5d[g * 16 + c] * u[c];
        }
        if (lane < 16) y5s[(size_t)b * 1024 + g * 16 + lane] = f2bf(gelu_(mine));
    }
}

DEVI void phase_sret(const int TIDX, const int BIDX, float* L, const Params& p) {
    const int tid = TIDX, lane = tid & 63, wid = tid >> 6;
    const float* zs = (const float*)(p.ws + WS_ZS); bf16_t* mix = (bf16_t*)(p.ws + WS_MIX0S);
    float* qs = L; float* ks = L + 128; float* red = L + 256; float* st = L + 256 + 2048;
    for (int it = BIDX; it < 512; it += gridDim.x) {
        const int b = it >> 2, h = it & 3, e4 = (tid & 63) * 4, dg = tid >> 6, d0 = dg * 16; const float gam = 1.0f - exp2f(-5.0f - (float)h);
        __syncthreads();
        if (tid < 128) qs[tid] = zs[(size_t)b * 5120 + h * 128 + tid]; else if (tid < 256) ks[tid - 128] = zs[(size_t)b * 5120 + 512 + h * 128 + tid - 128];
        const f32x4 v = *(const f32x4*)(zs + (size_t)b * 5120 + 1024 + h * 256 + e4);
        __syncthreads();
        const float* s0 = p.sret + ((size_t)it * 128 + d0) * 256 + e4; float* so = p.out + O_RETS + ((size_t)it * 128 + d0) * 256 + e4;
        f32x4 sv[16];
#pragma unroll
        for (int j = 0; j < 16; ++j) sv[j] = *(const f32x4*)(s0 + (size_t)j * 256);
        f32x4 o = {0.f, 0.f, 0.f, 0.f};
#pragma unroll
        for (int j = 0; j < 16; ++j) { const f32x4 s = sv[j] * gam + v * ks[d0 + j]; *(f32x4*)(so + (size_t)j * 256) = s; o += s * qs[d0 + j]; }
        *(f32x4*)(red + dg * 256 + e4) = o;
        __syncthreads();
        float tot = 0.f;
        if (tid < 256) {
#pragma unroll
            for (int k = 0; k < 8; ++k) tot += red[k * 256 + tid];
            const float s = wave_sum(tot); if (lane == 0) st[wid] = s; }
        __syncthreads();
        const float mu = (st[0] + st[1] + st[2] + st[3]) * (1.f / 256.f);
        __syncthreads();
        if (tid < 256) { const float dd = tot - mu; const float s = wave_sum(dd * dd); if (lane == 0) st[wid] = s; }
        __syncthreads();
        const float rs = rsqrtf((st[0] + st[1] + st[2] + st[3]) * (1.f / 256.f) + 1e-5f);
        if (tid < 256) mix[(size_t)b * 2048 + h * 256 + tid] = f2bf((tot - mu) * rs * p.gnw[h * 256 + tid] * zs[(size_t)b * 5120 + 2048 + h * 256 + tid]);
    }
}

DEVI void phase_shg(const int TIDX, const int BIDX, float* L, const Params& p) {
    const int tid = TIDX, lane = tid & 63, wid = tid >> 6;
    const float* z1 = (const float*)(p.ws + WS_Z1S); bf16_t* o1s = (bf16_t*)(p.ws + WS_O1S);
    float* qs = L; float* fs = L + 128; float* red = L + 256; float* st = L + 256 + 2048;
    for (int it = BIDX; it < 1024; it += gridDim.x) {
        const int b = it >> 3, h = it & 7, e4 = (tid & 31) * 4, dg = tid >> 5, d0 = dg * 8;
        __syncthreads();
        if (tid < 128) qs[tid] = z1[(size_t)b * 4096 + h * 128 + tid]; else if (tid < 256) fs[tid - 128] = z1[(size_t)b * 4096 + 1024 + h * 128 + tid - 128];
        const f32x4 iv = *(const f32x4*)(z1 + (size_t)b * 4096 + 2048 + h * 128 + e4);
        __syncthreads();
        const float* s0 = p.shg + ((size_t)it * 128 + d0) * 128 + e4; float* so = p.out + O_HGS + ((size_t)it * 128 + d0) * 128 + e4;
        f32x4 sv[8];
#pragma unroll
        for (int j = 0; j < 8; ++j) sv[j] = *(const f32x4*)(s0 + (size_t)j * 128);
        f32x4 o = {0.f, 0.f, 0.f, 0.f};
#pragma unroll
        for (int j = 0; j < 8; ++j) { const float f = fs[d0 + j]; const f32x4 s = sv[j] * f + iv * (1.f - f); *(f32x4*)(so + (size_t)j * 128) = s; o += s * qs[d0 + j]; }
        *(f32x4*)(red + dg * 128 + e4) = o;
        __syncthreads();
        float tot = 0.f;
        if (tid < 128) {
#pragma unroll
            for (int k = 0; k < 16; ++k) tot += red[k * 128 + tid];
            const float s = wave_sum(tot * tot); if (lane == 0) st[wid] = s; }
        __syncthreads();
        const float rs = rsqrtf((st[0] + st[1]) * (1.f / 128.f) + 1e-6f);
        if (tid < 128) o1s[(size_t)b * 1024 + h * 128 + tid] = f2bf(tot * rs * p.hgnw[h * 128 + tid] * z1[(size_t)b * 4096 + 3072 + h * 128 + tid]);
    }
}

DEVI void phase_final(const int TIDX, const int BIDX, const Params& p) {
    const int wid = TIDX >> 6, lane = TIDX & 63;
    for (int row = (BIDX * 8 + wid) * 2; row < MP + MS; row += gridDim.x * 16) {
        const bool smp = row >= MP; const size_t r = smp ? row - MP : row;
        float* x = p.out + (smp ? O_YS : O_YP) + r * 1024;
        f32x4 v[2][4]; float s0 = 0.f, s1 = 0.f;
#pragma unroll
        for (int i = 0; i < 4; ++i) { v[0][i] = *(const f32x4*)(x + i * 256 + lane * 4); v[1][i] = *(const f32x4*)(x + 1024 + i * 256 + lane * 4); }
#pragma unroll
        for (int i = 0; i < 4; ++i) {
            s0 += v[0][i][0] * v[0][i][0] + v[0][i][1] * v[0][i][1] + v[0][i][2] * v[0][i][2] + v[0][i][3] * v[0][i][3];
            s1 += v[1][i][0] * v[1][i][0] + v[1][i][1] * v[1][i][1] + v[1][i][2] * v[1][i][2] + v[1][i][3] * v[1][i][3];
        }
        s0 = wave_sum(s0); s1 = wave_sum(s1);
        const float r0 = rsqrtf(s0 * (1.0f / 1024.0f) + 1e-6f), r1 = rsqrtf(s1 * (1.0f / 1024.0f) + 1e-6f);
#pragma unroll
        for (int i = 0; i < 4; ++i) {
            const f32x4 w = *(const f32x4*)(p.fnormw + i * 256 + lane * 4);
            *(f32x4*)(x + i * 256 + lane * 4) = v[0][i] * r0 * w; *(f32x4*)(x + 1024 + i * 256 + lane * 4) = v[1][i] * r1 * w;
        }
    }
}

#define GRID_SYNC() do { asm volatile("s_waitcnt vmcnt(0) lgkmcnt(0)" ::: "memory"); cg::this_grid().sync(); } while (0)
constexpr int NPHASE = 13;
__global__ void __launch_bounds__(512, 2) mega(Params p0) {
    extern __shared__ __attribute__((aligned(16))) unsigned char shm[];
    LAS unsigned char* lds = (LAS unsigned char*)shm;
    const int G = gridDim.x;
#define OPQ int oz; asm volatile("s_mov_b32 %0, 0" : "=s"(oz)); int ozv; asm volatile("v_mov_b32 %0, 0" : "=v"(ozv)); \
    Params p = p0; p.ws = p0.ws + oz; p.out = p0.out + oz; const int TIDX = threadIdx.x + ozv, BIDX = blockIdx.x + oz; (void)TIDX; (void)BIDX;
    int my_xcc, my_rank;
    {
        int* sh = (int*)shm;
        if (threadIdx.x == 0) {
            const unsigned x = (unsigned)__builtin_amdgcn_s_getreg((3 << 11) | 20) & 7u;
            sh[0] = (int)x; sh[1] = (int)__hip_atomic_fetch_add((unsigned*)(p0.ws + WS_XCNT) + x * 32, 1u, __ATOMIC_RELAXED, __HIP_MEMORY_SCOPE_AGENT);
        }
        __syncthreads();
        my_xcc = __builtin_amdgcn_readfirstlane(sh[0]); my_rank = __builtin_amdgcn_readfirstlane(sh[1]);
        __syncthreads();
    }
    int gc = blockIdx.x;
    int ph_start = p0.ph_lo;
    if (ph_start == 0) {
        { OPQ phase_prep(TIDX, BIDX, (float*)shm, p); }
#if COOP
        GRID_SYNC();
        {
            bool ok = gridDim.x == 256;
            for (int x = 0; x < 8; ++x) ok = ok && (__hip_atomic_load((unsigned*)(p0.ws + WS_XCNT) + x * 32, __ATOMIC_RELAXED, __HIP_MEMORY_SCOPE_AGENT) == 32u);
            if (ok) gc = my_rank * 8 + my_xcc;
        }
#endif
        ph_start = 1;
    }
    for (int ph = ph_start; ph < p0.ph_hi; ++ph) {
        int la = -1, lb = -1, K = 1024, lda = 1024, ldb = 1024, Kb = 0;
        switch (ph) {
        case 1: la = L_IN0; lb = L_IN0S; break;
        case 2: la = L_GA; K = 256; lda = 384; ldb = 256; break;
        case 4: la = L_GB; K = 384; lda = 384; ldb = 384; lb = L_OUT0S; Kb = 2048; break;
        case 3: lb = L_GLUS; break;
        case 5: la = L_GLU; break;
        case 6: la = L_OUT0; K = 2048; lda = 2048; ldb = 2048; break;
        case 7: la = L_IN1; lb = L_IN1S; break;
        case 9: lb = L_OUT1S; break;
        case 11: la = L_OUT1; break;
        default: break;
        }
        for (int jj = 0; jj < 2; ++jj) {
            const int l = jj ? lb : la;
            if (l < 0) continue;
            OPQ
            Sched S; S.list = l; S.G = G; S.c = jj ? G - 1 - gc : gc + oz; S.wsp = p.ws; S.outp = p.out;
            if (jj && Kb) gemm_phase(TIDX, lds, Kb, Kb, Kb, false, S, p); else gemm_phase(TIDX, lds, K, lda, ldb, l == L_GLU, S, p);
        }
        __syncthreads();
        switch (ph) {
        case 2: { { OPQ phase_R1(TIDX, BIDX, (bf16_t*)shm, p); } __syncthreads(); { OPQ phase_sret(TIDX, BIDX, (float*)shm, p); } { OPQ phase_ss5(TIDX, BIDX, p); } } break;
        case 3: { { OPQ phase_s5scan(TIDX, BIDX, p); } { OPQ phase_R2(TIDX, gc + oz, p); } } break;
        case 4: { OPQ phase_R3(TIDX, gc + oz, (bf16_t*)shm, p); } break;
        case 8: { { OPQ phase_H1(TIDX, BIDX, (bf16_t*)shm, p); } __syncthreads(); { OPQ phase_shg(TIDX, BIDX, (float*)shm, p); } } break;
        case 9: { OPQ phase_H2(TIDX, gc + oz, p); } break;
        case 10: { OPQ phase_H3(TIDX, BIDX, (bf16_t*)shm, p); } break;
        case 12: { OPQ phase_final(TIDX, BIDX, p); } break;
        default: break;
        }
#if COOP
        if (ph + 1 < p0.ph_hi) GRID_SYNC();
#endif
    }
}

extern "C" void kernel_launch(void* const* d_in, const int* in_sizes, int n_in, void* d_out, int out_size, void* d_ws, size_t ws_size, hipStream_t stream) {
    constexpr size_t kDynLds = 131072;
    static int grid_blocks = 0;
    if (!grid_blocks) {
        hipFuncSetAttribute((const void*)mega, hipFuncAttributeMaxDynamicSharedMemorySize, (int)kDynLds);
        int dev = 0, cus = 0, per_cu = 0;
        hipGetDevice(&dev);
        hipDeviceGetAttribute(&cus, hipDeviceAttributeMultiprocessorCount, dev);
        hipOccupancyMaxActiveBlocksPerMultiprocessor(&per_cu, mega, 512, kDynLds);
        if (per_cu < 1) per_cu = 1;
        grid_blocks = cus;
        if (grid_blocks > 256) grid_blocks = 256;
    }
    Params p{};
    const float** f = (const float**)&p;
    for (int i = 0; i < 25; ++i) f[i] = (const float*)d_in[i];
    p.out = (float*)d_out; p.ws = (char*)d_ws;
#if COOP
    p.ph_lo = 0; p.ph_hi = PH_MAX;
    hipMemsetAsync((char*)d_ws + WS_XCNT, 0, 1024, stream);
    void* args[] = {&p};
    hipError_t e = hipLaunchCooperativeKernel((const void*)mega, dim3(grid_blocks), dim3(512), args, kDynLds, stream);
    if (e != hipSuccess) fprintf(stderr, "cooperative launch failed: %s (grid %d)\n", hipGetErrorString(e), grid_blocks);
#else
    for (int ph = 0; ph < NPHASE; ++ph) {
        p.ph_lo = ph; p.ph_hi = ph + 1;
        hipLaunchKernelGGL(mega, dim3(grid_blocks), dim3(512), kDynLds, stream, p);
    }
#endif
}
```
